# Optimizing an MI355X kernel written in HIP

```python
import math
import jax, jax.numpy as jnp
from jax import lax
import numpy as np

D_MODEL = 1024
BATCH = 16
SEQ = 2048
DEPTH = 1

NSA_HEADS = 8
NSA_KV_HEADS = 2
NSA_HEAD_DIM = 64
CMP_BLOCK = 32
CMP_STRIDE = 16
CMP_HIDDEN = 256
SEL_BLOCK = 64
SEL_TOPK = 8
WINDOW = 512
Q_BLOCK = 64
FORCE_BONUS = 1e4
GLA_HEADS = 4
GLA_KEY_DIM = 64
GLA_VAL_DIM = 128
GLA_CHUNK = 64
GLA_GATE_RANK = 16
GLA_TAU = 16.0
ROPE_THETA = 500000.0
ROPE_DIM = NSA_HEAD_DIM // 4
N_EXPERTS = 32
TOP_K = 4
D_FF = 1024
SWIGLU_LIMIT = 7.0
SWIGLU_ALPHA = 1.702
EXPERT_BLOCK = 256
EPS = 1e-6
NEG_INF = -1e30

NSA_WIDTH = NSA_HEADS * NSA_HEAD_DIM
NSA_KV_WIDTH = NSA_KV_HEADS * NSA_HEAD_DIM
GLA_KEY_WIDTH = GLA_HEADS * GLA_KEY_DIM
GLA_WIDTH = GLA_HEADS * GLA_VAL_DIM
IN_SIZES = (NSA_WIDTH, NSA_KV_WIDTH, NSA_KV_WIDTH, NSA_KV_WIDTH, NSA_KV_WIDTH, NSA_KV_WIDTH, NSA_KV_WIDTH,
            NSA_HEADS * 3, GLA_KEY_WIDTH, GLA_KEY_WIDTH, GLA_WIDTH, GLA_GATE_RANK, GLA_WIDTH)
IN_WIDTH = sum(IN_SIZES)

kernel_name = 'hybrid_nsa_gla_moe_block'


def rms_norm(t, g):
    tf = t.astype(jnp.float32)
    y = tf * lax.rsqrt(jnp.mean(tf * tf, axis=-1, keepdims=True) + EPS) * g.astype(jnp.float32)
    return y.astype(t.dtype)


def masked_softmax(s, mask):
    s = jnp.where(mask, s.astype(jnp.float32), NEG_INF)
    m = jnp.max(s, axis=-1, keepdims=True)
    p = jnp.exp(s - m) * mask
    den = jnp.sum(p, axis=-1, keepdims=True)
    return p / jnp.where(den > 0, den, 1.0)


def apply_partial_rope(t, positions):
    half = ROPE_DIM // 2
    inv_freq = jnp.exp(-math.log(ROPE_THETA) * jnp.arange(0, ROPE_DIM, 2, dtype=jnp.float32) / ROPE_DIM)
    ang = positions.astype(jnp.float32)[..., None] * inv_freq
    cos = jnp.cos(ang)[:, :, None, :]
    sin = jnp.sin(ang)[:, :, None, :]
    tf = t.astype(jnp.float32)
    x1 = tf[..., :half]
    x2 = tf[..., half:ROPE_DIM]
    out = jnp.concatenate([x1 * cos - x2 * sin, x2 * cos + x1 * sin, tf[..., ROPE_DIM:]], axis=-1)
    return out.astype(t.dtype)


def compress_blocks(t, pos_emb, w1, w2):
    B, S, Hk, dh = t.shape
    n_cmp = (S - CMP_BLOCK) // CMP_STRIDE + 1
    blk_idx = jnp.arange(n_cmp)[:, None] * CMP_STRIDE + jnp.arange(CMP_BLOCK)[None, :]
    tb = t[:, blk_idx] + pos_emb[None, None, :, None, :]
    tb = tb.transpose(0, 1, 3, 2, 4).reshape(B, n_cmp, Hk, CMP_BLOCK * dh)
    return jax.nn.silu(tb @ w1) @ w2


def nsa_mixer(q, k_c, v_c, k_s, v_s, k_w, v_w, gate_logits, positions, q_norm_g, k_norm_g,
              cmp_pos_k, cmp_w1_k, cmp_w2_k, cmp_pos_v, cmp_w1_v, cmp_w2_v):
    B, S = q.shape[0], q.shape[1]
    Hk = NSA_KV_HEADS
    G = NSA_HEADS // Hk
    dh = NSA_HEAD_DIM
    scale = dh ** -0.5
    kv = lambda t: t.reshape(B, S, Hk, dh)
    q = rms_norm(q.reshape(B, S, NSA_HEADS, dh), q_norm_g)
    q_rot = apply_partial_rope(q, positions)
    qg = q.reshape(B, S, Hk, G, dh)
    t_idx = jnp.arange(S)

    kc = rms_norm(compress_blocks(kv(k_c), cmp_pos_k, cmp_w1_k, cmp_w2_k), k_norm_g[0])
    vc = compress_blocks(kv(v_c), cmp_pos_v, cmp_w1_v, cmp_w2_v)
    n_cmp = kc.shape[1]
    cmp_start = jnp.arange(n_cmp) * CMP_STRIDE
    mask_c = (cmp_start + CMP_BLOCK - 1)[None, :] <= t_idx[:, None]
    s_c = jnp.einsum('bskgd,bnkd->bkgsn', qg, kc) * scale
    p_c = masked_softmax(s_c, mask_c)
    o_cmp = jnp.einsum('bkgsn,bnkd->bskgd', p_c.astype(vc.dtype), vc)

    n_sel = S // SEL_BLOCK
    k_sel = min(SEL_TOPK, n_sel)
    j = jnp.arange(n_sel)
    overlap = ((cmp_start[None, :] < (j[:, None] + 1) * SEL_BLOCK) &
               (cmp_start[None, :] + CMP_BLOCK > j[:, None] * SEL_BLOCK)).astype(jnp.float32)
    imp = jnp.einsum('bkgsn,jn->bksj', p_c, overlap)
    cur = t_idx // SEL_BLOCK
    valid = j[None, :] <= cur[:, None]
    forced = (j[None, :] == 0) | (j[None, :] == cur[:, None]) | (j[None, :] == cur[:, None] - 1)
    score = jnp.where(valid, imp + jnp.where(forced, FORCE_BONUS, 0.0), NEG_INF)
    _, sel_idx = lax.top_k(score, k_sel)

    ks = apply_partial_rope(rms_norm(kv(k_s), k_norm_g[1]), positions)
    ks_blocks = ks.reshape(B, n_sel, SEL_BLOCK, Hk, dh).transpose(0, 3, 1, 2, 4)
    vs_blocks = kv(v_s).reshape(B, n_sel, SEL_BLOCK, Hk, dh).transpose(0, 3, 1, 2, 4)
    kw = apply_partial_rope(rms_norm(kv(k_w), k_norm_g[2]), positions).transpose(0, 2, 1, 3)
    vw = kv(v_w).transpose(0, 2, 1, 3)
    pad = ((0, 0), (0, 0), (WINDOW, 0), (0, 0))
    kw_pad = jnp.pad(kw, pad)
    vw_pad = jnp.pad(vw, pad)

    n_qb = S // Q_BLOCK
    q_blocks = q_rot.reshape(B, n_qb, Q_BLOCK, Hk, G, dh).swapaxes(0, 1)
    idx_blocks = sel_idx.reshape(B, Hk, n_qb, Q_BLOCK, k_sel).transpose(2, 0, 1, 3, 4)
    b_ix = jnp.arange(B)[:, None, None, None]
    h_ix = jnp.arange(Hk)[None, :, None, None]

    def block_attn(args):
        c, qb, ib = args
        tq = c * Q_BLOCK + jnp.arange(Q_BLOCK)
        kg = ks_blocks[b_ix, h_ix, ib]
        vg = vs_blocks[b_ix, h_ix, ib]
        s = jnp.einsum('bqkgd,bkqnld->bkgqnl', qb, kg) * scale
        kpos = ib[..., None] * SEL_BLOCK + jnp.arange(SEL_BLOCK)
        m = (kpos <= tq[None, None, :, None, None])[:, :, None]
        shp = s.shape
        p = masked_softmax(s.reshape(shp[:4] + (k_sel * SEL_BLOCK,)),
                           m.reshape(B, Hk, 1, Q_BLOCK, k_sel * SEL_BLOCK)).reshape(shp)
        o_sel = jnp.einsum('bkgqnl,bkqnld->bqkgd', p.astype(vg.dtype), vg)
        kwin = lax.dynamic_slice_in_dim(kw_pad, c * Q_BLOCK, Q_BLOCK + WINDOW, axis=2)
        vwin = lax.dynamic_slice_in_dim(vw_pad, c * Q_BLOCK, Q_BLOCK + WINDOW, axis=2)
        jpos = c * Q_BLOCK - WINDOW + jnp.arange(Q_BLOCK + WINDOW)
        mw = (jpos[None, :] <= tq[:, None]) & (jpos[None, :] > tq[:, None] - WINDOW) & (jpos[None, :] >= 0)
        s_w = jnp.einsum('bqkgd,bkjd->bkgqj', qb, kwin) * scale
        p_w = masked_softmax(s_w, mw)
        o_win = jnp.einsum('bkgqj,bkjd->bqkgd', p_w.astype(vwin.dtype), vwin)
        return o_sel, o_win

    o_sel, o_win = lax.map(block_attn, (jnp.arange(n_qb), q_blocks, idx_blocks))
    o_sel = o_sel.swapaxes(0, 1).reshape(B, S, Hk, G, dh)
    o_win = o_win.swapaxes(0, 1).reshape(B, S, Hk, G, dh)

    gates = jax.nn.sigmoid(gate_logits.astype(jnp.float32)).reshape(B, S, Hk, G, 3).astype(o_cmp.dtype)
    o = gates[..., 0:1] * o_cmp + gates[..., 1:2] * o_sel + gates[..., 2:3] * o_win
    return o.reshape(B, S, NSA_WIDTH)


def gla_mixer(q, k, v, gate_lr, r, w_gate, b_gate, norm_g):
    B, S = q.shape[0], q.shape[1]
    H, dk, dv, C = GLA_HEADS, GLA_KEY_DIM, GLA_VAL_DIM, GLA_CHUNK
    n_ch = S // C
    f32 = jnp.float32
    log_a = jax.nn.log_sigmoid((gate_lr @ w_gate + b_gate).astype(f32)) / GLA_TAU

    def to_chunks(t, d):
        return t.astype(f32).reshape(B, n_ch, C, H, d).transpose(0, 3, 1, 2, 4)

    qf = to_chunks(q, dk) * (dk ** -0.5)
    kf = to_chunks(k, dk)
    vf = to_chunks(v, dv)
    b = jnp.cumsum(to_chunks(log_a, dk), axis=3)
    b_last = b[:, :, :, -1:, :]
    q_dec = qf * jnp.exp(b)
    k_dec = kf * jnp.exp(-b)
    k_state = kf * jnp.exp(b_last - b)
    causal = jnp.tril(jnp.ones((C, C), dtype=bool))
    attn = jnp.where(causal, jnp.einsum('bhncd,bhnsd->bhncs', q_dec, k_dec), 0.0)
    o_intra = jnp.einsum('bhncs,bhnse->bhnce', attn, vf)
    u = jnp.einsum('bhnsd,bhnse->bhnde', k_state, vf)
    decay = jnp.exp(b_last[:, :, :, 0, :])

    def step(state, inp):
        d, u_n = inp
        return d[..., None] * state + u_n, state

    _, s_prev = lax.scan(step, jnp.zeros((B, H, dk, dv), f32),
                         (decay.transpose(2, 0, 1, 3), u.transpose(2, 0, 1, 3, 4)))
    s_prev = s_prev.transpose(1, 2, 0, 3, 4)
    o_inter = jnp.einsum('bhncd,bhnde->bhnce', q_dec, s_prev)
    o = (o_intra + o_inter).transpose(0, 2, 3, 1, 4).reshape(B, S, H, dv)
    o = rms_norm(o, norm_g).reshape(B, S, GLA_WIDTH)
    return (o * jax.nn.silu(r.astype(f32))).astype(q.dtype)


def clamped_swiglu(h):
    x_glu = jnp.minimum(h[..., :D_FF], SWIGLU_LIMIT)
    x_lin = jnp.clip(h[..., D_FF:], -SWIGLU_LIMIT, SWIGLU_LIMIT)
    return x_glu * jax.nn.sigmoid(SWIGLU_ALPHA * x_glu) * (x_lin + 1.0)


def moe_ffn(h, w_router, b_router, w_gate_up, b_gate_up, w_down, b_down):
    B, S, D = h.shape
    xf = h.reshape(-1, D)
    M = xf.shape[0]
    logits = (xf @ w_router + b_router).astype(jnp.float32)
    top_vals, top_idx = lax.top_k(logits, TOP_K)
    gate = jax.nn.softmax(top_vals, axis=-1)
    A = M * TOP_K
    flat_e = top_idx.reshape(-1)
    flat_tok = jnp.arange(A, dtype=jnp.int32) // TOP_K
    order = jnp.argsort(flat_e)
    sorted_e = flat_e[order]
    sorted_tok = flat_tok[order]
    counts = jnp.zeros((N_EXPERTS,), jnp.int32).at[flat_e].add(1)
    padded = (counts + EXPERT_BLOCK - 1) // EXPERT_BLOCK * EXPERT_BLOCK
    start = jnp.cumsum(counts) - counts
    pend = jnp.cumsum(padded)
    pstart = pend - padded
    dest = pstart[sorted_e] + (jnp.arange(A, dtype=jnp.int32) - start[sorted_e])
    n_blocks = -(-(A + N_EXPERTS * (EXPERT_BLOCK - 1)) // EXPERT_BLOCK)
    R = n_blocks * EXPERT_BLOCK
    xs = jnp.zeros((R, D), xf.dtype).at[dest].set(xf[sorted_tok])
    block_e = jnp.minimum(jnp.searchsorted(pend, jnp.arange(n_blocks) * EXPERT_BLOCK, side='right'),
                          N_EXPERTS - 1)

    def expert_block(args):
        xb, e = args
        hgu = xb @ w_gate_up[e] + b_gate_up[e]
        return clamped_swiglu(hgu) @ w_down[e] + b_down[e]

    ys = lax.map(expert_block, (xs.reshape(n_blocks, EXPERT_BLOCK, D), block_e)).reshape(R, D)
    y_sorted = ys[dest] * gate.reshape(-1)[order][:, None].astype(ys.dtype)
    out = jax.ops.segment_sum(y_sorted, sorted_tok, num_segments=M)
    return out.reshape(B, S, D)


def setup_inputs(seed: int = 0) -> dict:
    key = jax.random.key(seed)
    ks = jax.random.split(key, 24)
    f32 = jnp.float32
    L = DEPTH
    dh = NSA_HEAD_DIM

    def nrm(k, shape, scale):
        return jax.random.normal(k, shape, f32) * scale

    x = nrm(ks[0], (BATCH, SEQ, D_MODEL), 1.0)
    offsets = jax.random.randint(ks[1], (BATCH, 1), 0, 1024, dtype=jnp.int32)
    positions = offsets + jnp.arange(SEQ, dtype=jnp.int32)[None, :]
    return {
        'x': x,
        'positions': positions,
        'norm1_g': 1.0 + nrm(ks[2], (L, D_MODEL), 0.02),
        'w_in': nrm(ks[3], (L, D_MODEL, IN_WIDTH), D_MODEL ** -0.5),
        'nsa_q_norm_g': 1.0 + nrm(ks[4], (L, dh), 0.02),
        'nsa_k_norm_g': 1.0 + nrm(ks[5], (L, 3, dh), 0.02),
        'cmp_pos_k': nrm(ks[6], (L, CMP_BLOCK, dh), 0.02),
        'cmp_w1_k': nrm(ks[7], (L, CMP_BLOCK * dh, CMP_HIDDEN), (CMP_BLOCK * dh) ** -0.5),
        'cmp_w2_k': nrm(ks[8], (L, CMP_HIDDEN, dh), CMP_HIDDEN ** -0.5),
        'cmp_pos_v': nrm(ks[9], (L, CMP_BLOCK, dh), 0.02),
        'cmp_w1_v': nrm(ks[10], (L, CMP_BLOCK * dh, CMP_HIDDEN), (CMP_BLOCK * dh) ** -0.5),
        'cmp_w2_v': nrm(ks[11], (L, CMP_HIDDEN, dh), CMP_HIDDEN ** -0.5),
        'gla_w_gate': nrm(ks[12], (L, GLA_GATE_RANK, GLA_KEY_WIDTH), GLA_GATE_RANK ** -0.5),
        'gla_b_gate': nrm(ks[13], (L, GLA_KEY_WIDTH), 0.1),
        'gla_norm_g': 1.0 + nrm(ks[14], (L, GLA_VAL_DIM), 0.02),
        'w_out': nrm(ks[15], (L, NSA_WIDTH + GLA_WIDTH, D_MODEL), (NSA_WIDTH + GLA_WIDTH) ** -0.5),
        'norm2_g': 1.0 + nrm(ks[16], (L, D_MODEL), 0.02),
        'w_router': nrm(ks[17], (L, D_MODEL, N_EXPERTS), D_MODEL ** -0.5),
        'b_router': nrm(ks[18], (L, N_EXPERTS), 0.01),
        'w_gate_up': nrm(ks[19], (L, N_EXPERTS, D_MODEL, 2 * D_FF), D_MODEL ** -0.5),
        'b_gate_up': nrm(ks[20], (L, N_EXPERTS, 2 * D_FF), 0.01),
        'w_down': nrm(ks[21], (L, N_EXPERTS, D_FF, D_MODEL), D_FF ** -0.5),
        'b_down': nrm(ks[22], (L, N_EXPERTS, D_MODEL), 0.01),
    }


def reference(x, positions, norm1_g, w_in, nsa_q_norm_g, nsa_k_norm_g, cmp_pos_k, cmp_w1_k, cmp_w2_k,
              cmp_pos_v, cmp_w1_v, cmp_w2_v, gla_w_gate, gla_b_gate, gla_norm_g, w_out, norm2_g,
              w_router, b_router, w_gate_up, b_gate_up, w_down, b_down):
    split_points = [int(p) for p in np.cumsum(IN_SIZES)[:-1]]
    for l in range(DEPTH):
        h = rms_norm(x, norm1_g[l])
        proj = h @ w_in[l]
        (nq, nkc, nvc, nks, nvs, nkw, nvw, ngate, gq, gk, gv, glr, gr) = jnp.split(proj, split_points, axis=-1)
        nsa_out = nsa_mixer(nq, nkc, nvc, nks, nvs, nkw, nvw, ngate, positions, nsa_q_norm_g[l], nsa_k_norm_g[l],
                            cmp_pos_k[l], cmp_w1_k[l], cmp_w2_k[l], cmp_pos_v[l], cmp_w1_v[l], cmp_w2_v[l])
        gla_out = gla_mixer(gq, gk, gv, glr, gr, gla_w_gate[l], gla_b_gate[l], gla_norm_g[l])
        x = x + jnp.concatenate([nsa_out, gla_out], axis=-1) @ w_out[l]
        h2 = rms_norm(x, norm2_g[l])
        x = x + moe_ffn(h2, w_router[l], b_router[l], w_gate_up[l], b_gate_up[l], w_down[l], b_down[l])
    return x
```

```cpp
#include <hip/hip_runtime.h>
#include <hip/hip_cooperative_groups.h>
#include <cstdint>
#include <cstdio>
namespace cg = cooperative_groups;

#ifndef MK_ONE_LAUNCH
#define MK_ONE_LAUNCH 0
#endif

#define LAS __attribute__((address_space(3)))
typedef unsigned short bf16_t;
typedef short bf16x8 __attribute__((ext_vector_type(8)));
typedef float f32x4 __attribute__((ext_vector_type(4)));
typedef float f32x2 __attribute__((ext_vector_type(2)));
typedef unsigned u32x4 __attribute__((ext_vector_type(4)));
typedef unsigned u32x2 __attribute__((ext_vector_type(2)));

constexpr int NB = 16, SEQ = 2048, DM = 1024, MTOK = NB * SEQ;
constexpr int NPROJ = 3072;
constexpr int CQ = 0, CKC = 512, CVC = 640, CKS = 768, CVS = 896, CKW = 1024, CVW = 1152, CGQ = 1280, CGK = 1536, CGV = 1792, CGR = 2304, CGATE = 2816, CGLR = 2840;
constexpr int NEXP = 32, DFF = 1024;
constexpr int MAXTILES = 544, XROWS = MAXTILES * 256;
constexpr float EPS = 1e-6f;
constexpr int NTHREADS = 512;
constexpr int LDS_BYTES = 160 * 1024;

constexpr size_t MiB = 1u << 20;
constexpr size_t WS_CTL = 0;
constexpr size_t WS_WIN = 2 * MiB;
constexpr size_t WS_WOUT = 8 * MiB;
constexpr size_t WS_CW1K = 10 * MiB, WS_CW1V = 11 * MiB;
constexpr size_t WS_CW2K = 12 * MiB, WS_CW2V = 12 * MiB + 512 * 1024;
constexpr size_t WS_CBIAS = 13 * MiB;
constexpr size_t WS_WRT = 13 * MiB + 512 * 1024;
constexpr size_t WS_WGU = 16 * MiB;
constexpr size_t WS_WD = 144 * MiB;
constexpr size_t WS_H = 208 * MiB;
constexpr size_t WS_PROJ = 272 * MiB;
constexpr size_t WS_QN = 464 * MiB, WS_QR = 496 * MiB;
constexpr size_t WS_KS = 528 * MiB, WS_KW = 536 * MiB;
constexpr size_t WS_VST = 544 * MiB, WS_VWT = 552 * MiB;
constexpr size_t WS_KC = 560 * MiB, WS_VCT = 561 * MiB;
constexpr size_t WS_U = 562 * MiB;
constexpr size_t WS_OI = 626 * MiB;
constexpr size_t WS_QD = 690 * MiB;
constexpr size_t WS_DEC = 722 * MiB;
constexpr size_t WS_SP = 723 * MiB;
constexpr size_t WS_ATT = 787 * MiB;
constexpr size_t WS_TOPI = 851 * MiB, WS_TOPG = 852 * MiB, WS_DEST = 853 * MiB;
constexpr size_t WS_XS = 272 * MiB;
constexpr size_t WS_ACT = 544 * MiB;
constexpr size_t WS_Y = 272 * MiB;
constexpr size_t WS_END = 854 * MiB;
constexpr int CW_CNT = 0, CW_FILL = 64;

struct Params {
    const float* in[23];
    float* out;
    unsigned char* ws;
};

__device__ __forceinline__ float bf2f(bf16_t v) { return __uint_as_float(((unsigned)v) << 16); }
__device__ __forceinline__ unsigned f2bf(float f) { unsigned u = __float_as_uint(f); return (u + 0x7fffu + ((u >> 16) & 1u)) >> 16; }
__device__ __forceinline__ unsigned pk2(float lo, float hi) { return f2bf(lo) | (f2bf(hi) << 16); }
__device__ __forceinline__ float wave_sum(float v) {
#pragma unroll
    for (int o = 1; o < 64; o <<= 1) v += __shfl_xor(v, o);
    return v;
}
#define LDS_WAIT() asm volatile("s_waitcnt lgkmcnt(0)" ::: "memory")
__device__ __forceinline__ float sigmoidf_(float x) { return 1.f / (1.f + __expf(-x)); }

namespace pg8 {
constexpr int BM = 256, BK = 64, HALF = 128, HTB = HALF * BK * 2, STAGE_BYTES = 8 * HTB, NXCD = 8, WGM = 8;
__device__ __forceinline__ int lds_byte(int r, int c) { const int st = (r >> 4) * 2 + (c >> 5), rr = r & 15, cc = c & 31, ob = rr * 64 + cc * 2; return st * 1024 + (ob ^ (((ob >> 9) & 1) << 5)); }
__device__ __forceinline__ void stage_rc(int b, int& R, int& C) { const int st = b / 1024, sb = b % 1024, swz = sb ^ (((sb >> 9) & 1) << 5); R = (st >> 1) * 16 + swz / 64; C = (st & 1) * 32 + (swz % 64) / 2; }
__device__ __forceinline__ int perm32(int rho) { const int n = rho >> 4, i = rho & 15; return 8 * (i >> 2) + 4 * n + (i & 3); }

struct Unit { int pm, pn, pb; };
struct Gemm { const bf16_t* A; const bf16_t* Bt; int K; };

__device__ __forceinline__ bool order_next(long L, int nM, int nN, int& pm, int& pn) {
    const int nwg = nM * nN; if (L >= nwg) return false;
    int wgid = (int)L; { const int q = nwg / NXCD, r = nwg % NXCD, xcd = wgid % NXCD, off = wgid / NXCD; wgid = (xcd < r ? xcd * (q + 1) : r * (q + 1) + (xcd - r) * q) + off; }
    const int nig = WGM * nN, gid = wgid / nig, fm = gid * WGM, gsz = (nM - fm) < WGM ? (nM - fm) : WGM;
    pm = fm + ((wgid % nig) % gsz); pn = (wgid % nig) / gsz; return true;
}
struct StaticOrder {
    int nM, nN, G, c;
    __device__ __forceinline__ bool next(int i, Unit& u) const { if (!order_next((long)i * G + c, nM, nN, u.pm, u.pn)) return false; u.pb = u.pn; return true; }
};
struct MoeOrder {
    int nM, nN, G, c; const LAS int* tile_e;
    __device__ __forceinline__ bool next(int i, Unit& u) const { if (!order_next((long)i * G + c, nM, nN, u.pm, u.pn)) return false; u.pb = tile_e[u.pm] * nN + u.pn; return true; }
};

__device__ __forceinline__ unsigned cvt_pk_bf16(float lo, float hi) { unsigned r; asm volatile("v_cvt_pk_bf16_f32 %0, %1, %2" : "=v"(r) : "v"(lo), "v"(hi)); return r; }

struct EpiBf16 {
    static constexpr bool PERM = true;
    bf16_t* O; int ldc;
    __device__ __forceinline__ void operator()(const f32x4 (&acc)[2][2][4][2], const Unit& u, int wr, int wc, int fr, int fq) const {
        const int row0 = u.pm * BM + wr * 64 + fr, col0 = u.pn * BM + wc * 32 + 8 * fq;
#pragma unroll
        for (int ai = 0; ai < 2; ++ai)
#pragma unroll
            for (int m = 0; m < 4; ++m) { bf16_t* rowp = O + (size_t)(row0 + ai * HALF + m * 16) * ldc + col0;
#pragma unroll
                for (int bj = 0; bj < 2; ++bj) { const f32x4 v0 = acc[ai][bj][m][0], v1 = acc[ai][bj][m][1];
                    u32x4 w; w.x = cvt_pk_bf16(v0[0], v0[1]); w.y = cvt_pk_bf16(v0[2], v0[3]); w.z = cvt_pk_bf16(v1[0], v1[1]); w.w = cvt_pk_bf16(v1[2], v1[3]);
                    *(u32x4*)(rowp + bj * HALF) = w; } }
    }
};
struct EpiResF32 {
    static constexpr bool PERM = false;
    const float* base; float* out; int ldc;
    __device__ __forceinline__ void operator()(const f32x4 (&acc)[2][2][4][2], const Unit& u, int wr, int wc, int fr, int fq) const {
        const int col0 = u.pn * BM + wc * 32 + 4 * fq;
#pragma unroll
        for (int ai = 0; ai < 2; ++ai)
#pragma unroll
            for (int m = 0; m < 4; ++m) { const size_t off = (size_t)(u.pm * BM + ai * HALF + wr * 64 + m * 16 + fr) * ldc + col0;
#pragma unroll
                for (int bj = 0; bj < 2; ++bj)
#pragma unroll
                    for (int n = 0; n < 2; ++n) { const f32x4 bs = *(const f32x4*)(base + off + bj * HALF + n * 16); *(f32x4*)(out + off + bj * HALF + n * 16) = bs + acc[ai][bj][m][n]; } }
    }
};
struct EpiSwiglu {
    static constexpr bool PERM = true;
    bf16_t* O; const float* bias; int nN;
    __device__ __forceinline__ void operator()(const f32x4 (&acc)[2][2][4][2], const Unit& u, int wr, int wc, int fr, int fq) const {
        const int e = u.pb / nN;
        const int row0 = u.pm * BM + wr * 64 + fr, ch = u.pn * HALF + wc * 32 + 8 * fq;
        const float* bg = bias + (size_t)e * 2048 + ch; const float* bl = bg + 1024;
        const f32x4 bg0 = *(const f32x4*)bg, bg1 = *(const f32x4*)(bg + 4), bl0 = *(const f32x4*)bl, bl1 = *(const f32x4*)(bl + 4);
#pragma unroll
        for (int ai = 0; ai < 2; ++ai)
#pragma unroll
            for (int m = 0; m < 4; ++m) {
                float r[8];
#pragma unroll
                for (int n = 0; n < 2; ++n)
#pragma unroll
                    for (int j = 0; j < 4; ++j) {
                        float gv = acc[ai][0][m][n][j] + (n ? bg1[j] : bg0[j]);
                        float lv = acc[ai][1][m][n][j] + (n ? bl1[j] : bl0[j]);
                        gv = fminf(gv, 7.0f); lv = fminf(fmaxf(lv, -7.0f), 7.0f);
                        r[n * 4 + j] = gv * (1.f / (1.f + __expf(-1.702f * gv))) * (lv + 1.0f);
                    }
                u32x4 w; w.x = cvt_pk_bf16(r[0], r[1]); w.y = cvt_pk_bf16(r[2], r[3]); w.z = cvt_pk_bf16(r[4], r[5]); w.w = cvt_pk_bf16(r[6], r[7]);
                *(u32x4*)(O + (size_t)(row0 + ai * HALF + m * 16) * DFF + ch) = w;
            }
    }
};
struct EpiDown {
    static constexpr bool PERM = true;
    bf16_t* O; const float* bias; int nN;
    __device__ __forceinline__ void operator()(const f32x4 (&acc)[2][2][4][2], const Unit& u, int wr, int wc, int fr, int fq) const {
        const int e = u.pb / nN;
        const int row0 = u.pm * BM + wr * 64 + fr, col0 = u.pn * BM + wc * 32 + 8 * fq;
        const float* bp = bias + (size_t)e * 1024 + col0;
        f32x4 bv[2][2];
#pragma unroll
        for (int bj = 0; bj < 2; ++bj)
#pragma unroll
            for (int n = 0; n < 2; ++n) bv[bj][n] = *(const f32x4*)(bp + bj * HALF + 4 * n);
#pragma unroll
        for (int ai = 0; ai < 2; ++ai)
#pragma unroll
            for (int m = 0; m < 4; ++m) { bf16_t* rowp = O + (size_t)(row0 + ai * HALF + m * 16) * 1024 + col0;
#pragma unroll
                for (int bj = 0; bj < 2; ++bj) { const f32x4 v0 = acc[ai][bj][m][0] + bv[bj][0], v1 = acc[ai][bj][m][1] + bv[bj][1];
                    u32x4 w; w.x = cvt_pk_bf16(v0[0], v0[1]); w.y = cvt_pk_bf16(v0[2], v0[3]); w.z = cvt_pk_bf16(v1[0], v1[1]); w.w = cvt_pk_bf16(v1[2], v1[3]);
                    *(u32x4*)(rowp + bj * HALF) = w; } }
    }
};

template <class Epi, class Sched>
__device__ __forceinline__ void gemm_phase(LAS unsigned char* lds, const Gemm g, const Sched& S, const Epi& E) {
    const int tid = threadIdx.x, wid = __builtin_amdgcn_readfirstlane(tid >> 6), lane = tid & 63, wr = wid >> 2, wc = wid & 3, fr = lane & 15, fq = lane >> 4;
    const int K = g.K, nt = K / BK;
    unsigned voffA[2], voffB[2];
#pragma unroll
    for (int i = 0; i < 2; ++i) { int R, C; stage_rc(tid * 16 + i * 8192, R, C); const int Rb = Epi::PERM ? ((R & ~31) + perm32(R & 31)) : R;
        voffA[i] = (unsigned)(R * K + C) * 2u; voffB[i] = (unsigned)(Rb * K + C) * 2u; }
    const size_t kstep = (size_t)(BK * 2);
    const size_t hstep = (size_t)HALF * K * 2;
    const size_t tstep = 2 * hstep;
    const unsigned ldsw = (unsigned)wid * 1024u;
    const int aoff = lds_byte(wr * 64 + fr, fq * 8), boff = lds_byte(wc * 32 + fr, fq * 8);
#define PG8_SA(b, h) (((b) * 2 + (h)) * HTB)
#define PG8_SB(b, h) ((4 + (b) * 2 + (h)) * HTB)
#define PG8_STAGE(bufoff, gbase, voff) do { _Pragma("unroll") for (int _i = 0; _i < 2; ++_i) \
        __builtin_amdgcn_global_load_lds((const unsigned*)((const char*)(gbase) + (voff)[_i]), (LAS unsigned*)(lds + (bufoff) + ldsw + _i * 8192), 16, 0, 0); } while (0)
#define PG8_LDA(dst, b, h) do { _Pragma("unroll") for (int m = 0; m < 4; ++m) _Pragma("unroll") for (int k = 0; k < 2; ++k) dst[m][k] = *(const LAS bf16x8*)(lds + PG8_SA(b, h) + aoff + m * 2048 + k * 1024); } while (0)
#define PG8_LDB(dst, b, h) do { _Pragma("unroll") for (int n = 0; n < 2; ++n) _Pragma("unroll") for (int k = 0; k < 2; ++k) dst[n][k] = *(const LAS bf16x8*)(lds + PG8_SB(b, h) + boff + n * 2048 + k * 1024); } while (0)
#define PG8_MMA(ai, bj, At, Bt) do { __builtin_amdgcn_s_setprio(1); _Pragma("unroll") for (int m = 0; m < 4; ++m) _Pragma("unroll") for (int n = 0; n < 2; ++n) _Pragma("unroll") for (int k = 0; k < 2; ++k) \
        acc[ai][bj][m][n] = __builtin_amdgcn_mfma_f32_16x16x32_bf16(Bt[n][k], At[m][k], acc[ai][bj][m][n], 0, 0, 0); __builtin_amdgcn_s_setprio(0); } while (0)
#define PG8_WAIT_V(n) asm volatile("s_waitcnt vmcnt(" #n ")" ::: "memory")
#define PG8_WAIT_L(n) asm volatile("s_waitcnt lgkmcnt(" #n ")" ::: "memory")
#define PG8_BAR __builtin_amdgcn_s_barrier()
#define PG8_SCHED __builtin_amdgcn_sched_barrier(0)
    Unit cur, nxt; int ui = 0;
    if (!S.next(0, cur)) return;
    f32x4 acc[2][2][4][2];
#pragma unroll
    for (int a = 0; a < 2; ++a)
#pragma unroll
        for (int b = 0; b < 2; ++b)
#pragma unroll
            for (int m = 0; m < 4; ++m)
#pragma unroll
                for (int n = 0; n < 2; ++n) acc[a][b][m][n] = (f32x4){0.f, 0.f, 0.f, 0.f};
    bf16x8 At[4][2], B0[2][2], B1[2][2];
    const char* cA = (const char*)g.A + (size_t)cur.pm * tstep; const char* cB = (const char*)g.Bt + (size_t)cur.pb * tstep;
    {
        PG8_STAGE(PG8_SB(0, 0), cB, voffB); PG8_STAGE(PG8_SB(0, 1), cB + hstep, voffB); PG8_STAGE(PG8_SA(0, 0), cA, voffA); PG8_STAGE(PG8_SA(0, 1), cA + hstep, voffA);
        if (wr == 1) PG8_BAR;
        PG8_WAIT_V(2); PG8_BAR;
        PG8_STAGE(PG8_SB(1, 0), cB + kstep, voffB); PG8_STAGE(PG8_SA(1, 0), cA + kstep, voffA); PG8_STAGE(PG8_SB(1, 1), cB + hstep + kstep, voffB);
        PG8_WAIT_V(6); PG8_BAR;
    }
    for (;;) {
        const bool has_next = S.next(ui + 1, nxt);
        const char* nA = has_next ? (const char*)g.A + (size_t)nxt.pm * tstep : cA; const char* nB = has_next ? (const char*)g.Bt + (size_t)nxt.pb * tstep : cB;
        for (int t = 0; t < nt; t += 2) {
            const bool last = (t == nt - 2);
            const char* a1 = cA + (size_t)(t + 1) * kstep;
            const char* a2 = last ? nA : cA + (size_t)(t + 2) * kstep; const char* b2 = last ? nB : cB + (size_t)(t + 2) * kstep;
            const char* a3 = a2 + kstep; const char* b3 = b2 + kstep;
            PG8_LDB(B0, 0, 0); PG8_LDB(B1, 0, 1); PG8_SCHED; PG8_LDA(At, 0, 0); PG8_STAGE(PG8_SA(1, 1), a1 + hstep, voffA);
            PG8_WAIT_V(8); PG8_WAIT_L(0); PG8_BAR; PG8_MMA(0, 0, At, B0); PG8_MMA(0, 1, At, B1); PG8_BAR; PG8_SCHED;
            PG8_LDA(At, 0, 1); PG8_STAGE(PG8_SB(0, 0), b2, voffB); PG8_STAGE(PG8_SB(0, 1), b2 + hstep, voffB); PG8_STAGE(PG8_SA(0, 0), a2, voffA);
            PG8_WAIT_V(8); PG8_WAIT_L(0); PG8_BAR; PG8_MMA(1, 0, At, B0); PG8_MMA(1, 1, At, B1); PG8_BAR; PG8_SCHED;
            PG8_LDB(B0, 1, 0); PG8_LDB(B1, 1, 1); PG8_SCHED; PG8_LDA(At, 1, 0); PG8_STAGE(PG8_SA(0, 1), a2 + hstep, voffA);
            PG8_WAIT_V(8); PG8_WAIT_L(0); PG8_BAR; PG8_MMA(0, 0, At, B0); PG8_MMA(0, 1, At, B1); PG8_BAR; PG8_SCHED;
            PG8_LDA(At, 1, 1); PG8_STAGE(PG8_SB(1, 0), b3, voffB); PG8_STAGE(PG8_SB(1, 1), b3 + hstep, voffB); PG8_STAGE(PG8_SA(1, 0), a3, voffA);
            PG8_WAIT_V(8); PG8_WAIT_L(0); PG8_BAR; PG8_MMA(1, 0, At, B0); PG8_MMA(1, 1, At, B1); PG8_BAR; PG8_SCHED;
        }
        if (wr == 0) PG8_BAR;
        E(acc, cur, wr, wc, fr, fq);
        if (!has_next) break;
#pragma unroll
        for (int a = 0; a < 2; ++a)
#pragma unroll
            for (int b = 0; b < 2; ++b)
#pragma unroll
                for (int m = 0; m < 4; ++m)
#pragma unroll
                    for (int n = 0; n < 2; ++n) acc[a][b][m][n] = (f32x4){0.f, 0.f, 0.f, 0.f};
        cur = nxt; cA = nA; cB = nB; ++ui;
        if (wr == 1) PG8_BAR;
    }
    PG8_WAIT_V(0);
    PG8_BAR;
#undef PG8_SA
#undef PG8_SB
#undef PG8_STAGE
#undef PG8_LDA
#undef PG8_LDB
#undef PG8_MMA
#undef PG8_WAIT_V
#undef PG8_WAIT_L
#undef PG8_BAR
#undef PG8_SCHED
}
}

__device__ __forceinline__ int win_map(int n) {
    if (n < 1280) return n;
    if (n < 2304) return n + 24;
    if (n < 2816) return n + 40;
    if (n < 2840) return n - 1536;
    if (n < 2856) return n - 512;
    return -1;
}
template <int MODE> __device__ __forceinline__ int colmap(int r) {
    if (MODE == 1) return win_map(r);
    if (MODE == 2) return ((r >> 7) & 1) * 1024 + (r >> 8) * 128 + (r & 127);
    return r;
}
template <int MODE>
__device__ __forceinline__ void transpose_item(const float* W, int K, int Nsrc, bf16_t* WT, int nblk, LAS float* scr, int item, int lane) {
    const int kb = item / nblk, nb = item % nblk, k0 = 64 * kb, n0 = 32 * nb;
    const int sc = colmap<MODE>(n0 + (lane & 31));
#pragma unroll 8
    for (int i = 0; i < 32; ++i) { const int kk = 2 * i + (lane >> 5); scr[kk * 33 + (lane & 31)] = sc >= 0 ? W[(size_t)(k0 + kk) * Nsrc + sc] : 0.f; }
    LDS_WAIT();
    const int c = lane & 7;
#pragma unroll
    for (int j = 0; j < 4; ++j) { const int n = (lane >> 3) + 8 * j; const LAS float* s = scr + (8 * c) * 33 + n;
        u32x4 o; o.x = pk2(s[0 * 33], s[1 * 33]); o.y = pk2(s[2 * 33], s[3 * 33]); o.z = pk2(s[4 * 33], s[5 * 33]); o.w = pk2(s[6 * 33], s[7 * 33]);
        *(u32x4*)(WT + (size_t)(n0 + n) * K + k0 + 8 * c) = o; }
    LDS_WAIT();
}
__device__ __forceinline__ void rms_row_to_bf16(const float* xrow, const float* g, bf16_t* orow, int lane) {
    const f32x4* xr = (const f32x4*)xrow + lane; const f32x4* gr = (const f32x4*)g + lane;
    f32x4 v[4]; float s = 0.f;
#pragma unroll
    for (int j = 0; j < 4; ++j) { v[j] = xr[64 * j]; s += (v[j].x * v[j].x + v[j].y * v[j].y) + (v[j].z * v[j].z + v[j].w * v[j].w); }
    const float rstd = 1.f / sqrtf(wave_sum(s) * (1.f / DM) + EPS);
    unsigned long long* o8 = (unsigned long long*)orow + lane;
#pragma unroll
    for (int j = 0; j < 4; ++j) { const f32x4 gg = gr[64 * j]; const f32x4 o = v[j] * rstd * gg;
        o8[64 * j] = (unsigned long long)pk2(o.x, o.y) | ((unsigned long long)pk2(o.z, o.w) << 32); }
}
__device__ __forceinline__ void phase0(const Params& p, LAS unsigned char* lds, int blk, int G) {
    const int tid = threadIdx.x, lane = tid & 63, wave = tid >> 6;
    LAS float* scr = (LAS float*)(lds + wave * 16384);
    const int gw = blk * 8 + wave, NGW = G * 8;
    unsigned char* ws = p.ws;
    constexpr int I_GU = 16 * 64, I_DN = 16 * 32;
    constexpr int N_GU = NEXP * I_GU, N_DN = NEXP * I_DN, N_IN = 16 * (NPROJ / 32), N_OUT = 16 * 32, N_C1 = 32 * 8, N_C2 = 4 * 2;
    constexpr int NITEMS = N_GU + N_DN + N_IN + N_OUT + 2 * N_C1 + 2 * N_C2;
    for (int it = gw; it < NITEMS; it += NGW) {
        int r = it;
        if (r < N_GU) { const int e = r / I_GU; transpose_item<2>(p.in[19] + (size_t)e * 1024 * 2048, 1024, 2048, (bf16_t*)(ws + WS_WGU) + (size_t)e * 2048 * 1024, 64, scr, r % I_GU, lane); continue; } r -= N_GU;
        if (r < N_DN) { const int e = r / I_DN; transpose_item<0>(p.in[21] + (size_t)e * 1024 * 1024, 1024, 1024, (bf16_t*)(ws + WS_WD) + (size_t)e * 1024 * 1024, 32, scr, r % I_DN, lane); continue; } r -= N_DN;
        if (r < N_IN) { transpose_item<1>(p.in[3], 1024, 2856, (bf16_t*)(ws + WS_WIN), NPROJ / 32, scr, r, lane); continue; } r -= N_IN;
        if (r < N_OUT) { transpose_item<0>(p.in[15], 1024, 1024, (bf16_t*)(ws + WS_WOUT), 32, scr, r, lane); continue; } r -= N_OUT;
        if (r < N_C1) { transpose_item<0>(p.in[7], 2048, 256, (bf16_t*)(ws + WS_CW1K), 8, scr, r, lane); continue; } r -= N_C1;
        if (r < N_C1) { transpose_item<0>(p.in[10], 2048, 256, (bf16_t*)(ws + WS_CW1V), 8, scr, r, lane); continue; } r -= N_C1;
        if (r < N_C2) { transpose_item<0>(p.in[8], 256, 64, (bf16_t*)(ws + WS_CW2K), 2, scr, r, lane); continue; } r -= N_C2;
        transpose_item<0>(p.in[11], 256, 64, (bf16_t*)(ws + WS_CW2V), 2, scr, r, lane);
    }
    for (int m = gw; m < MTOK; m += NGW) rms_row_to_bf16(p.in[0] + (size_t)m * DM, p.in[2], (bf16_t*)(ws + WS_H) + (size_t)m * DM, lane);
    for (int i = blk * NTHREADS + tid; i < NEXP * DM; i += G * NTHREADS) { const int e = i >> 10, d = i & 1023; ((float*)(ws + WS_WRT))[i] = p.in[16][d] * p.in[17][d * NEXP + e]; }
    if (blk == G - 1) {
        const int which = tid >> 8, j = tid & 255;
        const float* pos = which ? p.in[9] : p.in[6]; const float* w1 = which ? p.in[10] : p.in[7];
        float s = 0.f;
#pragma unroll 8
        for (int k = 0; k < 2048; ++k) s += pos[k] * w1[(size_t)k * 256 + j];
        ((float*)(ws + WS_CBIAS))[tid] = s;
    }
}

__device__ __forceinline__ void p2a_unit(const Params& p, LAS unsigned char* lds, int unit) {
    const int tid = threadIdx.x, lane = tid & 63, wave = tid >> 6;
    unsigned char* ws = p.ws;
    const bf16_t* PROJ = (const bf16_t*)(ws + WS_PROJ);
    const int b = unit >> 5, blkc = unit & 31, tok0 = unit * 64;
    const float gq = p.in[4][lane], gks = p.in[5][64 + lane], gkw = p.in[5][128 + lane];
    const float inv_freq = __expf(-13.122363377404328f * (float)(2 * (lane & 7)) * (1.f / 16.f));
    for (int ti = 0; ti < 8; ++ti) {
        const int i = wave * 8 + ti, t = tok0 + i;
        const float pos = (float)((const int*)p.in[1])[t];
        const float ang = pos * inv_freq;
        const float cs = cosf(ang), sn = sinf(ang);
        const bf16_t* pr = PROJ + (size_t)t * NPROJ;
#pragma unroll
        for (int v = 0; v < 12; ++v) {
            const int col = (v < 8) ? (CQ + v * 64) : (v < 10 ? CKS + (v - 8) * 64 : CKW + (v - 10) * 64);
            const float g = (v < 8) ? gq : (v < 10 ? gks : gkw);
            const float x = bf2f(pr[col + lane]);
            const float ss = wave_sum(x * x);
            float y = x * (1.f / sqrtf(ss * (1.f / 64.f) + EPS)) * g;
            const float partner = __shfl_xor(y, 8);
            float yr = y;
            if (lane < 8) yr = y * cs - partner * sn; else if (lane < 16) yr = y * cs + partner * sn;
            if (v < 8) {
                ((bf16_t*)(ws + WS_QN))[(size_t)t * 512 + v * 64 + lane] = (bf16_t)f2bf(y * 0.125f);
                ((bf16_t*)(ws + WS_QR))[(size_t)t * 512 + v * 64 + lane] = (bf16_t)f2bf(yr * 0.125f);
            } else if (v < 10) {
                ((bf16_t*)(ws + WS_KS))[((size_t)(b * 2 + (v - 8)) * SEQ + (t & (SEQ - 1))) * 64 + lane] = (bf16_t)f2bf(yr);
            } else {
                ((bf16_t*)(ws + WS_KW))[((size_t)(b * 2 + (v - 10)) * SEQ + (t & (SEQ - 1))) * 64 + lane] = (bf16_t)f2bf(yr);
            }
        }
    }
    LAS bf16_t* T = (LAS bf16_t*)lds;
    for (int v = 0; v < 4; ++v) {
        const int kh = v & 1, col = (v < 2 ? CVS : CVW) + kh * 64;
        __syncthreads();
        { const int tk = tid >> 3, ch = tid & 7; const u32x4 raw = *(const u32x4*)(PROJ + (size_t)(tok0 + tk) * NPROJ + col + 8 * ch);
#pragma unroll
          for (int q = 0; q < 4; ++q) { const unsigned wv = raw[q]; T[(8 * ch + 2 * q) * 72 + tk] = (bf16_t)(wv & 0xffffu); T[(8 * ch + 2 * q + 1) * 72 + tk] = (bf16_t)(wv >> 16); } }
        __syncthreads();
        { const int d = tid >> 3, ch = tid & 7; const u32x4 o = *(const LAS u32x4*)(T + d * 72 + 8 * ch);
          bf16_t* dst = (bf16_t*)(ws + (v < 2 ? WS_VST : WS_VWT)) + (((size_t)(b * 2 + kh) * 32 + blkc) * 64 + d) * 64 + 8 * ch;
          *(u32x4*)dst = o; }
    }
    __syncthreads();
}

__device__ __forceinline__ void p2b_unit(const Params& p, LAS unsigned char* lds, int unit) {
    const int tid = threadIdx.x, lane = tid & 63, w = tid >> 6, fr = lane & 15, fq = lane >> 4;
    unsigned char* ws = p.ws;
    const bf16_t* PROJ = (const bf16_t*)(ws + WS_PROJ);
    const int which = unit >> 6, rt = unit & 63;
    const bf16_t* W1T = (const bf16_t*)(ws + (which ? WS_CW1V : WS_CW1K));
    const bf16_t* W2T = (const bf16_t*)(ws + (which ? WS_CW2V : WS_CW2K));
    const float* cb = (const float*)(ws + WS_CBIAS) + which * 256;
    const int colbase = which ? CVC : CKC;
    LAS bf16_t* Hd = (LAS bf16_t*)lds;
    LAS float* Of = (LAS float*)(lds + 64 * 264 * 2);
    const bf16_t* arow[4];
#pragma unroll
    for (int m = 0; m < 4; ++m) { const int R = rt * 64 + 16 * m + fr; const int bb = R >> 8, kh = (R >> 7) & 1; int n = R & 127; if (n > 126) n = 126;
        arow[m] = PROJ + (size_t)(bb * SEQ + 16 * n) * NPROJ + colbase + kh * 64 + 8 * fq; }
    const bf16_t* brow[2];
#pragma unroll
    for (int nf = 0; nf < 2; ++nf) brow[nf] = W1T + (size_t)(32 * w + 16 * nf + fr) * 2048 + 8 * fq;
    f32x4 acc[4][2];
#pragma unroll
    for (int m = 0; m < 4; ++m)
#pragma unroll
        for (int nf = 0; nf < 2; ++nf) acc[m][nf] = (f32x4){0.f, 0.f, 0.f, 0.f};
#pragma unroll 2
    for (int ks = 0; ks < 64; ++ks) {
        bf16x8 a[4], bb2[2];
        const size_t aoff = (size_t)(ks >> 1) * NPROJ + 32 * (ks & 1);
#pragma unroll
        for (int m = 0; m < 4; ++m) a[m] = *(const bf16x8*)(arow[m] + aoff);
#pragma unroll
        for (int nf = 0; nf < 2; ++nf) bb2[nf] = *(const bf16x8*)(brow[nf] + 32 * ks);
#pragma unroll
        for (int m = 0; m < 4; ++m)
#pragma unroll
            for (int nf = 0; nf < 2; ++nf) acc[m][nf] = __builtin_amdgcn_mfma_f32_16x16x32_bf16(a[m], bb2[nf], acc[m][nf], 0, 0, 0);
    }
#pragma unroll
    for (int nf = 0; nf < 2; ++nf) { const int col = 32 * w + 16 * nf + fr; const float bias = cb[col];
#pragma unroll
        for (int m = 0; m < 4; ++m)
#pragma unroll
            for (int j = 0; j < 4; ++j) { const float hv = acc[m][nf][j] + bias; Hd[(16 * m + 4 * fq + j) * 264 + col] = (bf16_t)f2bf(hv * sigmoidf_(hv)); } }
    __syncthreads();
    {
        const int m2 = w >> 1;
        f32x4 acc2[2] = {(f32x4){0.f, 0.f, 0.f, 0.f}, (f32x4){0.f, 0.f, 0.f, 0.f}};
#pragma unroll
        for (int ks = 0; ks < 8; ++ks) {
            const bf16x8 a = *(const LAS bf16x8*)(Hd + (16 * m2 + fr) * 264 + 32 * ks + 8 * fq);
#pragma unroll
            for (int q = 0; q < 2; ++q) { const int nf2 = 2 * (w & 1) + q; const bf16x8 bv = *(const bf16x8*)(W2T + (size_t)(16 * nf2 + fr) * 256 + 32 * ks + 8 * fq);
                acc2[q] = __builtin_amdgcn_mfma_f32_16x16x32_bf16(a, bv, acc2[q], 0, 0, 0); }
        }
#pragma unroll
        for (int q = 0; q < 2; ++q) { const int nf2 = 2 * (w & 1) + q;
#pragma unroll
            for (int j = 0; j < 4; ++j) Of[(16 * m2 + 4 * fq + j) * 65 + 16 * nf2 + fr] = acc2[q][j]; }
    }
    __syncthreads();
    for (int rr = 0; rr < 8; ++rr) {
        const int r = 8 * w + rr, R = rt * 64 + r, bb = R >> 8, kh = (R >> 7) & 1, n = R & 127;
        float v = Of[r * 65 + lane];
        if (which == 0) {
            const float ss = wave_sum(v * v);
            v = v * (1.f / sqrtf(ss * (1.f / 64.f) + EPS)) * p.in[5][lane];
            if (n == 127) v = 0.f;
            ((bf16_t*)(ws + WS_KC))[((size_t)(bb * 2 + kh) * 128 + n) * 64 + lane] = (bf16_t)f2bf(v);
        } else {
            if (n == 127) v = 0.f;
            ((bf16_t*)(ws + WS_VCT))[((size_t)(bb * 2 + kh) * 64 + lane) * 128 + n] = (bf16_t)f2bf(v);
        }
    }
    __syncthreads();
}

__device__ __forceinline__ void p2c_unit(const Params& p, LAS unsigned char* lds, int unit) {
    const int tid = threadIdx.x;
    unsigned char* ws = p.ws;
    const bf16_t* PROJ = (const bf16_t*)(ws + WS_PROJ);
    const int n = unit & 31, h = (unit >> 5) & 3, b = unit >> 7;
    const int bh = b * 4 + h, tok0 = b * SEQ + n * 64;
    LAS float* QD = (LAS float*)lds;
    LAS float* KD = QD + 64 * 64;
    LAS float* KSt = KD + 64 * 65;
    LAS float* V = KSt + 64 * 64;
    LAS float* AT = V + 64 * 128;
    LAS float* BL = AT + 64 * 65;
    LAS float* GL = BL + 64 * 64;
    LAS float* WG = GL + 64 * 16;
    LAS float* BG = WG + 16 * 64;
    for (int i = tid; i < 64 * 16; i += NTHREADS) { const int t = i >> 4, r = i & 15; GL[i] = bf2f(PROJ[(size_t)(tok0 + t) * NPROJ + CGLR + r]); }
    for (int i = tid; i < 16 * 64; i += NTHREADS) { const int r = i >> 6, d = i & 63; WG[i] = p.in[12][r * 256 + h * 64 + d]; }
    if (tid < 64) BG[tid] = p.in[13][h * 64 + tid];
    for (int i = tid; i < 64 * 128; i += NTHREADS) { const int t = i >> 7, e = i & 127; V[i] = bf2f(PROJ[(size_t)(tok0 + t) * NPROJ + CGV + h * 128 + e]); }
    __syncthreads();
    for (int i = tid; i < 64 * 64; i += NTHREADS) { const int t = i >> 6, d = i & 63; float s = BG[d];
#pragma unroll
        for (int r = 0; r < 16; ++r) s += GL[t * 16 + r] * WG[r * 64 + d];
        const float ls = fminf(s, 0.f) - log1pf(__expf(-fabsf(s)));
        BL[i] = ls * (1.f / 16.f); }
    __syncthreads();
    if (tid < 64) { float s = 0.f; for (int t = 0; t < 64; ++t) { s += BL[t * 64 + tid]; BL[t * 64 + tid] = s; } }
    __syncthreads();
    for (int i = tid; i < 64 * 64; i += NTHREADS) { const int t = i >> 6, d = i & 63; const float bb = BL[i], bl = BL[63 * 64 + d];
        const float q = bf2f(PROJ[(size_t)(tok0 + t) * NPROJ + CGQ + h * 64 + d]), k = bf2f(PROJ[(size_t)(tok0 + t) * NPROJ + CGK + h * 64 + d]);
        const float qd = q * 0.125f * __expf(bb);
        QD[i] = qd; KD[t * 65 + d] = k * __expf(-bb); KSt[i] = k * __expf(bl - bb);
        ((float*)(ws + WS_QD))[((size_t)(bh * 32 + n) * 64 + t) * 64 + d] = qd; }
    if (tid < 64) ((float*)(ws + WS_DEC))[(size_t)(bh * 32 + n) * 64 + tid] = __expf(BL[63 * 64 + tid]);
    __syncthreads();
    { const int c = tid >> 3, sg = tid & 7;
#pragma unroll
      for (int jj = 0; jj < 8; ++jj) { const int s = sg + 8 * jj; float a = 0.f;
          if (s <= c) { for (int d = 0; d < 64; ++d) a += QD[c * 64 + d] * KD[s * 65 + d]; }
          AT[c * 65 + s] = a; } }
    __syncthreads();
    { const int c = tid >> 3, eg = tid & 7;
      f32x4 o[4] = {(f32x4){0.f,0.f,0.f,0.f}, (f32x4){0.f,0.f,0.f,0.f}, (f32x4){0.f,0.f,0.f,0.f}, (f32x4){0.f,0.f,0.f,0.f}};
      for (int s = 0; s <= c; ++s) { const float a = AT[c * 65 + s]; const LAS f32x4* vp = (const LAS f32x4*)(V + s * 128 + eg * 16);
#pragma unroll
          for (int q = 0; q < 4; ++q) o[q] += a * vp[q]; }
      f32x4* dst = (f32x4*)((float*)(ws + WS_OI) + ((size_t)(bh * 32 + n) * 64 + c) * 128 + eg * 16);
#pragma unroll
      for (int q = 0; q < 4; ++q) dst[q] = o[q];
      const int d = c;
      f32x4 u[4] = {(f32x4){0.f,0.f,0.f,0.f}, (f32x4){0.f,0.f,0.f,0.f}, (f32x4){0.f,0.f,0.f,0.f}, (f32x4){0.f,0.f,0.f,0.f}};
      for (int s = 0; s < 64; ++s) { const float a = KSt[s * 64 + d]; const LAS f32x4* vp = (const LAS f32x4*)(V + s * 128 + eg * 16);
#pragma unroll
          for (int q = 0; q < 4; ++q) u[q] += a * vp[q]; }
      f32x4* du = (f32x4*)((float*)(ws + WS_U) + ((size_t)(bh * 32 + n) * 64 + d) * 128 + eg * 16);
#pragma unroll
      for (int q = 0; q < 4; ++q) du[q] = u[q]; }
    __syncthreads();
}

__device__ __forceinline__ void p3a_scan(const Params& p, int blk, int G) {
    unsigned char* ws = p.ws;
    for (int gid = blk * NTHREADS + threadIdx.x; gid < 64 * 64 * 32; gid += G * NTHREADS) {
        const int bh = gid >> 11, d = (gid >> 5) & 63, e4 = gid & 31;
        f32x4 s = (f32x4){0.f, 0.f, 0.f, 0.f};
        for (int n = 0; n < 32; ++n) {
            const size_t o = ((size_t)(bh * 32 + n) * 64 + d) * 128 + e4 * 4;
            *(f32x4*)((float*)(ws + WS_SP) + o) = s;
            const float dc = ((const float*)(ws + WS_DEC))[(size_t)(bh * 32 + n) * 64 + d];
            s = dc * s + *(const f32x4*)((const float*)(ws + WS_U) + o);
        }
    }
}

__device__ __forceinline__ void p4_unit(const Params& p, LAS unsigned char* lds, int unit) {
    const int tid = threadIdx.x;
    unsigned char* ws = p.ws;
    const bf16_t* PROJ = (const bf16_t*)(ws + WS_PROJ);
    const int n = unit & 31, h = (unit >> 5) & 3, b = unit >> 7;
    const int bh = b * 4 + h, tok0 = b * SEQ + n * 64;
    LAS float* QD = (LAS float*)lds;
    LAS float* SP = QD + 64 * 64;
    const size_t cb = (size_t)(bh * 32 + n);
    for (int i = tid; i < 64 * 64 / 4; i += NTHREADS) ((LAS f32x4*)QD)[i] = ((const f32x4*)((const float*)(ws + WS_QD) + cb * 4096))[i];
    for (int i = tid; i < 64 * 128 / 4; i += NTHREADS) ((LAS f32x4*)SP)[i] = ((const f32x4*)((const float*)(ws + WS_SP) + cb * 8192))[i];
    __syncthreads();
    const int c = tid >> 3, eg = tid & 7;
    const f32x4* oi = (const f32x4*)((const float*)(ws + WS_OI) + (cb * 64 + c) * 128 + eg * 16);
    f32x4 o[4];
#pragma unroll
    for (int q = 0; q < 4; ++q) o[q] = oi[q];
    for (int d = 0; d < 64; ++d) { const float a = QD[c * 64 + d]; const LAS f32x4* sp = (const LAS f32x4*)(SP + d * 128 + eg * 16);
#pragma unroll
        for (int q = 0; q < 4; ++q) o[q] += a * sp[q]; }
    float ss = 0.f;
#pragma unroll
    for (int q = 0; q < 4; ++q) ss += (o[q].x * o[q].x + o[q].y * o[q].y) + (o[q].z * o[q].z + o[q].w * o[q].w);
    ss += __shfl_xor(ss, 1); ss += __shfl_xor(ss, 2); ss += __shfl_xor(ss, 4);
    const float rstd = 1.f / sqrtf(ss * (1.f / 128.f) + EPS);
    const int t = tok0 + c;
    const bf16_t* rp = PROJ + (size_t)t * NPROJ + CGR + h * 128 + eg * 16;
    const float* gn = p.in[14] + eg * 16;
    unsigned outw[8];
#pragma unroll
    for (int q = 0; q < 4; ++q) {
        float y[4];
#pragma unroll
        for (int j = 0; j < 4; ++j) { const float r = bf2f(rp[q * 4 + j]); y[j] = o[q][j] * rstd * gn[q * 4 + j] * (r * sigmoidf_(r)); }
        outw[2 * q] = pk2(y[0], y[1]); outw[2 * q + 1] = pk2(y[2], y[3]);
    }
    u32x4* dst = (u32x4*)((bf16_t*)(ws + WS_ATT) + (size_t)t * 1024 + 512 + h * 128 + eg * 16);
    dst[0] = (u32x4){outw[0], outw[1], outw[2], outw[3]}; dst[1] = (u32x4){outw[4], outw[5], outw[6], outw[7]};
    __syncthreads();
}

constexpr int NSA_KT = 0, NSA_VT = 9216, NSA_PW = 18432, NSA_IMPW = 18432 + 8 * 4608, NSA_SELM = NSA_IMPW + 4 * 64 * 33 * 4, NSA_UNI = NSA_SELM + 256;
constexpr float NEGBIG = -1e30f;

__device__ __forceinline__ void nsa_qk(const bf16x8 (&aq)[2][2], const LAS bf16_t* KT, f32x4 (&S)[2][4], int fr, int fq) {
#pragma unroll
    for (int nf = 0; nf < 4; ++nf) {
        bf16x8 bk[2];
#pragma unroll
        for (int ks = 0; ks < 2; ++ks) bk[ks] = *(const LAS bf16x8*)(KT + (16 * nf + fr) * 72 + 32 * ks + 8 * fq);
#pragma unroll
        for (int m = 0; m < 2; ++m) { f32x4 s = (f32x4){0.f, 0.f, 0.f, 0.f};
#pragma unroll
            for (int ks = 0; ks < 2; ++ks) s = __builtin_amdgcn_mfma_f32_16x16x32_bf16(aq[m][ks], bk[ks], s, 0, 0, 0);
            S[m][nf] = s; }
    }
}
__device__ __forceinline__ void nsa_pv(const LAS bf16_t* PWw, const LAS bf16_t* VT, f32x4 (&O)[2][4], int fr, int fq) {
    bf16x8 ap[2][2];
#pragma unroll
    for (int m = 0; m < 2; ++m)
#pragma unroll
        for (int ks = 0; ks < 2; ++ks) ap[m][ks] = *(const LAS bf16x8*)(PWw + (16 * m + fr) * 72 + 32 * ks + 8 * fq);
#pragma unroll
    for (int nfd = 0; nfd < 4; ++nfd) {
        bf16x8 bv[2];
#pragma unroll
        for (int ks = 0; ks < 2; ++ks) bv[ks] = *(const LAS bf16x8*)(VT + (16 * nfd + fr) * 72 + 32 * ks + 8 * fq);
#pragma unroll
        for (int m = 0; m < 2; ++m)
#pragma unroll
            for (int ks = 0; ks < 2; ++ks) O[m][nfd] = __builtin_amdgcn_mfma_f32_16x16x32_bf16(ap[m][ks], bv[ks], O[m][nfd], 0, 0, 0);
    }
}
__device__ __forceinline__ float red16_max(float v) { v = fmaxf(v, __shfl_xor(v, 1)); v = fmaxf(v, __shfl_xor(v, 2)); v = fmaxf(v, __shfl_xor(v, 4)); v = fmaxf(v, __shfl_xor(v, 8)); return v; }
__device__ __forceinline__ float red16_sum(float v) { v += __shfl_xor(v, 1); v += __shfl_xor(v, 2); v += __shfl_xor(v, 4); v += __shfl_xor(v, 8); return v; }

__device__ __forceinline__ void nsa_tile(const bf16x8 (&aq)[2][2], const LAS bf16_t* KT, const LAS bf16_t* VT, LAS bf16_t* PWw, float (&mrow)[2][4], float (&lrow)[2][4], f32x4 (&O)[2][4],
                                         unsigned rowok, int mode, int ibase, int fr, int fq) {
    f32x4 S[2][4];
    nsa_qk(aq, KT, S, fr, fq);
#pragma unroll
    for (int m = 0; m < 2; ++m)
#pragma unroll
        for (int j = 0; j < 4; ++j) {
            const int i = ibase + 16 * m + 4 * fq + j;
            const bool rok = (rowok >> (m * 4 + j)) & 1u;
            bool ok[4]; float mx = NEGBIG;
#pragma unroll
            for (int nf = 0; nf < 4; ++nf) { const int key = 16 * nf + fr; ok[nf] = rok && (mode == 0 || (mode == 1 ? key <= i : key > i)); mx = fmaxf(mx, ok[nf] ? S[m][nf][j] : NEGBIG); }
            mx = red16_max(mx);
            const float mnew = fmaxf(mrow[m][j], mx);
            const float alpha = __expf(mrow[m][j] - mnew);
            float rs = 0.f;
#pragma unroll
            for (int nf = 0; nf < 4; ++nf) { const float pv = ok[nf] ? __expf(S[m][nf][j] - mnew) : 0.f; rs += pv; PWw[(16 * m + 4 * fq + j) * 72 + 16 * nf + fr] = (bf16_t)f2bf(pv); }
            rs = red16_sum(rs);
            lrow[m][j] = lrow[m][j] * alpha + rs; mrow[m][j] = mnew;
#pragma unroll
            for (int nfd = 0; nfd < 4; ++nfd) O[m][nfd][j] *= alpha;
        }
    LDS_WAIT();
    nsa_pv(PWw, VT, O, fr, fq);
}
__device__ __forceinline__ void nsa_load_tile(LAS bf16_t* T, const bf16_t* src, int row_stride, int tid) {
    const int r = tid >> 3, ch = tid & 7;
    *(LAS u32x4*)(T + r * 72 + 8 * ch) = *(const u32x4*)(src + (size_t)r * row_stride + 8 * ch);
}

__device__ __forceinline__ void nsa_unit(const Params& p, LAS unsigned char* lds, int b, int kh, int c) {
    const int tid = threadIdx.x, lane = tid & 63, w = tid >> 6, fr = lane & 15, fq = lane >> 4, g = w >> 1, ih = w & 1;
    unsigned char* ws = p.ws;
    const int hh = kh * 4 + g, tok0 = b * SEQ + 64 * c, ibase = 32 * ih;
    const bf16_t* PROJ = (const bf16_t*)(ws + WS_PROJ);
    LAS bf16_t* KT = (LAS bf16_t*)(lds + NSA_KT); LAS bf16_t* VT = (LAS bf16_t*)(lds + NSA_VT);
    LAS bf16_t* PWw = (LAS bf16_t*)(lds + NSA_PW + w * 4608);
    LAS float* IMPW = (LAS float*)(lds + NSA_IMPW);
    LAS unsigned* SELM = (LAS unsigned*)(lds + NSA_SELM); LAS unsigned* UNI = (LAS unsigned*)(lds + NSA_UNI);
    const size_t bk = (size_t)(b * 2 + kh);
    f32x4 oacc[2][4];
#pragma unroll
    for (int m = 0; m < 2; ++m)
#pragma unroll
        for (int nfd = 0; nfd < 4; ++nfd) oacc[m][nfd] = (f32x4){0.f, 0.f, 0.f, 0.f};
    bf16x8 aq[2][2];
    if (tid == 0) *UNI = 0u;
    {
#pragma unroll
        for (int m = 0; m < 2; ++m)
#pragma unroll
            for (int ks = 0; ks < 2; ++ks) aq[m][ks] = *(const bf16x8*)((const bf16_t*)(ws + WS_QN) + (size_t)(tok0 + ibase + 16 * m + fr) * 512 + hh * 64 + 32 * ks + 8 * fq);
        const int nh = (4 * c + 2 >= 64) ? 2 : 1;
        f32x4 S0[2][4], S1[2][4];
#pragma unroll
        for (int m = 0; m < 2; ++m)
#pragma unroll
            for (int nf = 0; nf < 4; ++nf) S1[m][nf] = (f32x4){0.f, 0.f, 0.f, 0.f};
        __syncthreads();
        nsa_load_tile(KT, (const bf16_t*)(ws + WS_KC) + bk * 128 * 64, 64, tid);
        __syncthreads();
        nsa_qk(aq, KT, S0, fr, fq);
        if (nh == 2) {
            __syncthreads();
            nsa_load_tile(KT, (const bf16_t*)(ws + WS_KC) + bk * 128 * 64 + 64 * 64, 64, tid);
            __syncthreads();
            nsa_qk(aq, KT, S1, fr, fq);
        }
#pragma unroll
        for (int m = 0; m < 2; ++m)
#pragma unroll
            for (int j = 0; j < 4; ++j) {
                const int i = ibase + 16 * m + 4 * fq + j;
                const int nmax = (64 * c + i - 31) >> 4;
                float mx = NEGBIG;
#pragma unroll
                for (int nf = 0; nf < 4; ++nf) { const int n0 = 16 * nf + fr; mx = fmaxf(mx, n0 <= nmax ? S0[m][nf][j] : NEGBIG); mx = fmaxf(mx, n0 + 64 <= nmax ? S1[m][nf][j] : NEGBIG); }
                mx = red16_max(mx);
                float rs = 0.f;
#pragma unroll
                for (int nf = 0; nf < 4; ++nf) { const int n0 = 16 * nf + fr;
                    const float p0 = n0 <= nmax ? __expf(S0[m][nf][j] - mx) : 0.f, p1 = n0 + 64 <= nmax ? __expf(S1[m][nf][j] - mx) : 0.f;
                    S0[m][nf][j] = p0; S1[m][nf][j] = p1; rs += p0 + p1; }
                rs = red16_sum(rs);
                const float inv = rs > 0.f ? 1.f / rs : 0.f;
#pragma unroll
                for (int nf = 0; nf < 4; ++nf) { S0[m][nf][j] *= inv; S1[m][nf][j] *= inv; }
            }
        const int qmax = (4 * c + 3) >> 4;
#pragma unroll
        for (int q = 0; q < 8; ++q) {
            if (q <= qmax) {
#pragma unroll
                for (int m = 0; m < 2; ++m)
#pragma unroll
                    for (int j = 0; j < 4; ++j) {
                        const float v = (q < 4) ? S0[m][q & 3][j] : S1[m][q & 3][j];
                        float s4 = v + __shfl_xor(v, 1); s4 += __shfl_xor(s4, 2);
                        const float e1 = __shfl(v, (lane + 63) & 63);
                        float e2 = 0.f;
                        if (q > 0) { const float pvv = (q - 1 < 4) ? S0[m][(q - 1) & 3][j] : S1[m][(q - 1) & 3][j]; e2 = __shfl(pvv, (lane + 15) & 63); }
                        const float extra = (fr == 0) ? e2 : e1;
                        if ((fr & 3) == 0) IMPW[(g * 64 + ibase + 16 * m + 4 * fq + j) * 33 + 4 * q + (fr >> 2)] = s4 + extra;
                    }
            }
        }
        f32x4 ocmp[2][4];
#pragma unroll
        for (int m = 0; m < 2; ++m)
#pragma unroll
            for (int nfd = 0; nfd < 4; ++nfd) ocmp[m][nfd] = (f32x4){0.f, 0.f, 0.f, 0.f};
        for (int half = 0; half < nh; ++half) {
#pragma unroll
            for (int m = 0; m < 2; ++m)
#pragma unroll
                for (int nf = 0; nf < 4; ++nf)
#pragma unroll
                    for (int j = 0; j < 4; ++j) PWw[(16 * m + 4 * fq + j) * 72 + 16 * nf + fr] = (bf16_t)f2bf(half ? S1[m][nf][j] : S0[m][nf][j]);
            __syncthreads();
            nsa_load_tile(VT, (const bf16_t*)(ws + WS_VCT) + bk * 64 * 128 + 64 * half, 128, tid);
            __syncthreads();
            nsa_pv(PWw, VT, ocmp, fr, fq);
        }
#pragma unroll
        for (int m = 0; m < 2; ++m)
#pragma unroll
            for (int j = 0; j < 4; ++j) { const int t = tok0 + ibase + 16 * m + 4 * fq + j; const float gt = sigmoidf_(bf2f(PROJ[(size_t)t * NPROJ + CGATE + hh * 3 + 0]));
#pragma unroll
                for (int nfd = 0; nfd < 4; ++nfd) oacc[m][nfd][j] += gt * ocmp[m][nfd][j]; }
    }
    __syncthreads();
    if (tid < 64) {
        const int i = tid;
        float sc[32];
#pragma unroll
        for (int j = 0; j < 32; ++j) {
            float v = NEGBIG;
            if (j <= c) { v = (IMPW[(0 * 64 + i) * 33 + j] + IMPW[(1 * 64 + i) * 33 + j]) + (IMPW[(2 * 64 + i) * 33 + j] + IMPW[(3 * 64 + i) * 33 + j]);
                if (j == 0 || j == c || j == c - 1) v += 1e4f; }
            sc[j] = v;
        }
        const int nsel = (c + 1 < 8) ? c + 1 : 8;
        unsigned taken = 0u;
        for (int r = 0; r < nsel; ++r) {
            float best = -3e38f; int bj = 0;
#pragma unroll
            for (int j = 0; j < 32; ++j) { const bool can = (j <= c) && !((taken >> j) & 1u); if (can && sc[j] > best) { best = sc[j]; bj = j; } }
            taken |= 1u << bj;
        }
        SELM[i] = taken;
        atomicOr((unsigned*)UNI, taken);
    }
    __syncthreads();
    unsigned selbits[2][4];
#pragma unroll
    for (int m = 0; m < 2; ++m)
#pragma unroll
        for (int j = 0; j < 4; ++j) selbits[m][j] = SELM[ibase + 16 * m + 4 * fq + j];
    const unsigned uni = *UNI;
#pragma unroll
    for (int m = 0; m < 2; ++m)
#pragma unroll
        for (int ks = 0; ks < 2; ++ks) aq[m][ks] = *(const bf16x8*)((const bf16_t*)(ws + WS_QR) + (size_t)(tok0 + ibase + 16 * m + fr) * 512 + hh * 64 + 32 * ks + 8 * fq);
#pragma unroll 1
    for (int br = 0; br < 2; ++br) {
        float mrow[2][4], lrow[2][4]; f32x4 O[2][4];
#pragma unroll
        for (int m = 0; m < 2; ++m) {
#pragma unroll
            for (int j = 0; j < 4; ++j) { mrow[m][j] = NEGBIG; lrow[m][j] = 0.f; }
#pragma unroll
            for (int nfd = 0; nfd < 4; ++nfd) O[m][nfd] = (f32x4){0.f, 0.f, 0.f, 0.f};
        }
        const bf16_t* Kb = (const bf16_t*)(ws + (br ? WS_KW : WS_KS)) + bk * SEQ * 64;
        const bf16_t* Vb = (const bf16_t*)(ws + (br ? WS_VWT : WS_VST)) + bk * 32 * 4096;
        const int j0 = br ? (c - 8 > 0 ? c - 8 : 0) : 0;
        for (int jb = j0; jb <= c; ++jb) {
            unsigned rowok; int mode;
            if (br == 0) {
                if (!((uni >> jb) & 1u)) continue;
                rowok = 0u;
#pragma unroll
                for (int m = 0; m < 2; ++m)
#pragma unroll
                    for (int j = 0; j < 4; ++j) rowok |= ((selbits[m][j] >> jb) & 1u) << (m * 4 + j);
                mode = (jb == c) ? 1 : 0;
            } else { rowok = 0xffu; mode = (jb == c) ? 1 : ((jb == c - 8) ? 2 : 0); }
            __syncthreads();
            nsa_load_tile(KT, Kb + (size_t)jb * 4096, 64, tid);
            nsa_load_tile(VT, Vb + (size_t)jb * 4096, 64, tid);
            __syncthreads();
            nsa_tile(aq, KT, VT, PWw, mrow, lrow, O, rowok, mode, ibase, fr, fq);
        }
#pragma unroll
        for (int m = 0; m < 2; ++m)
#pragma unroll
            for (int j = 0; j < 4; ++j) { const int t = tok0 + ibase + 16 * m + 4 * fq + j; const float gt = sigmoidf_(bf2f(PROJ[(size_t)t * NPROJ + CGATE + hh * 3 + 1 + br]));
                const float sc = lrow[m][j] > 0.f ? gt / lrow[m][j] : 0.f;
#pragma unroll
                for (int nfd = 0; nfd < 4; ++nfd) oacc[m][nfd][j] += sc * O[m][nfd][j]; }
    }
#pragma unroll
    for (int m = 0; m < 2; ++m)
#pragma unroll
        for (int j = 0; j < 4; ++j) { const int t = tok0 + ibase + 16 * m + 4 * fq + j; bf16_t* dst = (bf16_t*)(ws + WS_ATT) + (size_t)t * 1024 + hh * 64 + fr;
#pragma unroll
            for (int nfd = 0; nfd < 4; ++nfd) dst[16 * nfd] = (bf16_t)f2bf(oacc[m][nfd][j]); }
    __syncthreads();
}

__device__ __forceinline__ void p6_chunk(const Params& p, LAS unsigned char* lds, int chunk) {
    const int tid = threadIdx.x, lane = tid & 63, wave = tid >> 6;
    unsigned char* ws = p.ws;
    LAS int* lcnt = (LAS int*)lds;
    if (tid < NEXP) lcnt[tid] = 0;
    __syncthreads();
    const float* WRT = (const float*)(ws + WS_WRT);
    for (int ti = 0; ti < 16; ++ti) {
        const int t = chunk * 128 + wave * 16 + ti;
        const f32x4* xr = (const f32x4*)(p.out + (size_t)t * DM) + lane; const f32x4* gr = (const f32x4*)p.in[16] + lane;
        f32x4 v[4]; float s = 0.f;
#pragma unroll
        for (int j = 0; j < 4; ++j) { v[j] = xr[64 * j]; s += (v[j].x * v[j].x + v[j].y * v[j].y) + (v[j].z * v[j].z + v[j].w * v[j].w); }
        const float rstd = 1.f / sqrtf(wave_sum(s) * (1.f / DM) + EPS);
        unsigned long long* o8 = (unsigned long long*)((bf16_t*)(ws + WS_H) + (size_t)t * DM) + lane;
#pragma unroll
        for (int j = 0; j < 4; ++j) { const f32x4 gg = gr[64 * j]; const f32x4 o = v[j] * rstd * gg;
            o8[64 * j] = (unsigned long long)pk2(o.x, o.y) | ((unsigned long long)pk2(o.z, o.w) << 32); }
        const int myexp = (lane >> 1) & 31;
        float mylg = 0.f;
        { const f32x4* wr = (const f32x4*)WRT + lane;
#pragma unroll 2
          for (int e = 0; e < 32; ++e, wr += DM / 4) { float a = 0.f;
#pragma unroll
              for (int j = 0; j < 4; ++j) { const f32x4 wv = wr[64 * j]; a += (v[j].x * wv.x + v[j].y * wv.y) + (v[j].z * wv.z + v[j].w * wv.w); }
              a = wave_sum(a);
              if (e == myexp) mylg = a; } }
        mylg = mylg * rstd + p.in[18][myexp];
        float tv[4]; int te[4];
#pragma unroll
        for (int r = 0; r < 4; ++r) {
            float bv = mylg; int be = myexp;
#pragma unroll
            for (int o = 1; o < 64; o <<= 1) { const float ov = __shfl_xor(bv, o); const int oe = __shfl_xor(be, o); if (ov > bv || (ov == bv && oe < be)) { bv = ov; be = oe; } }
            tv[r] = bv; te[r] = be;
            if (myexp == be) mylg = -3e38f;
        }
        const float e0 = 1.f, e1 = __expf(tv[1] - tv[0]), e2 = __expf(tv[2] - tv[0]), e3 = __expf(tv[3] - tv[0]);
        const float inv = 1.f / (e0 + e1 + e2 + e3);
        if (lane == 0) {
            *(int4*)((int*)(ws + WS_TOPI) + (size_t)t * 4) = make_int4(te[0], te[1], te[2], te[3]);
            *(f32x4*)((float*)(ws + WS_TOPG) + (size_t)t * 4) = (f32x4){e0 * inv, e1 * inv, e2 * inv, e3 * inv};
            atomicAdd((int*)&lcnt[te[0]], 1); atomicAdd((int*)&lcnt[te[1]], 1); atomicAdd((int*)&lcnt[te[2]], 1); atomicAdd((int*)&lcnt[te[3]], 1);
        }
    }
    __syncthreads();
    if (tid < NEXP) atomicAdd((int*)(ws + WS_CTL) + CW_CNT + tid, lcnt[tid]);
    __syncthreads();
}

__device__ __forceinline__ int build_tile_table(const Params& p, LAS int* tstart, LAS int* tile_e) {
    const int tid = threadIdx.x;
    const int* cnt = (const int*)(p.ws + WS_CTL) + CW_CNT;
    if (tid == 0) { int acc = 0; for (int e = 0; e < NEXP; ++e) { tstart[e] = acc; acc += (__hip_atomic_load(cnt + e, __ATOMIC_RELAXED, __HIP_MEMORY_SCOPE_AGENT) + 255) >> 8; } tstart[NEXP] = acc; }
    __syncthreads();
    const int total = tstart[NEXP];
    for (int i = tid; i < total; i += NTHREADS) { int e = 0;
        for (int q = 1; q < NEXP; ++q) if (tstart[q] <= i) e = q;
        tile_e[i] = e; }
    __syncthreads();
    return total;
}

__device__ __forceinline__ void p7_chunk(const Params& p, LAS unsigned char* lds, int chunk, const LAS int* tstart) {
    const int tid = threadIdx.x, lane = tid & 63, wave = tid >> 6;
    unsigned char* ws = p.ws;
    LAS int* lc = (LAS int*)lds; LAS int* lbase = lc + 32; LAS int* ldst = lbase + 32;
    if (tid < NEXP) lc[tid] = 0;
    __syncthreads();
    const int t = chunk * 128 + (tid >> 2), k = tid & 3;
    const int e = ((const int*)(ws + WS_TOPI))[(size_t)t * 4 + k];
    const int rank = atomicAdd((int*)&lc[e], 1);
    __syncthreads();
    if (tid < NEXP) lbase[tid] = atomicAdd((int*)(ws + WS_CTL) + CW_FILL + tid, lc[tid]);
    __syncthreads();
    const int dest = tstart[e] * 256 + lbase[e] + rank;
    ((int*)(ws + WS_DEST))[(size_t)t * 4 + k] = dest;
    ldst[tid] = dest;
    __syncthreads();
    for (int ti = 0; ti < 16; ++ti) {
        const int tl = wave * 16 + ti, tt = chunk * 128 + tl;
        const u32x4* src = (const u32x4*)((const bf16_t*)(ws + WS_H) + (size_t)tt * DM) + lane;
        const u32x4 a = src[0], bq = src[64];
#pragma unroll
        for (int kk = 0; kk < 4; ++kk) { u32x4* dst = (u32x4*)((bf16_t*)(ws + WS_XS) + (size_t)ldst[tl * 4 + kk] * DM) + lane; dst[0] = a; dst[64] = bq; }
    }
    __syncthreads();
}

__device__ __forceinline__ void p10_token(const Params& p, int t, int lane) {
    unsigned char* ws = p.ws;
    const int4 d4 = *(const int4*)((const int*)(ws + WS_DEST) + (size_t)t * 4);
    const f32x4 g4 = *(const f32x4*)((const float*)(ws + WS_TOPG) + (size_t)t * 4);
    const int dd[4] = {d4.x, d4.y, d4.z, d4.w};
    f32x4* xr = (f32x4*)(p.out + (size_t)t * DM);
#pragma unroll
    for (int half = 0; half < 2; ++half) {
        f32x4 a0 = xr[half * 128 + lane * 2], a1 = xr[half * 128 + lane * 2 + 1];
#pragma unroll
        for (int k = 0; k < 4; ++k) {
            const u32x4 y = *((const u32x4*)((const bf16_t*)(ws + WS_Y) + (size_t)dd[k] * DM) + half * 64 + lane);
            const float gk = g4[k];
            a0.x += gk * __uint_as_float(y.x << 16); a0.y += gk * __uint_as_float(y.x & 0xffff0000u);
            a0.z += gk * __uint_as_float(y.y << 16); a0.w += gk * __uint_as_float(y.y & 0xffff0000u);
            a1.x += gk * __uint_as_float(y.z << 16); a1.y += gk * __uint_as_float(y.z & 0xffff0000u);
            a1.z += gk * __uint_as_float(y.w << 16); a1.w += gk * __uint_as_float(y.w & 0xffff0000u);
        }
        xr[half * 128 + lane * 2] = a0; xr[half * 128 + lane * 2 + 1] = a1;
    }
}

template <int ph> __device__ __forceinline__ void mk_phase(const Params& p, LAS unsigned char* lds, int blk, int G) {
    unsigned char* ws = p.ws;
    const int tid = threadIdx.x;
    if constexpr (ph == 0) { phase0(p, lds, blk, G); }
    else if constexpr (ph == 1) {
        pg8::Gemm g{(const bf16_t*)(ws + WS_H), (const bf16_t*)(ws + WS_WIN), DM};
        pg8::StaticOrder S{MTOK / 256, NPROJ / 256, G, blk};
        pg8::EpiBf16 E{(bf16_t*)(ws + WS_PROJ), NPROJ};
        pg8::gemm_phase(lds, g, S, E);
    }
    else if constexpr (ph == 2) {
        for (int u = blk; u < 128 + 2048 + 512; u += G) {
            if (u < 128) p2b_unit(p, lds, u);
            else if (u < 128 + 2048) p2c_unit(p, lds, u - 128);
            else p2a_unit(p, lds, u - 128 - 2048);
        }
    }
    else if constexpr (ph == 3) {
        p3a_scan(p, blk, G);
        for (int r = 0; r * G < 1024; ++r) {
            const int u = r * G + ((r & 1) ? (G - 1 - blk) : blk);
            if (u >= 1024) continue;
            const int c = 31 - (u >> 5), bkh = u & 31;
            nsa_unit(p, lds, bkh >> 1, bkh & 1, c);
        }
    }
    else if constexpr (ph == 4) { for (int u = blk; u < 2048; u += G) p4_unit(p, lds, u); }
    else if constexpr (ph == 5) {
        pg8::Gemm g{(const bf16_t*)(ws + WS_ATT), (const bf16_t*)(ws + WS_WOUT), DM};
        pg8::StaticOrder S{MTOK / 256, DM / 256, G, blk};
        pg8::EpiResF32 E{p.in[0], p.out, DM};
        pg8::gemm_phase(lds, g, S, E);
    }
    else if constexpr (ph == 6) { for (int ch = blk; ch < MTOK / 128; ch += G) p6_chunk(p, lds, ch); }
    else if constexpr (ph == 7) {
        LAS int* tstart = (LAS int*)(lds + 8192); LAS int* tile_e = tstart + 64;
        build_tile_table(p, tstart, tile_e);
        for (int ch = blk; ch < MTOK / 128; ch += G) p7_chunk(p, lds, ch, tstart);
    }
    else if constexpr (ph == 8) {
        LAS int* tstart = (LAS int*)(lds + pg8::STAGE_BYTES); LAS int* tile_e = tstart + 64;
        const int total = build_tile_table(p, tstart, tile_e);
        pg8::Gemm g{(const bf16_t*)(ws + WS_XS), (const bf16_t*)(ws + WS_WGU), DM};
        pg8::MoeOrder S{total, 8, G, blk, tile_e};
        pg8::EpiSwiglu E{(bf16_t*)(ws + WS_ACT), p.in[20], 8};
        pg8::gemm_phase(lds, g, S, E);
    }
    else if constexpr (ph == 9) {
        LAS int* tstart = (LAS int*)(lds + pg8::STAGE_BYTES); LAS int* tile_e = tstart + 64;
        const int total = build_tile_table(p, tstart, tile_e);
        pg8::Gemm g{(const bf16_t*)(ws + WS_ACT), (const bf16_t*)(ws + WS_WD), DFF};
        pg8::MoeOrder S{total, 4, G, blk, tile_e};
        pg8::EpiDown E{(bf16_t*)(ws + WS_Y), p.in[22], 4};
        pg8::gemm_phase(lds, g, S, E);
    }
    else if constexpr (ph == 10) { for (int t = blk * 8 + (tid >> 6); t < MTOK; t += G * 8) p10_token(p, t, tid & 63); }
}

constexpr int NPHASES = 11;

template <int PH> __global__ void __launch_bounds__(NTHREADS, 2) mk_one(Params p) {
    extern __shared__ __attribute__((aligned(16))) unsigned char lds_raw[];
    mk_phase<PH>(p, (LAS unsigned char*)lds_raw, blockIdx.x, gridDim.x);
}
#if MK_ONE_LAUNCH
#define MK_RUN(PH) mk_phase<PH>(p, lds, blk, G)
__global__ void __launch_bounds__(NTHREADS, 2) mk_fwd(Params p) {
    extern __shared__ __attribute__((aligned(16))) unsigned char lds_raw[];
    LAS unsigned char* lds = (LAS unsigned char*)lds_raw;
    const int blk = blockIdx.x, G = gridDim.x;
    cg::grid_group grid = cg::this_grid();
    MK_RUN(0); grid.sync(); MK_RUN(1); grid.sync(); MK_RUN(2); grid.sync(); MK_RUN(3); grid.sync(); MK_RUN(4); grid.sync(); MK_RUN(5); grid.sync();
    MK_RUN(6); grid.sync(); MK_RUN(7); grid.sync(); MK_RUN(8); grid.sync(); MK_RUN(9); grid.sync(); MK_RUN(10);
}
#endif

extern "C" void kernel_launch(void* const* d_in, const int* in_sizes, int n_in, void* d_out, int out_size, void* d_ws, size_t ws_size, hipStream_t stream) {
    static int grid = 0;
    if (grid == 0) {
        int dev = 0, cus = 0, per_cu = 0;
        (void)hipGetDevice(&dev);
        (void)hipDeviceGetAttribute(&cus, hipDeviceAttributeMultiprocessorCount, dev);
#if MK_ONE_LAUNCH
        (void)hipFuncSetAttribute((const void*)mk_fwd, hipFuncAttributeMaxDynamicSharedMemorySize, LDS_BYTES);
        (void)hipOccupancyMaxActiveBlocksPerMultiprocessor(&per_cu, (const void*)mk_fwd, NTHREADS, LDS_BYTES);
#else
#define MK_ATTR(PH) (void)hipFuncSetAttribute((const void*)mk_one<PH>, hipFuncAttributeMaxDynamicSharedMemorySize, LDS_BYTES)
        MK_ATTR(0); MK_ATTR(1); MK_ATTR(2); MK_ATTR(3); MK_ATTR(4); MK_ATTR(5); MK_ATTR(6); MK_ATTR(7); MK_ATTR(8); MK_ATTR(9); MK_ATTR(10);
        per_cu = 1;
#endif
        if (per_cu < 1) { fprintf(stderr, "kernel_launch: occupancy query reports %d blocks/CU\n", per_cu); per_cu = 1; }
        grid = cus;
        if (ws_size < WS_END) { fprintf(stderr, "kernel_launch: workspace too small (%zu < %zu)\n", ws_size, (size_t)WS_END); grid = -1; }
        (void)hipGetLastError();
    }
    if (grid < 0) return;
    (void)hipMemsetAsync((char*)d_ws + WS_CTL, 0, 4096, stream);
    Params p{};
    for (int i = 0; i < 23; ++i) p.in[i] = (const float*)d_in[i];
    p.out = (float*)d_out; p.ws = (unsigned char*)d_ws;
#if MK_ONE_LAUNCH
    void* args[] = {&p};
    hipError_t e = hipLaunchCooperativeKernel((const void*)mk_fwd, dim3(grid), dim3(NTHREADS), args, LDS_BYTES, stream);
    if (e != hipSuccess) fprintf(stderr, "cooperative launch failed: %s (grid %d)\n", hipGetErrorString(e), grid);
#else
#define MK_LAUNCH(PH) hipLaunchKernelGGL(mk_one<PH>, dim3(grid), dim3(NTHREADS), LDS_BYTES, stream, p)
    MK_LAUNCH(0); MK_LAUNCH(1); MK_LAUNCH(2); MK_LAUNCH(3); MK_LAUNCH(4); MK_LAUNCH(5); MK_LAUNCH(6); MK_LAUNCH(7); MK_LAUNCH(8); MK_LAUNCH(9); MK_LAUNCH(10);
#endif
}
```

```cpp
#include <hip/hip_runtime.h>
#include <hip/hip_cooperative_groups.h>
#include <cstdint>
#include <cstdio>
namespace cg = cooperative_groups;

#ifndef MK_ONE_LAUNCH
#define MK_ONE_LAUNCH 1
#endif

#define LAS __attribute__((address_space(3)))
typedef unsigned short bf16_t;
typedef short bf16x8 __attribute__((ext_vector_type(8)));
typedef float f32x4 __attribute__((ext_vector_type(4)));
typedef float f32x2 __attribute__((ext_vector_type(2)));
typedef unsigned u32x4 __attribute__((ext_vector_type(4)));
typedef unsigned u32x2 __attribute__((ext_vector_type(2)));

constexpr int NB = 16, SEQ = 2048, DM = 1024, MTOK = NB * SEQ;
constexpr int NPROJ = 3072;
constexpr int CQ = 0, CKC = 512, CVC = 640, CKS = 768, CVS = 896, CKW = 1024, CVW = 1152, CGQ = 1280, CGK = 1536, CGV = 1792, CGR = 2304, CGATE = 2816, CGLR = 2840;
constexpr int NEXP = 32, DFF = 1024;
constexpr int MAXTILES = 544, XROWS = MAXTILES * 256;
constexpr float EPS = 1e-6f;
constexpr int NTHREADS = 512;
constexpr int LDS_BYTES = 160 * 1024;

constexpr size_t MiB = 1u << 20;
constexpr size_t WS_CTL = 0;
constexpr size_t WS_WIN = 2 * MiB;
constexpr size_t WS_WOUT = 8 * MiB;
constexpr size_t WS_CW1K = 10 * MiB, WS_CW1V = 11 * MiB;
constexpr size_t WS_CW2K = 12 * MiB, WS_CW2V = 12 * MiB + 512 * 1024;
constexpr size_t WS_CBIAS = 13 * MiB;
constexpr size_t WS_WRT = 13 * MiB + 512 * 1024;
constexpr size_t WS_WGU = 16 * MiB;
constexpr size_t WS_WD = 144 * MiB;
constexpr size_t WS_H = 208 * MiB;
constexpr size_t WS_PROJ = 272 * MiB;
constexpr size_t WS_QN = 464 * MiB, WS_QR = 496 * MiB;
constexpr size_t WS_KS = 528 * MiB, WS_KW = 536 * MiB;
constexpr size_t WS_VST = 544 * MiB, WS_VWT = 552 * MiB;
constexpr size_t WS_KC = 560 * MiB, WS_VCT = 561 * MiB;
constexpr size_t WS_U = 562 * MiB;
constexpr size_t WS_OI = 626 * MiB;
constexpr size_t WS_QD = 690 * MiB;
constexpr size_t WS_DEC = 722 * MiB;
constexpr size_t WS_SP = 723 * MiB;
constexpr size_t WS_ATT = 787 * MiB;
constexpr size_t WS_TOPI = 851 * MiB, WS_TOPG = 852 * MiB, WS_DEST = 853 * MiB;
constexpr size_t WS_XS = 272 * MiB;
constexpr size_t WS_ACT = 544 * MiB;
constexpr size_t WS_Y = 272 * MiB;
constexpr size_t WS_END = 854 * MiB;
constexpr int CW_CNT = 0, CW_FILL = 64;

struct Params {
    const float* in[23];
    float* out;
    unsigned char* ws;
};

__device__ __forceinline__ float bf2f(bf16_t v) { return __uint_as_float(((unsigned)v) << 16); }
__device__ __forceinline__ unsigned f2bf(float f) { unsigned u = __float_as_uint(f); return (u + 0x7fffu + ((u >> 16) & 1u)) >> 16; }
__device__ __forceinline__ unsigned pk2(float lo, float hi) { return f2bf(lo) | (f2bf(hi) << 16); }
__device__ __forceinline__ float wave_sum(float v) {
#pragma unroll
    for (int o = 1; o < 64; o <<= 1) v += __shfl_xor(v, o);
    return v;
}
#define LDS_WAIT() asm volatile("s_waitcnt lgkmcnt(0)" ::: "memory")
__device__ __forceinline__ float sigmoidf_(float x) { return 1.f / (1.f + __expf(-x)); }

namespace pg8 {
constexpr int BM = 256, BK = 64, HALF = 128, HTB = HALF * BK * 2, STAGE_BYTES = 8 * HTB, NXCD = 8, WGM = 8;
__device__ __forceinline__ int lds_byte(int r, int c) { const int st = (r >> 4) * 2 + (c >> 5), rr = r & 15, cc = c & 31, ob = rr * 64 + cc * 2; return st * 1024 + (ob ^ (((ob >> 9) & 1) << 5)); }
__device__ __forceinline__ void stage_rc(int b, int& R, int& C) { const int st = b / 1024, sb = b % 1024, swz = sb ^ (((sb >> 9) & 1) << 5); R = (st >> 1) * 16 + swz / 64; C = (st & 1) * 32 + (swz % 64) / 2; }
__device__ __forceinline__ int perm32(int rho) { const int n = rho >> 4, i = rho & 15; return 8 * (i >> 2) + 4 * n + (i & 3); }

struct Unit { int pm, pn, pb; };
struct Gemm { const bf16_t* A; const bf16_t* Bt; int K; };

__device__ __forceinline__ bool order_next(long L, int nM, int nN, int& pm, int& pn) {
    const int nwg = nM * nN; if (L >= nwg) return false;
    int wgid = (int)L; { const int q = nwg / NXCD, r = nwg % NXCD, xcd = wgid % NXCD, off = wgid / NXCD; wgid = (xcd < r ? xcd * (q + 1) : r * (q + 1) + (xcd - r) * q) + off; }
    const int nig = WGM * nN, gid = wgid / nig, fm = gid * WGM, gsz = (nM - fm) < WGM ? (nM - fm) : WGM;
    pm = fm + ((wgid % nig) % gsz); pn = (wgid % nig) / gsz; return true;
}
struct StaticOrder {
    int nM, nN, G, c;
    __device__ __forceinline__ bool next(int i, Unit& u) const { if (!order_next((long)i * G + c, nM, nN, u.pm, u.pn)) return false; u.pb = u.pn; return true; }
};
struct MoeOrder {
    int nM, nN, G, c; const LAS int* tile_e;
    __device__ __forceinline__ bool next(int i, Unit& u) const { if (!order_next((long)i * G + c, nM, nN, u.pm, u.pn)) return false; u.pb = tile_e[u.pm] * nN + u.pn; return true; }
};

__device__ __forceinline__ unsigned cvt_pk_bf16(float lo, float hi) { unsigned r; asm volatile("v_cvt_pk_bf16_f32 %0, %1, %2" : "=v"(r) : "v"(lo), "v"(hi)); return r; }

struct EpiBf16 {
    static constexpr bool PERM = true;
    bf16_t* O; int ldc;
    __device__ __forceinline__ void operator()(const f32x4 (&acc)[2][2][4][2], const Unit& u, int wr, int wc, int fr, int fq) const {
        const int row0 = u.pm * BM + wr * 64 + fr, col0 = u.pn * BM + wc * 32 + 8 * fq;
#pragma unroll
        for (int ai = 0; ai < 2; ++ai)
#pragma unroll
            for (int m = 0; m < 4; ++m) { bf16_t* rowp = O + (size_t)(row0 + ai * HALF + m * 16) * ldc + col0;
#pragma unroll
                for (int bj = 0; bj < 2; ++bj) { const f32x4 v0 = acc[ai][bj][m][0], v1 = acc[ai][bj][m][1];
                    u32x4 w; w.x = cvt_pk_bf16(v0[0], v0[1]); w.y = cvt_pk_bf16(v0[2], v0[3]); w.z = cvt_pk_bf16(v1[0], v1[1]); w.w = cvt_pk_bf16(v1[2], v1[3]);
                    *(u32x4*)(rowp + bj * HALF) = w; } }
    }
};
struct EpiResF32 {
    static constexpr bool PERM = false;
    const float* base; float* out; int ldc;
    __device__ __forceinline__ void operator()(const f32x4 (&acc)[2][2][4][2], const Unit& u, int wr, int wc, int fr, int fq) const {
        const int col0 = u.pn * BM + wc * 32 + 4 * fq;
#pragma unroll
        for (int ai = 0; ai < 2; ++ai)
#pragma unroll
            for (int m = 0; m < 4; ++m) { const size_t off = (size_t)(u.pm * BM + ai * HALF + wr * 64 + m * 16 + fr) * ldc + col0;
#pragma unroll
                for (int bj = 0; bj < 2; ++bj)
#pragma unroll
                    for (int n = 0; n < 2; ++n) { const f32x4 bs = *(const f32x4*)(base + off + bj * HALF + n * 16); *(f32x4*)(out + off + bj * HALF + n * 16) = bs + acc[ai][bj][m][n]; } }
    }
};
struct EpiSwiglu {
    static constexpr bool PERM = true;
    bf16_t* O; const float* bias; int nN;
    __device__ __forceinline__ void operator()(const f32x4 (&acc)[2][2][4][2], const Unit& u, int wr, int wc, int fr, int fq) const {
        const int e = u.pb / nN;
        const int row0 = u.pm * BM + wr * 64 + fr, ch = u.pn * HALF + wc * 32 + 8 * fq;
        const float* bg = bias + (size_t)e * 2048 + ch; const float* bl = bg + 1024;
        const f32x4 bg0 = *(const f32x4*)bg, bg1 = *(const f32x4*)(bg + 4), bl0 = *(const f32x4*)bl, bl1 = *(const f32x4*)(bl + 4);
#pragma unroll
        for (int ai = 0; ai < 2; ++ai)
#pragma unroll
            for (int m = 0; m < 4; ++m) {
                float r[8];
#pragma unroll
                for (int n = 0; n < 2; ++n)
#pragma unroll
                    for (int j = 0; j < 4; ++j) {
                        float gv = acc[ai][0][m][n][j] + (n ? bg1[j] : bg0[j]);
                        float lv = acc[ai][1][m][n][j] + (n ? bl1[j] : bl0[j]);
                        gv = fminf(gv, 7.0f); lv = fminf(fmaxf(lv, -7.0f), 7.0f);
                        r[n * 4 + j] = gv * (1.f / (1.f + __expf(-1.702f * gv))) * (lv + 1.0f);
                    }
                u32x4 w; w.x = cvt_pk_bf16(r[0], r[1]); w.y = cvt_pk_bf16(r[2], r[3]); w.z = cvt_pk_bf16(r[4], r[5]); w.w = cvt_pk_bf16(r[6], r[7]);
                *(u32x4*)(O + (size_t)(row0 + ai * HALF + m * 16) * DFF + ch) = w;
            }
    }
};
struct EpiDown {
    static constexpr bool PERM = true;
    bf16_t* O; const float* bias; int nN;
    __device__ __forceinline__ void operator()(const f32x4 (&acc)[2][2][4][2], const Unit& u, int wr, int wc, int fr, int fq) const {
        const int e = u.pb / nN;
        const int row0 = u.pm * BM + wr * 64 + fr, col0 = u.pn * BM + wc * 32 + 8 * fq;
        const float* bp = bias + (size_t)e * 1024 + col0;
        f32x4 bv[2][2];
#pragma unroll
        for (int bj = 0; bj < 2; ++bj)
#pragma unroll
            for (int n = 0; n < 2; ++n) bv[bj][n] = *(const f32x4*)(bp + bj * HALF + 4 * n);
#pragma unroll
        for (int ai = 0; ai < 2; ++ai)
#pragma unroll
            for (int m = 0; m < 4; ++m) { bf16_t* rowp = O + (size_t)(row0 + ai * HALF + m * 16) * 1024 + col0;
#pragma unroll
                for (int bj = 0; bj < 2; ++bj) { const f32x4 v0 = acc[ai][bj][m][0] + bv[bj][0], v1 = acc[ai][bj][m][1] + bv[bj][1];
                    u32x4 w; w.x = cvt_pk_bf16(v0[0], v0[1]); w.y = cvt_pk_bf16(v0[2], v0[3]); w.z = cvt_pk_bf16(v1[0], v1[1]); w.w = cvt_pk_bf16(v1[2], v1[3]);
                    *(u32x4*)(rowp + bj * HALF) = w; } }
    }
};

template <class Epi, class Sched>
__device__ __forceinline__ void gemm_phase(LAS unsigned char* lds, const Gemm g, const Sched& S, const Epi& E) {
    const int tid = threadIdx.x, wid = __builtin_amdgcn_readfirstlane(tid >> 6), lane = tid & 63, wr = wid >> 2, wc = wid & 3, fr = lane & 15, fq = lane >> 4;
    const int K = g.K, nt = K / BK;
    unsigned voffA[2], voffB[2];
#pragma unroll
    for (int i = 0; i < 2; ++i) { int R, C; stage_rc(tid * 16 + i * 8192, R, C); const int Rb = Epi::PERM ? ((R & ~31) + perm32(R & 31)) : R;
        voffA[i] = (unsigned)(R * K + C) * 2u; voffB[i] = (unsigned)(Rb * K + C) * 2u; }
    const size_t kstep = (size_t)(BK * 2);
    const size_t hstep = (size_t)HALF * K * 2;
    const size_t tstep = 2 * hstep;
    const unsigned ldsw = (unsigned)wid * 1024u;
    const int aoff = lds_byte(wr * 64 + fr, fq * 8), boff = lds_byte(wc * 32 + fr, fq * 8);
#define PG8_SA(b, h) (((b) * 2 + (h)) * HTB)
#define PG8_SB(b, h) ((4 + (b) * 2 + (h)) * HTB)
#define PG8_STAGE(bufoff, gbase, voff) do { _Pragma("unroll") for (int _i = 0; _i < 2; ++_i) \
        __builtin_amdgcn_global_load_lds((const unsigned*)((const char*)(gbase) + (voff)[_i]), (LAS unsigned*)(lds + (bufoff) + ldsw + _i * 8192), 16, 0, 0); } while (0)
#define PG8_LDA(dst, b, h) do { _Pragma("unroll") for (int m = 0; m < 4; ++m) _Pragma("unroll") for (int k = 0; k < 2; ++k) dst[m][k] = *(const LAS bf16x8*)(lds + PG8_SA(b, h) + aoff + m * 2048 + k * 1024); } while (0)
#define PG8_LDB(dst, b, h) do { _Pragma("unroll") for (int n = 0; n < 2; ++n) _Pragma("unroll") for (int k = 0; k < 2; ++k) dst[n][k] = *(const LAS bf16x8*)(lds + PG8_SB(b, h) + boff + n * 2048 + k * 1024); } while (0)
#define PG8_MMA(ai, bj, At, Bt) do { __builtin_amdgcn_s_setprio(1); _Pragma("unroll") for (int m = 0; m < 4; ++m) _Pragma("unroll") for (int n = 0; n < 2; ++n) _Pragma("unroll") for (int k = 0; k < 2; ++k) \
        acc[ai][bj][m][n] = __builtin_amdgcn_mfma_f32_16x16x32_bf16(Bt[n][k], At[m][k], acc[ai][bj][m][n], 0, 0, 0); __builtin_amdgcn_s_setprio(0); } while (0)
#define PG8_WAIT_V(n) asm volatile("s_waitcnt vmcnt(" #n ")" ::: "memory")
#define PG8_WAIT_L(n) asm volatile("s_waitcnt lgkmcnt(" #n ")" ::: "memory")
#define PG8_BAR __builtin_amdgcn_s_barrier()
#define PG8_SCHED __builtin_amdgcn_sched_barrier(0)
    Unit cur, nxt; int ui = 0;
    if (!S.next(0, cur)) return;
    f32x4 acc[2][2][4][2];
#pragma unroll
    for (int a = 0; a < 2; ++a)
#pragma unroll
        for (int b = 0; b < 2; ++b)
#pragma unroll
            for (int m = 0; m < 4; ++m)
#pragma unroll
                for (int n = 0; n < 2; ++n) acc[a][b][m][n] = (f32x4){0.f, 0.f, 0.f, 0.f};
    bf16x8 At[4][2], B0[2][2], B1[2][2];
    const char* cA = (const char*)g.A + (size_t)cur.pm * tstep; const char* cB = (const char*)g.Bt + (size_t)cur.pb * tstep;
    {
        PG8_STAGE(PG8_SB(0, 0), cB, voffB); PG8_STAGE(PG8_SB(0, 1), cB + hstep, voffB); PG8_STAGE(PG8_SA(0, 0), cA, voffA); PG8_STAGE(PG8_SA(0, 1), cA + hstep, voffA);
        if (wr == 1) PG8_BAR;
        PG8_WAIT_V(2); PG8_BAR;
        PG8_STAGE(PG8_SB(1, 0), cB + kstep, voffB); PG8_STAGE(PG8_SA(1, 0), cA + kstep, voffA); PG8_STAGE(PG8_SB(1, 1), cB + hstep + kstep, voffB);
        PG8_WAIT_V(6); PG8_BAR;
    }
    for (;;) {
        const bool has_next = S.next(ui + 1, nxt);
        const char* nA = has_next ? (const char*)g.A + (size_t)nxt.pm * tstep : cA; const char* nB = has_next ? (const char*)g.Bt + (size_t)nxt.pb * tstep : cB;
        for (int t = 0; t < nt; t += 2) {
            const bool last = (t == nt - 2);
            const char* a1 = cA + (size_t)(t + 1) * kstep;
            const char* a2 = last ? nA : cA + (size_t)(t + 2) * kstep; const char* b2 = last ? nB : cB + (size_t)(t + 2) * kstep;
            const char* a3 = a2 + kstep; const char* b3 = b2 + kstep;
            PG8_LDB(B0, 0, 0); PG8_LDB(B1, 0, 1); PG8_SCHED; PG8_LDA(At, 0, 0); PG8_STAGE(PG8_SA(1, 1), a1 + hstep, voffA);
            PG8_WAIT_V(8); PG8_WAIT_L(0); PG8_BAR; PG8_MMA(0, 0, At, B0); PG8_MMA(0, 1, At, B1); PG8_BAR; PG8_SCHED;
            PG8_LDA(At, 0, 1); PG8_STAGE(PG8_SB(0, 0), b2, voffB); PG8_STAGE(PG8_SB(0, 1), b2 + hstep, voffB); PG8_STAGE(PG8_SA(0, 0), a2, voffA);
            PG8_WAIT_V(8); PG8_WAIT_L(0); PG8_BAR; PG8_MMA(1, 0, At, B0); PG8_MMA(1, 1, At, B1); PG8_BAR; PG8_SCHED;
            PG8_LDB(B0, 1, 0); PG8_LDB(B1, 1, 1); PG8_SCHED; PG8_LDA(At, 1, 0); PG8_STAGE(PG8_SA(0, 1), a2 + hstep, voffA);
            PG8_WAIT_V(8); PG8_WAIT_L(0); PG8_BAR; PG8_MMA(0, 0, At, B0); PG8_MMA(0, 1, At, B1); PG8_BAR; PG8_SCHED;
            PG8_LDA(At, 1, 1); PG8_STAGE(PG8_SB(1, 0), b3, voffB); PG8_STAGE(PG8_SB(1, 1), b3 + hstep, voffB); PG8_STAGE(PG8_SA(1, 0), a3, voffA);
            PG8_WAIT_V(8); PG8_WAIT_L(0); PG8_BAR; PG8_MMA(1, 0, At, B0); PG8_MMA(1, 1, At, B1); PG8_BAR; PG8_SCHED;
        }
        if (wr == 0) PG8_BAR;
        E(acc, cur, wr, wc, fr, fq);
        if (!has_next) break;
#pragma unroll
        for (int a = 0; a < 2; ++a)
#pragma unroll
            for (int b = 0; b < 2; ++b)
#pragma unroll
                for (int m = 0; m < 4; ++m)
#pragma unroll
                    for (int n = 0; n < 2; ++n) acc[a][b][m][n] = (f32x4){0.f, 0.f, 0.f, 0.f};
        cur = nxt; cA = nA; cB = nB; ++ui;
        if (wr == 1) PG8_BAR;
    }
    PG8_WAIT_V(0);
    PG8_BAR;
#undef PG8_SA
#undef PG8_SB
#undef PG8_STAGE
#undef PG8_LDA
#undef PG8_LDB
#undef PG8_MMA
#undef PG8_WAIT_V
#undef PG8_WAIT_L
#undef PG8_BAR
#undef PG8_SCHED
}
}

__device__ __forceinline__ int win_map(int n) {
    if (n < 1280) return n;
    if (n < 2304) return n + 24;
    if (n < 2816) return n + 40;
    if (n < 2840) return n - 1536;
    if (n < 2856) return n - 512;
    return -1;
}
template <int MODE> __device__ __forceinline__ int colmap(int r) {
    if (MODE == 1) return win_map(r);
    if (MODE == 2) return ((r >> 7) & 1) * 1024 + (r >> 8) * 128 + (r & 127);
    return r;
}
template <int MODE>
__device__ __forceinline__ void transpose_item(const float* W, int K, int Nsrc, bf16_t* WT, int nblk, LAS float* scr, int item, int lane) {
    const int kb = item / nblk, nb = item % nblk, k0 = 64 * kb, n0 = 32 * nb;
    const int sc = colmap<MODE>(n0 + (lane & 31));
#pragma unroll 8
    for (int i = 0; i < 32; ++i) { const int kk = 2 * i + (lane >> 5); scr[kk * 33 + (lane & 31)] = sc >= 0 ? W[(size_t)(k0 + kk) * Nsrc + sc] : 0.f; }
    LDS_WAIT();
    const int c = lane & 7;
#pragma unroll
    for (int j = 0; j < 4; ++j) { const int n = (lane >> 3) + 8 * j; const LAS float* s = scr + (8 * c) * 33 + n;
        u32x4 o; o.x = pk2(s[0 * 33], s[1 * 33]); o.y = pk2(s[2 * 33], s[3 * 33]); o.z = pk2(s[4 * 33], s[5 * 33]); o.w = pk2(s[6 * 33], s[7 * 33]);
        *(u32x4*)(WT + (size_t)(n0 + n) * K + k0 + 8 * c) = o; }
    LDS_WAIT();
}
__device__ __forceinline__ void rms_row_to_bf16(const float* xrow, const float* g, bf16_t* orow, int lane) {
    const f32x4* xr = (const f32x4*)xrow + lane; const f32x4* gr = (const f32x4*)g + lane;
    f32x4 v[4]; float s = 0.f;
#pragma unroll
    for (int j = 0; j < 4; ++j) { v[j] = xr[64 * j]; s += (v[j].x * v[j].x + v[j].y * v[j].y) + (v[j].z * v[j].z + v[j].w * v[j].w); }
    const float rstd = 1.f / sqrtf(wave_sum(s) * (1.f / DM) + EPS);
    unsigned long long* o8 = (unsigned long long*)orow + lane;
#pragma unroll
    for (int j = 0; j < 4; ++j) { const f32x4 gg = gr[64 * j]; const f32x4 o = v[j] * rstd * gg;
        o8[64 * j] = (unsigned long long)pk2(o.x, o.y) | ((unsigned long long)pk2(o.z, o.w) << 32); }
}
__device__ __forceinline__ void phase0(const Params& p, LAS unsigned char* lds, int blk, int G) {
    const int tid = threadIdx.x, lane = tid & 63, wave = tid >> 6;
    LAS float* scr = (LAS float*)(lds + wave * 16384);
    const int gw = blk * 8 + wave, NGW = G * 8;
    unsigned char* ws = p.ws;
    constexpr int I_GU = 16 * 64, I_DN = 16 * 32;
    constexpr int N_GU = NEXP * I_GU, N_DN = NEXP * I_DN, N_IN = 16 * (NPROJ / 32), N_OUT = 16 * 32, N_C1 = 32 * 8, N_C2 = 4 * 2;
    constexpr int NITEMS = N_GU + N_DN + N_IN + N_OUT + 2 * N_C1 + 2 * N_C2;
    for (int it = gw; it < NITEMS; it += NGW) {
        int r = it;
        if (r < N_GU) { const int e = r / I_GU; transpose_item<2>(p.in[19] + (size_t)e * 1024 * 2048, 1024, 2048, (bf16_t*)(ws + WS_WGU) + (size_t)e * 2048 * 1024, 64, scr, r % I_GU, lane); continue; } r -= N_GU;
        if (r < N_DN) { const int e = r / I_DN; transpose_item<0>(p.in[21] + (size_t)e * 1024 * 1024, 1024, 1024, (bf16_t*)(ws + WS_WD) + (size_t)e * 1024 * 1024, 32, scr, r % I_DN, lane); continue; } r -= N_DN;
        if (r < N_IN) { transpose_item<1>(p.in[3], 1024, 2856, (bf16_t*)(ws + WS_WIN), NPROJ / 32, scr, r, lane); continue; } r -= N_IN;
        if (r < N_OUT) { transpose_item<0>(p.in[15], 1024, 1024, (bf16_t*)(ws + WS_WOUT), 32, scr, r, lane); continue; } r -= N_OUT;
        if (r < N_C1) { transpose_item<0>(p.in[7], 2048, 256, (bf16_t*)(ws + WS_CW1K), 8, scr, r, lane); continue; } r -= N_C1;
        if (r < N_C1) { transpose_item<0>(p.in[10], 2048, 256, (bf16_t*)(ws + WS_CW1V), 8, scr, r, lane); continue; } r -= N_C1;
        if (r < N_C2) { transpose_item<0>(p.in[8], 256, 64, (bf16_t*)(ws + WS_CW2K), 2, scr, r, lane); continue; } r -= N_C2;
        transpose_item<0>(p.in[11], 256, 64, (bf16_t*)(ws + WS_CW2V), 2, scr, r, lane);
    }
    for (int m = gw; m < MTOK; m += NGW) rms_row_to_bf16(p.in[0] + (size_t)m * DM, p.in[2], (bf16_t*)(ws + WS_H) + (size_t)m * DM, lane);
    for (int i = blk * NTHREADS + tid; i < NEXP * DM; i += G * NTHREADS) { const int e = i >> 10, d = i & 1023; ((float*)(ws + WS_WRT))[i] = p.in[16][d] * p.in[17][d * NEXP + e]; }
    if (blk == G - 1) {
        const int which = tid >> 8, j = tid & 255;
        const float* pos = which ? p.in[9] : p.in[6]; const float* w1 = which ? p.in[10] : p.in[7];
        float s = 0.f;
#pragma unroll 8
        for (int k = 0; k < 2048; ++k) s += pos[k] * w1[(size_t)k * 256 + j];
        ((float*)(ws + WS_CBIAS))[tid] = s;
    }
}

__device__ __forceinline__ void p2a_unit(const Params& p, LAS unsigned char* lds, int unit) {
    const int tid = threadIdx.x, lane = tid & 63, wave = tid >> 6;
    unsigned char* ws = p.ws;
    const bf16_t* PROJ = (const bf16_t*)(ws + WS_PROJ);
    const int b = unit >> 5, blkc = unit & 31, tok0 = unit * 64;
    const float gq = p.in[4][lane], gks = p.in[5][64 + lane], gkw = p.in[5][128 + lane];
    const float inv_freq = __expf(-13.122363377404328f * (float)(2 * (lane & 7)) * (1.f / 16.f));
    for (int ti = 0; ti < 8; ++ti) {
        const int i = wave * 8 + ti, t = tok0 + i;
        const float pos = (float)((const int*)p.in[1])[t];
        const float ang = pos * inv_freq;
        const float cs = cosf(ang), sn = sinf(ang);
        const bf16_t* pr = PROJ + (size_t)t * NPROJ;
#pragma unroll
        for (int v = 0; v < 12; ++v) {
            const int col = (v < 8) ? (CQ + v * 64) : (v < 10 ? CKS + (v - 8) * 64 : CKW + (v - 10) * 64);
            const float g = (v < 8) ? gq : (v < 10 ? gks : gkw);
            const float x = bf2f(pr[col + lane]);
            const float ss = wave_sum(x * x);
            float y = x * (1.f / sqrtf(ss * (1.f / 64.f) + EPS)) * g;
            const float partner = __shfl_xor(y, 8);
            float yr = y;
            if (lane < 8) yr = y * cs - partner * sn; else if (lane < 16) yr = y * cs + partner * sn;
            if (v < 8) {
                ((bf16_t*)(ws + WS_QN))[(size_t)t * 512 + v * 64 + lane] = (bf16_t)f2bf(y * 0.125f);
                ((bf16_t*)(ws + WS_QR))[(size_t)t * 512 + v * 64 + lane] = (bf16_t)f2bf(yr * 0.125f);
            } else if (v < 10) {
                ((bf16_t*)(ws + WS_KS))[((size_t)(b * 2 + (v - 8)) * SEQ + (t & (SEQ - 1))) * 64 + lane] = (bf16_t)f2bf(yr);
            } else {
                ((bf16_t*)(ws + WS_KW))[((size_t)(b * 2 + (v - 10)) * SEQ + (t & (SEQ - 1))) * 64 + lane] = (bf16_t)f2bf(yr);
            }
        }
    }
    LAS bf16_t* T = (LAS bf16_t*)lds;
    for (int v = 0; v < 4; ++v) {
        const int kh = v & 1, col = (v < 2 ? CVS : CVW) + kh * 64;
        __syncthreads();
        { const int tk = tid >> 3, ch = tid & 7; const u32x4 raw = *(const u32x4*)(PROJ + (size_t)(tok0 + tk) * NPROJ + col + 8 * ch);
#pragma unroll
          for (int q = 0; q < 4; ++q) { const unsigned wv = raw[q]; T[(8 * ch + 2 * q) * 72 + tk] = (bf16_t)(wv & 0xffffu); T[(8 * ch + 2 * q + 1) * 72 + tk] = (bf16_t)(wv >> 16); } }
        __syncthreads();
        { const int d = tid >> 3, ch = tid & 7; const u32x4 o = *(const LAS u32x4*)(T + d * 72 + 8 * ch);
          bf16_t* dst = (bf16_t*)(ws + (v < 2 ? WS_VST : WS_VWT)) + (((size_t)(b * 2 + kh) * 32 + blkc) * 64 + d) * 64 + 8 * ch;
          *(u32x4*)dst = o; }
    }
    __syncthreads();
}

__device__ __forceinline__ void p2b_unit(const Params& p, LAS unsigned char* lds, int unit) {
    const int tid = threadIdx.x, lane = tid & 63, w = tid >> 6, fr = lane & 15, fq = lane >> 4;
    unsigned char* ws = p.ws;
    const bf16_t* PROJ = (const bf16_t*)(ws + WS_PROJ);
    const int which = unit >> 6, rt = unit & 63;
    const bf16_t* W1T = (const bf16_t*)(ws + (which ? WS_CW1V : WS_CW1K));
    const bf16_t* W2T = (const bf16_t*)(ws + (which ? WS_CW2V : WS_CW2K));
    const float* cb = (const float*)(ws + WS_CBIAS) + which * 256;
    const int colbase = which ? CVC : CKC;
    LAS bf16_t* Hd = (LAS bf16_t*)lds;
    LAS float* Of = (LAS float*)(lds + 64 * 264 * 2);
    const bf16_t* arow[4];
#pragma unroll
    for (int m = 0; m < 4; ++m) { const int R = rt * 64 + 16 * m + fr; const int bb = R >> 8, kh = (R >> 7) & 1; int n = R & 127; if (n > 126) n = 126;
        arow[m] = PROJ + (size_t)(bb * SEQ + 16 * n) * NPROJ + colbase + kh * 64 + 8 * fq; }
    const bf16_t* brow[2];
#pragma unroll
    for (int nf = 0; nf < 2; ++nf) brow[nf] = W1T + (size_t)(32 * w + 16 * nf + fr) * 2048 + 8 * fq;
    f32x4 acc[4][2];
#pragma unroll
    for (int m = 0; m < 4; ++m)
#pragma unroll
        for (int nf = 0; nf < 2; ++nf) acc[m][nf] = (f32x4){0.f, 0.f, 0.f, 0.f};
#pragma unroll 2
    for (int ks = 0; ks < 64; ++ks) {
        bf16x8 a[4], bb2[2];
        const size_t aoff = (size_t)(ks >> 1) * NPROJ + 32 * (ks & 1);
#pragma unroll
        for (int m = 0; m < 4; ++m) a[m] = *(const bf16x8*)(arow[m] + aoff);
#pragma unroll
        for (int nf = 0; nf < 2; ++nf) bb2[nf] = *(const bf16x8*)(brow[nf] + 32 * ks);
#pragma unroll
        for (int m = 0; m < 4; ++m)
#pragma unroll
            for (int nf = 0; nf < 2; ++nf) acc[m][nf] = __builtin_amdgcn_mfma_f32_16x16x32_bf16(a[m], bb2[nf], acc[m][nf], 0, 0, 0);
    }
#pragma unroll
    for (int nf = 0; nf < 2; ++nf) { const int col = 32 * w + 16 * nf + fr; const float bias = cb[col];
#pragma unroll
        for (int m = 0; m < 4; ++m)
#pragma unroll
            for (int j = 0; j < 4; ++j) { const float hv = acc[m][nf][j] + bias; Hd[(16 * m + 4 * fq + j) * 264 + col] = (bf16_t)f2bf(hv * sigmoidf_(hv)); } }
    __syncthreads();
    {
        const int m2 = w >> 1;
        f32x4 acc2[2] = {(f32x4){0.f, 0.f, 0.f, 0.f}, (f32x4){0.f, 0.f, 0.f, 0.f}};
#pragma unroll
        for (int ks = 0; ks < 8; ++ks) {
            const bf16x8 a = *(const LAS bf16x8*)(Hd + (16 * m2 + fr) * 264 + 32 * ks + 8 * fq);
#pragma unroll
            for (int q = 0; q < 2; ++q) { const int nf2 = 2 * (w & 1) + q; const bf16x8 bv = *(const bf16x8*)(W2T + (size_t)(16 * nf2 + fr) * 256 + 32 * ks + 8 * fq);
                acc2[q] = __builtin_amdgcn_mfma_f32_16x16x32_bf16(a, bv, acc2[q], 0, 0, 0); }
        }
#pragma unroll
        for (int q = 0; q < 2; ++q) { const int nf2 = 2 * (w & 1) + q;
#pragma unroll
            for (int j = 0; j < 4; ++j) Of[(16 * m2 + 4 * fq + j) * 65 + 16 * nf2 + fr] = acc2[q][j]; }
    }
    __syncthreads();
    for (int rr = 0; rr < 8; ++rr) {
        const int r = 8 * w + rr, R = rt * 64 + r, bb = R >> 8, kh = (R >> 7) & 1, n = R & 127;
        float v = Of[r * 65 + lane];
        if (which == 0) {
            const float ss = wave_sum(v * v);
            v = v * (1.f / sqrtf(ss * (1.f / 64.f) + EPS)) * p.in[5][lane];
            if (n == 127) v = 0.f;
            ((bf16_t*)(ws + WS_KC))[((size_t)(bb * 2 + kh) * 128 + n) * 64 + lane] = (bf16_t)f2bf(v);
        } else {
            if (n == 127) v = 0.f;
            ((bf16_t*)(ws + WS_VCT))[((size_t)(bb * 2 + kh) * 64 + lane) * 128 + n] = (bf16_t)f2bf(v);
        }
    }
    __syncthreads();
}

__device__ __forceinline__ void p2c_unit(const Params& p, LAS unsigned char* lds, int unit) {
    const int tid = threadIdx.x;
    unsigned char* ws = p.ws;
    const bf16_t* PROJ = (const bf16_t*)(ws + WS_PROJ);
    const int n = unit & 31, h = (unit >> 5) & 3, b = unit >> 7;
    const int bh = b * 4 + h, tok0 = b * SEQ + n * 64;
    LAS float* QD = (LAS float*)lds;
    LAS float* KD = QD + 64 * 64;
    LAS float* KSt = KD + 64 * 65;
    LAS float* V = KSt + 64 * 64;
    LAS float* AT = V + 64 * 128;
    LAS float* BL = AT + 64 * 65;
    LAS float* GL = BL + 64 * 64;
    LAS float* WG = GL + 64 * 16;
    LAS float* BG = WG + 16 * 64;
    for (int i = tid; i < 64 * 16; i += NTHREADS) { const int t = i >> 4, r = i & 15; GL[i] = bf2f(PROJ[(size_t)(tok0 + t) * NPROJ + CGLR + r]); }
    for (int i = tid; i < 16 * 64; i += NTHREADS) { const int r = i >> 6, d = i & 63; WG[i] = p.in[12][r * 256 + h * 64 + d]; }
    if (tid < 64) BG[tid] = p.in[13][h * 64 + tid];
    for (int i = tid; i < 64 * 128; i += NTHREADS) { const int t = i >> 7, e = i & 127; V[i] = bf2f(PROJ[(size_t)(tok0 + t) * NPROJ + CGV + h * 128 + e]); }
    __syncthreads();
    for (int i = tid; i < 64 * 64; i += NTHREADS) { const int t = i >> 6, d = i & 63; float s = BG[d];
#pragma unroll
        for (int r = 0; r < 16; ++r) s += GL[t * 16 + r] * WG[r * 64 + d];
        const float ls = fminf(s, 0.f) - log1pf(__expf(-fabsf(s)));
        BL[i] = ls * (1.f / 16.f); }
    __syncthreads();
    if (tid < 64) { float s = 0.f; for (int t = 0; t < 64; ++t) { s += BL[t * 64 + tid]; BL[t * 64 + tid] = s; } }
    __syncthreads();
    for (int i = tid; i < 64 * 64; i += NTHREADS) { const int t = i >> 6, d = i & 63; const float bb = BL[i], bl = BL[63 * 64 + d];
        const float q = bf2f(PROJ[(size_t)(tok0 + t) * NPROJ + CGQ + h * 64 + d]), k = bf2f(PROJ[(size_t)(tok0 + t) * NPROJ + CGK + h * 64 + d]);
        const float qd = q * 0.125f * __expf(bb);
        QD[i] = qd; KD[t * 65 + d] = k * __expf(-bb); KSt[i] = k * __expf(bl - bb);
        ((float*)(ws + WS_QD))[((size_t)(bh * 32 + n) * 64 + t) * 64 + d] = qd; }
    if (tid < 64) ((float*)(ws + WS_DEC))[(size_t)(bh * 32 + n) * 64 + tid] = __expf(BL[63 * 64 + tid]);
    __syncthreads();
    { const int c = tid >> 3, sg = tid & 7;
#pragma unroll
      for (int jj = 0; jj < 8; ++jj) { const int s = sg + 8 * jj; float a = 0.f;
          if (s <= c) { for (int d = 0; d < 64; ++d) a += QD[c * 64 + d] * KD[s * 65 + d]; }
          AT[c * 65 + s] = a; } }
    __syncthreads();
    { const int c = tid >> 3, eg = tid & 7;
      f32x4 o[4] = {(f32x4){0.f,0.f,0.f,0.f}, (f32x4){0.f,0.f,0.f,0.f}, (f32x4){0.f,0.f,0.f,0.f}, (f32x4){0.f,0.f,0.f,0.f}};
      for (int s = 0; s <= c; ++s) { const float a = AT[c * 65 + s]; const LAS f32x4* vp = (const LAS f32x4*)(V + s * 128 + eg * 16);
#pragma unroll
          for (int q = 0; q < 4; ++q) o[q] += a * vp[q]; }
      f32x4* dst = (f32x4*)((float*)(ws + WS_OI) + ((size_t)(bh * 32 + n) * 64 + c) * 128 + eg * 16);
#pragma unroll
      for (int q = 0; q < 4; ++q) dst[q] = o[q];
      const int d = c;
      f32x4 u[4] = {(f32x4){0.f,0.f,0.f,0.f}, (f32x4){0.f,0.f,0.f,0.f}, (f32x4){0.f,0.f,0.f,0.f}, (f32x4){0.f,0.f,0.f,0.f}};
      for (int s = 0; s < 64; ++s) { const float a = KSt[s * 64 + d]; const LAS f32x4* vp = (const LAS f32x4*)(V + s * 128 + eg * 16);
#pragma unroll
          for (int q = 0; q < 4; ++q) u[q] += a * vp[q]; }
      f32x4* du = (f32x4*)((float*)(ws + WS_U) + ((size_t)(bh * 32 + n) * 64 + d) * 128 + eg * 16);
#pragma unroll
      for (int q = 0; q < 4; ++q) du[q] = u[q]; }
    __syncthreads();
}

__device__ __forceinline__ void p3a_scan(const Params& p, int blk, int G) {
    unsigned char* ws = p.ws;
    for (int gid = blk * NTHREADS + threadIdx.x; gid < 64 * 64 * 32; gid += G * NTHREADS) {
        const int bh = gid >> 11, d = (gid >> 5) & 63, e4 = gid & 31;
        f32x4 s = (f32x4){0.f, 0.f, 0.f, 0.f};
        for (int n = 0; n < 32; ++n) {
            const size_t o = ((size_t)(bh * 32 + n) * 64 + d) * 128 + e4 * 4;
            *(f32x4*)((float*)(ws + WS_SP) + o) = s;
            const float dc = ((const float*)(ws + WS_DEC))[(size_t)(bh * 32 + n) * 64 + d];
            s = dc * s + *(const f32x4*)((const float*)(ws + WS_U) + o);
        }
    }
}

__device__ __forceinline__ void p4_unit(const Params& p, LAS unsigned char* lds, int unit) {
    const int tid = threadIdx.x;
    unsigned char* ws = p.ws;
    const bf16_t* PROJ = (const bf16_t*)(ws + WS_PROJ);
    const int n = unit & 31, h = (unit >> 5) & 3, b = unit >> 7;
    const int bh = b * 4 + h, tok0 = b * SEQ + n * 64;
    LAS float* QD = (LAS float*)lds;
    LAS float* SP = QD + 64 * 64;
    const size_t cb = (size_t)(bh * 32 + n);
    for (int i = tid; i < 64 * 64 / 4; i += NTHREADS) ((LAS f32x4*)QD)[i] = ((const f32x4*)((const float*)(ws + WS_QD) + cb * 4096))[i];
    for (int i = tid; i < 64 * 128 / 4; i += NTHREADS) ((LAS f32x4*)SP)[i] = ((const f32x4*)((const float*)(ws + WS_SP) + cb * 8192))[i];
    __syncthreads();
    const int c = tid >> 3, eg = tid & 7;
    const f32x4* oi = (const f32x4*)((const float*)(ws + WS_OI) + (cb * 64 + c) * 128 + eg * 16);
    f32x4 o[4];
#pragma unroll
    for (int q = 0; q < 4; ++q) o[q] = oi[q];
    for (int d = 0; d < 64; ++d) { const float a = QD[c * 64 + d]; const LAS f32x4* sp = (const LAS f32x4*)(SP + d * 128 + eg * 16);
#pragma unroll
        for (int q = 0; q < 4; ++q) o[q] += a * sp[q]; }
    float ss = 0.f;
#pragma unroll
    for (int q = 0; q < 4; ++q) ss += (o[q].x * o[q].x + o[q].y * o[q].y) + (o[q].z * o[q].z + o[q].w * o[q].w);
    ss += __shfl_xor(ss, 1); ss += __shfl_xor(ss, 2); ss += __shfl_xor(ss, 4);
    const float rstd = 1.f / sqrtf(ss * (1.f / 128.f) + EPS);
    const int t = tok0 + c;
    const bf16_t* rp = PROJ + (size_t)t * NPROJ + CGR + h * 128 + eg * 16;
    const float* gn = p.in[14] + eg * 16;
    unsigned outw[8];
#pragma unroll
    for (int q = 0; q < 4; ++q) {
        float y[4];
#pragma unroll
        for (int j = 0; j < 4; ++j) { const float r = bf2f(rp[q * 4 + j]); y[j] = o[q][j] * rstd * gn[q * 4 + j] * (r * sigmoidf_(r)); }
        outw[2 * q] = pk2(y[0], y[1]); outw[2 * q + 1] = pk2(y[2], y[3]);
    }
    u32x4* dst = (u32x4*)((bf16_t*)(ws + WS_ATT) + (size_t)t * 1024 + 512 + h * 128 + eg * 16);
    dst[0] = (u32x4){outw[0], outw[1], outw[2], outw[3]}; dst[1] = (u32x4){outw[4], outw[5], outw[6], outw[7]};
    __syncthreads();
}

constexpr int NSA_KT = 0, NSA_VT = 9216, NSA_PW = 18432, NSA_IMPW = 18432 + 8 * 4608, NSA_SELM = NSA_IMPW + 4 * 64 * 33 * 4, NSA_UNI = NSA_SELM + 256;
constexpr float NEGBIG = -1e30f;

__device__ __forceinline__ void nsa_qk(const bf16x8 (&aq)[2][2], const LAS bf16_t* KT, f32x4 (&S)[2][4], int fr, int fq) {
#pragma unroll
    for (int nf = 0; nf < 4; ++nf) {
        bf16x8 bk[2];
#pragma unroll
        for (int ks = 0; ks < 2; ++ks) bk[ks] = *(const LAS bf16x8*)(KT + (16 * nf + fr) * 72 + 32 * ks + 8 * fq);
#pragma unroll
        for (int m = 0; m < 2; ++m) { f32x4 s = (f32x4){0.f, 0.f, 0.f, 0.f};
#pragma unroll
            for (int ks = 0; ks < 2; ++ks) s = __builtin_amdgcn_mfma_f32_16x16x32_bf16(aq[m][ks], bk[ks], s, 0, 0, 0);
            S[m][nf] = s; }
    }
}
__device__ __forceinline__ void nsa_pv(const LAS bf16_t* PWw, const LAS bf16_t* VT, f32x4 (&O)[2][4], int fr, int fq) {
    bf16x8 ap[2][2];
#pragma unroll
    for (int m = 0; m < 2; ++m)
#pragma unroll
        for (int ks = 0; ks < 2; ++ks) ap[m][ks] = *(const LAS bf16x8*)(PWw + (16 * m + fr) * 72 + 32 * ks + 8 * fq);
#pragma unroll
    for (int nfd = 0; nfd < 4; ++nfd) {
        bf16x8 bv[2];
#pragma unroll
        for (int ks = 0; ks < 2; ++ks) bv[ks] = *(const LAS bf16x8*)(VT + (16 * nfd + fr) * 72 + 32 * ks + 8 * fq);
#pragma unroll
        for (int m = 0; m < 2; ++m)
#pragma unroll
            for (int ks = 0; ks < 2; ++ks) O[m][nfd] = __builtin_amdgcn_mfma_f32_16x16x32_bf16(ap[m][ks], bv[ks], O[m][nfd], 0, 0, 0);
    }
}
template <int CTRL> __device__ __forceinline__ float dppf(float v) { return __int_as_float(__builtin_amdgcn_update_dpp(0, __float_as_int(v), CTRL, 0xf, 0xf, true)); }
__device__ __forceinline__ float red16_max(float v) { v = fmaxf(v, dppf<0xB1>(v)); v = fmaxf(v, dppf<0x4E>(v)); v = fmaxf(v, dppf<0x141>(v)); v = fmaxf(v, dppf<0x140>(v)); return v; }
__device__ __forceinline__ float red16_sum(float v) { v += dppf<0xB1>(v); v += dppf<0x4E>(v); v += dppf<0x141>(v); v += dppf<0x140>(v); return v; }

__device__ __forceinline__ void nsa_tile(const bf16x8 (&aq)[2][2], const LAS bf16_t* KT, const LAS bf16_t* VT, LAS bf16_t* PWw, float (&mrow)[2][4], float (&lrow)[2][4], f32x4 (&O)[2][4],
                                         unsigned rowok, int mode, int ibase, int cq, int koff, int fr_, int fq_) {
    int fr = fr_, fq = fq_;
    asm volatile("" : "+v"(fr), "+v"(fq));
    f32x4 S[2][4];
    nsa_qk(aq, KT, S, fr, fq);
#pragma unroll
    for (int m = 0; m < 2; ++m)
#pragma unroll
        for (int j = 0; j < 4; ++j) {
            const int i = ibase + 16 * m + 4 * fq + j;
            const bool rok = (rowok >> (m * 4 + j)) & 1u;
            const int thr = (mode == 3) ? (((cq + i - 31) >> 4) - koff) : i;
            bool ok[4]; float mx = NEGBIG;
#pragma unroll
            for (int nf = 0; nf < 4; ++nf) { const int key = 16 * nf + fr; ok[nf] = rok && (mode == 0 || (mode == 2 ? key > thr : key <= thr)); mx = fmaxf(mx, ok[nf] ? S[m][nf][j] : NEGBIG); }
            mx = red16_max(mx);
            const float mnew = fmaxf(mrow[m][j], mx);
            const float alpha = __expf(mrow[m][j] - mnew);
            float rs = 0.f;
#pragma unroll
            for (int nf = 0; nf < 4; ++nf) { const float pv = ok[nf] ? __expf(S[m][nf][j] - mnew) : 0.f; rs += pv; PWw[(16 * m + 4 * fq + j) * 72 + 16 * nf + fr] = (bf16_t)f2bf(pv); }
            rs = red16_sum(rs);
            lrow[m][j] = lrow[m][j] * alpha + rs; mrow[m][j] = mnew;
#pragma unroll
            for (int nfd = 0; nfd < 4; ++nfd) O[m][nfd][j] *= alpha;
        }
    LDS_WAIT();
    nsa_pv(PWw, VT, O, fr, fq);
}
__device__ __forceinline__ void nsa_load_tile(LAS bf16_t* T, const bf16_t* src, int row_stride, int tid) {
    const int r = tid >> 3, ch = tid & 7;
    *(LAS u32x4*)(T + r * 72 + 8 * ch) = *(const u32x4*)(src + (size_t)r * row_stride + 8 * ch);
}

__device__ __forceinline__ void nsa_unit(const Params& p, LAS unsigned char* lds, int b, int kh, int c) {
    const int tid = threadIdx.x, lane = tid & 63, w = tid >> 6, fr = lane & 15, fq = lane >> 4, g = w >> 1, ih = w & 1;
    unsigned char* ws = p.ws;
    const int hh = kh * 4 + g, tok0 = b * SEQ + 64 * c, ibase = 32 * ih;
    const bf16_t* PROJ = (const bf16_t*)(ws + WS_PROJ);
    LAS bf16_t* KT = (LAS bf16_t*)(lds + NSA_KT); LAS bf16_t* VT = (LAS bf16_t*)(lds + NSA_VT);
    LAS bf16_t* PWw = (LAS bf16_t*)(lds + NSA_PW + w * 4608);
    LAS float* IMPW = (LAS float*)(lds + NSA_IMPW);
    LAS unsigned* SELM = (LAS unsigned*)(lds + NSA_SELM); LAS unsigned* UNI = (LAS unsigned*)(lds + NSA_UNI);
    const size_t bk = (size_t)(b * 2 + kh);
    f32x4 oacc[2][4];
#pragma unroll
    for (int m = 0; m < 2; ++m)
#pragma unroll
        for (int nfd = 0; nfd < 4; ++nfd) oacc[m][nfd] = (f32x4){0.f, 0.f, 0.f, 0.f};
    bf16x8 aq[2][2];
    if (tid == 0) *UNI = 0u;
    {
#pragma unroll
        for (int m = 0; m < 2; ++m)
#pragma unroll
            for (int ks = 0; ks < 2; ++ks) aq[m][ks] = *(const bf16x8*)((const bf16_t*)(ws + WS_QN) + (size_t)(tok0 + ibase + 16 * m + fr) * 512 + hh * 64 + 32 * ks + 8 * fq);
        const int nh = (4 * c + 2 >= 64) ? 2 : 1;
        float mrow[2][4], lrow[2][4]; f32x4 O[2][4];
#pragma unroll
        for (int m = 0; m < 2; ++m) {
#pragma unroll
            for (int j = 0; j < 4; ++j) { mrow[m][j] = NEGBIG; lrow[m][j] = 0.f; }
#pragma unroll
            for (int nfd = 0; nfd < 4; ++nfd) O[m][nfd] = (f32x4){0.f, 0.f, 0.f, 0.f};
        }
        for (int half = 0; half < nh; ++half) {
            __syncthreads();
            nsa_load_tile(KT, (const bf16_t*)(ws + WS_KC) + bk * 128 * 64 + half * 64 * 64, 64, tid);
            nsa_load_tile(VT, (const bf16_t*)(ws + WS_VCT) + bk * 64 * 128 + 64 * half, 128, tid);
            __syncthreads();
            nsa_tile(aq, KT, VT, PWw, mrow, lrow, O, 0xffu, 3, ibase, 64 * c, 64 * half, fr, fq);
        }
#pragma unroll
        for (int m = 0; m < 2; ++m)
#pragma unroll
            for (int j = 0; j < 4; ++j) { const int t = tok0 + ibase + 16 * m + 4 * fq + j; const float gt = sigmoidf_(bf2f(PROJ[(size_t)t * NPROJ + CGATE + hh * 3 + 0]));
                const float sc = lrow[m][j] > 0.f ? gt / lrow[m][j] : 0.f;
                lrow[m][j] = lrow[m][j] > 0.f ? 1.f / lrow[m][j] : 0.f;
#pragma unroll
                for (int nfd = 0; nfd < 4; ++nfd) oacc[m][nfd][j] = sc * O[m][nfd][j]; }
        float carry[2][4];
#pragma unroll
        for (int m = 0; m < 2; ++m)
#pragma unroll
            for (int j = 0; j < 4; ++j) carry[m][j] = 0.f;
        for (int half = 0; half < nh; ++half) {
            f32x4 S[2][4];
            int fr = lane & 15, fq = lane >> 4;
            asm volatile("" : "+v"(fr), "+v"(fq));
            if (half != nh - 1 || nh == 2) {
                __syncthreads();
                nsa_load_tile(KT, (const bf16_t*)(ws + WS_KC) + bk * 128 * 64 + half * 64 * 64, 64, tid);
                __syncthreads();
            }
            nsa_qk(aq, KT, S, fr, fq);
#pragma unroll
            for (int m = 0; m < 2; ++m)
#pragma unroll
                for (int j = 0; j < 4; ++j) {
                    const int i = ibase + 16 * m + 4 * fq + j;
                    const int thr = ((64 * c + i - 31) >> 4) - 64 * half;
                    float prev = carry[m][j];
#pragma unroll
                    for (int nf = 0; nf < 4; ++nf) {
                        const int key = 16 * nf + fr;
                        const float v = key <= thr ? __expf(S[m][nf][j] - mrow[m][j]) * lrow[m][j] : 0.f;
                        float s4 = v + dppf<0xB1>(v); s4 += dppf<0x4E>(s4);
                        const float e1 = dppf<0x121>(v), e2 = dppf<0x121>(prev);
                        const float extra = (fr == 0) ? e2 : e1;
                        if ((fr & 3) == 0) IMPW[(g * 64 + i) * 33 + 16 * half + 4 * nf + (fr >> 2)] = s4 + extra;
                        prev = v;
                    }
                    carry[m][j] = prev;
                }
        }
    }
    __syncthreads();
    {
        LAS float* SC = (LAS float*)(lds + NSA_KT);
#pragma unroll
        for (int q = 0; q < 4; ++q) { const int pr = q * NTHREADS + tid, i = pr >> 5, j = pr & 31;
            float v = NEGBIG;
            if (j <= c) { v = (IMPW[(0 * 64 + i) * 33 + j] + IMPW[(1 * 64 + i) * 33 + j]) + (IMPW[(2 * 64 + i) * 33 + j] + IMPW[(3 * 64 + i) * 33 + j]);
                if (j == 0 || j == c || j == c - 1) v += 1e4f; }
            SC[i * 33 + j] = v; }
        __syncthreads();
#pragma unroll 1
        for (int q = 0; q < 4; ++q) { const int pr = q * NTHREADS + tid, i = pr >> 5, j = pr & 31;
            const float my = SC[i * 33 + j]; int rank = 0;
#pragma unroll
            for (int k = 0; k < 32; ++k) { const float o = SC[i * 33 + k]; rank += (o > my || (o == my && k < j)) ? 1 : 0; }
            const bool sel = (j <= c) && rank < 8;
            const unsigned long long bal = __ballot(sel);
            const unsigned msk = (lane & 32) ? (unsigned)(bal >> 32) : (unsigned)bal;
            if (j == 0) { SELM[i] = msk; atomicOr((unsigned*)UNI, msk); } }
    }
    __syncthreads();
    unsigned selbits[2][4];
#pragma unroll
    for (int m = 0; m < 2; ++m)
#pragma unroll
        for (int j = 0; j < 4; ++j) selbits[m][j] = SELM[ibase + 16 * m + 4 * fq + j];
    const unsigned uni = *UNI;
#pragma unroll
    for (int m = 0; m < 2; ++m)
#pragma unroll
        for (int ks = 0; ks < 2; ++ks) aq[m][ks] = *(const bf16x8*)((const bf16_t*)(ws + WS_QR) + (size_t)(tok0 + ibase + 16 * m + fr) * 512 + hh * 64 + 32 * ks + 8 * fq);
#pragma unroll 1
    for (int br = 0; br < 2; ++br) {
        float mrow[2][4], lrow[2][4]; f32x4 O[2][4];
#pragma unroll
        for (int m = 0; m < 2; ++m) {
#pragma unroll
            for (int j = 0; j < 4; ++j) { mrow[m][j] = NEGBIG; lrow[m][j] = 0.f; }
#pragma unroll
            for (int nfd = 0; nfd < 4; ++nfd) O[m][nfd] = (f32x4){0.f, 0.f, 0.f, 0.f};
        }
        const bf16_t* Kb = (const bf16_t*)(ws + (br ? WS_KW : WS_KS)) + bk * SEQ * 64;
        const bf16_t* Vb = (const bf16_t*)(ws + (br ? WS_VWT : WS_VST)) + bk * 32 * 4096;
        const int j0 = br ? (c - 8 > 0 ? c - 8 : 0) : 0;
        for (int jb = j0; jb <= c; ++jb) {
            unsigned rowok; int mode;
            if (br == 0) {
                if (!((uni >> jb) & 1u)) continue;
                rowok = 0u;
#pragma unroll
                for (int m = 0; m < 2; ++m)
#pragma unroll
                    for (int j = 0; j < 4; ++j) rowok |= ((selbits[m][j] >> jb) & 1u) << (m * 4 + j);
                mode = (jb == c) ? 1 : 0;
            } else { rowok = 0xffu; mode = (jb == c) ? 1 : ((jb == c - 8) ? 2 : 0); }
            __syncthreads();
            nsa_load_tile(KT, Kb + (size_t)jb * 4096, 64, tid);
            nsa_load_tile(VT, Vb + (size_t)jb * 4096, 64, tid);
            __syncthreads();
            nsa_tile(aq, KT, VT, PWw, mrow, lrow, O, rowok, mode, ibase, 0, 0, fr, fq);
        }
#pragma unroll
        for (int m = 0; m < 2; ++m)
#pragma unroll
            for (int j = 0; j < 4; ++j) { const int t = tok0 + ibase + 16 * m + 4 * fq + j; const float gt = sigmoidf_(bf2f(PROJ[(size_t)t * NPROJ + CGATE + hh * 3 + 1 + br]));
                const float sc = lrow[m][j] > 0.f ? gt / lrow[m][j] : 0.f;
#pragma unroll
                for (int nfd = 0; nfd < 4; ++nfd) oacc[m][nfd][j] += sc * O[m][nfd][j]; }
    }
#pragma unroll
    for (int m = 0; m < 2; ++m)
#pragma unroll
        for (int j = 0; j < 4; ++j) { const int t = tok0 + ibase + 16 * m + 4 * fq + j; bf16_t* dst = (bf16_t*)(ws + WS_ATT) + (size_t)t * 1024 + hh * 64 + fr;
#pragma unroll
            for (int nfd = 0; nfd < 4; ++nfd) dst[16 * nfd] = (bf16_t)f2bf(oacc[m][nfd][j]); }
    __syncthreads();
}

__device__ __forceinline__ void p6_chunk(const Params& p, LAS unsigned char* lds, int chunk) {
    const int tid = threadIdx.x, lane = tid & 63, wave = tid >> 6;
    unsigned char* ws = p.ws;
    LAS int* lcnt = (LAS int*)lds;
    if (tid < NEXP) lcnt[tid] = 0;
    __syncthreads();
    const float* WRT = (const float*)(ws + WS_WRT);
    for (int ti = 0; ti < 16; ++ti) {
        const int t = chunk * 128 + wave * 16 + ti;
        const f32x4* xr = (const f32x4*)(p.out + (size_t)t * DM) + lane; const f32x4* gr = (const f32x4*)p.in[16] + lane;
        f32x4 v[4]; float s = 0.f;
#pragma unroll
        for (int j = 0; j < 4; ++j) { v[j] = xr[64 * j]; s += (v[j].x * v[j].x + v[j].y * v[j].y) + (v[j].z * v[j].z + v[j].w * v[j].w); }
        const float rstd = 1.f / sqrtf(wave_sum(s) * (1.f / DM) + EPS);
        unsigned long long* o8 = (unsigned long long*)((bf16_t*)(ws + WS_H) + (size_t)t * DM) + lane;
#pragma unroll
        for (int j = 0; j < 4; ++j) { const f32x4 gg = gr[64 * j]; const f32x4 o = v[j] * rstd * gg;
            o8[64 * j] = (unsigned long long)pk2(o.x, o.y) | ((unsigned long long)pk2(o.z, o.w) << 32); }
        const int myexp = (lane >> 1) & 31;
        float mylg = 0.f;
        { const f32x4* wr = (const f32x4*)WRT + lane;
#pragma unroll 2
          for (int e = 0; e < 32; ++e, wr += DM / 4) { float a = 0.f;
#pragma unroll
              for (int j = 0; j < 4; ++j) { const f32x4 wv = wr[64 * j]; a += (v[j].x * wv.x + v[j].y * wv.y) + (v[j].z * wv.z + v[j].w * wv.w); }
              a = wave_sum(a);
              if (e == myexp) mylg = a; } }
        mylg = mylg * rstd + p.in[18][myexp];
        float tv[4]; int te[4];
#pragma unroll
        for (int r = 0; r < 4; ++r) {
            float bv = mylg; int be = myexp;
#pragma unroll
            for (int o = 1; o < 64; o <<= 1) { const float ov = __shfl_xor(bv, o); const int oe = __shfl_xor(be, o); if (ov > bv || (ov == bv && oe < be)) { bv = ov; be = oe; } }
            tv[r] = bv; te[r] = be;
            if (myexp == be) mylg = -3e38f;
        }
        const float e0 = 1.f, e1 = __expf(tv[1] - tv[0]), e2 = __expf(tv[2] - tv[0]), e3 = __expf(tv[3] - tv[0]);
        const float inv = 1.f / (e0 + e1 + e2 + e3);
        if (lane == 0) {
            *(int4*)((int*)(ws + WS_TOPI) + (size_t)t * 4) = make_int4(te[0], te[1], te[2], te[3]);
            *(f32x4*)((float*)(ws + WS_TOPG) + (size_t)t * 4) = (f32x4){e0 * inv, e1 * inv, e2 * inv, e3 * inv};
            atomicAdd((int*)&lcnt[te[0]], 1); atomicAdd((int*)&lcnt[te[1]], 1); atomicAdd((int*)&lcnt[te[2]], 1); atomicAdd((int*)&lcnt[te[3]], 1);
        }
    }
    __syncthreads();
    if (tid < NEXP) atomicAdd((int*)(ws + WS_CTL) + CW_CNT + tid, lcnt[tid]);
    __syncthreads();
}

__device__ __forceinline__ int build_tile_table(const Params& p, LAS int* tstart, LAS int* tile_e) {
    const int tid = threadIdx.x;
    const int* cnt = (const int*)(p.ws + WS_CTL) + CW_CNT;
    if (tid == 0) { int acc = 0; for (int e = 0; e < NEXP; ++e) { tstart[e] = acc; acc += (__hip_atomic_load(cnt + e, __ATOMIC_RELAXED, __HIP_MEMORY_SCOPE_AGENT) + 255) >> 8; } tstart[NEXP] = acc; }
    __syncthreads();
    const int total = tstart[NEXP];
    for (int i = tid; i < total; i += NTHREADS) { int e = 0;
        for (int q = 1; q < NEXP; ++q) if (tstart[q] <= i) e = q;
        tile_e[i] = e; }
    __syncthreads();
    return total;
}

__device__ __forceinline__ void p7_chunk(const Params& p, LAS unsigned char* lds, int chunk, const LAS int* tstart) {
    const int tid = threadIdx.x, lane = tid & 63, wave = tid >> 6;
    unsigned char* ws = p.ws;
    LAS int* lc = (LAS int*)lds; LAS int* lbase = lc + 32; LAS int* ldst = lbase + 32;
    if (tid < NEXP) lc[tid] = 0;
    __syncthreads();
    const int t = chunk * 128 + (tid >> 2), k = tid & 3;
    const int e = ((const int*)(ws + WS_TOPI))[(size_t)t * 4 + k];
    const int rank = atomicAdd((int*)&lc[e], 1);
    __syncthreads();
    if (tid < NEXP) lbase[tid] = atomicAdd((int*)(ws + WS_CTL) + CW_FILL + tid, lc[tid]);
    __syncthreads();
    const int dest = tstart[e] * 256 + lbase[e] + rank;
    ((int*)(ws + WS_DEST))[(size_t)t * 4 + k] = dest;
    ldst[tid] = dest;
    __syncthreads();
    for (int ti = 0; ti < 16; ++ti) {
        const int tl = wave * 16 + ti, tt = chunk * 128 + tl;
        const u32x4* src = (const u32x4*)((const bf16_t*)(ws + WS_H) + (size_t)tt * DM) + lane;
        const u32x4 a = src[0], bq = src[64];
#pragma unroll
        for (int kk = 0; kk < 4; ++kk) { u32x4* dst = (u32x4*)((bf16_t*)(ws + WS_XS) + (size_t)ldst[tl * 4 + kk] * DM) + lane; dst[0] = a; dst[64] = bq; }
    }
    __syncthreads();
}

__device__ __forceinline__ void p10_token(const Params& p, int t, int lane) {
    unsigned char* ws = p.ws;
    const int4 d4 = *(const int4*)((const int*)(ws + WS_DEST) + (size_t)t * 4);
    const f32x4 g4 = *(const f32x4*)((const float*)(ws + WS_TOPG) + (size_t)t * 4);
    const int dd[4] = {d4.x, d4.y, d4.z, d4.w};
    f32x4* xr = (f32x4*)(p.out + (size_t)t * DM);
#pragma unroll
    for (int half = 0; half < 2; ++half) {
        f32x4 a0 = xr[half * 128 + lane * 2], a1 = xr[half * 128 + lane * 2 + 1];
#pragma unroll
        for (int k = 0; k < 4; ++k) {
            const u32x4 y = *((const u32x4*)((const bf16_t*)(ws + WS_Y) + (size_t)dd[k] * DM) + half * 64 + lane);
            const float gk = g4[k];
            a0.x += gk * __uint_as_float(y.x << 16); a0.y += gk * __uint_as_float(y.x & 0xffff0000u);
            a0.z += gk * __uint_as_float(y.y << 16); a0.w += gk * __uint_as_float(y.y & 0xffff0000u);
            a1.x += gk * __uint_as_float(y.z << 16); a1.y += gk * __uint_as_float(y.z & 0xffff0000u);
            a1.z += gk * __uint_as_float(y.w << 16); a1.w += gk * __uint_as_float(y.w & 0xffff0000u);
        }
        xr[half * 128 + lane * 2] = a0; xr[half * 128 + lane * 2 + 1] = a1;
    }
}

template <int ph> __device__ __forceinline__ void mk_phase(const Params& p, LAS unsigned char* lds, int blk, int G) {
    unsigned char* ws = p.ws;
    const int tid = threadIdx.x;
    if constexpr (ph == 0) { phase0(p, lds, blk, G); }
    else if constexpr (ph == 1) {
        pg8::Gemm g{(const bf16_t*)(ws + WS_H), (const bf16_t*)(ws + WS_WIN), DM};
        pg8::StaticOrder S{MTOK / 256, NPROJ / 256, G, blk};
        pg8::EpiBf16 E{(bf16_t*)(ws + WS_PROJ), NPROJ};
        pg8::gemm_phase(lds, g, S, E);
    }
    else if constexpr (ph == 2) {
        for (int u = blk; u < 128 + 2048 + 512; u += G) {
            if (u < 128) p2b_unit(p, lds, u);
            else if (u < 128 + 2048) p2c_unit(p, lds, u - 128);
            else p2a_unit(p, lds, u - 128 - 2048);
        }
    }
    else if constexpr (ph == 3) {
        p3a_scan(p, blk, G);
        for (int r = 0; r * G < 1024; ++r) {
            const int u = r * G + ((r & 1) ? (G - 1 - blk) : blk);
            if (u >= 1024) continue;
            const int c = 31 - (u >> 5), bkh = u & 31;
            nsa_unit(p, lds, bkh >> 1, bkh & 1, c);
        }
    }
    else if constexpr (ph == 4) { for (int u = blk; u < 2048; u += G) p4_unit(p, lds, u); }
    else if constexpr (ph == 5) {
        pg8::Gemm g{(const bf16_t*)(ws + WS_ATT), (const bf16_t*)(ws + WS_WOUT), DM};
        pg8::StaticOrder S{MTOK / 256, DM / 256, G, blk};
        pg8::EpiResF32 E{p.in[0], p.out, DM};
        pg8::gemm_phase(lds, g, S, E);
    }
    else if constexpr (ph == 6) { for (int ch = blk; ch < MTOK / 128; ch += G) p6_chunk(p, lds, ch); }
    else if constexpr (ph == 7) {
        LAS int* tstart = (LAS int*)(lds + 8192); LAS int* tile_e = tstart + 64;
        build_tile_table(p, tstart, tile_e);
        for (int ch = blk; ch < MTOK / 128; ch += G) p7_chunk(p, lds, ch, tstart);
    }
    else if constexpr (ph == 8) {
        LAS int* tstart = (LAS int*)(lds + pg8::STAGE_BYTES); LAS int* tile_e = tstart + 64;
        const int total = build_tile_table(p, tstart, tile_e);
        pg8::Gemm g{(const bf16_t*)(ws + WS_XS), (const bf16_t*)(ws + WS_WGU), DM};
        pg8::MoeOrder S{total, 8, G, blk, tile_e};
        pg8::EpiSwiglu E{(bf16_t*)(ws + WS_ACT), p.in[20], 8};
        pg8::gemm_phase(lds, g, S, E);
    }
    else if constexpr (ph == 9) {
        LAS int* tstart = (LAS int*)(lds + pg8::STAGE_BYTES); LAS int* tile_e = tstart + 64;
        const int total = build_tile_table(p, tstart, tile_e);
        pg8::Gemm g{(const bf16_t*)(ws + WS_ACT), (const bf16_t*)(ws + WS_WD), DFF};
        pg8::MoeOrder S{total, 4, G, blk, tile_e};
        pg8::EpiDown E{(bf16_t*)(ws + WS_Y), p.in[22], 4};
        pg8::gemm_phase(lds, g, S, E);
    }
    else if constexpr (ph == 10) { for (int t = blk * 8 + (tid >> 6); t < MTOK; t += G * 8) p10_token(p, t, tid & 63); }
}

constexpr int NPHASES = 11;

template <int PH> __global__ void __launch_bounds__(NTHREADS, 2) mk_one(Params p) {
    extern __shared__ __attribute__((aligned(16))) unsigned char lds_raw[];
    mk_phase<PH>(p, (LAS unsigned char*)lds_raw, blockIdx.x, gridDim.x);
}
#if MK_ONE_LAUNCH
#define MK_RUN(PH) mk_phase<PH>(p, lds, blk, G)
__global__ void __launch_bounds__(NTHREADS, 2) mk_fwd(Params p) {
    extern __shared__ __attribute__((aligned(16))) unsigned char lds_raw[];
    LAS unsigned char* lds = (LAS unsigned char*)lds_raw;
    const int blk = blockIdx.x, G = gridDim.x;
    cg::grid_group grid = cg::this_grid();
    MK_RUN(0); grid.sync(); MK_RUN(1); grid.sync(); MK_RUN(2); grid.sync(); MK_RUN(3); grid.sync(); MK_RUN(4); grid.sync(); MK_RUN(5); grid.sync();
    MK_RUN(6); grid.sync(); MK_RUN(7); grid.sync(); MK_RUN(8); grid.sync(); MK_RUN(9); grid.sync(); MK_RUN(10);
}
#endif

extern "C" void kernel_launch(void* const* d_in, const int* in_sizes, int n_in, void* d_out, int out_size, void* d_ws, size_t ws_size, hipStream_t stream) {
    static int grid = 0;
    if (grid == 0) {
        int dev = 0, cus = 0, per_cu = 0;
        (void)hipGetDevice(&dev);
        (void)hipDeviceGetAttribute(&cus, hipDeviceAttributeMultiprocessorCount, dev);
#if MK_ONE_LAUNCH
        (void)hipFuncSetAttribute((const void*)mk_fwd, hipFuncAttributeMaxDynamicSharedMemorySize, LDS_BYTES);
        (void)hipOccupancyMaxActiveBlocksPerMultiprocessor(&per_cu, (const void*)mk_fwd, NTHREADS, LDS_BYTES);
#else
#define MK_ATTR(PH) (void)hipFuncSetAttribute((const void*)mk_one<PH>, hipFuncAttributeMaxDynamicSharedMemorySize, LDS_BYTES)
        MK_ATTR(0); MK_ATTR(1); MK_ATTR(2); MK_ATTR(3); MK_ATTR(4); MK_ATTR(5); MK_ATTR(6); MK_ATTR(7); MK_ATTR(8); MK_ATTR(9); MK_ATTR(10);
        per_cu = 1;
#endif
        if (per_cu < 1) { fprintf(stderr, "kernel_launch: occupancy query reports %d blocks/CU\n", per_cu); per_cu = 1; }
        grid = cus;
        if (ws_size < WS_END) { fprintf(stderr, "kernel_launch: workspace too small (%zu < %zu)\n", ws_size, (size_t)WS_END); grid = -1; }
        (void)hipGetLastError();
    }
    if (grid < 0) return;
    (void)hipMemsetAsync((char*)d_ws + WS_CTL, 0, 4096, stream);
    Params p{};
    for (int i = 0; i < 23; ++i) p.in[i] = (const float*)d_in[i];
    p.out = (float*)d_out; p.ws = (unsigned char*)d_ws;
#if MK_ONE_LAUNCH
    void* args[] = {&p};
    hipError_t e = hipLaunchCooperativeKernel((const void*)mk_fwd, dim3(grid), dim3(NTHREADS), args, LDS_BYTES, stream);
    if (e != hipSuccess) fprintf(stderr, "cooperative launch failed: %s (grid %d)\n", hipGetErrorString(e), grid);
#else
#define MK_LAUNCH(PH) hipLaunchKernelGGL(mk_one<PH>, dim3(grid), dim3(NTHREADS), LDS_BYTES, stream, p)
    MK_LAUNCH(0); MK_LAUNCH(1); MK_LAUNCH(2); MK_LAUNCH(3); MK_LAUNCH(4); MK_LAUNCH(5); MK_LAUNCH(6); MK_LAUNCH(7); MK_LAUNCH(8); MK_LAUNCH(9); MK_LAUNCH(10);
#endif
}
```

```cpp
#include <hip/hip_runtime.h>
#include <hip/hip_cooperative_groups.h>
#include <cstdint>
#include <cstdio>
namespace cg = cooperative_groups;

#ifndef MK_ONE_LAUNCH
#define MK_ONE_LAUNCH 1
#endif

#define LAS __attribute__((address_space(3)))
typedef unsigned short bf16_t;
typedef short bf16x8 __attribute__((ext_vector_type(8)));
typedef float f32x4 __attribute__((ext_vector_type(4)));
typedef float f32x2 __attribute__((ext_vector_type(2)));
typedef unsigned u32x4 __attribute__((ext_vector_type(4)));
typedef unsigned u32x2 __attribute__((ext_vector_type(2)));

constexpr int NB = 16, SEQ = 2048, DM = 1024, MTOK = NB * SEQ;
constexpr int NPROJ = 3072;
constexpr int CQ = 0, CKC = 512, CVC = 640, CKS = 768, CVS = 896, CKW = 1024, CVW = 1152, CGQ = 1280, CGK = 1536, CGV = 1792, CGR = 2304, CGATE = 2816, CGLR = 2840;
constexpr int NEXP = 32, DFF = 1024;
constexpr int MAXTILES = 544, XROWS = MAXTILES * 256;
constexpr float EPS = 1e-6f;
constexpr int NTHREADS = 512;
constexpr int LDS_BYTES = 160 * 1024;

constexpr size_t MiB = 1u << 20;
constexpr size_t WS_CTL = 0;
constexpr size_t WS_WIN = 2 * MiB;
constexpr size_t WS_WOUT = 8 * MiB;
constexpr size_t WS_CW1K = 10 * MiB, WS_CW1V = 11 * MiB;
constexpr size_t WS_CW2K = 12 * MiB, WS_CW2V = 12 * MiB + 512 * 1024;
constexpr size_t WS_CBIAS = 13 * MiB;
constexpr size_t WS_WRT = 13 * MiB + 512 * 1024;
constexpr size_t WS_WGU = 16 * MiB;
constexpr size_t WS_WD = 144 * MiB;
constexpr size_t WS_H = 208 * MiB;
constexpr size_t WS_PROJ = 272 * MiB;
constexpr size_t WS_QN = 464 * MiB, WS_QR = 496 * MiB;
constexpr size_t WS_KS = 528 * MiB, WS_KW = 536 * MiB;
constexpr size_t WS_VST = 544 * MiB, WS_VWT = 552 * MiB;
constexpr size_t WS_KC = 560 * MiB, WS_VCT = 561 * MiB;
constexpr size_t WS_U = 562 * MiB;
constexpr size_t WS_OI = 626 * MiB;
constexpr size_t WS_QD = 690 * MiB;
constexpr size_t WS_DEC = 722 * MiB;
constexpr size_t WS_SP = 723 * MiB;
constexpr size_t WS_ATT = 787 * MiB;
constexpr size_t WS_TOPI = 851 * MiB, WS_TOPG = 852 * MiB, WS_DEST = 853 * MiB;
constexpr size_t WS_XS = 272 * MiB;
constexpr size_t WS_ACT = 544 * MiB;
constexpr size_t WS_Y = 272 * MiB;
constexpr size_t WS_X1 = 854 * MiB;
constexpr size_t WS_END = 982 * MiB;
constexpr int CW_CNT = 0, CW_FILL = 64, CW_Q3 = 128, CW_BAR = 1024;
constexpr int CTL_BYTES = 32768;

struct Params {
    const float* in[23];
    float* out;
    unsigned char* ws;
};

__device__ __forceinline__ float bf2f(bf16_t v) { return __uint_as_float(((unsigned)v) << 16); }
__device__ __forceinline__ unsigned f2bf(float f) { unsigned u = __float_as_uint(f); return (u + 0x7fffu + ((u >> 16) & 1u)) >> 16; }
__device__ __forceinline__ unsigned pk2(float lo, float hi) { return f2bf(lo) | (f2bf(hi) << 16); }
__device__ __forceinline__ float wave_sum(float v) {
#pragma unroll
    for (int o = 1; o < 64; o <<= 1) v += __shfl_xor(v, o);
    return v;
}
#define LDS_WAIT() asm volatile("s_waitcnt lgkmcnt(0)" ::: "memory")
#define BAR_LDS() do { asm volatile("s_waitcnt lgkmcnt(0)" ::: "memory"); __builtin_amdgcn_s_barrier(); asm volatile("" ::: "memory"); } while (0)
__device__ __forceinline__ int opaque_tid() { int t = threadIdx.x; asm volatile("" : "+v"(t)); return t; }
__device__ __forceinline__ float sigmoidf_(float x) { return 1.f / (1.f + __expf(-x)); }

namespace pg8 {
constexpr int BM = 256, BK = 64, HALF = 128, HTB = HALF * BK * 2, STAGE_BYTES = 8 * HTB, NXCD = 8, WGM = 8;
__device__ __forceinline__ int lds_byte(int r, int c) { const int st = (r >> 4) * 2 + (c >> 5), rr = r & 15, cc = c & 31, ob = rr * 64 + cc * 2; return st * 1024 + (ob ^ (((ob >> 9) & 1) << 5)); }
__device__ __forceinline__ void stage_rc(int b, int& R, int& C) { const int st = b / 1024, sb = b % 1024, swz = sb ^ (((sb >> 9) & 1) << 5); R = (st >> 1) * 16 + swz / 64; C = (st & 1) * 32 + (swz % 64) / 2; }
__device__ __forceinline__ int perm32(int rho) { const int n = rho >> 4, i = rho & 15; return 8 * (i >> 2) + 4 * n + (i & 3); }

struct Unit { int pm, pn, pb; };
struct Gemm { const bf16_t* A; const bf16_t* Bt; int K; };

__device__ __forceinline__ bool order_next(long L, int nM, int nN, int& pm, int& pn) {
    const int nwg = nM * nN; if (L >= nwg) return false;
    int wgid = (int)L; { const int q = nwg / NXCD, r = nwg % NXCD, xcd = wgid % NXCD, off = wgid / NXCD; wgid = (xcd < r ? xcd * (q + 1) : r * (q + 1) + (xcd - r) * q) + off; }
    const int nig = WGM * nN, gid = wgid / nig, fm = gid * WGM, gsz = (nM - fm) < WGM ? (nM - fm) : WGM;
    pm = fm + ((wgid % nig) % gsz); pn = (wgid % nig) / gsz; return true;
}
struct StaticOrder {
    int nM, nN, G, c;
    __device__ __forceinline__ bool next(int i, Unit& u) const { if (!order_next((long)i * G + c, nM, nN, u.pm, u.pn)) return false; u.pb = u.pn; return true; }
};
struct MoeOrder {
    int nM, nN, G, c; const LAS int* tile_e;
    __device__ __forceinline__ bool next(int i, Unit& u) const { if (!order_next((long)i * G + c, nM, nN, u.pm, u.pn)) return false; u.pb = tile_e[u.pm] * nN + u.pn; return true; }
};

__device__ __forceinline__ unsigned cvt_pk_bf16(float lo, float hi) { unsigned r; asm volatile("v_cvt_pk_bf16_f32 %0, %1, %2" : "=v"(r) : "v"(lo), "v"(hi)); return r; }

struct EpiBf16 {
    static constexpr bool PERM = true;
    bf16_t* O; int ldc;
    __device__ __forceinline__ void operator()(const f32x4 (&acc)[2][2][4][2], const Unit& u, int wr, int wc, int fr, int fq) const {
        const int row0 = u.pm * BM + wr * 64 + fr, col0 = u.pn * BM + wc * 32 + 8 * fq;
#pragma unroll
        for (int ai = 0; ai < 2; ++ai)
#pragma unroll
            for (int m = 0; m < 4; ++m) { bf16_t* rowp = O + (size_t)(row0 + ai * HALF + m * 16) * ldc + col0;
#pragma unroll
                for (int bj = 0; bj < 2; ++bj) { const f32x4 v0 = acc[ai][bj][m][0], v1 = acc[ai][bj][m][1];
                    u32x4 w; w.x = cvt_pk_bf16(v0[0], v0[1]); w.y = cvt_pk_bf16(v0[2], v0[3]); w.z = cvt_pk_bf16(v1[0], v1[1]); w.w = cvt_pk_bf16(v1[2], v1[3]);
                    *(u32x4*)(rowp + bj * HALF) = w; } }
    }
};
struct EpiResF32 {
    static constexpr bool PERM = false;
    const float* base; float* out; int ldc;
    __device__ __forceinline__ void operator()(const f32x4 (&acc)[2][2][4][2], const Unit& u, int wr, int wc, int fr, int fq) const {
        const int col0 = u.pn * BM + wc * 32 + 4 * fq;
#pragma unroll
        for (int ai = 0; ai < 2; ++ai)
#pragma unroll
            for (int m = 0; m < 4; ++m) { const size_t off = (size_t)(u.pm * BM + ai * HALF + wr * 64 + m * 16 + fr) * ldc + col0;
#pragma unroll
                for (int bj = 0; bj < 2; ++bj)
#pragma unroll
                    for (int n = 0; n < 2; ++n) { const f32x4 bs = *(const f32x4*)(base + off + bj * HALF + n * 16); *(f32x4*)(out + off + bj * HALF + n * 16) = bs + acc[ai][bj][m][n]; } }
    }
};
struct EpiSwiglu {
    static constexpr bool PERM = true;
    bf16_t* O; const float* bias; int nN;
    __device__ __forceinline__ void operator()(const f32x4 (&acc)[2][2][4][2], const Unit& u, int wr, int wc, int fr, int fq) const {
        const int e = u.pb / nN;
        const int row0 = u.pm * BM + wr * 64 + fr, ch = u.pn * HALF + wc * 32 + 8 * fq;
        const float* bg = bias + (size_t)e * 2048 + ch; const float* bl = bg + 1024;
        const f32x4 bg0 = *(const f32x4*)bg, bg1 = *(const f32x4*)(bg + 4), bl0 = *(const f32x4*)bl, bl1 = *(const f32x4*)(bl + 4);
#pragma unroll
        for (int ai = 0; ai < 2; ++ai)
#pragma unroll
            for (int m = 0; m < 4; ++m) {
                float r[8];
#pragma unroll
                for (int n = 0; n < 2; ++n)
#pragma unroll
                    for (int j = 0; j < 4; ++j) {
                        float gv = acc[ai][0][m][n][j] + (n ? bg1[j] : bg0[j]);
                        float lv = acc[ai][1][m][n][j] + (n ? bl1[j] : bl0[j]);
                        gv = fminf(gv, 7.0f); lv = fminf(fmaxf(lv, -7.0f), 7.0f);
                        r[n * 4 + j] = gv * (1.f / (1.f + __expf(-1.702f * gv))) * (lv + 1.0f);
                    }
                u32x4 w; w.x = cvt_pk_bf16(r[0], r[1]); w.y = cvt_pk_bf16(r[2], r[3]); w.z = cvt_pk_bf16(r[4], r[5]); w.w = cvt_pk_bf16(r[6], r[7]);
                *(u32x4*)(O + (size_t)(row0 + ai * HALF + m * 16) * DFF + ch) = w;
            }
    }
};
struct EpiDown {
    static constexpr bool PERM = true;
    bf16_t* O; const float* bias; int nN;
    __device__ __forceinline__ void operator()(const f32x4 (&acc)[2][2][4][2], const Unit& u, int wr, int wc, int fr, int fq) const {
        const int e = u.pb / nN;
        const int row0 = u.pm * BM + wr * 64 + fr, col0 = u.pn * BM + wc * 32 + 8 * fq;
        const float* bp = bias + (size_t)e * 1024 + col0;
        f32x4 bv[2][2];
#pragma unroll
        for (int bj = 0; bj < 2; ++bj)
#pragma unroll
            for (int n = 0; n < 2; ++n) bv[bj][n] = *(const f32x4*)(bp + bj * HALF + 4 * n);
#pragma unroll
        for (int ai = 0; ai < 2; ++ai)
#pragma unroll
            for (int m = 0; m < 4; ++m) { bf16_t* rowp = O + (size_t)(row0 + ai * HALF + m * 16) * 1024 + col0;
#pragma unroll
                for (int bj = 0; bj < 2; ++bj) { const f32x4 v0 = acc[ai][bj][m][0] + bv[bj][0], v1 = acc[ai][bj][m][1] + bv[bj][1];
                    u32x4 w; w.x = cvt_pk_bf16(v0[0], v0[1]); w.y = cvt_pk_bf16(v0[2], v0[3]); w.z = cvt_pk_bf16(v1[0], v1[1]); w.w = cvt_pk_bf16(v1[2], v1[3]);
                    *(u32x4*)(rowp + bj * HALF) = w; } }
    }
};

template <class Epi, class Sched>
__device__ __forceinline__ void gemm_phase(LAS unsigned char* lds, const Gemm g, const Sched& S, const Epi& E) {
    const int tid = opaque_tid(), wid = __builtin_amdgcn_readfirstlane(tid >> 6), lane = tid & 63, wr = wid >> 2, wc = wid & 3, fr = lane & 15, fq = lane >> 4;
    const int K = g.K, nt = K / BK;
    unsigned voffA[2], voffB[2];
#pragma unroll
    for (int i = 0; i < 2; ++i) { int R, C; stage_rc(tid * 16 + i * 8192, R, C); const int Rb = Epi::PERM ? ((R & ~31) + perm32(R & 31)) : R;
        voffA[i] = (unsigned)(R * K + C) * 2u; voffB[i] = (unsigned)(Rb * K + C) * 2u; }
    const size_t kstep = (size_t)(BK * 2);
    const size_t hstep = (size_t)HALF * K * 2;
    const size_t tstep = 2 * hstep;
    const unsigned ldsw = (unsigned)wid * 1024u;
    const int aoff = lds_byte(wr * 64 + fr, fq * 8), boff = lds_byte(wc * 32 + fr, fq * 8);
#define PG8_SA(b, h) (((b) * 2 + (h)) * HTB)
#define PG8_SB(b, h) ((4 + (b) * 2 + (h)) * HTB)
#define PG8_STAGE(bufoff, gbase, voff) do { _Pragma("unroll") for (int _i = 0; _i < 2; ++_i) \
        __builtin_amdgcn_global_load_lds((const unsigned*)((const char*)(gbase) + (voff)[_i]), (LAS unsigned*)(lds + (bufoff) + ldsw + _i * 8192), 16, 0, 0); } while (0)
#define PG8_LDA(dst, b, h) do { _Pragma("unroll") for (int m = 0; m < 4; ++m) _Pragma("unroll") for (int k = 0; k < 2; ++k) dst[m][k] = *(const LAS bf16x8*)(lds + PG8_SA(b, h) + aoff + m * 2048 + k * 1024); } while (0)
#define PG8_LDB(dst, b, h) do { _Pragma("unroll") for (int n = 0; n < 2; ++n) _Pragma("unroll") for (int k = 0; k < 2; ++k) dst[n][k] = *(const LAS bf16x8*)(lds + PG8_SB(b, h) + boff + n * 2048 + k * 1024); } while (0)
#define PG8_MMA(ai, bj, At, Bt) do { __builtin_amdgcn_s_setprio(1); _Pragma("unroll") for (int m = 0; m < 4; ++m) _Pragma("unroll") for (int n = 0; n < 2; ++n) _Pragma("unroll") for (int k = 0; k < 2; ++k) \
        acc[ai][bj][m][n] = __builtin_amdgcn_mfma_f32_16x16x32_bf16(Bt[n][k], At[m][k], acc[ai][bj][m][n], 0, 0, 0); __builtin_amdgcn_s_setprio(0); } while (0)
#define PG8_WAIT_V(n) asm volatile("s_waitcnt vmcnt(" #n ")" ::: "memory")
#define PG8_WAIT_L(n) asm volatile("s_waitcnt lgkmcnt(" #n ")" ::: "memory")
#define PG8_BAR __builtin_amdgcn_s_barrier()
#define PG8_SCHED __builtin_amdgcn_sched_barrier(0)
    Unit cur, nxt; int ui = 0;
    if (!S.next(0, cur)) return;
    f32x4 acc[2][2][4][2];
#pragma unroll
    for (int a = 0; a < 2; ++a)
#pragma unroll
        for (int b = 0; b < 2; ++b)
#pragma unroll
            for (int m = 0; m < 4; ++m)
#pragma unroll
                for (int n = 0; n < 2; ++n) acc[a][b][m][n] = (f32x4){0.f, 0.f, 0.f, 0.f};
    bf16x8 At[4][2], B0[2][2], B1[2][2];
    const char* cA = (const char*)g.A + (size_t)cur.pm * tstep; const char* cB = (const char*)g.Bt + (size_t)cur.pb * tstep;
    {
        PG8_STAGE(PG8_SB(0, 0), cB, voffB); PG8_STAGE(PG8_SB(0, 1), cB + hstep, voffB); PG8_STAGE(PG8_SA(0, 0), cA, voffA); PG8_STAGE(PG8_SA(0, 1), cA + hstep, voffA);
        if (wr == 1) PG8_BAR;
        PG8_WAIT_V(2); PG8_BAR;
        PG8_STAGE(PG8_SB(1, 0), cB + kstep, voffB); PG8_STAGE(PG8_SA(1, 0), cA + kstep, voffA); PG8_STAGE(PG8_SB(1, 1), cB + hstep + kstep, voffB);
        PG8_WAIT_V(6); PG8_BAR;
    }
    for (;;) {
        const bool has_next = S.next(ui + 1, nxt);
        const char* nA = has_next ? (const char*)g.A + (size_t)nxt.pm * tstep : cA; const char* nB = has_next ? (const char*)g.Bt + (size_t)nxt.pb * tstep : cB;
        for (int t = 0; t < nt; t += 2) {
            const bool last = (t == nt - 2);
            const char* a1 = cA + (size_t)(t + 1) * kstep;
            const char* a2 = last ? nA : cA + (size_t)(t + 2) * kstep; const char* b2 = last ? nB : cB + (size_t)(t + 2) * kstep;
            const char* a3 = a2 + kstep; const char* b3 = b2 + kstep;
            PG8_LDB(B0, 0, 0); PG8_LDB(B1, 0, 1); PG8_SCHED; PG8_LDA(At, 0, 0); PG8_STAGE(PG8_SA(1, 1), a1 + hstep, voffA);
            PG8_WAIT_V(8); PG8_WAIT_L(0); PG8_BAR; PG8_MMA(0, 0, At, B0); PG8_MMA(0, 1, At, B1); PG8_BAR; PG8_SCHED;
            PG8_LDA(At, 0, 1); PG8_STAGE(PG8_SB(0, 0), b2, voffB); PG8_STAGE(PG8_SB(0, 1), b2 + hstep, voffB); PG8_STAGE(PG8_SA(0, 0), a2, voffA);
            PG8_WAIT_V(8); PG8_WAIT_L(0); PG8_BAR; PG8_MMA(1, 0, At, B0); PG8_MMA(1, 1, At, B1); PG8_BAR; PG8_SCHED;
            PG8_LDB(B0, 1, 0); PG8_LDB(B1, 1, 1); PG8_SCHED; PG8_LDA(At, 1, 0); PG8_STAGE(PG8_SA(0, 1), a2 + hstep, voffA);
            PG8_WAIT_V(8); PG8_WAIT_L(0); PG8_BAR; PG8_MMA(0, 0, At, B0); PG8_MMA(0, 1, At, B1); PG8_BAR; PG8_SCHED;
            PG8_LDA(At, 1, 1); PG8_STAGE(PG8_SB(1, 0), b3, voffB); PG8_STAGE(PG8_SB(1, 1), b3 + hstep, voffB); PG8_STAGE(PG8_SA(1, 0), a3, voffA);
            PG8_WAIT_V(8); PG8_WAIT_L(0); PG8_BAR; PG8_MMA(1, 0, At, B0); PG8_MMA(1, 1, At, B1); PG8_BAR; PG8_SCHED;
        }
        if (wr == 0) PG8_BAR;
        E(acc, cur, wr, wc, fr, fq);
        if (!has_next) break;
#pragma unroll
        for (int a = 0; a < 2; ++a)
#pragma unroll
            for (int b = 0; b < 2; ++b)
#pragma unroll
                for (int m = 0; m < 4; ++m)
#pragma unroll
                    for (int n = 0; n < 2; ++n) acc[a][b][m][n] = (f32x4){0.f, 0.f, 0.f, 0.f};
        cur = nxt; cA = nA; cB = nB; ++ui;
        if (wr == 1) PG8_BAR;
    }
    PG8_WAIT_V(0);
    PG8_BAR;
#undef PG8_SA
#undef PG8_SB
#undef PG8_STAGE
#undef PG8_LDA
#undef PG8_LDB
#undef PG8_MMA
#undef PG8_WAIT_V
#undef PG8_WAIT_L
#undef PG8_BAR
#undef PG8_SCHED
}
}

__device__ __forceinline__ int win_map(int n) {
    if (n < 1280) return n;
    if (n < 2304) return n + 24;
    if (n < 2816) return n + 40;
    if (n < 2840) return n - 1536;
    if (n < 2856) return n - 512;
    return -1;
}
template <int MODE> __device__ __forceinline__ int colmap(int r) {
    if (MODE == 1) return win_map(r);
    if (MODE == 2) return ((r >> 7) & 1) * 1024 + (r >> 8) * 128 + (r & 127);
    return r;
}
template <int MODE>
__device__ __forceinline__ void transpose_item(const float* W, int K, int Nsrc, bf16_t* WT, int nblk, LAS float* scr, int item, int lane) {
    const int kb = item / nblk, nb = item % nblk, k0 = 64 * kb, n0 = 32 * nb;
    const int sc = colmap<MODE>(n0 + (lane & 31));
#pragma unroll 8
    for (int i = 0; i < 32; ++i) { const int kk = 2 * i + (lane >> 5); scr[kk * 33 + (lane & 31)] = sc >= 0 ? W[(size_t)(k0 + kk) * Nsrc + sc] : 0.f; }
    LDS_WAIT();
    const int c = lane & 7;
#pragma unroll
    for (int j = 0; j < 4; ++j) { const int n = (lane >> 3) + 8 * j; const LAS float* s = scr + (8 * c) * 33 + n;
        u32x4 o; o.x = pk2(s[0 * 33], s[1 * 33]); o.y = pk2(s[2 * 33], s[3 * 33]); o.z = pk2(s[4 * 33], s[5 * 33]); o.w = pk2(s[6 * 33], s[7 * 33]);
        *(u32x4*)(WT + (size_t)(n0 + n) * K + k0 + 8 * c) = o; }
    LDS_WAIT();
}
__device__ __forceinline__ void rms_row_to_bf16(const float* xrow, const float* g, bf16_t* orow, int lane) {
    const f32x4* xr = (const f32x4*)xrow + lane; const f32x4* gr = (const f32x4*)g + lane;
    f32x4 v[4]; float s = 0.f;
#pragma unroll
    for (int j = 0; j < 4; ++j) { v[j] = xr[64 * j]; s += (v[j].x * v[j].x + v[j].y * v[j].y) + (v[j].z * v[j].z + v[j].w * v[j].w); }
    const float rstd = 1.f / sqrtf(wave_sum(s) * (1.f / DM) + EPS);
    unsigned long long* o8 = (unsigned long long*)orow + lane;
#pragma unroll
    for (int j = 0; j < 4; ++j) { const f32x4 gg = gr[64 * j]; const f32x4 o = v[j] * rstd * gg;
        o8[64 * j] = (unsigned long long)pk2(o.x, o.y) | ((unsigned long long)pk2(o.z, o.w) << 32); }
}
__device__ __forceinline__ void phase0(const Params& p, LAS unsigned char* lds, int blk, int G) {
    const int tid = opaque_tid(), lane = tid & 63, wave = tid >> 6;
    LAS float* scr = (LAS float*)(lds + wave * 16384);
    const int gw = blk * 8 + wave, NGW = G * 8;
    unsigned char* ws = p.ws;
    constexpr int I_GU = 16 * 64, I_DN = 16 * 32;
    constexpr int N_GU = NEXP * I_GU, N_DN = NEXP * I_DN, N_IN = 16 * (NPROJ / 32), N_OUT = 16 * 32, N_C1 = 32 * 8, N_C2 = 4 * 2;
    constexpr int NITEMS = N_GU + N_DN + N_IN + N_OUT + 2 * N_C1 + 2 * N_C2;
    for (int it = gw; it < NITEMS; it += NGW) {
        int r = it;
        if (r < N_GU) { const int e = r / I_GU; transpose_item<2>(p.in[19] + (size_t)e * 1024 * 2048, 1024, 2048, (bf16_t*)(ws + WS_WGU) + (size_t)e * 2048 * 1024, 64, scr, r % I_GU, lane); continue; } r -= N_GU;
        if (r < N_DN) { const int e = r / I_DN; transpose_item<0>(p.in[21] + (size_t)e * 1024 * 1024, 1024, 1024, (bf16_t*)(ws + WS_WD) + (size_t)e * 1024 * 1024, 32, scr, r % I_DN, lane); continue; } r -= N_DN;
        if (r < N_IN) { transpose_item<1>(p.in[3], 1024, 2856, (bf16_t*)(ws + WS_WIN), NPROJ / 32, scr, r, lane); continue; } r -= N_IN;
        if (r < N_OUT) { transpose_item<0>(p.in[15], 1024, 1024, (bf16_t*)(ws + WS_WOUT), 32, scr, r, lane); continue; } r -= N_OUT;
        if (r < N_C1) { transpose_item<0>(p.in[7], 2048, 256, (bf16_t*)(ws + WS_CW1K), 8, scr, r, lane); continue; } r -= N_C1;
        if (r < N_C1) { transpose_item<0>(p.in[10], 2048, 256, (bf16_t*)(ws + WS_CW1V), 8, scr, r, lane); continue; } r -= N_C1;
        if (r < N_C2) { transpose_item<0>(p.in[8], 256, 64, (bf16_t*)(ws + WS_CW2K), 2, scr, r, lane); continue; } r -= N_C2;
        transpose_item<0>(p.in[11], 256, 64, (bf16_t*)(ws + WS_CW2V), 2, scr, r, lane);
    }
    for (int m = gw; m < MTOK; m += NGW) rms_row_to_bf16(p.in[0] + (size_t)m * DM, p.in[2], (bf16_t*)(ws + WS_H) + (size_t)m * DM, lane);
    for (int i = blk * NTHREADS + tid; i < NEXP * DM; i += G * NTHREADS) { const int e = i >> 10, d = i & 1023; ((float*)(ws + WS_WRT))[i] = p.in[16][d] * p.in[17][d * NEXP + e]; }
    if (blk == G - 1) {
        const int which = tid >> 8, j = tid & 255;
        const float* pos = which ? p.in[9] : p.in[6]; const float* w1 = which ? p.in[10] : p.in[7];
        float s = 0.f;
#pragma unroll 8
        for (int k = 0; k < 2048; ++k) s += pos[k] * w1[(size_t)k * 256 + j];
        ((float*)(ws + WS_CBIAS))[tid] = s;
    }
}

__device__ __forceinline__ void p2a_unit(const Params& p, LAS unsigned char* lds, int unit) {
    const int tid = opaque_tid(), lane = tid & 63, wave = tid >> 6;
    unsigned char* ws = p.ws;
    const bf16_t* PROJ = (const bf16_t*)(ws + WS_PROJ);
    const int b = unit >> 5, blkc = unit & 31, tok0 = unit * 64;
    const float gq = p.in[4][lane], gks = p.in[5][64 + lane], gkw = p.in[5][128 + lane];
    const float inv_freq = __expf(-13.122363377404328f * (float)(2 * (lane & 7)) * (1.f / 16.f));
    for (int ti = 0; ti < 8; ++ti) {
        const int i = wave * 8 + ti, t = tok0 + i;
        const float pos = (float)((const int*)p.in[1])[t];
        const float ang = pos * inv_freq;
        const float cs = cosf(ang), sn = sinf(ang);
        const bf16_t* pr = PROJ + (size_t)t * NPROJ;
#pragma unroll
        for (int v = 0; v < 12; ++v) {
            const int col = (v < 8) ? (CQ + v * 64) : (v < 10 ? CKS + (v - 8) * 64 : CKW + (v - 10) * 64);
            const float g = (v < 8) ? gq : (v < 10 ? gks : gkw);
            const float x = bf2f(pr[col + lane]);
            const float ss = wave_sum(x * x);
            float y = x * (1.f / sqrtf(ss * (1.f / 64.f) + EPS)) * g;
            const float partner = __shfl_xor(y, 8);
            float yr = y;
            if (lane < 8) yr = y * cs - partner * sn; else if (lane < 16) yr = y * cs + partner * sn;
            if (v < 8) {
                ((bf16_t*)(ws + WS_QN))[(size_t)t * 512 + v * 64 + lane] = (bf16_t)f2bf(y * 0.125f);
                ((bf16_t*)(ws + WS_QR))[(size_t)t * 512 + v * 64 + lane] = (bf16_t)f2bf(yr * 0.125f);
            } else if (v < 10) {
                ((bf16_t*)(ws + WS_KS))[((size_t)(b * 2 + (v - 8)) * SEQ + (t & (SEQ - 1))) * 64 + lane] = (bf16_t)f2bf(yr);
            } else {
                ((bf16_t*)(ws + WS_KW))[((size_t)(b * 2 + (v - 10)) * SEQ + (t & (SEQ - 1))) * 64 + lane] = (bf16_t)f2bf(yr);
            }
        }
    }
    LAS bf16_t* T = (LAS bf16_t*)lds;
    for (int v = 0; v < 4; ++v) {
        const int kh = v & 1, col = (v < 2 ? CVS : CVW) + kh * 64;
        __syncthreads();
        { const int tk = tid >> 3, ch = tid & 7; const u32x4 raw = *(const u32x4*)(PROJ + (size_t)(tok0 + tk) * NPROJ + col + 8 * ch);
#pragma unroll
          for (int q = 0; q < 4; ++q) { const unsigned wv = raw[q]; T[(8 * ch + 2 * q) * 72 + tk] = (bf16_t)(wv & 0xffffu); T[(8 * ch + 2 * q + 1) * 72 + tk] = (bf16_t)(wv >> 16); } }
        __syncthreads();
        { const int d = tid >> 3, ch = tid & 7; const u32x4 o = *(const LAS u32x4*)(T + d * 72 + 8 * ch);
          bf16_t* dst = (bf16_t*)(ws + (v < 2 ? WS_VST : WS_VWT)) + (((size_t)(b * 2 + kh) * 32 + blkc) * 64 + d) * 64 + 8 * ch;
          *(u32x4*)dst = o; }
    }
    __syncthreads();
}

__device__ __forceinline__ void p2b_unit(const Params& p, LAS unsigned char* lds, int unit) {
    const int tid = opaque_tid(), lane = tid & 63, w = tid >> 6, fr = lane & 15, fq = lane >> 4;
    unsigned char* ws = p.ws;
    const bf16_t* PROJ = (const bf16_t*)(ws + WS_PROJ);
    const int which = unit >> 6, rt = unit & 63;
    const bf16_t* W1T = (const bf16_t*)(ws + (which ? WS_CW1V : WS_CW1K));
    const bf16_t* W2T = (const bf16_t*)(ws + (which ? WS_CW2V : WS_CW2K));
    const float* cb = (const float*)(ws + WS_CBIAS) + which * 256;
    const int colbase = which ? CVC : CKC;
    LAS bf16_t* Hd = (LAS bf16_t*)lds;
    LAS float* Of = (LAS float*)(lds + 64 * 264 * 2);
    const bf16_t* arow[4];
#pragma unroll
    for (int m = 0; m < 4; ++m) { const int R = rt * 64 + 16 * m + fr; const int bb = R >> 8, kh = (R >> 7) & 1; int n = R & 127; if (n > 126) n = 126;
        arow[m] = PROJ + (size_t)(bb * SEQ + 16 * n) * NPROJ + colbase + kh * 64 + 8 * fq; }
    const bf16_t* brow[2];
#pragma unroll
    for (int nf = 0; nf < 2; ++nf) brow[nf] = W1T + (size_t)(32 * w + 16 * nf + fr) * 2048 + 8 * fq;
    f32x4 acc[4][2];
#pragma unroll
    for (int m = 0; m < 4; ++m)
#pragma unroll
        for (int nf = 0; nf < 2; ++nf) acc[m][nf] = (f32x4){0.f, 0.f, 0.f, 0.f};
#pragma unroll 2
    for (int ks = 0; ks < 64; ++ks) {
        bf16x8 a[4], bb2[2];
        const size_t aoff = (size_t)(ks >> 1) * NPROJ + 32 * (ks & 1);
#pragma unroll
        for (int m = 0; m < 4; ++m) a[m] = *(const bf16x8*)(arow[m] + aoff);
#pragma unroll
        for (int nf = 0; nf < 2; ++nf) bb2[nf] = *(const bf16x8*)(brow[nf] + 32 * ks);
#pragma unroll
        for (int m = 0; m < 4; ++m)
#pragma unroll
            for (int nf = 0; nf < 2; ++nf) acc[m][nf] = __builtin_amdgcn_mfma_f32_16x16x32_bf16(a[m], bb2[nf], acc[m][nf], 0, 0, 0);
    }
#pragma unroll
    for (int nf = 0; nf < 2; ++nf) { const int col = 32 * w + 16 * nf + fr; const float bias = cb[col];
#pragma unroll
        for (int m = 0; m < 4; ++m)
#pragma unroll
            for (int j = 0; j < 4; ++j) { const float hv = acc[m][nf][j] + bias; Hd[(16 * m + 4 * fq + j) * 264 + col] = (bf16_t)f2bf(hv * sigmoidf_(hv)); } }
    __syncthreads();
    {
        const int m2 = w >> 1;
        f32x4 acc2[2] = {(f32x4){0.f, 0.f, 0.f, 0.f}, (f32x4){0.f, 0.f, 0.f, 0.f}};
#pragma unroll
        for (int ks = 0; ks < 8; ++ks) {
            const bf16x8 a = *(const LAS bf16x8*)(Hd + (16 * m2 + fr) * 264 + 32 * ks + 8 * fq);
#pragma unroll
            for (int q = 0; q < 2; ++q) { const int nf2 = 2 * (w & 1) + q; const bf16x8 bv = *(const bf16x8*)(W2T + (size_t)(16 * nf2 + fr) * 256 + 32 * ks + 8 * fq);
                acc2[q] = __builtin_amdgcn_mfma_f32_16x16x32_bf16(a, bv, acc2[q], 0, 0, 0); }
        }
#pragma unroll
        for (int q = 0; q < 2; ++q) { const int nf2 = 2 * (w & 1) + q;
#pragma unroll
            for (int j = 0; j < 4; ++j) Of[(16 * m2 + 4 * fq + j) * 65 + 16 * nf2 + fr] = acc2[q][j]; }
    }
    __syncthreads();
    for (int rr = 0; rr < 8; ++rr) {
        const int r = 8 * w + rr, R = rt * 64 + r, bb = R >> 8, kh = (R >> 7) & 1, n = R & 127;
        float v = Of[r * 65 + lane];
        if (which == 0) {
            const float ss = wave_sum(v * v);
            v = v * (1.f / sqrtf(ss * (1.f / 64.f) + EPS)) * p.in[5][lane];
            if (n == 127) v = 0.f;
            ((bf16_t*)(ws + WS_KC))[((size_t)(bb * 2 + kh) * 128 + n) * 64 + lane] = (bf16_t)f2bf(v);
        } else {
            if (n == 127) v = 0.f;
            ((bf16_t*)(ws + WS_VCT))[((size_t)(bb * 2 + kh) * 64 + lane) * 128 + n] = (bf16_t)f2bf(v);
        }
    }
    __syncthreads();
}

constexpr int NSA_KT0 = 0, NSA_VT0 = 9216, NSA_KT1 = 18432, NSA_VT1 = 27648, NSA_PW = 36864, NSA_IMPW = NSA_PW  ,
              NSA_SELM = NSA_PW + 8 * 4608, NSA_UNI = NSA_SELM + 256, NSA_OUT = NSA_UNI + 256;
static_assert(4 * 64 * 33 * 4 <= 8 * 4608 && NSA_OUT + 256 * 68 * 4 <= LDS_BYTES - 16, "NSA LDS map");
constexpr float NEGBIG = -1e30f;

template <int CTRL> __device__ __forceinline__ float dppf(float v) { return __int_as_float(__builtin_amdgcn_update_dpp(0, __float_as_int(v), CTRL, 0xf, 0xf, true)); }
__device__ __forceinline__ float red16_max(float v) { v = fmaxf(v, dppf<0xB1>(v)); v = fmaxf(v, dppf<0x4E>(v)); v = fmaxf(v, dppf<0x141>(v)); v = fmaxf(v, dppf<0x140>(v)); return v; }
__device__ __forceinline__ float red16_sum(float v) { v += dppf<0xB1>(v); v += dppf<0x4E>(v); v += dppf<0x141>(v); v += dppf<0x140>(v); return v; }

__device__ __forceinline__ void nsa_qk(const bf16x8 (&aq)[2][2], const LAS bf16_t* KT, f32x4 (&S)[2][4], int fr, int fq) {
#pragma unroll
    for (int nf = 0; nf < 4; ++nf) {
        bf16x8 bk[2];
#pragma unroll
        for (int ks = 0; ks < 2; ++ks) bk[ks] = *(const LAS bf16x8*)(KT + (16 * nf + fr) * 72 + 32 * ks + 8 * fq);
#pragma unroll
        for (int m = 0; m < 2; ++m) { f32x4 s = (f32x4){0.f, 0.f, 0.f, 0.f};
#pragma unroll
            for (int ks = 0; ks < 2; ++ks) s = __builtin_amdgcn_mfma_f32_16x16x32_bf16(aq[m][ks], bk[ks], s, 0, 0, 0);
            S[m][nf] = s; }
    }
}
__device__ __forceinline__ void nsa_pv(const LAS bf16_t* PWw, const LAS bf16_t* VT, f32x4 (&O)[2][4], int fr, int fq) {
    bf16x8 ap[2][2];
#pragma unroll
    for (int m = 0; m < 2; ++m)
#pragma unroll
        for (int ks = 0; ks < 2; ++ks) ap[m][ks] = *(const LAS bf16x8*)(PWw + (16 * m + fr) * 72 + 32 * ks + 8 * fq);
#pragma unroll
    for (int nfd = 0; nfd < 4; ++nfd) {
        bf16x8 bv[2];
#pragma unroll
        for (int ks = 0; ks < 2; ++ks) bv[ks] = *(const LAS bf16x8*)(VT + (16 * nfd + fr) * 72 + 32 * ks + 8 * fq);
#pragma unroll
        for (int m = 0; m < 2; ++m)
#pragma unroll
            for (int ks = 0; ks < 2; ++ks) O[m][nfd] = __builtin_amdgcn_mfma_f32_16x16x32_bf16(ap[m][ks], bv[ks], O[m][nfd], 0, 0, 0);
    }
}
__device__ __forceinline__ void nsa_bounds(int mode, bool rok, int i, int cq, int koff, int& lo, int& hi) {
    hi = (mode == 1) ? i : ((mode == 3) ? (((cq + i - 31) >> 4) - koff) : 63);
    lo = (mode == 2) ? i + 1 : 0;
    hi = rok ? hi : -1;
}
constexpr float NSA_SHIFT = 10.0f, LOG2E = 1.4426950408889634f;
__device__ __forceinline__ void nsa_tile(const bf16x8 (&aq)[2][2], const LAS bf16_t* KT, const LAS bf16_t* VT, LAS bf16_t* PWw, float (&lsum)[2][4], f32x4 (&O)[2][4],
                                         unsigned rowok, int mode, int ibase, int cq, int koff, int fr_, int fq_) {
    int fr = fr_, fq = fq_;
    asm volatile("" : "+v"(fr), "+v"(fq));
    f32x4 S[2][4];
    nsa_qk(aq, KT, S, fr, fq);
#pragma unroll
    for (int m = 0; m < 2; ++m)
#pragma unroll
        for (int j = 0; j < 4; ++j) {
            const int i = ibase + 16 * m + 4 * fq + j;
            int lo, hi; nsa_bounds(mode, (rowok >> (m * 4 + j)) & 1u, i, cq, koff, lo, hi);
            float pv[4];
#pragma unroll
            for (int nf = 0; nf < 4; ++nf) { const int key = 4 * fr + nf; const bool ok = (key >= lo) & (key <= hi);
                const float e = __builtin_amdgcn_exp2f(S[m][nf][j] * LOG2E - NSA_SHIFT * LOG2E); pv[nf] = ok ? e : 0.f; }
            lsum[m][j] += (pv[0] + pv[1]) + (pv[2] + pv[3]);
            u32x2 pw; pw.x = pg8::cvt_pk_bf16(pv[0], pv[1]); pw.y = pg8::cvt_pk_bf16(pv[2], pv[3]);
            *(LAS u32x2*)(PWw + (16 * m + 4 * fq + j) * 72 + 4 * fr) = pw;
        }
    LDS_WAIT();
    nsa_pv(PWw, VT, O, fr, fq);
}
struct NsaStage { u32x4 k, v; };
__device__ __forceinline__ void nsa_fetch(NsaStage& st, const bf16_t* Ksrc, int kstride, const bf16_t* Vsrc, int vstride, int tid) {
    const int r = tid >> 3, ch = tid & 7;
    st.k = *(const u32x4*)(Ksrc + (size_t)r * kstride + 8 * ch);
    st.v = *(const u32x4*)(Vsrc + (size_t)r * vstride + 8 * ch);
}
__device__ __forceinline__ void nsa_commit(const NsaStage& st, LAS bf16_t* KT, LAS bf16_t* VT, int tid) {
    const int r = tid >> 3, ch = tid & 7;
    *(LAS u32x4*)(KT + (16 * (r & 3) + (r >> 2)) * 72 + 8 * ch) = st.k;
    *(LAS u32x4*)(VT + r * 72 + 8 * ch) = st.v;
}

__device__ __forceinline__ void nsa_unit(const Params& p, LAS unsigned char* lds, int b, int kh, int c) {
    const int tid = opaque_tid(), lane = tid & 63, w = tid >> 6, fr = lane & 15, fq = lane >> 4, g = w >> 1, ih = w & 1;
    unsigned char* ws = p.ws;
    const int hh = kh * 4 + g, tok0 = b * SEQ + 64 * c, ibase = 32 * ih;
    const bf16_t* PROJ = (const bf16_t*)(ws + WS_PROJ);
    LAS bf16_t* PWw = (LAS bf16_t*)(lds + NSA_PW + w * 4608);
    LAS float* IMPW = (LAS float*)(lds + NSA_IMPW);
    LAS unsigned* SELM = (LAS unsigned*)(lds + NSA_SELM); LAS unsigned* UNI = (LAS unsigned*)(lds + NSA_UNI);
    LAS float* OUTw = (LAS float*)(lds + NSA_OUT) + (w * 32) * 68;
    const size_t bk = (size_t)(b * 2 + kh);
#define NSA_KTB(bb) ((LAS bf16_t*)(lds + ((bb) ? NSA_KT1 : NSA_KT0)))
#define NSA_VTB(bb) ((LAS bf16_t*)(lds + ((bb) ? NSA_VT1 : NSA_VT0)))
    bf16x8 aq[2][2];
    NsaStage st;
    if (tid == 0) *UNI = 0u;
    {
#pragma unroll
        for (int m = 0; m < 2; ++m)
#pragma unroll
            for (int ks = 0; ks < 2; ++ks) aq[m][ks] = *(const bf16x8*)((const bf16_t*)(ws + WS_QN) + (size_t)(tok0 + ibase + 16 * m + fr) * 512 + hh * 64 + 32 * ks + 8 * fq);
        const int nh = (4 * c + 2 >= 64) ? 2 : 1;
        const bf16_t* KCb = (const bf16_t*)(ws + WS_KC) + bk * 128 * 64; const bf16_t* VCb = (const bf16_t*)(ws + WS_VCT) + bk * 64 * 128;
        float lrow[2][4]; f32x4 O[2][4];
#pragma unroll
        for (int m = 0; m < 2; ++m) {
#pragma unroll
            for (int j = 0; j < 4; ++j) lrow[m][j] = 0.f;
#pragma unroll
            for (int nfd = 0; nfd < 4; ++nfd) O[m][nfd] = (f32x4){0.f, 0.f, 0.f, 0.f};
        }
        nsa_fetch(st, KCb, 64, VCb, 128, tid);
        BAR_LDS();
        nsa_commit(st, NSA_KTB(0), NSA_VTB(0), tid);
        if (nh == 2) { nsa_fetch(st, KCb + 64 * 64, 64, VCb + 64, 128, tid); nsa_commit(st, NSA_KTB(1), NSA_VTB(1), tid); }
        BAR_LDS();
        for (int half = 0; half < nh; ++half) nsa_tile(aq, NSA_KTB(half), NSA_VTB(half), PWw, lrow, O, 0xffu, 3, ibase, 64 * c, 64 * half, fr, fq);
#pragma unroll
        for (int m = 0; m < 2; ++m)
#pragma unroll
            for (int j = 0; j < 4; ++j) { const int t = tok0 + ibase + 16 * m + 4 * fq + j; const float gt = sigmoidf_(bf2f(PROJ[(size_t)t * NPROJ + CGATE + hh * 3 + 0]));
                const float lt = red16_sum(lrow[m][j]);
                const float inv = lt > 0.f ? 1.f / lt : 0.f;
                lrow[m][j] = inv;
#pragma unroll
                for (int nfd = 0; nfd < 4; ++nfd) OUTw[(16 * m + 4 * fq + j) * 68 + 16 * nfd + fr] = gt * inv * O[m][nfd][j]; }
        BAR_LDS();
        float carry[2][4];
#pragma unroll
        for (int m = 0; m < 2; ++m)
#pragma unroll
            for (int j = 0; j < 4; ++j) carry[m][j] = 0.f;
        for (int half = 0; half < nh; ++half) {
            f32x4 S[2][4];
            int fr2 = fr, fq2 = fq;
            asm volatile("" : "+v"(fr2), "+v"(fq2));
            nsa_qk(aq, NSA_KTB(half), S, fr2, fq2);
#pragma unroll
            for (int m = 0; m < 2; ++m)
#pragma unroll
                for (int j = 0; j < 4; ++j) {
                    const int i = ibase + 16 * m + 4 * fq2 + j;
                    const int hi = ((64 * c + i - 31) >> 4) - 64 * half;
                    float pv[4];
#pragma unroll
                    for (int nf = 0; nf < 4; ++nf) pv[nf] = (4 * fr2 + nf <= hi) ? __builtin_amdgcn_exp2f(S[m][nf][j] * LOG2E - NSA_SHIFT * LOG2E) * lrow[m][j] : 0.f;
                    const float e1 = dppf<0x121>(pv[3]), e2 = dppf<0x121>(carry[m][j]);
                    const float extra = (fr2 == 0) ? e2 : e1;
                    IMPW[(g * 64 + i) * 33 + 16 * half + fr2] = ((pv[0] + pv[1]) + (pv[2] + pv[3])) + extra;
                    carry[m][j] = pv[3];
                }
        }
    }
    BAR_LDS();
    {
        LAS float* SC = (LAS float*)(lds + NSA_KT0);
#pragma unroll
        for (int q = 0; q < 4; ++q) { const int pr = q * NTHREADS + tid, i = pr >> 5, j = pr & 31;
            float v = NEGBIG;
            if (j <= c) { v = (IMPW[(0 * 64 + i) * 33 + j] + IMPW[(1 * 64 + i) * 33 + j]) + (IMPW[(2 * 64 + i) * 33 + j] + IMPW[(3 * 64 + i) * 33 + j]);
                if (j == 0 || j == c || j == c - 1) v += 1e4f; }
            SC[i * 33 + j] = v; }
        BAR_LDS();
#pragma unroll 1
        for (int q = 0; q < 4; ++q) { const int pr = q * NTHREADS + tid, i = pr >> 5, j = pr & 31;
            const float my = SC[i * 33 + j]; int rank = 0;
#pragma unroll
            for (int k = 0; k < 32; ++k) { const float o = SC[i * 33 + k]; rank += (o > my || (o == my && k < j)) ? 1 : 0; }
            const bool sel = (j <= c) && rank < 8;
            const unsigned long long bal = __ballot(sel);
            const unsigned msk = (lane & 32) ? (unsigned)(bal >> 32) : (unsigned)bal;
            if (j == 0) { SELM[i] = msk; atomicOr((unsigned*)UNI, msk); } }
    }
    BAR_LDS();
    const unsigned uni = *UNI;
#pragma unroll
    for (int m = 0; m < 2; ++m)
#pragma unroll
        for (int ks = 0; ks < 2; ++ks) aq[m][ks] = *(const bf16x8*)((const bf16_t*)(ws + WS_QR) + (size_t)(tok0 + ibase + 16 * m + fr) * 512 + hh * 64 + 32 * ks + 8 * fq);
#pragma unroll 1
    for (int br = 0; br < 2; ++br) {
        float lrow[2][4]; f32x4 O[2][4];
#pragma unroll
        for (int m = 0; m < 2; ++m) {
#pragma unroll
            for (int j = 0; j < 4; ++j) lrow[m][j] = 0.f;
#pragma unroll
            for (int nfd = 0; nfd < 4; ++nfd) O[m][nfd] = (f32x4){0.f, 0.f, 0.f, 0.f};
        }
        const bf16_t* Kb = (const bf16_t*)(ws + (br ? WS_KW : WS_KS)) + bk * SEQ * 64;
        const bf16_t* Vb = (const bf16_t*)(ws + (br ? WS_VWT : WS_VST)) + bk * 32 * 4096;
        unsigned todo = br ? ((c >= 8 ? (0x1ffu << (c - 8)) : ((2u << c) - 1u))) : (uni & ((c == 31) ? 0xffffffffu : ((2u << c) - 1u)));
        int cur = __builtin_ctz(todo); todo &= todo - 1u;
        nsa_fetch(st, Kb + (size_t)cur * 4096, 64, Vb + (size_t)cur * 4096, 64, tid);
        BAR_LDS();
        nsa_commit(st, NSA_KTB(0), NSA_VTB(0), tid);
        int nxt = todo ? __builtin_ctz(todo) : -1; if (todo) todo &= todo - 1u;
        if (nxt >= 0) nsa_fetch(st, Kb + (size_t)nxt * 4096, 64, Vb + (size_t)nxt * 4096, 64, tid);
        BAR_LDS();
        int bb = 0;
        for (;;) {
            unsigned rowok; int mode;
            if (br == 0) {
                rowok = 0u;
#pragma unroll
                for (int m = 0; m < 2; ++m)
#pragma unroll
                    for (int j = 0; j < 4; ++j) rowok |= ((SELM[ibase + 16 * m + 4 * fq + j] >> cur) & 1u) << (m * 4 + j);
                mode = (cur == c) ? 1 : 0;
            } else { rowok = 0xffu; mode = (cur == c) ? 1 : ((cur == c - 8) ? 2 : 0); }
            nsa_tile(aq, NSA_KTB(bb), NSA_VTB(bb), PWw, lrow, O, rowok, mode, ibase, 0, 0, fr, fq);
            if (nxt < 0) break;
            nsa_commit(st, NSA_KTB(bb ^ 1), NSA_VTB(bb ^ 1), tid);
            cur = nxt;
            nxt = todo ? __builtin_ctz(todo) : -1; if (todo) todo &= todo - 1u;
            if (nxt >= 0) nsa_fetch(st, Kb + (size_t)nxt * 4096, 64, Vb + (size_t)nxt * 4096, 64, tid);
            BAR_LDS();
            bb ^= 1;
        }
#pragma unroll
        for (int m = 0; m < 2; ++m)
#pragma unroll
            for (int j = 0; j < 4; ++j) { const int t = tok0 + ibase + 16 * m + 4 * fq + j; const float gt = sigmoidf_(bf2f(PROJ[(size_t)t * NPROJ + CGATE + hh * 3 + 1 + br]));
                const float lt = red16_sum(lrow[m][j]);
                const float sc = lt > 0.f ? gt / lt : 0.f;
#pragma unroll
                for (int nfd = 0; nfd < 4; ++nfd) OUTw[(16 * m + 4 * fq + j) * 68 + 16 * nfd + fr] += sc * O[m][nfd][j]; }
    }
    LDS_WAIT();
#pragma unroll
    for (int q = 0; q < 4; ++q) {
        const int r = 8 * q + (lane >> 3), ch = lane & 7;
        const LAS f32x4* src = (const LAS f32x4*)(OUTw + r * 68 + 8 * ch);
        const f32x4 a = src[0], bq = src[1];
        u32x4 o; o.x = pk2(a[0], a[1]); o.y = pk2(a[2], a[3]); o.z = pk2(bq[0], bq[1]); o.w = pk2(bq[2], bq[3]);
        *(u32x4*)((bf16_t*)(ws + WS_ATT) + (size_t)(tok0 + ibase + r) * 1024 + hh * 64 + 8 * ch) = o;
    }
#undef NSA_KTB
#undef NSA_VTB
}

constexpr int GLA_QD = 0, GLA_KD = 9216, GLA_KST = 18432, GLA_VT = 27648, GLA_AT = 46080, GLA_ST = 55296, GLA_WG = 73728  , GLA_DEC = 77824  ,
              GLA_OT = 78336  , GLA_END = GLA_OT + 64 * 132 * 4;
static_assert(GLA_END <= LDS_BYTES - 64, "GLA LDS map");
template <int CTRL, int RMASK> __device__ __forceinline__ float dppf_rm(float v) { return __int_as_float(__builtin_amdgcn_update_dpp(0, __float_as_int(v), CTRL, RMASK, 0xf, false)); }
__device__ __forceinline__ float wave_incl_scan(float v) {
    v += __int_as_float(__builtin_amdgcn_update_dpp(0, __float_as_int(v), 0x111, 0xf, 0xf, true));
    v += __int_as_float(__builtin_amdgcn_update_dpp(0, __float_as_int(v), 0x112, 0xf, 0xf, true));
    v += __int_as_float(__builtin_amdgcn_update_dpp(0, __float_as_int(v), 0x114, 0xf, 0xf, true));
    v += __int_as_float(__builtin_amdgcn_update_dpp(0, __float_as_int(v), 0x118, 0xf, 0xf, true));
    v += dppf_rm<0x142, 0xa>(v);
    v += dppf_rm<0x143, 0xc>(v);
    return v;
}
struct GlaStage { u32x4 q, k, g0, g1, v0, v1; };
__device__ __forceinline__ void gla_fetch(GlaStage& st, const bf16_t* PROJ, int tok0, int h, int lane, int w) {
    const bf16_t* row = PROJ + (size_t)(tok0 + lane) * NPROJ;
    st.q = *(const u32x4*)(row + CGQ + h * 64 + 8 * w);
    st.k = *(const u32x4*)(row + CGK + h * 64 + 8 * w);
    st.g0 = *(const u32x4*)(row + CGLR); st.g1 = *(const u32x4*)(row + CGLR + 8);
    st.v0 = *(const u32x4*)(row + CGV + h * 128 + 16 * w); st.v1 = *(const u32x4*)(row + CGV + h * 128 + 16 * w + 8);
}
__device__ __forceinline__ float bflo(unsigned u) { return __uint_as_float(u << 16); }
__device__ __forceinline__ float bfhi(unsigned u) { return __uint_as_float(u & 0xffff0000u); }

__device__ __forceinline__ void gla_unit(const Params& p, LAS unsigned char* lds, int b, int h) {
    const int tid = opaque_tid(), lane = tid & 63, w = tid >> 6, fr = lane & 15, fq = lane >> 4;
    unsigned char* ws = p.ws;
    const bf16_t* PROJ = (const bf16_t*)(ws + WS_PROJ);
    LAS bf16_t* Qd = (LAS bf16_t*)(lds + GLA_QD); LAS bf16_t* Kd = (LAS bf16_t*)(lds + GLA_KD); LAS bf16_t* KsT = (LAS bf16_t*)(lds + GLA_KST);
    LAS bf16_t* VT = (LAS bf16_t*)(lds + GLA_VT); LAS bf16_t* At = (LAS bf16_t*)(lds + GLA_AT); LAS bf16_t* ST = (LAS bf16_t*)(lds + GLA_ST);
    LAS float* WG = (LAS float*)(lds + GLA_WG); LAS float* DEC = (LAS float*)(lds + GLA_DEC); LAS float* OT = (LAS float*)(lds + GLA_OT);
    BAR_LDS();
    for (int i = tid; i < 16 * 64; i += NTHREADS) WG[i] = p.in[12][(i >> 6) * 256 + h * 64 + (i & 63)];
    for (int i = tid; i < 128 * 72 / 2; i += NTHREADS) ((LAS unsigned*)ST)[i] = 0u;
    float bg[8];
#pragma unroll
    for (int q = 0; q < 8; ++q) bg[q] = p.in[13][h * 64 + 8 * w + q];
    const int md = w & 3, nfe0 = 4 * (w >> 2);
    f32x4 Sreg[4];
#pragma unroll
    for (int x = 0; x < 4; ++x) Sreg[x] = (f32x4){0.f, 0.f, 0.f, 0.f};
    GlaStage st;
    gla_fetch(st, PROJ, b * SEQ, h, lane, w);
    BAR_LDS();
#pragma unroll 1
    for (int n = 0; n < 32; ++n) {
        const int tok0 = b * SEQ + n * 64;
        float gl[16];
        { const unsigned gw[8] = {st.g0.x, st.g0.y, st.g0.z, st.g0.w, st.g1.x, st.g1.y, st.g1.z, st.g1.w};
#pragma unroll
          for (int q = 0; q < 8; ++q) { gl[2 * q] = bflo(gw[q]); gl[2 * q + 1] = bfhi(gw[q]); } }
        float bcum[8], blast[8];
#pragma unroll
        for (int q = 0; q < 8; ++q) {
            float x = bg[q];
#pragma unroll
            for (int r = 0; r < 16; ++r) x += gl[r] * WG[r * 64 + 8 * w + q];
            const float la = (fminf(x, 0.f) - __logf(1.f + __expf(-fabsf(x)))) * (1.f / 16.f);
            bcum[q] = wave_incl_scan(la);
            blast[q] = __int_as_float(__builtin_amdgcn_readlane(__float_as_int(bcum[q]), 63));
        }
        {
            const unsigned qw[4] = {st.q.x, st.q.y, st.q.z, st.q.w}, kw[4] = {st.k.x, st.k.y, st.k.z, st.k.w};
            unsigned qo[4], ko[4];
#pragma unroll
            for (int q2 = 0; q2 < 4; ++q2) {
                const float e0 = __expf(bcum[2 * q2]), e1 = __expf(bcum[2 * q2 + 1]);
                const float i0 = __expf(-bcum[2 * q2]), i1 = __expf(-bcum[2 * q2 + 1]);
                const float k0 = bflo(kw[q2]), k1 = bfhi(kw[q2]);
                qo[q2] = pg8::cvt_pk_bf16(bflo(qw[q2]) * 0.125f * e0, bfhi(qw[q2]) * 0.125f * e1);
                ko[q2] = pg8::cvt_pk_bf16(k0 * i0, k1 * i1);
                KsT[(8 * w + 2 * q2) * 72 + lane] = (bf16_t)f2bf(k0 * __expf(blast[2 * q2] - bcum[2 * q2]));
                KsT[(8 * w + 2 * q2 + 1) * 72 + lane] = (bf16_t)f2bf(k1 * __expf(blast[2 * q2 + 1] - bcum[2 * q2 + 1]));
            }
            *(LAS u32x4*)(Qd + lane * 72 + 8 * w) = (u32x4){qo[0], qo[1], qo[2], qo[3]};
            *(LAS u32x4*)(Kd + lane * 72 + 8 * w) = (u32x4){ko[0], ko[1], ko[2], ko[3]};
            if (lane == 63) {
#pragma unroll
                for (int q = 0; q < 8; ++q) DEC[(n & 1) * 64 + 8 * w + q] = __expf(bcum[q]);
            }
            const unsigned vw[8] = {st.v0.x, st.v0.y, st.v0.z, st.v0.w, st.v1.x, st.v1.y, st.v1.z, st.v1.w};
#pragma unroll
            for (int q = 0; q < 8; ++q) { VT[(16 * w + 2 * q) * 72 + lane] = (bf16_t)(vw[q] & 0xffffu); VT[(16 * w + 2 * q + 1) * 72 + lane] = (bf16_t)(vw[q] >> 16); }
        }
        if (n < 31) gla_fetch(st, PROJ, tok0 + 64, h, lane, w);
        const int ec = tid >> 3, eg = tid & 7;
        const u32x4 r0 = *(const u32x4*)(PROJ + (size_t)(tok0 + ec) * NPROJ + CGR + h * 128 + 16 * eg), r1 = *(const u32x4*)(PROJ + (size_t)(tok0 + ec) * NPROJ + CGR + h * 128 + 16 * eg + 8);
        BAR_LDS();
        {
            const int m = w >> 1;
            bf16x8 a[2];
#pragma unroll
            for (int ks = 0; ks < 2; ++ks) a[ks] = *(const LAS bf16x8*)(Qd + (16 * m + fr) * 72 + 32 * ks + 8 * fq);
#pragma unroll
            for (int x = 0; x < 2; ++x) { const int nf = 2 * (w & 1) + x;
                f32x4 s = (f32x4){0.f, 0.f, 0.f, 0.f};
                if (nf <= m) {
#pragma unroll
                    for (int ks = 0; ks < 2; ++ks) { const bf16x8 bk = *(const LAS bf16x8*)(Kd + (16 * nf + fr) * 72 + 32 * ks + 8 * fq); s = __builtin_amdgcn_mfma_f32_16x16x32_bf16(a[ks], bk, s, 0, 0, 0); }
                }
#pragma unroll
                for (int j = 0; j < 4; ++j) { const int cc = 16 * m + 4 * fq + j, ss = 16 * nf + fr; At[cc * 72 + ss] = (bf16_t)f2bf(ss <= cc ? s[j] : 0.f); } }
        }
        f32x4 U[4];
        {
            bf16x8 a[2];
#pragma unroll
            for (int ks = 0; ks < 2; ++ks) a[ks] = *(const LAS bf16x8*)(KsT + (16 * md + fr) * 72 + 32 * ks + 8 * fq);
#pragma unroll
            for (int x = 0; x < 4; ++x) { f32x4 s = (f32x4){0.f, 0.f, 0.f, 0.f};
#pragma unroll
                for (int ks = 0; ks < 2; ++ks) { const bf16x8 bv = *(const LAS bf16x8*)(VT + (16 * (nfe0 + x) + fr) * 72 + 32 * ks + 8 * fq); s = __builtin_amdgcn_mfma_f32_16x16x32_bf16(a[ks], bv, s, 0, 0, 0); }
                U[x] = s; }
        }
        BAR_LDS();
        {
            bf16x8 aa[2], aq2[2];
#pragma unroll
            for (int ks = 0; ks < 2; ++ks) { aa[ks] = *(const LAS bf16x8*)(At + (16 * md + fr) * 72 + 32 * ks + 8 * fq); aq2[ks] = *(const LAS bf16x8*)(Qd + (16 * md + fr) * 72 + 32 * ks + 8 * fq); }
#pragma unroll
            for (int x = 0; x < 4; ++x) { f32x4 s = (f32x4){0.f, 0.f, 0.f, 0.f};
#pragma unroll
                for (int ks = 0; ks < 2; ++ks) { const bf16x8 bv = *(const LAS bf16x8*)(VT + (16 * (nfe0 + x) + fr) * 72 + 32 * ks + 8 * fq); s = __builtin_amdgcn_mfma_f32_16x16x32_bf16(aa[ks], bv, s, 0, 0, 0); }
#pragma unroll
                for (int ks = 0; ks < 2; ++ks) { const bf16x8 bs = *(const LAS bf16x8*)(ST + (16 * (nfe0 + x) + fr) * 72 + 32 * ks + 8 * fq); s = __builtin_amdgcn_mfma_f32_16x16x32_bf16(aq2[ks], bs, s, 0, 0, 0); }
#pragma unroll
                for (int j = 0; j < 4; ++j) OT[(16 * md + 4 * fq + j) * 132 + 16 * (nfe0 + x) + fr] = s[j]; }
        }
        BAR_LDS();
        {
            const LAS f32x4* dp = (const LAS f32x4*)(DEC + (n & 1) * 64 + 16 * md + 4 * fq); const f32x4 dc = dp[0];
#pragma unroll
            for (int x = 0; x < 4; ++x) { Sreg[x] = dc * Sreg[x] + U[x];
                u32x2 o; o.x = pg8::cvt_pk_bf16(Sreg[x][0], Sreg[x][1]); o.y = pg8::cvt_pk_bf16(Sreg[x][2], Sreg[x][3]);
                *(LAS u32x2*)(ST + (16 * (nfe0 + x) + fr) * 72 + 16 * md + 4 * fq) = o; }
        }
        {
            const LAS f32x4* op = (const LAS f32x4*)(OT + ec * 132 + 16 * eg);
            f32x4 o[4]; float ss = 0.f;
#pragma unroll
            for (int q = 0; q < 4; ++q) { o[q] = op[q]; ss += (o[q].x * o[q].x + o[q].y * o[q].y) + (o[q].z * o[q].z + o[q].w * o[q].w); }
            ss += dppf<0xB1>(ss); ss += dppf<0x4E>(ss); ss += dppf<0x141>(ss);
            const float rstd = 1.f / sqrtf(ss * (1.f / 128.f) + EPS);
            const unsigned rw[8] = {r0.x, r0.y, r0.z, r0.w, r1.x, r1.y, r1.z, r1.w};
            const float* gn = p.in[14] + 16 * eg;
            unsigned ow[8];
#pragma unroll
            for (int q = 0; q < 8; ++q) { const float ra = bflo(rw[q]), rb = bfhi(rw[q]);
                const float ya = o[q >> 1][(2 * q) & 3] * rstd * gn[2 * q] * (ra * sigmoidf_(ra)), yb = o[q >> 1][(2 * q + 1) & 3] * rstd * gn[2 * q + 1] * (rb * sigmoidf_(rb));
                ow[q] = pg8::cvt_pk_bf16(ya, yb); }
            u32x4* dst = (u32x4*)((bf16_t*)(ws + WS_ATT) + (size_t)(tok0 + ec) * 1024 + 512 + h * 128 + 16 * eg);
            dst[0] = (u32x4){ow[0], ow[1], ow[2], ow[3]}; dst[1] = (u32x4){ow[4], ow[5], ow[6], ow[7]};
        }
    }
}

__device__ __forceinline__ void p6_chunk(const Params& p, LAS unsigned char* lds, int chunk) {
    const int tid = opaque_tid(), lane = tid & 63, wave = tid >> 6;
    unsigned char* ws = p.ws;
    LAS int* lcnt = (LAS int*)lds;
    if (tid < NEXP) lcnt[tid] = 0;
    __syncthreads();
    const float* WRT = (const float*)(ws + WS_WRT);
    for (int ti = 0; ti < 16; ++ti) {
        const int t = chunk * 128 + wave * 16 + ti;
        const f32x4* xr = (const f32x4*)((const float*)(ws + WS_X1) + (size_t)t * DM) + lane; const f32x4* gr = (const f32x4*)p.in[16] + lane;
        f32x4 v[4]; float s = 0.f;
#pragma unroll
        for (int j = 0; j < 4; ++j) { v[j] = xr[64 * j]; s += (v[j].x * v[j].x + v[j].y * v[j].y) + (v[j].z * v[j].z + v[j].w * v[j].w); }
        const float rstd = 1.f / sqrtf(wave_sum(s) * (1.f / DM) + EPS);
        unsigned long long* o8 = (unsigned long long*)((bf16_t*)(ws + WS_H) + (size_t)t * DM) + lane;
#pragma unroll
        for (int j = 0; j < 4; ++j) { const f32x4 gg = gr[64 * j]; const f32x4 o = v[j] * rstd * gg;
            o8[64 * j] = (unsigned long long)pk2(o.x, o.y) | ((unsigned long long)pk2(o.z, o.w) << 32); }
        const int myexp = (lane >> 1) & 31;
        float mylg = 0.f;
        { const f32x4* wr = (const f32x4*)WRT + lane;
#pragma unroll 2
          for (int e = 0; e < 32; ++e, wr += DM / 4) { float a = 0.f;
#pragma unroll
              for (int j = 0; j < 4; ++j) { const f32x4 wv = wr[64 * j]; a += (v[j].x * wv.x + v[j].y * wv.y) + (v[j].z * wv.z + v[j].w * wv.w); }
              a = wave_sum(a);
              if (e == myexp) mylg = a; } }
        mylg = mylg * rstd + p.in[18][myexp];
        float tv[4]; int te[4];
#pragma unroll
        for (int r = 0; r < 4; ++r) {
            float bv = mylg; int be = myexp;
#pragma unroll
            for (int o = 1; o < 64; o <<= 1) { const float ov = __shfl_xor(bv, o); const int oe = __shfl_xor(be, o); if (ov > bv || (ov == bv && oe < be)) { bv = ov; be = oe; } }
            tv[r] = bv; te[r] = be;
            if (myexp == be) mylg = -3e38f;
        }
        const float e0 = 1.f, e1 = __expf(tv[1] - tv[0]), e2 = __expf(tv[2] - tv[0]), e3 = __expf(tv[3] - tv[0]);
        const float inv = 1.f / (e0 + e1 + e2 + e3);
        if (lane == 0) {
            *(int4*)((int*)(ws + WS_TOPI) + (size_t)t * 4) = make_int4(te[0], te[1], te[2], te[3]);
            *(f32x4*)((float*)(ws + WS_TOPG) + (size_t)t * 4) = (f32x4){e0 * inv, e1 * inv, e2 * inv, e3 * inv};
            atomicAdd((int*)&lcnt[te[0]], 1); atomicAdd((int*)&lcnt[te[1]], 1); atomicAdd((int*)&lcnt[te[2]], 1); atomicAdd((int*)&lcnt[te[3]], 1);
        }
    }
    __syncthreads();
    if (tid < NEXP) atomicAdd((int*)(ws + WS_CTL) + CW_CNT + tid, lcnt[tid]);
    __syncthreads();
}

__device__ __forceinline__ int build_tile_table(const Params& p, LAS int* tstart, LAS int* tile_e) {
    const int tid = opaque_tid();
    const int* cnt = (const int*)(p.ws + WS_CTL) + CW_CNT;
    if (tid == 0) { int acc = 0; for (int e = 0; e < NEXP; ++e) { tstart[e] = acc; acc += (__hip_atomic_load(cnt + e, __ATOMIC_RELAXED, __HIP_MEMORY_SCOPE_AGENT) + 255) >> 8; } tstart[NEXP] = acc; }
    __syncthreads();
    const int total = tstart[NEXP];
    for (int i = tid; i < total; i += NTHREADS) { int e = 0;
        for (int q = 1; q < NEXP; ++q) if (tstart[q] <= i) e = q;
        tile_e[i] = e; }
    __syncthreads();
    return total;
}

__device__ __forceinline__ void p7_chunk(const Params& p, LAS unsigned char* lds, int chunk, const LAS int* tstart) {
    const int tid = opaque_tid(), lane = tid & 63, wave = tid >> 6;
    unsigned char* ws = p.ws;
    LAS int* lc = (LAS int*)lds; LAS int* lbase = lc + 32; LAS int* ldst = lbase + 32;
    if (tid < NEXP) lc[tid] = 0;
    __syncthreads();
    const int t = chunk * 128 + (tid >> 2), k = tid & 3;
    const int e = ((const int*)(ws + WS_TOPI))[(size_t)t * 4 + k];
    const int rank = atomicAdd((int*)&lc[e], 1);
    __syncthreads();
    if (tid < NEXP) lbase[tid] = atomicAdd((int*)(ws + WS_CTL) + CW_FILL + tid, lc[tid]);
    __syncthreads();
    const int dest = tstart[e] * 256 + lbase[e] + rank;
    ((int*)(ws + WS_DEST))[(size_t)t * 4 + k] = dest;
    ldst[tid] = dest;
    __syncthreads();
    for (int ti = 0; ti < 16; ++ti) {
        const int tl = wave * 16 + ti, tt = chunk * 128 + tl;
        const u32x4* src = (const u32x4*)((const bf16_t*)(ws + WS_H) + (size_t)tt * DM) + lane;
        const u32x4 a = src[0], bq = src[64];
#pragma unroll
        for (int kk = 0; kk < 4; ++kk) { u32x4* dst = (u32x4*)((bf16_t*)(ws + WS_XS) + (size_t)ldst[tl * 4 + kk] * DM) + lane; dst[0] = a; dst[64] = bq; }
    }
    __syncthreads();
}

__device__ __forceinline__ void p10_token(const Params& p, int t, int lane) {
    unsigned char* ws = p.ws;
    const int4 d4 = *(const int4*)((const int*)(ws + WS_DEST) + (size_t)t * 4);
    const f32x4 g4 = *(const f32x4*)((const float*)(ws + WS_TOPG) + (size_t)t * 4);
    const int dd[4] = {d4.x, d4.y, d4.z, d4.w};
    const f32x4* xr = (const f32x4*)((const float*)(ws + WS_X1) + (size_t)t * DM);
    f32x4* orow = (f32x4*)(p.out + (size_t)t * DM);
#pragma unroll
    for (int half = 0; half < 2; ++half) {
        f32x4 a0 = xr[half * 128 + lane * 2], a1 = xr[half * 128 + lane * 2 + 1];
#pragma unroll
        for (int k = 0; k < 4; ++k) {
            const u32x4 y = *((const u32x4*)((const bf16_t*)(ws + WS_Y) + (size_t)dd[k] * DM) + half * 64 + lane);
            const float gk = g4[k];
            a0.x += gk * __uint_as_float(y.x << 16); a0.y += gk * __uint_as_float(y.x & 0xffff0000u);
            a0.z += gk * __uint_as_float(y.y << 16); a0.w += gk * __uint_as_float(y.y & 0xffff0000u);
            a1.x += gk * __uint_as_float(y.z << 16); a1.y += gk * __uint_as_float(y.z & 0xffff0000u);
            a1.z += gk * __uint_as_float(y.w << 16); a1.w += gk * __uint_as_float(y.w & 0xffff0000u);
        }
        orow[half * 128 + lane * 2] = a0; orow[half * 128 + lane * 2 + 1] = a1;
    }
}

#define XB_TMO      128
#define XB_XCNT(j)  (256  + 64 * (j))
#define XB_XSUB(j)  (1280 + 64 * (j))
#define XB_XGEN(j)  (2304 + 64 * (j))
#define XB_TOP      3328
#define XB_TOPGEN   3392
#define XCD_BAR_WORDS 3456
#define XB_SPIN_CAP (1u << 22)
__device__ __forceinline__ unsigned xb_ld(unsigned* p)              { return __hip_atomic_load(p, __ATOMIC_RELAXED, __HIP_MEMORY_SCOPE_AGENT); }
__device__ __forceinline__ unsigned xb_add(unsigned* p, unsigned v) { return __hip_atomic_fetch_add(p, v, __ATOMIC_RELAXED, __HIP_MEMORY_SCOPE_AGENT); }
__device__ __forceinline__ unsigned xb_xcc_id() { return (unsigned)__builtin_amdgcn_s_getreg((3 << 11) | 20) & 0xFu; }
#define XB_SPIN(cond, bar) do { unsigned _sp = 0; while (cond) { __builtin_amdgcn_s_sleep(1); \
    if ((++_sp & 255u) == 0u) { if (xb_ld(&(bar)[XB_TMO])) break; if (_sp > XB_SPIN_CAP) { atomicAdd(&(bar)[XB_TMO], 1u); break; } } } } while (0)
struct XcdBarrier { unsigned* bar; unsigned x; volatile LAS unsigned* st; };
__device__ __forceinline__ XcdBarrier xcd_barrier_post(unsigned* bar, volatile LAS unsigned* st) {
    XcdBarrier b; b.bar = bar; b.x = xb_xcc_id(); b.st = st;
    if (threadIdx.x == 0) (void)xb_add(&bar[XB_XCNT(b.x)], 1u);
    return b;
}
__device__ __forceinline__ void xcd_barrier_complete(unsigned* bar, unsigned x, unsigned& nloc, unsigned& nx) {
    const unsigned G = gridDim.x * gridDim.y * gridDim.z;
    unsigned sum, cnt, mine, sp = 0u;
    for (;;) {
        sum = 0u; cnt = 0u; mine = 0u;
#pragma unroll
        for (unsigned j = 0; j < 16; ++j) { const unsigned c = xb_ld(&bar[XB_XCNT(j)]); sum += c; cnt += (c > 0u) ? 1u : 0u; mine = (j == x) ? c : mine; }
        if (sum == G) break;
        __builtin_amdgcn_s_sleep(1);
        if ((++sp & 255u) == 0u) { if (xb_ld(&bar[XB_TMO])) break; if (sp > XB_SPIN_CAP) { atomicAdd(&bar[XB_TMO], 1u); break; } }
    }
    nloc = mine > 0u ? mine : 1u; nx = cnt > 0u ? cnt : 1u;
}
__device__ __forceinline__ void xcd_barrier(const XcdBarrier& b) {
    asm volatile("s_waitcnt vmcnt(0)" ::: "memory");
    __syncthreads();
    if (threadIdx.x == 0) {
        unsigned* bar = b.bar;
        __builtin_amdgcn_s_waitcnt(0);
        unsigned nloc = b.st[0], nx = b.st[1];
        if (nloc == 0u) { xcd_barrier_complete(bar, b.x, nloc, nx); b.st[0] = nloc; b.st[1] = nx; }
        const unsigned old = xb_add(&bar[XB_XSUB(b.x)], 1u);
        const unsigned gen = old / nloc;
        if (old + 1u == (gen + 1u) * nloc) {
            __builtin_amdgcn_fence(__ATOMIC_RELEASE, "agent");
            asm volatile("s_waitcnt vmcnt(0)" ::: "memory");
            const unsigned og = xb_add(&bar[XB_TOP], 1u);
            const unsigned tg = og / nx;
            if (og + 1u == (tg + 1u) * nx) xb_add(&bar[XB_TOPGEN], 1u);
            else XB_SPIN(xb_ld(&bar[XB_TOPGEN]) == tg, bar);
            __builtin_amdgcn_fence(__ATOMIC_ACQUIRE, "agent");
            xb_add(&bar[XB_XGEN(b.x)], 1u);
            asm volatile("s_waitcnt vmcnt(0)" ::: "memory");
        } else {
            XB_SPIN(xb_ld(&bar[XB_XGEN(b.x)]) == gen, bar);
            __builtin_amdgcn_fence(__ATOMIC_ACQUIRE, "agent");
            asm volatile("s_waitcnt vmcnt(0)" ::: "memory");
        }
    }
    __syncthreads();
}

template <int ph> __device__ __forceinline__ void mk_phase(const Params& p, LAS unsigned char* lds, int blk, int G) {
    unsigned char* ws = p.ws;
    const int tid = opaque_tid();
    if constexpr (ph == 0) { phase0(p, lds, blk, G); }
    else if constexpr (ph == 1) {
        pg8::Gemm g{(const bf16_t*)(ws + WS_H), (const bf16_t*)(ws + WS_WIN), DM};
        pg8::StaticOrder S{MTOK / 256, NPROJ / 256, G, blk};
        pg8::EpiBf16 E{(bf16_t*)(ws + WS_PROJ), NPROJ};
        pg8::gemm_phase(lds, g, S, E);
    }
    else if constexpr (ph == 2) {
        for (int u = blk; u < 128 + 512; u += G) {
            if (u < 128) p2b_unit(p, lds, u);
            else p2a_unit(p, lds, u - 128);
        }
    }
    else if constexpr (ph == 3) {
        LAS int* qslot = (LAS int*)(lds + LDS_BYTES - 64);
        for (;;) {
            __syncthreads();
            if (tid == 0) *qslot = (int)__hip_atomic_fetch_add((unsigned*)(ws + WS_CTL) + CW_Q3, 1u, __ATOMIC_RELAXED, __HIP_MEMORY_SCOPE_AGENT);
            __syncthreads();
            const int it = *qslot;
            if (it >= 64 + 1024) break;
            if (it < 64) gla_unit(p, lds, it >> 2, it & 3);
            else { const int u = it - 64, c = 31 - (u >> 5), bkh = u & 31; nsa_unit(p, lds, bkh >> 1, bkh & 1, c); }
        }
    }
    else if constexpr (ph == 4) { }
    else if constexpr (ph == 5) {
        pg8::Gemm g{(const bf16_t*)(ws + WS_ATT), (const bf16_t*)(ws + WS_WOUT), DM};
        pg8::StaticOrder S{MTOK / 256, DM / 256, G, blk};
        pg8::EpiResF32 E{p.in[0], (float*)(ws + WS_X1), DM};
        pg8::gemm_phase(lds, g, S, E);
    }
    else if constexpr (ph == 6) { for (int ch = blk; ch < MTOK / 128; ch += G) p6_chunk(p, lds, ch); }
    else if constexpr (ph == 7) {
        LAS int* tstart = (LAS int*)(lds + 8192); LAS int* tile_e = tstart + 64;
        build_tile_table(p, tstart, tile_e);
        for (int ch = blk; ch < MTOK / 128; ch += G) p7_chunk(p, lds, ch, tstart);
    }
    else if constexpr (ph == 8) {
        LAS int* tstart = (LAS int*)(lds + pg8::STAGE_BYTES); LAS int* tile_e = tstart + 64;
        const int total = build_tile_table(p, tstart, tile_e);
        pg8::Gemm g{(const bf16_t*)(ws + WS_XS), (const bf16_t*)(ws + WS_WGU), DM};
        pg8::MoeOrder S{total, 8, G, blk, tile_e};
        pg8::EpiSwiglu E{(bf16_t*)(ws + WS_ACT), p.in[20], 8};
        pg8::gemm_phase(lds, g, S, E);
    }
    else if constexpr (ph == 9) {
        LAS int* tstart = (LAS int*)(lds + pg8::STAGE_BYTES); LAS int* tile_e = tstart + 64;
        const int total = build_tile_table(p, tstart, tile_e);
        pg8::Gemm g{(const bf16_t*)(ws + WS_ACT), (const bf16_t*)(ws + WS_WD), DFF};
        pg8::MoeOrder S{total, 4, G, blk, tile_e};
        pg8::EpiDown E{(bf16_t*)(ws + WS_Y), p.in[22], 4};
        pg8::gemm_phase(lds, g, S, E);
    }
    else if constexpr (ph == 10) { for (int t = blk * 8 + (tid >> 6); t < MTOK; t += G * 8) p10_token(p, t, tid & 63); }
}

constexpr int NPHASES = 11;

template <int PH> __global__ void __launch_bounds__(NTHREADS, 2) mk_one(Params p) {
    extern __shared__ __attribute__((aligned(16))) unsigned char lds_raw[];
    mk_phase<PH>(p, (LAS unsigned char*)lds_raw, blockIdx.x, gridDim.x);
}
#if MK_ONE_LAUNCH
#define MK_RUN(PH) mk_phase<PH>(p, lds, blk, G)
__global__ void __launch_bounds__(NTHREADS, 2) mk_fwd(Params p) {
    extern __shared__ __attribute__((aligned(16))) unsigned char lds_raw[];
    LAS unsigned char* lds = (LAS unsigned char*)lds_raw;
    const int blk = blockIdx.x, G = gridDim.x;
    volatile LAS unsigned* bst = (volatile LAS unsigned*)(lds + LDS_BYTES - 16);
    if (threadIdx.x < 4) bst[threadIdx.x] = 0u;
    __syncthreads();
    const XcdBarrier gbar = xcd_barrier_post((unsigned*)(p.ws + WS_CTL) + CW_BAR, bst);
#define GSYNC() xcd_barrier(gbar)
#ifndef MK_REP_PHASE
#define MK_REP_PHASE -1
#endif
#ifndef MK_REP_N
#define MK_REP_N 0
#endif
#define MK_STEP(PH) do { MK_RUN(PH); if (MK_REP_PHASE == (PH)) { for (int r_ = 0; r_ < MK_REP_N; ++r_) { GSYNC(); MK_RUN(PH); } } if (MK_REP_PHASE == 100 + (PH)) { for (int r_ = 0; r_ < MK_REP_N; ++r_) GSYNC(); } } while (0)
    MK_STEP(0); GSYNC(); MK_STEP(1); GSYNC(); MK_STEP(2); GSYNC(); MK_STEP(3); GSYNC(); MK_STEP(5); GSYNC();
    MK_STEP(6); GSYNC(); MK_STEP(7); GSYNC(); MK_STEP(8); GSYNC(); MK_STEP(9); GSYNC(); MK_STEP(10);
}
#endif

extern "C" void kernel_launch(void* const* d_in, const int* in_sizes, int n_in, void* d_out, int out_size, void* d_ws, size_t ws_size, hipStream_t stream) {
    static int grid = 0;
    if (grid == 0) {
        int dev = 0, cus = 0, per_cu = 0;
        (void)hipGetDevice(&dev);
        (void)hipDeviceGetAttribute(&cus, hipDeviceAttributeMultiprocessorCount, dev);
#if MK_ONE_LAUNCH
        (void)hipFuncSetAttribute((const void*)mk_fwd, hipFuncAttributeMaxDynamicSharedMemorySize, LDS_BYTES);
        (void)hipOccupancyMaxActiveBlocksPerMultiprocessor(&per_cu, (const void*)mk_fwd, NTHREADS, LDS_BYTES);
#else
#define MK_ATTR(PH) (void)hipFuncSetAttribute((const void*)mk_one<PH>, hipFuncAttributeMaxDynamicSharedMemorySize, LDS_BYTES)
        MK_ATTR(0); MK_ATTR(1); MK_ATTR(2); MK_ATTR(3); MK_ATTR(4); MK_ATTR(5); MK_ATTR(6); MK_ATTR(7); MK_ATTR(8); MK_ATTR(9); MK_ATTR(10);
        per_cu = 1;
#endif
        if (per_cu < 1) { fprintf(stderr, "kernel_launch: occupancy query reports %d blocks/CU\n", per_cu); per_cu = 1; }
        grid = cus;
        if (ws_size < WS_END) { fprintf(stderr, "kernel_launch: workspace too small (%zu < %zu)\n", ws_size, (size_t)WS_END); grid = -1; }
        (void)hipGetLastError();
    }
    if (grid < 0) return;
    (void)hipMemsetAsync((char*)d_ws + WS_CTL, 0, CTL_BYTES, stream);
    Params p{};
    for (int i = 0; i < 23; ++i) p.in[i] = (const float*)d_in[i];
    p.out = (float*)d_out; p.ws = (unsigned char*)d_ws;
#if MK_ONE_LAUNCH
    hipLaunchKernelGGL(mk_fwd, dim3(grid), dim3(NTHREADS), LDS_BYTES, stream, p);
#else
#define MK_LAUNCH(PH) hipLaunchKernelGGL(mk_one<PH>, dim3(grid), dim3(NTHREADS), LDS_BYTES, stream, p)
    MK_LAUNCH(0); MK_LAUNCH(1); MK_LAUNCH(2); MK_LAUNCH(3); MK_LAUNCH(4); MK_LAUNCH(5); MK_LAUNCH(6); MK_LAUNCH(7); MK_LAUNCH(8); MK_LAUNCH(9); MK_LAUNCH(10);
#endif
}
```

```cpp
#include <hip/hip_runtime.h>
#include <hip/hip_cooperative_groups.h>
#include <cstdint>
#include <cstdio>
namespace cg = cooperative_groups;

#ifndef MK_ONE_LAUNCH
#define MK_ONE_LAUNCH 1
#endif

#define LAS __attribute__((address_space(3)))
typedef unsigned short bf16_t;
typedef short bf16x8 __attribute__((ext_vector_type(8)));
typedef float f32x4 __attribute__((ext_vector_type(4)));
typedef float f32x2 __attribute__((ext_vector_type(2)));
typedef unsigned u32x4 __attribute__((ext_vector_type(4)));
typedef unsigned u32x2 __attribute__((ext_vector_type(2)));

constexpr int NB = 16, SEQ = 2048, DM = 1024, MTOK = NB * SEQ;
constexpr int NPROJ = 3072;
constexpr int CQ = 0, CKC = 512, CVC = 640, CKS = 768, CVS = 896, CKW = 1024, CVW = 1152, CGQ = 1280, CGK = 1536, CGV = 1792, CGR = 2304, CGATE = 2816, CGLR = 2840;
constexpr int NEXP = 32, DFF = 1024;
constexpr int MAXTILES = 544, XROWS = MAXTILES * 256;
constexpr float EPS = 1e-6f;
constexpr int NTHREADS = 512;
constexpr int LDS_BYTES = 160 * 1024;

constexpr size_t MiB = 1u << 20;
constexpr size_t WS_CTL = 0;
constexpr size_t WS_WIN = 2 * MiB;
constexpr size_t WS_WOUT = 8 * MiB;
constexpr size_t WS_CW1K = 10 * MiB, WS_CW1V = 11 * MiB;
constexpr size_t WS_CW2K = 12 * MiB, WS_CW2V = 12 * MiB + 512 * 1024;
constexpr size_t WS_CBIAS = 13 * MiB;
constexpr size_t WS_WRT = 13 * MiB + 512 * 1024;
constexpr size_t WS_WGU = 16 * MiB;
constexpr size_t WS_WD = 144 * MiB;
constexpr size_t WS_H = 208 * MiB;
constexpr size_t WS_PROJ = 272 * MiB;
constexpr size_t WS_QN = 464 * MiB, WS_QR = 496 * MiB;
constexpr size_t WS_KS = 528 * MiB, WS_KW = 536 * MiB;
constexpr size_t WS_VST = 544 * MiB, WS_VWT = 552 * MiB;
constexpr size_t WS_KC = 560 * MiB, WS_VCT = 561 * MiB;
constexpr size_t WS_U = 562 * MiB;
constexpr size_t WS_OI = 626 * MiB;
constexpr size_t WS_QD = 690 * MiB;
constexpr size_t WS_DEC = 722 * MiB;
constexpr size_t WS_SP = 723 * MiB;
constexpr size_t WS_ATT = 787 * MiB;
constexpr size_t WS_TOPI = 851 * MiB, WS_TOPG = 852 * MiB, WS_DEST = 853 * MiB;
constexpr size_t WS_XS = 272 * MiB;
constexpr size_t WS_ACT = 544 * MiB;
constexpr size_t WS_Y = 272 * MiB;
constexpr size_t WS_X1 = 854 * MiB;
constexpr size_t WS_END = 982 * MiB;
constexpr int CW_CNT = 0, CW_FILL = 64, CW_Q3 = 128, CW_BAR = 1024;
constexpr int CTL_BYTES = 32768;

struct Params {
    const float* in[23];
    float* out;
    unsigned char* ws;
};

__device__ __forceinline__ float bf2f(bf16_t v) { return __uint_as_float(((unsigned)v) << 16); }
__device__ __forceinline__ unsigned f2bf(float f) { unsigned u = __float_as_uint(f); return (u + 0x7fffu + ((u >> 16) & 1u)) >> 16; }
__device__ __forceinline__ unsigned pk2(float lo, float hi) { return f2bf(lo) | (f2bf(hi) << 16); }
__device__ __forceinline__ float wave_sum(float v) {
#pragma unroll
    for (int o = 1; o < 64; o <<= 1) v += __shfl_xor(v, o);
    return v;
}
#define LDS_WAIT() asm volatile("s_waitcnt lgkmcnt(0)" ::: "memory")
#define BAR_LDS() do { asm volatile("s_waitcnt lgkmcnt(0)" ::: "memory"); __builtin_amdgcn_s_barrier(); asm volatile("" ::: "memory"); } while (0)
__device__ __forceinline__ int opaque_tid() { int t = threadIdx.x; asm volatile("" : "+v"(t)); return t; }
__device__ __forceinline__ float sigmoidf_(float x) { return 1.f / (1.f + __expf(-x)); }

namespace pg8 {
constexpr int BM = 256, BK = 64, HALF = 128, HTB = HALF * BK * 2, STAGE_BYTES = 8 * HTB, NXCD = 8, WGM = 8;
__device__ __forceinline__ int lds_byte(int r, int c) { const int st = (r >> 4) * 2 + (c >> 5), rr = r & 15, cc = c & 31, ob = rr * 64 + cc * 2; return st * 1024 + (ob ^ (((ob >> 9) & 1) << 5)); }
__device__ __forceinline__ void stage_rc(int b, int& R, int& C) { const int st = b / 1024, sb = b % 1024, swz = sb ^ (((sb >> 9) & 1) << 5); R = (st >> 1) * 16 + swz / 64; C = (st & 1) * 32 + (swz % 64) / 2; }
__device__ __forceinline__ int perm32(int rho) { const int n = rho >> 4, i = rho & 15; return 8 * (i >> 2) + 4 * n + (i & 3); }

struct Unit { int pm, pn, pb; };
struct Gemm { const bf16_t* A; const bf16_t* Bt; int K; };

__device__ __forceinline__ bool order_next(long L, int nM, int nN, int& pm, int& pn) {
    const int nwg = nM * nN; if (L >= nwg) return false;
    int wgid = (int)L; { const int q = nwg / NXCD, r = nwg % NXCD, xcd = wgid % NXCD, off = wgid / NXCD; wgid = (xcd < r ? xcd * (q + 1) : r * (q + 1) + (xcd - r) * q) + off; }
    const int nig = WGM * nN, gid = wgid / nig, fm = gid * WGM, gsz = (nM - fm) < WGM ? (nM - fm) : WGM;
    pm = fm + ((wgid % nig) % gsz); pn = (wgid % nig) / gsz; return true;
}
struct StaticOrder {
    int nM, nN, G, c;
    __device__ __forceinline__ bool next(int i, Unit& u) const { if (!order_next((long)i * G + c, nM, nN, u.pm, u.pn)) return false; u.pb = u.pn; return true; }
};
struct MoeOrder {
    int nM, nN, G, c; const LAS int* tile_e;
    __device__ __forceinline__ bool next(int i, Unit& u) const { if (!order_next((long)i * G + c, nM, nN, u.pm, u.pn)) return false; u.pb = tile_e[u.pm] * nN + u.pn; return true; }
};

__device__ __forceinline__ unsigned cvt_pk_bf16(float lo, float hi) { unsigned r; asm volatile("v_cvt_pk_bf16_f32 %0, %1, %2" : "=v"(r) : "v"(lo), "v"(hi)); return r; }

struct EpiBf16 {
    static constexpr bool PERM = true;
    bf16_t* O; int ldc;
    __device__ __forceinline__ void operator()(const f32x4 (&acc)[2][2][4][2], const Unit& u, int wr, int wc, int fr, int fq) const {
        const int row0 = u.pm * BM + wr * 64 + fr, col0 = u.pn * BM + wc * 32 + 8 * fq;
#pragma unroll
        for (int ai = 0; ai < 2; ++ai)
#pragma unroll
            for (int m = 0; m < 4; ++m) { bf16_t* rowp = O + (size_t)(row0 + ai * HALF + m * 16) * ldc + col0;
#pragma unroll
                for (int bj = 0; bj < 2; ++bj) { const f32x4 v0 = acc[ai][bj][m][0], v1 = acc[ai][bj][m][1];
                    u32x4 w; w.x = cvt_pk_bf16(v0[0], v0[1]); w.y = cvt_pk_bf16(v0[2], v0[3]); w.z = cvt_pk_bf16(v1[0], v1[1]); w.w = cvt_pk_bf16(v1[2], v1[3]);
                    *(u32x4*)(rowp + bj * HALF) = w; } }
    }
};
struct EpiResF32 {
    static constexpr bool PERM = false;
    const float* base; float* out; int ldc;
    __device__ __forceinline__ void operator()(const f32x4 (&acc)[2][2][4][2], const Unit& u, int wr, int wc, int fr, int fq) const {
        const int col0 = u.pn * BM + wc * 32 + 4 * fq;
#pragma unroll
        for (int ai = 0; ai < 2; ++ai)
#pragma unroll
            for (int m = 0; m < 4; ++m) { const size_t off = (size_t)(u.pm * BM + ai * HALF + wr * 64 + m * 16 + fr) * ldc + col0;
#pragma unroll
                for (int bj = 0; bj < 2; ++bj)
#pragma unroll
                    for (int n = 0; n < 2; ++n) { const f32x4 bs = *(const f32x4*)(base + off + bj * HALF + n * 16); *(f32x4*)(out + off + bj * HALF + n * 16) = bs + acc[ai][bj][m][n]; } }
    }
};
struct EpiSwiglu {
    static constexpr bool PERM = true;
    bf16_t* O; const float* bias; int nN;
    __device__ __forceinline__ void operator()(const f32x4 (&acc)[2][2][4][2], const Unit& u, int wr, int wc, int fr, int fq) const {
        const int e = u.pb / nN;
        const int row0 = u.pm * BM + wr * 64 + fr, ch = u.pn * HALF + wc * 32 + 8 * fq;
        const float* bg = bias + (size_t)e * 2048 + ch; const float* bl = bg + 1024;
        const f32x4 bg0 = *(const f32x4*)bg, bg1 = *(const f32x4*)(bg + 4), bl0 = *(const f32x4*)bl, bl1 = *(const f32x4*)(bl + 4);
#pragma unroll
        for (int ai = 0; ai < 2; ++ai)
#pragma unroll
            for (int m = 0; m < 4; ++m) {
                float r[8];
#pragma unroll
                for (int n = 0; n < 2; ++n)
#pragma unroll
                    for (int j = 0; j < 4; ++j) {
                        float gv = acc[ai][0][m][n][j] + (n ? bg1[j] : bg0[j]);
                        float lv = acc[ai][1][m][n][j] + (n ? bl1[j] : bl0[j]);
                        gv = fminf(gv, 7.0f); lv = fminf(fmaxf(lv, -7.0f), 7.0f);
                        r[n * 4 + j] = gv * (1.f / (1.f + __expf(-1.702f * gv))) * (lv + 1.0f);
                    }
                u32x4 w; w.x = cvt_pk_bf16(r[0], r[1]); w.y = cvt_pk_bf16(r[2], r[3]); w.z = cvt_pk_bf16(r[4], r[5]); w.w = cvt_pk_bf16(r[6], r[7]);
                *(u32x4*)(O + (size_t)(row0 + ai * HALF + m * 16) * DFF + ch) = w;
            }
    }
};
struct EpiDown {
    static constexpr bool PERM = true;
    bf16_t* O; const float* bias; int nN;
    __device__ __forceinline__ void operator()(const f32x4 (&acc)[2][2][4][2], const Unit& u, int wr, int wc, int fr, int fq) const {
        const int e = u.pb / nN;
        const int row0 = u.pm * BM + wr * 64 + fr, col0 = u.pn * BM + wc * 32 + 8 * fq;
        const float* bp = bias + (size_t)e * 1024 + col0;
        f32x4 bv[2][2];
#pragma unroll
        for (int bj = 0; bj < 2; ++bj)
#pragma unroll
            for (int n = 0; n < 2; ++n) bv[bj][n] = *(const f32x4*)(bp + bj * HALF + 4 * n);
#pragma unroll
        for (int ai = 0; ai < 2; ++ai)
#pragma unroll
            for (int m = 0; m < 4; ++m) { bf16_t* rowp = O + (size_t)(row0 + ai * HALF + m * 16) * 1024 + col0;
#pragma unroll
                for (int bj = 0; bj < 2; ++bj) { const f32x4 v0 = acc[ai][bj][m][0] + bv[bj][0], v1 = acc[ai][bj][m][1] + bv[bj][1];
                    u32x4 w; w.x = cvt_pk_bf16(v0[0], v0[1]); w.y = cvt_pk_bf16(v0[2], v0[3]); w.z = cvt_pk_bf16(v1[0], v1[1]); w.w = cvt_pk_bf16(v1[2], v1[3]);
                    *(u32x4*)(rowp + bj * HALF) = w; } }
    }
};

template <class Epi, class Sched>
__device__ __forceinline__ void gemm_phase(LAS unsigned char* lds, const Gemm g, const Sched& S, const Epi& E) {
    const int tid = opaque_tid(), wid = __builtin_amdgcn_readfirstlane(tid >> 6), lane = tid & 63, wr = wid >> 2, wc = wid & 3, fr = lane & 15, fq = lane >> 4;
    const int K = g.K, nt = K / BK;
    unsigned voffA[2], voffB[2];
#pragma unroll
    for (int i = 0; i < 2; ++i) { int R, C; stage_rc(tid * 16 + i * 8192, R, C); const int Rb = Epi::PERM ? ((R & ~31) + perm32(R & 31)) : R;
        voffA[i] = (unsigned)(R * K + C) * 2u; voffB[i] = (unsigned)(Rb * K + C) * 2u; }
    const size_t kstep = (size_t)(BK * 2);
    const size_t hstep = (size_t)HALF * K * 2;
    const size_t tstep = 2 * hstep;
    const unsigned ldsw = (unsigned)wid * 1024u;
    const int aoff = lds_byte(wr * 64 + fr, fq * 8), boff = lds_byte(wc * 32 + fr, fq * 8);
#define PG8_SA(b, h) (((b) * 2 + (h)) * HTB)
#define PG8_SB(b, h) ((4 + (b) * 2 + (h)) * HTB)
#define PG8_STAGE(bufoff, gbase, voff) do { _Pragma("unroll") for (int _i = 0; _i < 2; ++_i) \
        __builtin_amdgcn_global_load_lds((const unsigned*)((const char*)(gbase) + (voff)[_i]), (LAS unsigned*)(lds + (bufoff) + ldsw + _i * 8192), 16, 0, 0); } while (0)
#define PG8_LDA(dst, b, h) do { _Pragma("unroll") for (int m = 0; m < 4; ++m) _Pragma("unroll") for (int k = 0; k < 2; ++k) dst[m][k] = *(const LAS bf16x8*)(lds + PG8_SA(b, h) + aoff + m * 2048 + k * 1024); } while (0)
#define PG8_LDB(dst, b, h) do { _Pragma("unroll") for (int n = 0; n < 2; ++n) _Pragma("unroll") for (int k = 0; k < 2; ++k) dst[n][k] = *(const LAS bf16x8*)(lds + PG8_SB(b, h) + boff + n * 2048 + k * 1024); } while (0)
#define PG8_MMA(ai, bj, At, Bt) do { __builtin_amdgcn_s_setprio(1); _Pragma("unroll") for (int m = 0; m < 4; ++m) _Pragma("unroll") for (int n = 0; n < 2; ++n) _Pragma("unroll") for (int k = 0; k < 2; ++k) \
        acc[ai][bj][m][n] = __builtin_amdgcn_mfma_f32_16x16x32_bf16(Bt[n][k], At[m][k], acc[ai][bj][m][n], 0, 0, 0); __builtin_amdgcn_s_setprio(0); } while (0)
#define PG8_WAIT_V(n) asm volatile("s_waitcnt vmcnt(" #n ")" ::: "memory")
#define PG8_WAIT_L(n) asm volatile("s_waitcnt lgkmcnt(" #n ")" ::: "memory")
#define PG8_BAR __builtin_amdgcn_s_barrier()
#define PG8_SCHED __builtin_amdgcn_sched_barrier(0)
    Unit cur, nxt; int ui = 0;
    if (!S.next(0, cur)) return;
    f32x4 acc[2][2][4][2];
#pragma unroll
    for (int a = 0; a < 2; ++a)
#pragma unroll
        for (int b = 0; b < 2; ++b)
#pragma unroll
            for (int m = 0; m < 4; ++m)
#pragma unroll
                for (int n = 0; n < 2; ++n) acc[a][b][m][n] = (f32x4){0.f, 0.f, 0.f, 0.f};
    bf16x8 At[4][2], B0[2][2], B1[2][2];
    const char* cA = (const char*)g.A + (size_t)cur.pm * tstep; const char* cB = (const char*)g.Bt + (size_t)cur.pb * tstep;
    {
        PG8_STAGE(PG8_SB(0, 0), cB, voffB); PG8_STAGE(PG8_SB(0, 1), cB + hstep, voffB); PG8_STAGE(PG8_SA(0, 0), cA, voffA); PG8_STAGE(PG8_SA(0, 1), cA + hstep, voffA);
        if (wr == 1) PG8_BAR;
        PG8_WAIT_V(2); PG8_BAR;
        PG8_STAGE(PG8_SB(1, 0), cB + kstep, voffB); PG8_STAGE(PG8_SA(1, 0), cA + kstep, voffA); PG8_STAGE(PG8_SB(1, 1), cB + hstep + kstep, voffB);
        PG8_WAIT_V(6); PG8_BAR;
    }
    for (;;) {
        const bool has_next = S.next(ui + 1, nxt);
        const char* nA = has_next ? (const char*)g.A + (size_t)nxt.pm * tstep : cA; const char* nB = has_next ? (const char*)g.Bt + (size_t)nxt.pb * tstep : cB;
        for (int t = 0; t < nt; t += 2) {
            const bool last = (t == nt - 2);
            const char* a1 = cA + (size_t)(t + 1) * kstep;
            const char* a2 = last ? nA : cA + (size_t)(t + 2) * kstep; const char* b2 = last ? nB : cB + (size_t)(t + 2) * kstep;
            const char* a3 = a2 + kstep; const char* b3 = b2 + kstep;
            PG8_LDB(B0, 0, 0); PG8_LDB(B1, 0, 1); PG8_SCHED; PG8_LDA(At, 0, 0); PG8_STAGE(PG8_SA(1, 1), a1 + hstep, voffA);
            PG8_WAIT_V(8); PG8_WAIT_L(0); PG8_BAR; PG8_MMA(0, 0, At, B0); PG8_MMA(0, 1, At, B1); PG8_BAR; PG8_SCHED;
            PG8_LDA(At, 0, 1); PG8_STAGE(PG8_SB(0, 0), b2, voffB); PG8_STAGE(PG8_SB(0, 1), b2 + hstep, voffB); PG8_STAGE(PG8_SA(0, 0), a2, voffA);
            PG8_WAIT_V(8); PG8_WAIT_L(0); PG8_BAR; PG8_MMA(1, 0, At, B0); PG8_MMA(1, 1, At, B1); PG8_BAR; PG8_SCHED;
            PG8_LDB(B0, 1, 0); PG8_LDB(B1, 1, 1); PG8_SCHED; PG8_LDA(At, 1, 0); PG8_STAGE(PG8_SA(0, 1), a2 + hstep, voffA);
            PG8_WAIT_V(8); PG8_WAIT_L(0); PG8_BAR; PG8_MMA(0, 0, At, B0); PG8_MMA(0, 1, At, B1); PG8_BAR; PG8_SCHED;
            PG8_LDA(At, 1, 1); PG8_STAGE(PG8_SB(1, 0), b3, voffB); PG8_STAGE(PG8_SB(1, 1), b3 + hstep, voffB); PG8_STAGE(PG8_SA(1, 0), a3, voffA);
            PG8_WAIT_V(8); PG8_WAIT_L(0); PG8_BAR; PG8_MMA(1, 0, At, B0); PG8_MMA(1, 1, At, B1); PG8_BAR; PG8_SCHED;
        }
        if (wr == 0) PG8_BAR;
        E(acc, cur, wr, wc, fr, fq);
        if (!has_next) break;
#pragma unroll
        for (int a = 0; a < 2; ++a)
#pragma unroll
            for (int b = 0; b < 2; ++b)
#pragma unroll
                for (int m = 0; m < 4; ++m)
#pragma unroll
                    for (int n = 0; n < 2; ++n) acc[a][b][m][n] = (f32x4){0.f, 0.f, 0.f, 0.f};
        cur = nxt; cA = nA; cB = nB; ++ui;
        if (wr == 1) PG8_BAR;
    }
    PG8_WAIT_V(0);
    PG8_BAR;
#undef PG8_SA
#undef PG8_SB
#undef PG8_STAGE
#undef PG8_LDA
#undef PG8_LDB
#undef PG8_MMA
#undef PG8_WAIT_V
#undef PG8_WAIT_L
#undef PG8_BAR
#undef PG8_SCHED
}
}

__device__ __forceinline__ int win_map(int n) {
    if (n < 1280) return n;
    if (n < 2304) return n + 24;
    if (n < 2816) return n + 40;
    if (n < 2840) return n - 1536;
    if (n < 2856) return n - 512;
    return -1;
}
template <int MODE> __device__ __forceinline__ int colmap(int r) {
    if (MODE == 1) return win_map(r);
    if (MODE == 2) return ((r >> 7) & 1) * 1024 + (r >> 8) * 128 + (r & 127);
    return r;
}
template <int MODE>
__device__ __forceinline__ void transpose_item(const float* W, int K, int Nsrc, bf16_t* WT, int nblk, LAS float* scr, int item, int lane) {
    const int kb = item / nblk, nb = item % nblk, k0 = 64 * kb, n0 = 64 * nb;
    const int nq = 4 * (lane & 15), kq = lane >> 4;
    const int sc = colmap<MODE>(n0 + nq);
    f32x4 v[16];
#pragma unroll
    for (int i = 0; i < 16; ++i) v[i] = sc >= 0 ? *(const f32x4*)(W + (size_t)(k0 + 4 * i + kq) * Nsrc + sc) : (f32x4){0.f, 0.f, 0.f, 0.f};
#pragma unroll
    for (int i = 0; i < 16; ++i) { LAS float* d = scr + (4 * i + kq) * 65 + nq; d[0] = v[i].x; d[1] = v[i].y; d[2] = v[i].z; d[3] = v[i].w; }
    LDS_WAIT();
    const int c = lane & 7;
#pragma unroll
    for (int j = 0; j < 8; ++j) { const int n = (lane >> 3) + 8 * j; const LAS float* s = scr + (8 * c) * 65 + n;
        u32x4 o; o.x = pk2(s[0 * 65], s[1 * 65]); o.y = pk2(s[2 * 65], s[3 * 65]); o.z = pk2(s[4 * 65], s[5 * 65]); o.w = pk2(s[6 * 65], s[7 * 65]);
        *(u32x4*)(WT + (size_t)(n0 + n) * K + k0 + 8 * c) = o; }
    LDS_WAIT();
}
__device__ __forceinline__ void rms_row_to_bf16(const float* xrow, const float* g, bf16_t* orow, int lane) {
    const f32x4* xr = (const f32x4*)xrow + lane; const f32x4* gr = (const f32x4*)g + lane;
    f32x4 v[4]; float s = 0.f;
#pragma unroll
    for (int j = 0; j < 4; ++j) { v[j] = xr[64 * j]; s += (v[j].x * v[j].x + v[j].y * v[j].y) + (v[j].z * v[j].z + v[j].w * v[j].w); }
    const float rstd = 1.f / sqrtf(wave_sum(s) * (1.f / DM) + EPS);
    unsigned long long* o8 = (unsigned long long*)orow + lane;
#pragma unroll
    for (int j = 0; j < 4; ++j) { const f32x4 gg = gr[64 * j]; const f32x4 o = v[j] * rstd * gg;
        o8[64 * j] = (unsigned long long)pk2(o.x, o.y) | ((unsigned long long)pk2(o.z, o.w) << 32); }
}
__device__ __forceinline__ void phase0(const Params& p, LAS unsigned char* lds, int blk, int G) {
    const int tid = opaque_tid(), lane = tid & 63, wave = tid >> 6;
    LAS float* scr = (LAS float*)(lds + wave * 16640);
    const int gw = blk * 8 + wave, NGW = G * 8;
    unsigned char* ws = p.ws;
    constexpr int I_GU = 16 * 32, I_DN = 16 * 16;
    constexpr int N_GU = NEXP * I_GU, N_DN = NEXP * I_DN, N_IN = 16 * (NPROJ / 64), N_OUT = 16 * 16, N_C1 = 32 * 4, N_C2 = 4 * 1;
    constexpr int NITEMS = N_GU + N_DN + N_IN + N_OUT + 2 * N_C1 + 2 * N_C2;
    for (int it = gw; it < NITEMS; it += NGW) {
        int r = it;
        if (r < N_GU) { const int e = r / I_GU; transpose_item<2>(p.in[19] + (size_t)e * 1024 * 2048, 1024, 2048, (bf16_t*)(ws + WS_WGU) + (size_t)e * 2048 * 1024, 32, scr, r % I_GU, lane); continue; } r -= N_GU;
        if (r < N_DN) { const int e = r / I_DN; transpose_item<0>(p.in[21] + (size_t)e * 1024 * 1024, 1024, 1024, (bf16_t*)(ws + WS_WD) + (size_t)e * 1024 * 1024, 16, scr, r % I_DN, lane); continue; } r -= N_DN;
        if (r < N_IN) { transpose_item<1>(p.in[3], 1024, 2856, (bf16_t*)(ws + WS_WIN), NPROJ / 64, scr, r, lane); continue; } r -= N_IN;
        if (r < N_OUT) { transpose_item<0>(p.in[15], 1024, 1024, (bf16_t*)(ws + WS_WOUT), 16, scr, r, lane); continue; } r -= N_OUT;
        if (r < N_C1) { transpose_item<0>(p.in[7], 2048, 256, (bf16_t*)(ws + WS_CW1K), 4, scr, r, lane); continue; } r -= N_C1;
        if (r < N_C1) { transpose_item<0>(p.in[10], 2048, 256, (bf16_t*)(ws + WS_CW1V), 4, scr, r, lane); continue; } r -= N_C1;
        if (r < N_C2) { transpose_item<0>(p.in[8], 256, 64, (bf16_t*)(ws + WS_CW2K), 1, scr, r, lane); continue; } r -= N_C2;
        transpose_item<0>(p.in[11], 256, 64, (bf16_t*)(ws + WS_CW2V), 1, scr, r, lane);
    }
    for (int m = gw; m < MTOK; m += NGW) rms_row_to_bf16(p.in[0] + (size_t)m * DM, p.in[2], (bf16_t*)(ws + WS_H) + (size_t)m * DM, lane);
    for (int i = blk * NTHREADS + tid; i < NEXP * DM; i += G * NTHREADS) { const int e = i >> 10, d = i & 1023; ((float*)(ws + WS_WRT))[i] = p.in[16][d] * p.in[17][d * NEXP + e]; }
    if (blk == G - 1) {
        const int which = tid >> 8, j = tid & 255;
        const float* pos = which ? p.in[9] : p.in[6]; const float* w1 = which ? p.in[10] : p.in[7];
        float s = 0.f;
#pragma unroll 8
        for (int k = 0; k < 2048; ++k) s += pos[k] * w1[(size_t)k * 256 + j];
        ((float*)(ws + WS_CBIAS))[tid] = s;
    }
}

__device__ __forceinline__ void p2a_unit(const Params& p, LAS unsigned char* lds, int unit) {
    const int tid = opaque_tid(), lane = tid & 63, wave = tid >> 6;
    unsigned char* ws = p.ws;
    const bf16_t* PROJ = (const bf16_t*)(ws + WS_PROJ);
    const int b = unit >> 5, blkc = unit & 31, tok0 = unit * 64;
    const float gq = p.in[4][lane], gks = p.in[5][64 + lane], gkw = p.in[5][128 + lane];
    const float inv_freq = __expf(-13.122363377404328f * (float)(2 * (lane & 7)) * (1.f / 16.f));
    for (int ti = 0; ti < 8; ++ti) {
        const int i = wave * 8 + ti, t = tok0 + i;
        const float pos = (float)((const int*)p.in[1])[t];
        const float ang = pos * inv_freq;
        const float cs = cosf(ang), sn = sinf(ang);
        const bf16_t* pr = PROJ + (size_t)t * NPROJ;
#pragma unroll
        for (int v = 0; v < 12; ++v) {
            const int col = (v < 8) ? (CQ + v * 64) : (v < 10 ? CKS + (v - 8) * 64 : CKW + (v - 10) * 64);
            const float g = (v < 8) ? gq : (v < 10 ? gks : gkw);
            const float x = bf2f(pr[col + lane]);
            const float ss = wave_sum(x * x);
            float y = x * (1.f / sqrtf(ss * (1.f / 64.f) + EPS)) * g;
            const float partner = __shfl_xor(y, 8);
            float yr = y;
            if (lane < 8) yr = y * cs - partner * sn; else if (lane < 16) yr = y * cs + partner * sn;
            if (v < 8) {
                ((bf16_t*)(ws + WS_QN))[(size_t)t * 512 + v * 64 + lane] = (bf16_t)f2bf(y * 0.125f);
                ((bf16_t*)(ws + WS_QR))[(size_t)t * 512 + v * 64 + lane] = (bf16_t)f2bf(yr * 0.125f);
            } else if (v < 10) {
                ((bf16_t*)(ws + WS_KS))[((size_t)(b * 2 + (v - 8)) * SEQ + (t & (SEQ - 1))) * 64 + lane] = (bf16_t)f2bf(yr);
            } else {
                ((bf16_t*)(ws + WS_KW))[((size_t)(b * 2 + (v - 10)) * SEQ + (t & (SEQ - 1))) * 64 + lane] = (bf16_t)f2bf(yr);
            }
        }
    }
    LAS bf16_t* T = (LAS bf16_t*)lds;
    for (int v = 0; v < 4; ++v) {
        const int kh = v & 1, col = (v < 2 ? CVS : CVW) + kh * 64;
        __syncthreads();
        { const int tk = tid >> 3, ch = tid & 7; const u32x4 raw = *(const u32x4*)(PROJ + (size_t)(tok0 + tk) * NPROJ + col + 8 * ch);
#pragma unroll
          for (int q = 0; q < 4; ++q) { const unsigned wv = raw[q]; T[(8 * ch + 2 * q) * 72 + tk] = (bf16_t)(wv & 0xffffu); T[(8 * ch + 2 * q + 1) * 72 + tk] = (bf16_t)(wv >> 16); } }
        __syncthreads();
        { const int d = tid >> 3, ch = tid & 7; const u32x4 o = *(const LAS u32x4*)(T + d * 72 + 8 * ch);
          bf16_t* dst = (bf16_t*)(ws + (v < 2 ? WS_VST : WS_VWT)) + (((size_t)(b * 2 + kh) * 32 + blkc) * 64 + d) * 64 + 8 * ch;
          *(u32x4*)dst = o; }
    }
    __syncthreads();
}

__device__ __forceinline__ void p2b_unit(const Params& p, LAS unsigned char* lds, int unit) {
    const int tid = opaque_tid(), lane = tid & 63, w = tid >> 6, fr = lane & 15, fq = lane >> 4;
    unsigned char* ws = p.ws;
    const bf16_t* PROJ = (const bf16_t*)(ws + WS_PROJ);
    const int which = unit >> 6, rt = unit & 63;
    const bf16_t* W1T = (const bf16_t*)(ws + (which ? WS_CW1V : WS_CW1K));
    const bf16_t* W2T = (const bf16_t*)(ws + (which ? WS_CW2V : WS_CW2K));
    const float* cb = (const float*)(ws + WS_CBIAS) + which * 256;
    const int colbase = which ? CVC : CKC;
    LAS bf16_t* Hd = (LAS bf16_t*)lds;
    LAS float* Of = (LAS float*)(lds + 64 * 264 * 2);
    const bf16_t* arow[4];
#pragma unroll
    for (int m = 0; m < 4; ++m) { const int R = rt * 64 + 16 * m + fr; const int bb = R >> 8, kh = (R >> 7) & 1; int n = R & 127; if (n > 126) n = 126;
        arow[m] = PROJ + (size_t)(bb * SEQ + 16 * n) * NPROJ + colbase + kh * 64 + 8 * fq; }
    const bf16_t* brow[2];
#pragma unroll
    for (int nf = 0; nf < 2; ++nf) brow[nf] = W1T + (size_t)(32 * w + 16 * nf + fr) * 2048 + 8 * fq;
    f32x4 acc[4][2];
#pragma unroll
    for (int m = 0; m < 4; ++m)
#pragma unroll
        for (int nf = 0; nf < 2; ++nf) acc[m][nf] = (f32x4){0.f, 0.f, 0.f, 0.f};
#pragma unroll 2
    for (int ks = 0; ks < 64; ++ks) {
        bf16x8 a[4], bb2[2];
        const size_t aoff = (size_t)(ks >> 1) * NPROJ + 32 * (ks & 1);
#pragma unroll
        for (int m = 0; m < 4; ++m) a[m] = *(const bf16x8*)(arow[m] + aoff);
#pragma unroll
        for (int nf = 0; nf < 2; ++nf) bb2[nf] = *(const bf16x8*)(brow[nf] + 32 * ks);
#pragma unroll
        for (int m = 0; m < 4; ++m)
#pragma unroll
            for (int nf = 0; nf < 2; ++nf) acc[m][nf] = __builtin_amdgcn_mfma_f32_16x16x32_bf16(a[m], bb2[nf], acc[m][nf], 0, 0, 0);
    }
#pragma unroll
    for (int nf = 0; nf < 2; ++nf) { const int col = 32 * w + 16 * nf + fr; const float bias = cb[col];
#pragma unroll
        for (int m = 0; m < 4; ++m)
#pragma unroll
            for (int j = 0; j < 4; ++j) { const float hv = acc[m][nf][j] + bias; Hd[(16 * m + 4 * fq + j) * 264 + col] = (bf16_t)f2bf(hv * sigmoidf_(hv)); } }
    __syncthreads();
    {
        const int m2 = w >> 1;
        f32x4 acc2[2] = {(f32x4){0.f, 0.f, 0.f, 0.f}, (f32x4){0.f, 0.f, 0.f, 0.f}};
#pragma unroll
        for (int ks = 0; ks < 8; ++ks) {
            const bf16x8 a = *(const LAS bf16x8*)(Hd + (16 * m2 + fr) * 264 + 32 * ks + 8 * fq);
#pragma unroll
            for (int q = 0; q < 2; ++q) { const int nf2 = 2 * (w & 1) + q; const bf16x8 bv = *(const bf16x8*)(W2T + (size_t)(16 * nf2 + fr) * 256 + 32 * ks + 8 * fq);
                acc2[q] = __builtin_amdgcn_mfma_f32_16x16x32_bf16(a, bv, acc2[q], 0, 0, 0); }
        }
#pragma unroll
        for (int q = 0; q < 2; ++q) { const int nf2 = 2 * (w & 1) + q;
#pragma unroll
            for (int j = 0; j < 4; ++j) Of[(16 * m2 + 4 * fq + j) * 65 + 16 * nf2 + fr] = acc2[q][j]; }
    }
    __syncthreads();
    for (int rr = 0; rr < 8; ++rr) {
        const int r = 8 * w + rr, R = rt * 64 + r, bb = R >> 8, kh = (R >> 7) & 1, n = R & 127;
        float v = Of[r * 65 + lane];
        if (which == 0) {
            const float ss = wave_sum(v * v);
            v = v * (1.f / sqrtf(ss * (1.f / 64.f) + EPS)) * p.in[5][lane];
            if (n == 127) v = 0.f;
            ((bf16_t*)(ws + WS_KC))[((size_t)(bb * 2 + kh) * 128 + n) * 64 + lane] = (bf16_t)f2bf(v);
        } else {
            if (n == 127) v = 0.f;
            ((bf16_t*)(ws + WS_VCT))[((size_t)(bb * 2 + kh) * 64 + lane) * 128 + n] = (bf16_t)f2bf(v);
        }
    }
    __syncthreads();
}

constexpr int NSA_KT0 = 0, NSA_VT0 = 9216, NSA_KT1 = 18432, NSA_VT1 = 27648, NSA_PW = 36864, NSA_IMPW = NSA_PW  ,
              NSA_SELM = NSA_PW + 8 * 4608, NSA_UNI = NSA_SELM + 256, NSA_OUT = NSA_UNI + 256;
static_assert(4 * 64 * 33 * 4 <= 8 * 4608 && NSA_OUT + 256 * 68 * 4 <= LDS_BYTES - 16, "NSA LDS map");
constexpr float NEGBIG = -1e30f;

template <int CTRL> __device__ __forceinline__ float dppf(float v) { return __int_as_float(__builtin_amdgcn_update_dpp(0, __float_as_int(v), CTRL, 0xf, 0xf, true)); }
__device__ __forceinline__ float red16_max(float v) { v = fmaxf(v, dppf<0xB1>(v)); v = fmaxf(v, dppf<0x4E>(v)); v = fmaxf(v, dppf<0x141>(v)); v = fmaxf(v, dppf<0x140>(v)); return v; }
__device__ __forceinline__ float red16_sum(float v) { v += dppf<0xB1>(v); v += dppf<0x4E>(v); v += dppf<0x141>(v); v += dppf<0x140>(v); return v; }

__device__ __forceinline__ void nsa_qk(const bf16x8 (&aq)[2][2], const LAS bf16_t* KT, f32x4 (&S)[2][4], int fr, int fq) {
#pragma unroll
    for (int nf = 0; nf < 4; ++nf) {
        bf16x8 bk[2];
#pragma unroll
        for (int ks = 0; ks < 2; ++ks) bk[ks] = *(const LAS bf16x8*)(KT + (16 * nf + fr) * 72 + 32 * ks + 8 * fq);
#pragma unroll
        for (int m = 0; m < 2; ++m) { f32x4 s = (f32x4){0.f, 0.f, 0.f, 0.f};
#pragma unroll
            for (int ks = 0; ks < 2; ++ks) s = __builtin_amdgcn_mfma_f32_16x16x32_bf16(aq[m][ks], bk[ks], s, 0, 0, 0);
            S[m][nf] = s; }
    }
}
__device__ __forceinline__ void nsa_pv(const LAS bf16_t* PWw, const LAS bf16_t* VT, f32x4 (&O)[2][4], int fr, int fq) {
    bf16x8 ap[2][2];
#pragma unroll
    for (int m = 0; m < 2; ++m)
#pragma unroll
        for (int ks = 0; ks < 2; ++ks) ap[m][ks] = *(const LAS bf16x8*)(PWw + (16 * m + fr) * 72 + 32 * ks + 8 * fq);
#pragma unroll
    for (int nfd = 0; nfd < 4; ++nfd) {
        bf16x8 bv[2];
#pragma unroll
        for (int ks = 0; ks < 2; ++ks) bv[ks] = *(const LAS bf16x8*)(VT + (16 * nfd + fr) * 72 + 32 * ks + 8 * fq);
#pragma unroll
        for (int m = 0; m < 2; ++m)
#pragma unroll
            for (int ks = 0; ks < 2; ++ks) O[m][nfd] = __builtin_amdgcn_mfma_f32_16x16x32_bf16(ap[m][ks], bv[ks], O[m][nfd], 0, 0, 0);
    }
}
__device__ __forceinline__ void nsa_bounds(int mode, bool rok, int i, int cq, int koff, int& lo, int& hi) {
    hi = (mode == 1) ? i : ((mode == 3) ? (((cq + i - 31) >> 4) - koff) : 63);
    lo = (mode == 2) ? i + 1 : 0;
    hi = rok ? hi : -1;
}
constexpr float NSA_SHIFT = 10.0f, LOG2E = 1.4426950408889634f;
__device__ __forceinline__ void nsa_tile(const bf16x8 (&aq)[2][2], const LAS bf16_t* KT, const LAS bf16_t* VT, LAS bf16_t* PWw, float (&lsum)[2][4], f32x4 (&O)[2][4],
                                         unsigned rowok, int mode, int ibase, int cq, int koff, int fr_, int fq_) {
    int fr = fr_, fq = fq_;
    asm volatile("" : "+v"(fr), "+v"(fq));
    f32x4 S[2][4];
    nsa_qk(aq, KT, S, fr, fq);
#pragma unroll
    for (int m = 0; m < 2; ++m)
#pragma unroll
        for (int j = 0; j < 4; ++j) {
            const int i = ibase + 16 * m + 4 * fq + j;
            int lo, hi; nsa_bounds(mode, (rowok >> (m * 4 + j)) & 1u, i, cq, koff, lo, hi);
            float pv[4];
#pragma unroll
            for (int nf = 0; nf < 4; ++nf) { const int key = 4 * fr + nf; const bool ok = (key >= lo) & (key <= hi);
                const float e = __builtin_amdgcn_exp2f(S[m][nf][j] * LOG2E - NSA_SHIFT * LOG2E); pv[nf] = ok ? e : 0.f; }
            lsum[m][j] += (pv[0] + pv[1]) + (pv[2] + pv[3]);
            u32x2 pw; pw.x = pg8::cvt_pk_bf16(pv[0], pv[1]); pw.y = pg8::cvt_pk_bf16(pv[2], pv[3]);
            *(LAS u32x2*)(PWw + (16 * m + 4 * fq + j) * 72 + 4 * fr) = pw;
        }
    LDS_WAIT();
    nsa_pv(PWw, VT, O, fr, fq);
}
struct NsaStage { u32x4 k, v; };
__device__ __forceinline__ void nsa_fetch(NsaStage& st, const bf16_t* Ksrc, int kstride, const bf16_t* Vsrc, int vstride, int tid) {
    const int r = tid >> 3, ch = tid & 7;
    st.k = *(const u32x4*)(Ksrc + (size_t)r * kstride + 8 * ch);
    st.v = *(const u32x4*)(Vsrc + (size_t)r * vstride + 8 * ch);
}
__device__ __forceinline__ void nsa_commit(const NsaStage& st, LAS bf16_t* KT, LAS bf16_t* VT, int tid) {
    const int r = tid >> 3, ch = tid & 7;
    *(LAS u32x4*)(KT + (16 * (r & 3) + (r >> 2)) * 72 + 8 * ch) = st.k;
    *(LAS u32x4*)(VT + r * 72 + 8 * ch) = st.v;
}

__device__ __forceinline__ void nsa_unit(const Params& p, LAS unsigned char* lds, int b, int kh, int c) {
    const int tid = opaque_tid(), lane = tid & 63, w = tid >> 6, fr = lane & 15, fq = lane >> 4, g = w >> 1, ih = w & 1;
    unsigned char* ws = p.ws;
    const int hh = kh * 4 + g, tok0 = b * SEQ + 64 * c, ibase = 32 * ih;
    const bf16_t* PROJ = (const bf16_t*)(ws + WS_PROJ);
    LAS bf16_t* PWw = (LAS bf16_t*)(lds + NSA_PW + w * 4608);
    LAS float* IMPW = (LAS float*)(lds + NSA_IMPW);
    LAS unsigned* SELM = (LAS unsigned*)(lds + NSA_SELM); LAS unsigned* UNI = (LAS unsigned*)(lds + NSA_UNI);
    LAS float* OUTw = (LAS float*)(lds + NSA_OUT) + (w * 32) * 68;
    const size_t bk = (size_t)(b * 2 + kh);
#define NSA_KTB(bb) ((LAS bf16_t*)(lds + ((bb) ? NSA_KT1 : NSA_KT0)))
#define NSA_VTB(bb) ((LAS bf16_t*)(lds + ((bb) ? NSA_VT1 : NSA_VT0)))
    bf16x8 aq[2][2];
    NsaStage st;
    if (tid == 0) *UNI = 0u;
    {
#pragma unroll
        for (int m = 0; m < 2; ++m)
#pragma unroll
            for (int ks = 0; ks < 2; ++ks) aq[m][ks] = *(const bf16x8*)((const bf16_t*)(ws + WS_QN) + (size_t)(tok0 + ibase + 16 * m + fr) * 512 + hh * 64 + 32 * ks + 8 * fq);
        const int nh = (4 * c + 2 >= 64) ? 2 : 1;
        const bf16_t* KCb = (const bf16_t*)(ws + WS_KC) + bk * 128 * 64; const bf16_t* VCb = (const bf16_t*)(ws + WS_VCT) + bk * 64 * 128;
        float lrow[2][4]; f32x4 O[2][4];
#pragma unroll
        for (int m = 0; m < 2; ++m) {
#pragma unroll
            for (int j = 0; j < 4; ++j) lrow[m][j] = 0.f;
#pragma unroll
            for (int nfd = 0; nfd < 4; ++nfd) O[m][nfd] = (f32x4){0.f, 0.f, 0.f, 0.f};
        }
        nsa_fetch(st, KCb, 64, VCb, 128, tid);
        BAR_LDS();
        nsa_commit(st, NSA_KTB(0), NSA_VTB(0), tid);
        if (nh == 2) { nsa_fetch(st, KCb + 64 * 64, 64, VCb + 64, 128, tid); nsa_commit(st, NSA_KTB(1), NSA_VTB(1), tid); }
        BAR_LDS();
        for (int half = 0; half < nh; ++half) nsa_tile(aq, NSA_KTB(half), NSA_VTB(half), PWw, lrow, O, 0xffu, 3, ibase, 64 * c, 64 * half, fr, fq);
#pragma unroll
        for (int m = 0; m < 2; ++m)
#pragma unroll
            for (int j = 0; j < 4; ++j) { const int t = tok0 + ibase + 16 * m + 4 * fq + j; const float gt = sigmoidf_(bf2f(PROJ[(size_t)t * NPROJ + CGATE + hh * 3 + 0]));
                const float lt = red16_sum(lrow[m][j]);
                const float inv = lt > 0.f ? 1.f / lt : 0.f;
                lrow[m][j] = inv;
#pragma unroll
                for (int nfd = 0; nfd < 4; ++nfd) OUTw[(16 * m + 4 * fq + j) * 68 + 16 * nfd + fr] = gt * inv * O[m][nfd][j]; }
        BAR_LDS();
        float carry[2][4];
#pragma unroll
        for (int m = 0; m < 2; ++m)
#pragma unroll
            for (int j = 0; j < 4; ++j) carry[m][j] = 0.f;
        for (int half = 0; half < nh; ++half) {
            f32x4 S[2][4];
            int fr2 = fr, fq2 = fq;
            asm volatile("" : "+v"(fr2), "+v"(fq2));
            nsa_qk(aq, NSA_KTB(half), S, fr2, fq2);
#pragma unroll
            for (int m = 0; m < 2; ++m)
#pragma unroll
                for (int j = 0; j < 4; ++j) {
                    const int i = ibase + 16 * m + 4 * fq2 + j;
                    const int hi = ((64 * c + i - 31) >> 4) - 64 * half;
                    float pv[4];
#pragma unroll
                    for (int nf = 0; nf < 4; ++nf) pv[nf] = (4 * fr2 + nf <= hi) ? __builtin_amdgcn_exp2f(S[m][nf][j] * LOG2E - NSA_SHIFT * LOG2E) * lrow[m][j] : 0.f;
                    const float e1 = dppf<0x121>(pv[3]), e2 = dppf<0x121>(carry[m][j]);
                    const float extra = (fr2 == 0) ? e2 : e1;
                    IMPW[(g * 64 + i) * 33 + 16 * half + fr2] = ((pv[0] + pv[1]) + (pv[2] + pv[3])) + extra;
                    carry[m][j] = pv[3];
                }
        }
    }
    BAR_LDS();
    {
        LAS float* SC = (LAS float*)(lds + NSA_KT0);
#pragma unroll
        for (int q = 0; q < 4; ++q) { const int pr = q * NTHREADS + tid, i = pr >> 5, j = pr & 31;
            float v = NEGBIG;
            if (j <= c) { v = (IMPW[(0 * 64 + i) * 33 + j] + IMPW[(1 * 64 + i) * 33 + j]) + (IMPW[(2 * 64 + i) * 33 + j] + IMPW[(3 * 64 + i) * 33 + j]);
                if (j == 0 || j == c || j == c - 1) v += 1e4f; }
            SC[i * 33 + j] = v; }
        BAR_LDS();
#pragma unroll 1
        for (int q = 0; q < 4; ++q) { const int pr = q * NTHREADS + tid, i = pr >> 5, j = pr & 31;
            const float my = SC[i * 33 + j]; int rank = 0;
#pragma unroll
            for (int k = 0; k < 32; ++k) { const float o = SC[i * 33 + k]; rank += (o > my || (o == my && k < j)) ? 1 : 0; }
            const bool sel = (j <= c) && rank < 8;
            const unsigned long long bal = __ballot(sel);
            const unsigned msk = (lane & 32) ? (unsigned)(bal >> 32) : (unsigned)bal;
            if (j == 0) { SELM[i] = msk; atomicOr((unsigned*)UNI, msk); } }
    }
    BAR_LDS();
    const unsigned uni = *UNI;
#pragma unroll
    for (int m = 0; m < 2; ++m)
#pragma unroll
        for (int ks = 0; ks < 2; ++ks) aq[m][ks] = *(const bf16x8*)((const bf16_t*)(ws + WS_QR) + (size_t)(tok0 + ibase + 16 * m + fr) * 512 + hh * 64 + 32 * ks + 8 * fq);
#pragma unroll 1
    for (int br = 0; br < 2; ++br) {
        float lrow[2][4]; f32x4 O[2][4];
#pragma unroll
        for (int m = 0; m < 2; ++m) {
#pragma unroll
            for (int j = 0; j < 4; ++j) lrow[m][j] = 0.f;
#pragma unroll
            for (int nfd = 0; nfd < 4; ++nfd) O[m][nfd] = (f32x4){0.f, 0.f, 0.f, 0.f};
        }
        const bf16_t* Kb = (const bf16_t*)(ws + (br ? WS_KW : WS_KS)) + bk * SEQ * 64;
        const bf16_t* Vb = (const bf16_t*)(ws + (br ? WS_VWT : WS_VST)) + bk * 32 * 4096;
        unsigned todo = br ? ((c >= 8 ? (0x1ffu << (c - 8)) : ((2u << c) - 1u))) : (uni & ((c == 31) ? 0xffffffffu : ((2u << c) - 1u)));
        int cur = __builtin_ctz(todo); todo &= todo - 1u;
        nsa_fetch(st, Kb + (size_t)cur * 4096, 64, Vb + (size_t)cur * 4096, 64, tid);
        BAR_LDS();
        nsa_commit(st, NSA_KTB(0), NSA_VTB(0), tid);
        int nxt = todo ? __builtin_ctz(todo) : -1; if (todo) todo &= todo - 1u;
        if (nxt >= 0) nsa_fetch(st, Kb + (size_t)nxt * 4096, 64, Vb + (size_t)nxt * 4096, 64, tid);
        BAR_LDS();
        int bb = 0;
        for (;;) {
            unsigned rowok; int mode;
            if (br == 0) {
                rowok = 0u;
#pragma unroll
                for (int m = 0; m < 2; ++m)
#pragma unroll
                    for (int j = 0; j < 4; ++j) rowok |= ((SELM[ibase + 16 * m + 4 * fq + j] >> cur) & 1u) << (m * 4 + j);
                mode = (cur == c) ? 1 : 0;
            } else { rowok = 0xffu; mode = (cur == c) ? 1 : ((cur == c - 8) ? 2 : 0); }
            nsa_tile(aq, NSA_KTB(bb), NSA_VTB(bb), PWw, lrow, O, rowok, mode, ibase, 0, 0, fr, fq);
            if (nxt < 0) break;
            nsa_commit(st, NSA_KTB(bb ^ 1), NSA_VTB(bb ^ 1), tid);
            cur = nxt;
            nxt = todo ? __builtin_ctz(todo) : -1; if (todo) todo &= todo - 1u;
            if (nxt >= 0) nsa_fetch(st, Kb + (size_t)nxt * 4096, 64, Vb + (size_t)nxt * 4096, 64, tid);
            BAR_LDS();
            bb ^= 1;
        }
#pragma unroll
        for (int m = 0; m < 2; ++m)
#pragma unroll
            for (int j = 0; j < 4; ++j) { const int t = tok0 + ibase + 16 * m + 4 * fq + j; const float gt = sigmoidf_(bf2f(PROJ[(size_t)t * NPROJ + CGATE + hh * 3 + 1 + br]));
                const float lt = red16_sum(lrow[m][j]);
                const float sc = lt > 0.f ? gt / lt : 0.f;
#pragma unroll
                for (int nfd = 0; nfd < 4; ++nfd) OUTw[(16 * m + 4 * fq + j) * 68 + 16 * nfd + fr] += sc * O[m][nfd][j]; }
    }
    LDS_WAIT();
#pragma unroll
    for (int q = 0; q < 4; ++q) {
        const int r = 8 * q + (lane >> 3), ch = lane & 7;
        const LAS f32x4* src = (const LAS f32x4*)(OUTw + r * 68 + 8 * ch);
        const f32x4 a = src[0], bq = src[1];
        u32x4 o; o.x = pk2(a[0], a[1]); o.y = pk2(a[2], a[3]); o.z = pk2(bq[0], bq[1]); o.w = pk2(bq[2], bq[3]);
        *(u32x4*)((bf16_t*)(ws + WS_ATT) + (size_t)(tok0 + ibase + r) * 1024 + hh * 64 + 8 * ch) = o;
    }
#undef NSA_KTB
#undef NSA_VTB
}

constexpr int GLA_QD = 0, GLA_KD = 9216, GLA_KST = 18432, GLA_VT = 27648, GLA_AT = 46080, GLA_ST = 55296, GLA_WG = 73728  , GLA_DEC = 77824  ,
              GLA_OT = 78336  , GLA_END = GLA_OT + 64 * 132 * 4;
static_assert(GLA_END <= LDS_BYTES - 64, "GLA LDS map");
template <int CTRL, int RMASK> __device__ __forceinline__ float dppf_rm(float v) { return __int_as_float(__builtin_amdgcn_update_dpp(0, __float_as_int(v), CTRL, RMASK, 0xf, false)); }
__device__ __forceinline__ float wave_incl_scan(float v) {
    v += __int_as_float(__builtin_amdgcn_update_dpp(0, __float_as_int(v), 0x111, 0xf, 0xf, true));
    v += __int_as_float(__builtin_amdgcn_update_dpp(0, __float_as_int(v), 0x112, 0xf, 0xf, true));
    v += __int_as_float(__builtin_amdgcn_update_dpp(0, __float_as_int(v), 0x114, 0xf, 0xf, true));
    v += __int_as_float(__builtin_amdgcn_update_dpp(0, __float_as_int(v), 0x118, 0xf, 0xf, true));
    v += dppf_rm<0x142, 0xa>(v);
    v += dppf_rm<0x143, 0xc>(v);
    return v;
}
struct GlaStage { u32x4 q, k, g0, g1, v0, v1; };
__device__ __forceinline__ void gla_fetch(GlaStage& st, const bf16_t* PROJ, int tok0, int h, int lane, int w) {
    const bf16_t* row = PROJ + (size_t)(tok0 + lane) * NPROJ;
    st.q = *(const u32x4*)(row + CGQ + h * 64 + 8 * w);
    st.k = *(const u32x4*)(row + CGK + h * 64 + 8 * w);
    st.g0 = *(const u32x4*)(row + CGLR); st.g1 = *(const u32x4*)(row + CGLR + 8);
    st.v0 = *(const u32x4*)(row + CGV + h * 128 + 16 * w); st.v1 = *(const u32x4*)(row + CGV + h * 128 + 16 * w + 8);
}
__device__ __forceinline__ float bflo(unsigned u) { return __uint_as_float(u << 16); }
__device__ __forceinline__ float bfhi(unsigned u) { return __uint_as_float(u & 0xffff0000u); }

__device__ __forceinline__ void gla_unit(const Params& p, LAS unsigned char* lds, int b, int h) {
    const int tid = opaque_tid(), lane = tid & 63, w = tid >> 6, fr = lane & 15, fq = lane >> 4;
    unsigned char* ws = p.ws;
    const bf16_t* PROJ = (const bf16_t*)(ws + WS_PROJ);
    LAS bf16_t* Qd = (LAS bf16_t*)(lds + GLA_QD); LAS bf16_t* Kd = (LAS bf16_t*)(lds + GLA_KD); LAS bf16_t* KsT = (LAS bf16_t*)(lds + GLA_KST);
    LAS bf16_t* VT = (LAS bf16_t*)(lds + GLA_VT); LAS bf16_t* At = (LAS bf16_t*)(lds + GLA_AT); LAS bf16_t* ST = (LAS bf16_t*)(lds + GLA_ST);
    LAS float* WG = (LAS float*)(lds + GLA_WG); LAS float* DEC = (LAS float*)(lds + GLA_DEC); LAS float* OT = (LAS float*)(lds + GLA_OT);
    BAR_LDS();
    for (int i = tid; i < 16 * 64; i += NTHREADS) WG[i] = p.in[12][(i >> 6) * 256 + h * 64 + (i & 63)];
    for (int i = tid; i < 128 * 72 / 2; i += NTHREADS) ((LAS unsigned*)ST)[i] = 0u;
    float bg[8];
#pragma unroll
    for (int q = 0; q < 8; ++q) bg[q] = p.in[13][h * 64 + 8 * w + q];
    const int md = w & 3, nfe0 = 4 * (w >> 2);
    f32x4 Sreg[4];
#pragma unroll
    for (int x = 0; x < 4; ++x) Sreg[x] = (f32x4){0.f, 0.f, 0.f, 0.f};
    GlaStage st;
    gla_fetch(st, PROJ, b * SEQ, h, lane, w);
    BAR_LDS();
#pragma unroll 1
    for (int n = 0; n < 32; ++n) {
        const int tok0 = b * SEQ + n * 64;
        float gl[16];
        { const unsigned gw[8] = {st.g0.x, st.g0.y, st.g0.z, st.g0.w, st.g1.x, st.g1.y, st.g1.z, st.g1.w};
#pragma unroll
          for (int q = 0; q < 8; ++q) { gl[2 * q] = bflo(gw[q]); gl[2 * q + 1] = bfhi(gw[q]); } }
        float bcum[8], blast[8];
#pragma unroll
        for (int q = 0; q < 8; ++q) {
            float x = bg[q];
#pragma unroll
            for (int r = 0; r < 16; ++r) x += gl[r] * WG[r * 64 + 8 * w + q];
            const float la = (fminf(x, 0.f) - __logf(1.f + __expf(-fabsf(x)))) * (1.f / 16.f);
            bcum[q] = wave_incl_scan(la);
            blast[q] = __int_as_float(__builtin_amdgcn_readlane(__float_as_int(bcum[q]), 63));
        }
        {
            const unsigned qw[4] = {st.q.x, st.q.y, st.q.z, st.q.w}, kw[4] = {st.k.x, st.k.y, st.k.z, st.k.w};
            unsigned qo[4], ko[4];
#pragma unroll
            for (int q2 = 0; q2 < 4; ++q2) {
                const float e0 = __expf(bcum[2 * q2]), e1 = __expf(bcum[2 * q2 + 1]);
                const float i0 = __expf(-bcum[2 * q2]), i1 = __expf(-bcum[2 * q2 + 1]);
                const float k0 = bflo(kw[q2]), k1 = bfhi(kw[q2]);
                qo[q2] = pg8::cvt_pk_bf16(bflo(qw[q2]) * 0.125f * e0, bfhi(qw[q2]) * 0.125f * e1);
                ko[q2] = pg8::cvt_pk_bf16(k0 * i0, k1 * i1);
                KsT[(8 * w + 2 * q2) * 72 + lane] = (bf16_t)f2bf(k0 * __expf(blast[2 * q2] - bcum[2 * q2]));
                KsT[(8 * w + 2 * q2 + 1) * 72 + lane] = (bf16_t)f2bf(k1 * __expf(blast[2 * q2 + 1] - bcum[2 * q2 + 1]));
            }
            *(LAS u32x4*)(Qd + lane * 72 + 8 * w) = (u32x4){qo[0], qo[1], qo[2], qo[3]};
            *(LAS u32x4*)(Kd + lane * 72 + 8 * w) = (u32x4){ko[0], ko[1], ko[2], ko[3]};
            if (lane == 63) {
#pragma unroll
                for (int q = 0; q < 8; ++q) DEC[(n & 1) * 64 + 8 * w + q] = __expf(bcum[q]);
            }
            const unsigned vw[8] = {st.v0.x, st.v0.y, st.v0.z, st.v0.w, st.v1.x, st.v1.y, st.v1.z, st.v1.w};
#pragma unroll
            for (int q = 0; q < 8; ++q) { VT[(16 * w + 2 * q) * 72 + lane] = (bf16_t)(vw[q] & 0xffffu); VT[(16 * w + 2 * q + 1) * 72 + lane] = (bf16_t)(vw[q] >> 16); }
        }
        if (n < 31) gla_fetch(st, PROJ, tok0 + 64, h, lane, w);
        const int ec = tid >> 3, eg = tid & 7;
        const u32x4 r0 = *(const u32x4*)(PROJ + (size_t)(tok0 + ec) * NPROJ + CGR + h * 128 + 16 * eg), r1 = *(const u32x4*)(PROJ + (size_t)(tok0 + ec) * NPROJ + CGR + h * 128 + 16 * eg + 8);
        BAR_LDS();
        {
            const int m = w >> 1;
            bf16x8 a[2];
#pragma unroll
            for (int ks = 0; ks < 2; ++ks) a[ks] = *(const LAS bf16x8*)(Qd + (16 * m + fr) * 72 + 32 * ks + 8 * fq);
#pragma unroll
            for (int x = 0; x < 2; ++x) { const int nf = 2 * (w & 1) + x;
                f32x4 s = (f32x4){0.f, 0.f, 0.f, 0.f};
                if (nf <= m) {
#pragma unroll
                    for (int ks = 0; ks < 2; ++ks) { const bf16x8 bk = *(const LAS bf16x8*)(Kd + (16 * nf + fr) * 72 + 32 * ks + 8 * fq); s = __builtin_amdgcn_mfma_f32_16x16x32_bf16(a[ks], bk, s, 0, 0, 0); }
                }
#pragma unroll
                for (int j = 0; j < 4; ++j) { const int cc = 16 * m + 4 * fq + j, ss = 16 * nf + fr; At[cc * 72 + ss] = (bf16_t)f2bf(ss <= cc ? s[j] : 0.f); } }
        }
        f32x4 U[4];
        {
            bf16x8 a[2];
#pragma unroll
            for (int ks = 0; ks < 2; ++ks) a[ks] = *(const LAS bf16x8*)(KsT + (16 * md + fr) * 72 + 32 * ks + 8 * fq);
#pragma unroll
            for (int x = 0; x < 4; ++x) { f32x4 s = (f32x4){0.f, 0.f, 0.f, 0.f};
#pragma unroll
                for (int ks = 0; ks < 2; ++ks) { const bf16x8 bv = *(const LAS bf16x8*)(VT + (16 * (nfe0 + x) + fr) * 72 + 32 * ks + 8 * fq); s = __builtin_amdgcn_mfma_f32_16x16x32_bf16(a[ks], bv, s, 0, 0, 0); }
                U[x] = s; }
        }
        BAR_LDS();
        {
            bf16x8 aa[2], aq2[2];
#pragma unroll
            for (int ks = 0; ks < 2; ++ks) { aa[ks] = *(const LAS bf16x8*)(At + (16 * md + fr) * 72 + 32 * ks + 8 * fq); aq2[ks] = *(const LAS bf16x8*)(Qd + (16 * md + fr) * 72 + 32 * ks + 8 * fq); }
#pragma unroll
            for (int x = 0; x < 4; ++x) { f32x4 s = (f32x4){0.f, 0.f, 0.f, 0.f};
#pragma unroll
                for (int ks = 0; ks < 2; ++ks) { const bf16x8 bv = *(const LAS bf16x8*)(VT + (16 * (nfe0 + x) + fr) * 72 + 32 * ks + 8 * fq); s = __builtin_amdgcn_mfma_f32_16x16x32_bf16(aa[ks], bv, s, 0, 0, 0); }
#pragma unroll
                for (int ks = 0; ks < 2; ++ks) { const bf16x8 bs = *(const LAS bf16x8*)(ST + (16 * (nfe0 + x) + fr) * 72 + 32 * ks + 8 * fq); s = __builtin_amdgcn_mfma_f32_16x16x32_bf16(aq2[ks], bs, s, 0, 0, 0); }
#pragma unroll
                for (int j = 0; j < 4; ++j) OT[(16 * md + 4 * fq + j) * 132 + 16 * (nfe0 + x) + fr] = s[j]; }
        }
        BAR_LDS();
        {
            const LAS f32x4* dp = (const LAS f32x4*)(DEC + (n & 1) * 64 + 16 * md + 4 * fq); const f32x4 dc = dp[0];
#pragma unroll
            for (int x = 0; x < 4; ++x) { Sreg[x] = dc * Sreg[x] + U[x];
                u32x2 o; o.x = pg8::cvt_pk_bf16(Sreg[x][0], Sreg[x][1]); o.y = pg8::cvt_pk_bf16(Sreg[x][2], Sreg[x][3]);
                *(LAS u32x2*)(ST + (16 * (nfe0 + x) + fr) * 72 + 16 * md + 4 * fq) = o; }
        }
        {
            const LAS f32x4* op = (const LAS f32x4*)(OT + ec * 132 + 16 * eg);
            f32x4 o[4]; float ss = 0.f;
#pragma unroll
            for (int q = 0; q < 4; ++q) { o[q] = op[q]; ss += (o[q].x * o[q].x + o[q].y * o[q].y) + (o[q].z * o[q].z + o[q].w * o[q].w); }
            ss += dppf<0xB1>(ss); ss += dppf<0x4E>(ss); ss += dppf<0x141>(ss);
            const float rstd = 1.f / sqrtf(ss * (1.f / 128.f) + EPS);
            const unsigned rw[8] = {r0.x, r0.y, r0.z, r0.w, r1.x, r1.y, r1.z, r1.w};
            const float* gn = p.in[14] + 16 * eg;
            unsigned ow[8];
#pragma unroll
            for (int q = 0; q < 8; ++q) { const float ra = bflo(rw[q]), rb = bfhi(rw[q]);
                const float ya = o[q >> 1][(2 * q) & 3] * rstd * gn[2 * q] * (ra * sigmoidf_(ra)), yb = o[q >> 1][(2 * q + 1) & 3] * rstd * gn[2 * q + 1] * (rb * sigmoidf_(rb));
                ow[q] = pg8::cvt_pk_bf16(ya, yb); }
            u32x4* dst = (u32x4*)((bf16_t*)(ws + WS_ATT) + (size_t)(tok0 + ec) * 1024 + 512 + h * 128 + 16 * eg);
            dst[0] = (u32x4){ow[0], ow[1], ow[2], ow[3]}; dst[1] = (u32x4){ow[4], ow[5], ow[6], ow[7]};
        }
    }
}

__device__ __forceinline__ void p6_chunk(const Params& p, LAS unsigned char* lds, int chunk) {
    const int tid = opaque_tid(), lane = tid & 63, wave = tid >> 6, fr = lane & 15, fq = lane >> 4;
    unsigned char* ws = p.ws;
    LAS int* lcnt = (LAS int*)lds;
    LAS float* LG = (LAS float*)(lds + 256) + wave * (16 * 33 + 16);
    LAS float* RS = LG + 16 * 33;
    if (tid < NEXP) lcnt[tid] = 0;
    __syncthreads();
    const float* WRT = (const float*)(ws + WS_WRT);
    const float* X1 = (const float*)(ws + WS_X1);
    const int t0 = chunk * 128 + wave * 16;
    {
        const float* ap = X1 + (size_t)(t0 + fr) * DM + 4 * fq;
        const float* bp0 = WRT + (size_t)fr * DM + 4 * fq; const float* bp1 = bp0 + 16 * DM;
        f32x4 acc0 = (f32x4){0.f, 0.f, 0.f, 0.f}, acc1 = (f32x4){0.f, 0.f, 0.f, 0.f};
        float ssq = 0.f;
#pragma unroll 4
        for (int ks = 0; ks < 64; ++ks) {
            const f32x4 a4 = *(const f32x4*)(ap + 16 * ks), b0 = *(const f32x4*)(bp0 + 16 * ks), b1 = *(const f32x4*)(bp1 + 16 * ks);
            ssq += (a4.x * a4.x + a4.y * a4.y) + (a4.z * a4.z + a4.w * a4.w);
#pragma unroll
            for (int i = 0; i < 4; ++i) { acc0 = __builtin_amdgcn_mfma_f32_16x16x4f32(a4[i], b0[i], acc0, 0, 0, 0); acc1 = __builtin_amdgcn_mfma_f32_16x16x4f32(a4[i], b1[i], acc1, 0, 0, 0); }
        }
        ssq += __shfl_xor(ssq, 16); ssq += __shfl_xor(ssq, 32);
        const float rstd = 1.f / sqrtf(ssq * (1.f / DM) + EPS);
        if (fq == 0) RS[fr] = rstd;
#pragma unroll
        for (int j = 0; j < 4; ++j) { LG[(4 * fq + j) * 33 + fr] = acc0[j]; LG[(4 * fq + j) * 33 + 16 + fr] = acc1[j]; }
    }
    LDS_WAIT();
    if (lane < 16) {
        const int t = t0 + lane; const float rstd = RS[lane];
        unsigned taken = 0u; float tv[4]; int te[4];
#pragma unroll
        for (int r = 0; r < 4; ++r) { float best = -3e38f; int be = 0;
#pragma unroll 8
            for (int e = 0; e < 32; ++e) { const float v = LG[lane * 33 + e] * rstd + p.in[18][e]; const bool can = !((taken >> e) & 1u); if (can && v > best) { best = v; be = e; } }
            taken |= 1u << be; tv[r] = best; te[r] = be; }
        const float e0 = 1.f, e1 = __expf(tv[1] - tv[0]), e2 = __expf(tv[2] - tv[0]), e3 = __expf(tv[3] - tv[0]);
        const float inv = 1.f / (e0 + e1 + e2 + e3);
        *(int4*)((int*)(ws + WS_TOPI) + (size_t)t * 4) = make_int4(te[0], te[1], te[2], te[3]);
        *(f32x4*)((float*)(ws + WS_TOPG) + (size_t)t * 4) = (f32x4){e0 * inv, e1 * inv, e2 * inv, e3 * inv};
        atomicAdd((int*)&lcnt[te[0]], 1); atomicAdd((int*)&lcnt[te[1]], 1); atomicAdd((int*)&lcnt[te[2]], 1); atomicAdd((int*)&lcnt[te[3]], 1);
    }
    for (int ti = 0; ti < 16; ++ti) {
        const int t = t0 + ti; const float rstd = RS[ti];
        const f32x4* xr = (const f32x4*)(X1 + (size_t)t * DM) + lane; const f32x4* gr = (const f32x4*)p.in[16] + lane;
        unsigned long long* o8 = (unsigned long long*)((bf16_t*)(ws + WS_H) + (size_t)t * DM) + lane;
#pragma unroll
        for (int j = 0; j < 4; ++j) { const f32x4 gg = gr[64 * j]; const f32x4 o = xr[64 * j] * rstd * gg;
            o8[64 * j] = (unsigned long long)pk2(o.x, o.y) | ((unsigned long long)pk2(o.z, o.w) << 32); }
    }
    __syncthreads();
    if (tid < NEXP) atomicAdd((int*)(ws + WS_CTL) + CW_CNT + tid, lcnt[tid]);
    __syncthreads();
}

__device__ __forceinline__ int build_tile_table(const Params& p, LAS int* tstart, LAS int* tile_e) {
    const int tid = opaque_tid();
    const int* cnt = (const int*)(p.ws + WS_CTL) + CW_CNT;
    if (tid == 0) { int acc = 0; for (int e = 0; e < NEXP; ++e) { tstart[e] = acc; acc += (__hip_atomic_load(cnt + e, __ATOMIC_RELAXED, __HIP_MEMORY_SCOPE_AGENT) + 255) >> 8; } tstart[NEXP] = acc; }
    __syncthreads();
    const int total = tstart[NEXP];
    for (int i = tid; i < total; i += NTHREADS) { int e = 0;
        for (int q = 1; q < NEXP; ++q) if (tstart[q] <= i) e = q;
        tile_e[i] = e; }
    __syncthreads();
    return total;
}

__device__ __forceinline__ void p7_chunk(const Params& p, LAS unsigned char* lds, int chunk, const LAS int* tstart) {
    const int tid = opaque_tid(), lane = tid & 63, wave = tid >> 6;
    unsigned char* ws = p.ws;
    LAS int* lc = (LAS int*)lds; LAS int* lbase = lc + 32; LAS int* ldst = lbase + 32;
    if (tid < NEXP) lc[tid] = 0;
    __syncthreads();
    const int t = chunk * 128 + (tid >> 2), k = tid & 3;
    const int e = ((const int*)(ws + WS_TOPI))[(size_t)t * 4 + k];
    const int rank = atomicAdd((int*)&lc[e], 1);
    __syncthreads();
    if (tid < NEXP) lbase[tid] = atomicAdd((int*)(ws + WS_CTL) + CW_FILL + tid, lc[tid]);
    __syncthreads();
    const int dest = tstart[e] * 256 + lbase[e] + rank;
    ((int*)(ws + WS_DEST))[(size_t)t * 4 + k] = dest;
    ldst[tid] = dest;
    __syncthreads();
    for (int ti = 0; ti < 16; ++ti) {
        const int tl = wave * 16 + ti, tt = chunk * 128 + tl;
        const u32x4* src = (const u32x4*)((const bf16_t*)(ws + WS_H) + (size_t)tt * DM) + lane;
        const u32x4 a = src[0], bq = src[64];
#pragma unroll
        for (int kk = 0; kk < 4; ++kk) { u32x4* dst = (u32x4*)((bf16_t*)(ws + WS_XS) + (size_t)ldst[tl * 4 + kk] * DM) + lane; dst[0] = a; dst[64] = bq; }
    }
    __syncthreads();
}

__device__ __forceinline__ void p10_token(const Params& p, int t, int lane) {
    unsigned char* ws = p.ws;
    const int4 d4 = *(const int4*)((const int*)(ws + WS_DEST) + (size_t)t * 4);
    const f32x4 g4 = *(const f32x4*)((const float*)(ws + WS_TOPG) + (size_t)t * 4);
    const int dd[4] = {d4.x, d4.y, d4.z, d4.w};
    const f32x4* xr = (const f32x4*)((const float*)(ws + WS_X1) + (size_t)t * DM);
    f32x4* orow = (f32x4*)(p.out + (size_t)t * DM);
#pragma unroll
    for (int half = 0; half < 2; ++half) {
        f32x4 a0 = xr[half * 128 + lane * 2], a1 = xr[half * 128 + lane * 2 + 1];
#pragma unroll
        for (int k = 0; k < 4; ++k) {
            const u32x4 y = *((const u32x4*)((const bf16_t*)(ws + WS_Y) + (size_t)dd[k] * DM) + half * 64 + lane);
            const float gk = g4[k];
            a0.x += gk * __uint_as_float(y.x << 16); a0.y += gk * __uint_as_float(y.x & 0xffff0000u);
            a0.z += gk * __uint_as_float(y.y << 16); a0.w += gk * __uint_as_float(y.y & 0xffff0000u);
            a1.x += gk * __uint_as_float(y.z << 16); a1.y += gk * __uint_as_float(y.z & 0xffff0000u);
            a1.z += gk * __uint_as_float(y.w << 16); a1.w += gk * __uint_as_float(y.w & 0xffff0000u);
        }
        orow[half * 128 + lane * 2] = a0; orow[half * 128 + lane * 2 + 1] = a1;
    }
}

#define XB_TMO      128
#define XB_XCNT(j)  (256  + 64 * (j))
#define XB_XSUB(j)  (1280 + 64 * (j))
#define XB_XGEN(j)  (2304 + 64 * (j))
#define XB_TOP      3328
#define XB_TOPGEN   3392
#define XCD_BAR_WORDS 3456
#define XB_SPIN_CAP (1u << 22)
__device__ __forceinline__ unsigned xb_ld(unsigned* p)              { return __hip_atomic_load(p, __ATOMIC_RELAXED, __HIP_MEMORY_SCOPE_AGENT); }
__device__ __forceinline__ unsigned xb_add(unsigned* p, unsigned v) { return __hip_atomic_fetch_add(p, v, __ATOMIC_RELAXED, __HIP_MEMORY_SCOPE_AGENT); }
__device__ __forceinline__ unsigned xb_xcc_id() { return (unsigned)__builtin_amdgcn_s_getreg((3 << 11) | 20) & 0xFu; }
#define XB_SPIN(cond, bar) do { unsigned _sp = 0; while (cond) { __builtin_amdgcn_s_sleep(1); \
    if ((++_sp & 255u) == 0u) { if (xb_ld(&(bar)[XB_TMO])) break; if (_sp > XB_SPIN_CAP) { atomicAdd(&(bar)[XB_TMO], 1u); break; } } } } while (0)
struct XcdBarrier { unsigned* bar; unsigned x; volatile LAS unsigned* st; };
__device__ __forceinline__ XcdBarrier xcd_barrier_post(unsigned* bar, volatile LAS unsigned* st) {
    XcdBarrier b; b.bar = bar; b.x = xb_xcc_id(); b.st = st;
    if (threadIdx.x == 0) (void)xb_add(&bar[XB_XCNT(b.x)], 1u);
    return b;
}
__device__ __forceinline__ void xcd_barrier_complete(unsigned* bar, unsigned x, unsigned& nloc, unsigned& nx) {
    const unsigned G = gridDim.x * gridDim.y * gridDim.z;
    unsigned sum, cnt, mine, sp = 0u;
    for (;;) {
        sum = 0u; cnt = 0u; mine = 0u;
#pragma unroll
        for (unsigned j = 0; j < 16; ++j) { const unsigned c = xb_ld(&bar[XB_XCNT(j)]); sum += c; cnt += (c > 0u) ? 1u : 0u; mine = (j == x) ? c : mine; }
        if (sum == G) break;
        __builtin_amdgcn_s_sleep(1);
        if ((++sp & 255u) == 0u) { if (xb_ld(&bar[XB_TMO])) break; if (sp > XB_SPIN_CAP) { atomicAdd(&bar[XB_TMO], 1u); break; } }
    }
    nloc = mine > 0u ? mine : 1u; nx = cnt > 0u ? cnt : 1u;
}
__device__ __forceinline__ void xcd_barrier(const XcdBarrier& b) {
    asm volatile("s_waitcnt vmcnt(0)" ::: "memory");
    __syncthreads();
    if (threadIdx.x == 0) {
        unsigned* bar = b.bar;
        __builtin_amdgcn_s_waitcnt(0);
        unsigned nloc = b.st[0], nx = b.st[1];
        if (nloc == 0u) { xcd_barrier_complete(bar, b.x, nloc, nx); b.st[0] = nloc; b.st[1] = nx; }
        const unsigned old = xb_add(&bar[XB_XSUB(b.x)], 1u);
        const unsigned gen = old / nloc;
        if (old + 1u == (gen + 1u) * nloc) {
            __builtin_amdgcn_fence(__ATOMIC_RELEASE, "agent");
            asm volatile("s_waitcnt vmcnt(0)" ::: "memory");
            const unsigned og = xb_add(&bar[XB_TOP], 1u);
            const unsigned tg = og / nx;
            if (og + 1u == (tg + 1u) * nx) xb_add(&bar[XB_TOPGEN], 1u);
            else XB_SPIN(xb_ld(&bar[XB_TOPGEN]) == tg, bar);
            __builtin_amdgcn_fence(__ATOMIC_ACQUIRE, "agent");
            xb_add(&bar[XB_XGEN(b.x)], 1u);
            asm volatile("s_waitcnt vmcnt(0)" ::: "memory");
        } else {
            XB_SPIN(xb_ld(&bar[XB_XGEN(b.x)]) == gen, bar);
            __builtin_amdgcn_fence(__ATOMIC_ACQUIRE, "agent");
            asm volatile("s_waitcnt vmcnt(0)" ::: "memory");
        }
    }
    __syncthreads();
}

template <int ph> __device__ __forceinline__ void mk_phase(const Params& p, LAS unsigned char* lds, int blk, int G) {
    unsigned char* ws = p.ws;
    const int tid = opaque_tid();
    if constexpr (ph == 0) { phase0(p, lds, blk, G); }
    else if constexpr (ph == 1) {
        pg8::Gemm g{(const bf16_t*)(ws + WS_H), (const bf16_t*)(ws + WS_WIN), DM};
        pg8::StaticOrder S{MTOK / 256, NPROJ / 256, G, blk};
        pg8::EpiBf16 E{(bf16_t*)(ws + WS_PROJ), NPROJ};
        pg8::gemm_phase(lds, g, S, E);
    }
    else if constexpr (ph == 2) {
        for (int u = blk; u < 128 + 512; u += G) {
            if (u < 128) p2b_unit(p, lds, u);
            else p2a_unit(p, lds, u - 128);
        }
    }
    else if constexpr (ph == 3) {
        LAS int* qslot = (LAS int*)(lds + LDS_BYTES - 64);
        for (;;) {
            __syncthreads();
            if (tid == 0) *qslot = (int)__hip_atomic_fetch_add((unsigned*)(ws + WS_CTL) + CW_Q3, 1u, __ATOMIC_RELAXED, __HIP_MEMORY_SCOPE_AGENT);
            __syncthreads();
            const int it = *qslot;
            if (it >= 64 + 1024) break;
            if (it < 64) gla_unit(p, lds, it >> 2, it & 3);
            else { const int u = it - 64, c = 31 - (u >> 5), bkh = u & 31; nsa_unit(p, lds, bkh >> 1, bkh & 1, c); }
        }
    }
    else if constexpr (ph == 4) { }
    else if constexpr (ph == 5) {
        pg8::Gemm g{(const bf16_t*)(ws + WS_ATT), (const bf16_t*)(ws + WS_WOUT), DM};
        pg8::StaticOrder S{MTOK / 256, DM / 256, G, blk};
        pg8::EpiResF32 E{p.in[0], (float*)(ws + WS_X1), DM};
        pg8::gemm_phase(lds, g, S, E);
    }
    else if constexpr (ph == 6) { for (int ch = blk; ch < MTOK / 128; ch += G) p6_chunk(p, lds, ch); }
    else if constexpr (ph == 7) {
        LAS int* tstart = (LAS int*)(lds + 8192); LAS int* tile_e = tstart + 64;
        build_tile_table(p, tstart, tile_e);
        for (int ch = blk; ch < MTOK / 128; ch += G) p7_chunk(p, lds, ch, tstart);
    }
    else if constexpr (ph == 8) {
        LAS int* tstart = (LAS int*)(lds + pg8::STAGE_BYTES); LAS int* tile_e = tstart + 64;
        const int total = build_tile_table(p, tstart, tile_e);
        pg8::Gemm g{(const bf16_t*)(ws + WS_XS), (const bf16_t*)(ws + WS_WGU), DM};
        pg8::MoeOrder S{total, 8, G, blk, tile_e};
        pg8::EpiSwiglu E{(bf16_t*)(ws + WS_ACT), p.in[20], 8};
        pg8::gemm_phase(lds, g, S, E);
    }
    else if constexpr (ph == 9) {
        LAS int* tstart = (LAS int*)(lds + pg8::STAGE_BYTES); LAS int* tile_e = tstart + 64;
        const int total = build_tile_table(p, tstart, tile_e);
        pg8::Gemm g{(const bf16_t*)(ws + WS_ACT), (const bf16_t*)(ws + WS_WD), DFF};
        pg8::MoeOrder S{total, 4, G, blk, tile_e};
        pg8::EpiDown E{(bf16_t*)(ws + WS_Y), p.in[22], 4};
        pg8::gemm_phase(lds, g, S, E);
    }
    else if constexpr (ph == 10) { for (int t = blk * 8 + (tid >> 6); t < MTOK; t += G * 8) p10_token(p, t, tid & 63); }
}

constexpr int NPHASES = 11;

template <int PH> __global__ void __launch_bounds__(NTHREADS, 2) mk_one(Params p) {
    extern __shared__ __attribute__((aligned(16))) unsigned char lds_raw[];
    mk_phase<PH>(p, (LAS unsigned char*)lds_raw, blockIdx.x, gridDim.x);
}
#if MK_ONE_LAUNCH
#define MK_RUN(PH) mk_phase<PH>(p, lds, blk, G)
__global__ void __launch_bounds__(NTHREADS, 2) mk_fwd(Params p) {
    extern __shared__ __attribute__((aligned(16))) unsigned char lds_raw[];
    LAS unsigned char* lds = (LAS unsigned char*)lds_raw;
    const int blk = blockIdx.x, G = gridDim.x;
    volatile LAS unsigned* bst = (volatile LAS unsigned*)(lds + LDS_BYTES - 16);
    if (threadIdx.x < 4) bst[threadIdx.x] = 0u;
    __syncthreads();
    const XcdBarrier gbar = xcd_barrier_post((unsigned*)(p.ws + WS_CTL) + CW_BAR, bst);
#define GSYNC() xcd_barrier(gbar)
#ifndef MK_REP_PHASE
#define MK_REP_PHASE -1
#endif
#ifndef MK_REP_N
#define MK_REP_N 0
#endif
#define MK_STEP(PH) do { MK_RUN(PH); if (MK_REP_PHASE == (PH)) { for (int r_ = 0; r_ < MK_REP_N; ++r_) { GSYNC(); MK_RUN(PH); } } if (MK_REP_PHASE == 100 + (PH)) { for (int r_ = 0; r_ < MK_REP_N; ++r_) GSYNC(); } } while (0)
    MK_STEP(0); GSYNC(); MK_STEP(1); GSYNC(); MK_STEP(2); GSYNC(); MK_STEP(3); GSYNC(); MK_STEP(5); GSYNC();
    MK_STEP(6); GSYNC(); MK_STEP(7); GSYNC(); MK_STEP(8); GSYNC(); MK_STEP(9); GSYNC(); MK_STEP(10);
}
#endif

extern "C" void kernel_launch(void* const* d_in, const int* in_sizes, int n_in, void* d_out, int out_size, void* d_ws, size_t ws_size, hipStream_t stream) {
    static int grid = 0;
    if (grid == 0) {
        int dev = 0, cus = 0, per_cu = 0;
        (void)hipGetDevice(&dev);
        (void)hipDeviceGetAttribute(&cus, hipDeviceAttributeMultiprocessorCount, dev);
#if MK_ONE_LAUNCH
        (void)hipFuncSetAttribute((const void*)mk_fwd, hipFuncAttributeMaxDynamicSharedMemorySize, LDS_BYTES);
        (void)hipOccupancyMaxActiveBlocksPerMultiprocessor(&per_cu, (const void*)mk_fwd, NTHREADS, LDS_BYTES);
#else
#define MK_ATTR(PH) (void)hipFuncSetAttribute((const void*)mk_one<PH>, hipFuncAttributeMaxDynamicSharedMemorySize, LDS_BYTES)
        MK_ATTR(0); MK_ATTR(1); MK_ATTR(2); MK_ATTR(3); MK_ATTR(4); MK_ATTR(5); MK_ATTR(6); MK_ATTR(7); MK_ATTR(8); MK_ATTR(9); MK_ATTR(10);
        per_cu = 1;
#endif
        if (per_cu < 1) { fprintf(stderr, "kernel_launch: occupancy query reports %d blocks/CU\n", per_cu); per_cu = 1; }
        grid = cus;
        if (ws_size < WS_END) { fprintf(stderr, "kernel_launch: workspace too small (%zu < %zu)\n", ws_size, (size_t)WS_END); grid = -1; }
        (void)hipGetLastError();
    }
    if (grid < 0) return;
    (void)hipMemsetAsync((char*)d_ws + WS_CTL, 0, CTL_BYTES, stream);
    Params p{};
    for (int i = 0; i < 23; ++i) p.in[i] = (const float*)d_in[i];
    p.out = (float*)d_out; p.ws = (unsigned char*)d_ws;
#if MK_ONE_LAUNCH
    hipLaunchKernelGGL(mk_fwd, dim3(grid), dim3(NTHREADS), LDS_BYTES, stream, p);
#else
#ifndef MK_DUP_PHASE
#define MK_DUP_PHASE -1
#endif
#define MK_LAUNCH1(PH) do { if ((PH) == 3) (void)hipMemsetAsync((char*)d_ws + WS_CTL + 4 * CW_Q3, 0, 4, stream); if ((PH) == 6) (void)hipMemsetAsync((char*)d_ws + WS_CTL + 4 * CW_CNT, 0, 128, stream); if ((PH) == 7) (void)hipMemsetAsync((char*)d_ws + WS_CTL + 4 * CW_FILL, 0, 128, stream); hipLaunchKernelGGL(mk_one<PH>, dim3(grid), dim3(NTHREADS), LDS_BYTES, stream, p); } while (0)
#define MK_LAUNCH(PH) do { MK_LAUNCH1(PH); if (MK_DUP_PHASE == (PH)) MK_LAUNCH1(PH); } while (0)
    MK_LAUNCH(0); MK_LAUNCH(1); MK_LAUNCH(2); MK_LAUNCH(3); MK_LAUNCH(5); MK_LAUNCH(6); MK_LAUNCH(7); MK_LAUNCH(8); MK_LAUNCH(9); MK_LAUNCH(10);
#endif
}
```

```cpp
#include <hip/hip_runtime.h>
#include <hip/hip_cooperative_groups.h>
#include <cstdint>
#include <cstdio>
namespace cg = cooperative_groups;

#ifndef MK_ONE_LAUNCH
#define MK_ONE_LAUNCH 1
#endif

#define LAS __attribute__((address_space(3)))
typedef unsigned short bf16_t;
typedef short bf16x8 __attribute__((ext_vector_type(8)));
typedef float f32x4 __attribute__((ext_vector_type(4)));
typedef float f32x2 __attribute__((ext_vector_type(2)));
typedef unsigned u32x4 __attribute__((ext_vector_type(4)));
typedef unsigned u32x2 __attribute__((ext_vector_type(2)));
typedef int i32x8 __attribute__((ext_vector_type(8)));
typedef int i32x4 __attribute__((ext_vector_type(4)));

constexpr int NB = 16, SEQ = 2048, DM = 1024, MTOK = NB * SEQ;
constexpr int NPROJ = 3072;
constexpr int CQ = 0, CKC = 512, CVC = 640, CKS = 768, CVS = 896, CKW = 1024, CVW = 1152, CGQ = 1280, CGK = 1536, CGV = 1792, CGR = 2304, CGATE = 2816, CGLR = 2840;
constexpr int NEXP = 32, DFF = 1024;
constexpr int MAXTILES = 544, XROWS = MAXTILES * 256;
constexpr float EPS = 1e-6f;
constexpr int NTHREADS = 512;
constexpr int LDS_BYTES = 160 * 1024;

constexpr size_t MiB = 1u << 20;
constexpr size_t WS_CTL = 0;
constexpr size_t WS_WIN = 2 * MiB;
constexpr size_t WS_WOUT = 8 * MiB;
constexpr size_t WS_CW1K = 10 * MiB, WS_CW1V = 11 * MiB;
constexpr size_t WS_CW2K = 12 * MiB, WS_CW2V = 12 * MiB + 512 * 1024;
constexpr size_t WS_CBIAS = 13 * MiB;
constexpr size_t WS_WRT = 13 * MiB + 512 * 1024;
constexpr size_t WS_WGU = 16 * MiB;
constexpr size_t WS_WD = 144 * MiB;
constexpr size_t WS_H = 208 * MiB;
constexpr size_t WS_PROJ = 272 * MiB;
constexpr size_t WS_QN = 464 * MiB, WS_QR = 496 * MiB;
constexpr size_t WS_KS = 528 * MiB, WS_KW = 536 * MiB;
constexpr size_t WS_VST = 544 * MiB, WS_VWT = 552 * MiB;
constexpr size_t WS_KC = 560 * MiB, WS_VCT = 561 * MiB;
constexpr size_t WS_U = 562 * MiB;
constexpr size_t WS_OI = 626 * MiB;
constexpr size_t WS_QD = 690 * MiB;
constexpr size_t WS_DEC = 722 * MiB;
constexpr size_t WS_SP = 723 * MiB;
constexpr size_t WS_ATT = 787 * MiB;
constexpr size_t WS_TOPI = 851 * MiB, WS_TOPG = 852 * MiB, WS_DEST = 853 * MiB;
constexpr size_t WS_XS = 272 * MiB;
constexpr size_t WS_ACT = 544 * MiB;
constexpr size_t WS_Y = 272 * MiB;
constexpr size_t WS_X1 = 854 * MiB;
constexpr size_t WS_END = 982 * MiB;
constexpr int CW_CNT = 0, CW_FILL = 64, CW_Q3 = 128, CW_Q2 = 129, CW_BAR = 1024;
constexpr int CTL_BYTES = 32768;

struct Params {
    const float* in[23];
    float* out;
    unsigned char* ws;
};

__device__ __forceinline__ float bf2f(bf16_t v) { return __uint_as_float(((unsigned)v) << 16); }
__device__ __forceinline__ unsigned f2bf(float f) { unsigned u = __float_as_uint(f); return (u + 0x7fffu + ((u >> 16) & 1u)) >> 16; }
__device__ __forceinline__ unsigned pk2(float lo, float hi) { return f2bf(lo) | (f2bf(hi) << 16); }
__device__ __forceinline__ unsigned pk4_fp8(float a, float b, float c, float d) { int r = __builtin_amdgcn_cvt_pk_fp8_f32(a, b, 0, false); r = __builtin_amdgcn_cvt_pk_fp8_f32(c, d, r, true); return (unsigned)r; }
__device__ __forceinline__ float wave_sum(float v) {
#pragma unroll
    for (int o = 1; o < 64; o <<= 1) v += __shfl_xor(v, o);
    return v;
}
#define LDS_WAIT() asm volatile("s_waitcnt lgkmcnt(0)" ::: "memory")
#define BAR_LDS() do { asm volatile("s_waitcnt lgkmcnt(0)" ::: "memory"); __builtin_amdgcn_s_barrier(); asm volatile("" ::: "memory"); } while (0)
__device__ __forceinline__ int opaque_tid() { int t = threadIdx.x; asm volatile("" : "+v"(t)); return t; }
__device__ __forceinline__ float sigmoidf_(float x) { return 1.f / (1.f + __expf(-x)); }
template <int CTRL> __device__ __forceinline__ float dppf(float v) { return __int_as_float(__builtin_amdgcn_update_dpp(0, __float_as_int(v), CTRL, 0xf, 0xf, true)); }
__device__ __forceinline__ float red16_max(float v) { v = fmaxf(v, dppf<0xB1>(v)); v = fmaxf(v, dppf<0x4E>(v)); v = fmaxf(v, dppf<0x141>(v)); v = fmaxf(v, dppf<0x140>(v)); return v; }
__device__ __forceinline__ float red16_sum(float v) { v += dppf<0xB1>(v); v += dppf<0x4E>(v); v += dppf<0x141>(v); v += dppf<0x140>(v); return v; }


namespace pg8 {
constexpr int BM = 256, BK = 64, HALF = 128, HTB = HALF * BK * 2, STAGE_BYTES = 8 * HTB, NXCD = 8, WGM = 8;
__device__ __forceinline__ int lds_byte(int r, int c) { const int st = (r >> 4) * 2 + (c >> 5), rr = r & 15, cc = c & 31, ob = rr * 64 + cc * 2; return st * 1024 + (ob ^ (((ob >> 9) & 1) << 5)); }
__device__ __forceinline__ void stage_rc(int b, int& R, int& C) { const int st = b / 1024, sb = b % 1024, swz = sb ^ (((sb >> 9) & 1) << 5); R = (st >> 1) * 16 + swz / 64; C = (st & 1) * 32 + (swz % 64) / 2; }
__device__ __forceinline__ int perm32(int rho) { const int n = rho >> 4, i = rho & 15; return 8 * (i >> 2) + 4 * n + (i & 3); }

struct Unit { int pm, pn, pb; };
struct Gemm { const void* A; const void* Bt; int Kb; };

__device__ __forceinline__ bool order_next(long L, int nM, int nN, int& pm, int& pn) {
    const int nwg = nM * nN; if (L >= nwg) return false;
    int wgid = (int)L; { const int q = nwg / NXCD, r = nwg % NXCD, xcd = wgid % NXCD, off = wgid / NXCD; wgid = (xcd < r ? xcd * (q + 1) : r * (q + 1) + (xcd - r) * q) + off; }
    const int nig = WGM * nN, gid = wgid / nig, fm = gid * WGM, gsz = (nM - fm) < WGM ? (nM - fm) : WGM;
    pm = fm + ((wgid % nig) % gsz); pn = (wgid % nig) / gsz; return true;
}
struct StaticOrder {
    int nM, nN, G, c;
    __device__ __forceinline__ bool next(int i, Unit& u) const { if (!order_next((long)i * G + c, nM, nN, u.pm, u.pn)) return false; u.pb = u.pn; return true; }
};
struct MoeOrder {
    int nM, nN, G, c; const LAS int* tile_e;
    __device__ __forceinline__ bool next(int i, Unit& u) const { if (!order_next((long)i * G + c, nM, nN, u.pm, u.pn)) return false; u.pb = __builtin_amdgcn_readfirstlane(tile_e[u.pm] * nN + u.pn); return true; }
};

__device__ __forceinline__ void mfma8_acc(f32x4& c, const i32x8& a, const i32x8& b, int scl) {
    asm volatile("v_mfma_scale_f32_16x16x128_f8f6f4 %0, %1, %2, %0, %3, %3 op_sel_hi:[0,0,0]" : "+v"(c) : "v"(a), "v"(b), "v"(scl)); }
__device__ __forceinline__ i32x8 frag8(bf16x8 lo, bf16x8 hi) { const i32x4 a = __builtin_bit_cast(i32x4, lo), b = __builtin_bit_cast(i32x4, hi); return (i32x8){a.x, a.y, a.z, a.w, b.x, b.y, b.z, b.w}; }
__device__ __forceinline__ unsigned cvt_pk_bf16(float lo, float hi) { unsigned r; asm volatile("v_cvt_pk_bf16_f32 %0, %1, %2" : "=v"(r) : "v"(lo), "v"(hi)); return r; }

struct EpiBf16 {
    static constexpr bool PERM = true;
    bf16_t* O; int ldc;
    __device__ __forceinline__ void operator()(const f32x4 (&acc)[2][2][4][2], const Unit& u, int wr, int wc, int fr, int fq) const {
        const int row0 = u.pm * BM + wr * 64 + fr, col0 = u.pn * BM + wc * 32 + 8 * fq;
#pragma unroll
        for (int ai = 0; ai < 2; ++ai)
#pragma unroll
            for (int m = 0; m < 4; ++m) { bf16_t* rowp = O + (size_t)(row0 + ai * HALF + m * 16) * ldc + col0;
#pragma unroll
                for (int bj = 0; bj < 2; ++bj) { const f32x4 v0 = acc[ai][bj][m][0], v1 = acc[ai][bj][m][1];
                    u32x4 w; w.x = cvt_pk_bf16(v0[0], v0[1]); w.y = cvt_pk_bf16(v0[2], v0[3]); w.z = cvt_pk_bf16(v1[0], v1[1]); w.w = cvt_pk_bf16(v1[2], v1[3]);
                    *(u32x4*)(rowp + bj * HALF) = w; } }
    }
};
struct EpiResF32 {
    static constexpr bool PERM = false;
    const float* base; float* out; int ldc;
    __device__ __forceinline__ void operator()(const f32x4 (&acc)[2][2][4][2], const Unit& u, int wr, int wc, int fr, int fq) const {
        const int col0 = u.pn * BM + wc * 32 + 4 * fq;
#pragma unroll
        for (int ai = 0; ai < 2; ++ai)
#pragma unroll
            for (int m = 0; m < 4; ++m) { const size_t off = (size_t)(u.pm * BM + ai * HALF + wr * 64 + m * 16 + fr) * ldc + col0;
#pragma unroll
                for (int bj = 0; bj < 2; ++bj)
#pragma unroll
                    for (int n = 0; n < 2; ++n) { const f32x4 bs = *(const f32x4*)(base + off + bj * HALF + n * 16); *(f32x4*)(out + off + bj * HALF + n * 16) = bs + acc[ai][bj][m][n]; } }
    }
};
struct EpiSwiglu {
    static constexpr bool PERM = true;
    unsigned char* O; const float* bias; int nN;
    __device__ __forceinline__ void operator()(const f32x4 (&acc)[2][2][4][2], const Unit& u, int wr, int wc, int fr, int fq) const {
        const int e = u.pb / nN;
        const int row0 = u.pm * BM + wr * 64 + fr, ch = u.pn * HALF + wc * 32 + 8 * fq;
        const float* bg = bias + (size_t)e * 2048 + ch; const float* bl = bg + 1024;
        const f32x4 bg0 = *(const f32x4*)bg, bg1 = *(const f32x4*)(bg + 4), bl0 = *(const f32x4*)bl, bl1 = *(const f32x4*)(bl + 4);
#pragma unroll
        for (int ai = 0; ai < 2; ++ai)
#pragma unroll
            for (int m = 0; m < 4; ++m) {
                float r[8];
#pragma unroll
                for (int n = 0; n < 2; ++n)
#pragma unroll
                    for (int j = 0; j < 4; ++j) {
                        float gv = acc[ai][0][m][n][j] * (1.f / 32.f) + (n ? bg1[j] : bg0[j]);
                        float lv = acc[ai][1][m][n][j] * (1.f / 32.f) + (n ? bl1[j] : bl0[j]);
                        gv = fminf(gv, 7.0f); lv = fminf(fmaxf(lv, -7.0f), 7.0f);
                        r[n * 4 + j] = gv * (1.f / (1.f + __expf(-1.702f * gv))) * (lv + 1.0f);
                    }
                u32x2 w; w.x = pk4_fp8(r[0], r[1], r[2], r[3]); w.y = pk4_fp8(r[4], r[5], r[6], r[7]);
                *(u32x2*)(O + (size_t)(row0 + ai * HALF + m * 16) * DFF + ch) = w;
            }
    }
};
struct EpiDown {
    static constexpr bool PERM = true;
    bf16_t* O; const float* bias; int nN;
    __device__ __forceinline__ void operator()(const f32x4 (&acc)[2][2][4][2], const Unit& u, int wr, int wc, int fr, int fq) const {
        const int e = u.pb / nN;
        const int row0 = u.pm * BM + wr * 64 + fr, col0 = u.pn * BM + wc * 32 + 8 * fq;
        const float* bp = bias + (size_t)e * 1024 + col0;
        f32x4 bv[2][2];
#pragma unroll
        for (int bj = 0; bj < 2; ++bj)
#pragma unroll
            for (int n = 0; n < 2; ++n) bv[bj][n] = *(const f32x4*)(bp + bj * HALF + 4 * n);
#pragma unroll
        for (int ai = 0; ai < 2; ++ai)
#pragma unroll
            for (int m = 0; m < 4; ++m) { bf16_t* rowp = O + (size_t)(row0 + ai * HALF + m * 16) * 1024 + col0;
#pragma unroll
                for (int bj = 0; bj < 2; ++bj) { const f32x4 v0 = acc[ai][bj][m][0] * (1.f / 32.f) + bv[bj][0], v1 = acc[ai][bj][m][1] * (1.f / 32.f) + bv[bj][1];
                    u32x4 w; w.x = cvt_pk_bf16(v0[0], v0[1]); w.y = cvt_pk_bf16(v0[2], v0[3]); w.z = cvt_pk_bf16(v1[0], v1[1]); w.w = cvt_pk_bf16(v1[2], v1[3]);
                    *(u32x4*)(rowp + bj * HALF) = w; } }
    }
};

template <bool FP8, class Epi, class Sched>
__device__ __forceinline__ void gemm_phase(LAS unsigned char* lds, const Gemm g, const Sched& S, const Epi& E) {
    const int tid = opaque_tid(), wid = __builtin_amdgcn_readfirstlane(tid >> 6), lane = tid & 63, wr = wid >> 2, wc = wid & 3, fr = lane & 15, fq = lane >> 4;
    const int Kb = g.Kb, nt = Kb / 128;
    unsigned voffA[2], voffB[2];
#pragma unroll
    for (int i = 0; i < 2; ++i) { int R, C; stage_rc(tid * 16 + i * 8192, R, C); const int Rb = Epi::PERM ? ((R & ~31) + perm32(R & 31)) : R;
        voffA[i] = (unsigned)(R * Kb + C * 2); voffB[i] = (unsigned)(Rb * Kb + C * 2); }
    const size_t kstep = (size_t)(BK * 2);
    const size_t hstep = (size_t)HALF * Kb;
    const size_t tstep = 2 * hstep;
    const unsigned ldsw = (unsigned)wid * 1024u;
    const int aoff = FP8 ? lds_byte(wr * 64 + fr, fq * 16) : lds_byte(wr * 64 + fr, fq * 8), boff = FP8 ? lds_byte(wc * 32 + fr, fq * 16) : lds_byte(wc * 32 + fr, fq * 8);
#define PG8_SA(b, h) (((b) * 2 + (h)) * HTB)
#define PG8_SB(b, h) ((4 + (b) * 2 + (h)) * HTB)
#define PG8_STAGE(bufoff, gbase, voff) do { _Pragma("unroll") for (int _i = 0; _i < 2; ++_i) \
        __builtin_amdgcn_global_load_lds((const unsigned*)((const char*)(gbase) + (voff)[_i]), (LAS unsigned*)(lds + (bufoff) + ldsw + _i * 8192), 16, 0, 0); } while (0)
#define PG8_LDA(dst, b, h) do { if constexpr (FP8) { _Pragma("unroll") for (int m = 0; m < 4; ++m) dst##8[m] = *(const LAS i32x8*)(lds + PG8_SA(b, h) + aoff + m * 2048); } \
        else { _Pragma("unroll") for (int m = 0; m < 4; ++m) _Pragma("unroll") for (int k = 0; k < 2; ++k) dst[m][k] = *(const LAS bf16x8*)(lds + PG8_SA(b, h) + aoff + m * 2048 + k * 1024); } } while (0)
#define PG8_LDB(dst, b, h) do { if constexpr (FP8) { _Pragma("unroll") for (int n = 0; n < 2; ++n) dst##8[n] = *(const LAS i32x8*)(lds + PG8_SB(b, h) + boff + n * 2048); } \
        else { _Pragma("unroll") for (int n = 0; n < 2; ++n) _Pragma("unroll") for (int k = 0; k < 2; ++k) dst[n][k] = *(const LAS bf16x8*)(lds + PG8_SB(b, h) + boff + n * 2048 + k * 1024); } } while (0)
#define PG8_MMA(ai, bj, At, Bt) do { __builtin_amdgcn_s_setprio(1); _Pragma("unroll") for (int m = 0; m < 4; ++m) _Pragma("unroll") for (int n = 0; n < 2; ++n) { \
        if constexpr (FP8) mfma8_acc(acc[ai][bj][m][n], Bt##8[n], At##8[m], scl); \
        else { _Pragma("unroll") for (int k = 0; k < 2; ++k) acc[ai][bj][m][n] = __builtin_amdgcn_mfma_f32_16x16x32_bf16(Bt[n][k], At[m][k], acc[ai][bj][m][n], 0, 0, 0); } } \
        __builtin_amdgcn_s_setprio(0); } while (0)
#define PG8_WAIT_V(n) asm volatile("s_waitcnt vmcnt(" #n ")" ::: "memory")
#define PG8_WAIT_L(n) asm volatile("s_waitcnt lgkmcnt(" #n ")" ::: "memory")
#define PG8_BAR __builtin_amdgcn_s_barrier()
#define PG8_SCHED __builtin_amdgcn_sched_barrier(0)
    Unit cur, nxt; int ui = 0;
    if (!S.next(0, cur)) return;
    f32x4 acc[2][2][4][2];
#pragma unroll
    for (int a = 0; a < 2; ++a)
#pragma unroll
        for (int b = 0; b < 2; ++b)
#pragma unroll
            for (int m = 0; m < 4; ++m)
#pragma unroll
                for (int n = 0; n < 2; ++n) acc[a][b][m][n] = (f32x4){0.f, 0.f, 0.f, 0.f};
    bf16x8 At[4][2], B0[2][2], B1[2][2];
    i32x8 At8[4], B08[2], B18[2];
    int scl = 0x7f7f7f7f; asm volatile("" : "+v"(scl));
    const char* cA = (const char*)g.A + (size_t)cur.pm * tstep; const char* cB = (const char*)g.Bt + (size_t)cur.pb * tstep;
    {
        PG8_STAGE(PG8_SB(0, 0), cB, voffB); PG8_STAGE(PG8_SB(0, 1), cB + hstep, voffB); PG8_STAGE(PG8_SA(0, 0), cA, voffA); PG8_STAGE(PG8_SA(0, 1), cA + hstep, voffA);
        if (wr == 1) PG8_BAR;
        PG8_WAIT_V(2); PG8_BAR;
        PG8_STAGE(PG8_SB(1, 0), cB + kstep, voffB); PG8_STAGE(PG8_SA(1, 0), cA + kstep, voffA); PG8_STAGE(PG8_SB(1, 1), cB + hstep + kstep, voffB);
        PG8_WAIT_V(6); PG8_BAR;
    }
    for (;;) {
        const bool has_next = S.next(ui + 1, nxt);
        const char* nA = has_next ? (const char*)g.A + (size_t)nxt.pm * tstep : cA; const char* nB = has_next ? (const char*)g.Bt + (size_t)nxt.pb * tstep : cB;
#pragma unroll 1
        for (int t = 0; t < nt; t += 2) {
            const bool last = (t == nt - 2);
            const char* a1 = cA + (size_t)(t + 1) * kstep;
            const char* a2 = last ? nA : cA + (size_t)(t + 2) * kstep; const char* b2 = last ? nB : cB + (size_t)(t + 2) * kstep;
            const char* a3 = a2 + kstep; const char* b3 = b2 + kstep;
            PG8_LDB(B0, 0, 0); PG8_LDB(B1, 0, 1); PG8_SCHED; PG8_LDA(At, 0, 0); PG8_STAGE(PG8_SA(1, 1), a1 + hstep, voffA);
            PG8_WAIT_V(8); PG8_WAIT_L(0); PG8_BAR; PG8_MMA(0, 0, At, B0); PG8_MMA(0, 1, At, B1); PG8_BAR; PG8_SCHED;
            PG8_LDA(At, 0, 1); PG8_STAGE(PG8_SB(0, 0), b2, voffB); PG8_STAGE(PG8_SB(0, 1), b2 + hstep, voffB); PG8_STAGE(PG8_SA(0, 0), a2, voffA);
            PG8_WAIT_V(8); PG8_WAIT_L(0); PG8_BAR; PG8_MMA(1, 0, At, B0); PG8_MMA(1, 1, At, B1); PG8_BAR; PG8_SCHED;
            PG8_LDB(B0, 1, 0); PG8_LDB(B1, 1, 1); PG8_SCHED; PG8_LDA(At, 1, 0); PG8_STAGE(PG8_SA(0, 1), a2 + hstep, voffA);
            PG8_WAIT_V(8); PG8_WAIT_L(0); PG8_BAR; PG8_MMA(0, 0, At, B0); PG8_MMA(0, 1, At, B1); PG8_BAR; PG8_SCHED;
            PG8_LDA(At, 1, 1); PG8_STAGE(PG8_SB(1, 0), b3, voffB); PG8_STAGE(PG8_SB(1, 1), b3 + hstep, voffB); PG8_STAGE(PG8_SA(1, 0), a3, voffA);
            PG8_WAIT_V(8); PG8_WAIT_L(0); PG8_BAR; PG8_MMA(1, 0, At, B0); PG8_MMA(1, 1, At, B1); PG8_BAR; PG8_SCHED;
        }
        if (wr == 0) PG8_BAR;
        if constexpr (FP8) asm volatile("s_nop 15\n\ts_nop 15" ::: "memory");
        E(acc, cur, wr, wc, fr, fq);
        if (!has_next) break;
#pragma unroll
        for (int a = 0; a < 2; ++a)
#pragma unroll
            for (int b = 0; b < 2; ++b)
#pragma unroll
                for (int m = 0; m < 4; ++m)
#pragma unroll
                    for (int n = 0; n < 2; ++n) acc[a][b][m][n] = (f32x4){0.f, 0.f, 0.f, 0.f};
        cur = nxt; cA = nA; cB = nB; ++ui;
        if (wr == 1) PG8_BAR;
    }
    PG8_WAIT_V(0);
    PG8_BAR;
#undef PG8_SA
#undef PG8_SB
#undef PG8_STAGE
#undef PG8_LDA
#undef PG8_LDB
#undef PG8_MMA
#undef PG8_WAIT_V
#undef PG8_WAIT_L
#undef PG8_BAR
#undef PG8_SCHED
}
}

__device__ __forceinline__ int win_map(int n) {
    if (n < 1280) return n;
    if (n < 2304) return n + 24;
    if (n < 2816) return n + 40;
    if (n < 2840) return n - 1536;
    if (n < 2856) return n - 512;
    return -1;
}
template <int MODE> __device__ __forceinline__ int colmap(int r) {
    if (MODE == 1) return win_map(r);
    if (MODE == 2) return ((r >> 7) & 1) * 1024 + (r >> 8) * 128 + (r & 127);
    return r;
}
template <int MODE, bool OUT8>
__device__ __forceinline__ void transpose_item(const float* W, int K, int Nsrc, void* WTv, int nblk, LAS float* scr, int item, int lane) {
    const int kb = item / nblk, nb = item % nblk, k0 = 64 * kb, n0 = 64 * nb;
    const int nq = 4 * (lane & 15), kq = lane >> 4;
    const int sc = colmap<MODE>(n0 + nq);
    f32x4 v[16];
#pragma unroll
    for (int i = 0; i < 16; ++i) v[i] = sc >= 0 ? __builtin_nontemporal_load((const f32x4*)(W + (size_t)(k0 + 4 * i + kq) * Nsrc + sc)) : (f32x4){0.f, 0.f, 0.f, 0.f};
#pragma unroll
    for (int i = 0; i < 16; ++i) { LAS float* d = scr + (4 * i + kq) * 65 + nq; d[0] = v[i].x; d[1] = v[i].y; d[2] = v[i].z; d[3] = v[i].w; }
    LDS_WAIT();
    const int c = lane & 7;
#pragma unroll
    for (int j = 0; j < 8; ++j) { const int n = (lane >> 3) + 8 * j; const LAS float* s = scr + (8 * c) * 65 + n;
        if (OUT8) {
            u32x2 o; o.x = pk4_fp8(s[0 * 65] * 32.f, s[1 * 65] * 32.f, s[2 * 65] * 32.f, s[3 * 65] * 32.f); o.y = pk4_fp8(s[4 * 65] * 32.f, s[5 * 65] * 32.f, s[6 * 65] * 32.f, s[7 * 65] * 32.f);
            *(u32x2*)((unsigned char*)WTv + (size_t)(n0 + n) * K + k0 + 8 * c) = o;
        } else {
            u32x4 o; o.x = pk2(s[0 * 65], s[1 * 65]); o.y = pk2(s[2 * 65], s[3 * 65]); o.z = pk2(s[4 * 65], s[5 * 65]); o.w = pk2(s[6 * 65], s[7 * 65]);
            *(u32x4*)((bf16_t*)WTv + (size_t)(n0 + n) * K + k0 + 8 * c) = o; } }
    LDS_WAIT();
}
template <int NR>
__device__ __forceinline__ void rms_rows_to_bf16(const float* x0, size_t xstride, const float* g, bf16_t* o0, size_t ostride, int lane) {
    f32x4 v[NR][4];
#pragma unroll
    for (int r = 0; r < NR; ++r) { const f32x4* xr = (const f32x4*)(x0 + r * xstride) + lane;
#pragma unroll
        for (int j = 0; j < 4; ++j) v[r][j] = __builtin_nontemporal_load(xr + 64 * j); }
    const f32x4* gr = (const f32x4*)g + lane;
    f32x4 gg[4];
#pragma unroll
    for (int j = 0; j < 4; ++j) gg[j] = gr[64 * j];
#pragma unroll
    for (int r = 0; r < NR; ++r) {
        float s = 0.f;
#pragma unroll
        for (int j = 0; j < 4; ++j) s += (v[r][j].x * v[r][j].x + v[r][j].y * v[r][j].y) + (v[r][j].z * v[r][j].z + v[r][j].w * v[r][j].w);
        const float rstd = 1.f / sqrtf(wave_sum(s) * (1.f / DM) + EPS);
        unsigned long long* o8 = (unsigned long long*)(o0 + r * ostride) + lane;
#pragma unroll
        for (int j = 0; j < 4; ++j) { const f32x4 o = v[r][j] * rstd * gg[j];
            o8[64 * j] = (unsigned long long)pk2(o.x, o.y) | ((unsigned long long)pk2(o.z, o.w) << 32); }
    }
}
__device__ __forceinline__ void phase0(const Params& p, LAS unsigned char* lds, int blk, int G) {
    const int tid = opaque_tid(), lane = tid & 63, wave = tid >> 6;
    LAS float* scr = (LAS float*)(lds + wave * 16640);
    const int gw = blk * 8 + wave, NGW = G * 8;
    unsigned char* ws = p.ws;
    constexpr int I_GU = 16 * 32, I_DN = 16 * 16;
    constexpr int N_GU = NEXP * I_GU, N_DN = NEXP * I_DN, N_IN = 16 * (NPROJ / 64), N_OUT = 16 * 16, N_C1 = 32 * 4, N_C2 = 4 * 1;
    constexpr int NITEMS = N_GU + N_DN + N_IN + N_OUT + 2 * N_C1 + 2 * N_C2;
    for (int it = gw; it < NITEMS; it += NGW) {
        int r = it;
        if (r < N_GU) { const int e = r / I_GU; transpose_item<2, true>(p.in[19] + (size_t)e * 1024 * 2048, 1024, 2048, ws + WS_WGU + (size_t)e * 2048 * 1024, 32, scr, r % I_GU, lane); continue; } r -= N_GU;
        if (r < N_DN) { const int e = r / I_DN; transpose_item<0, true>(p.in[21] + (size_t)e * 1024 * 1024, 1024, 1024, ws + WS_WD + (size_t)e * 1024 * 1024, 16, scr, r % I_DN, lane); continue; } r -= N_DN;
        if (r < N_IN) { transpose_item<1, false>(p.in[3], 1024, 2856, (bf16_t*)(ws + WS_WIN), NPROJ / 64, scr, r, lane); continue; } r -= N_IN;
        if (r < N_OUT) { transpose_item<0, false>(p.in[15], 1024, 1024, (bf16_t*)(ws + WS_WOUT), 16, scr, r, lane); continue; } r -= N_OUT;
        if (r < N_C1) { transpose_item<0, false>(p.in[7], 2048, 256, (bf16_t*)(ws + WS_CW1K), 4, scr, r, lane); continue; } r -= N_C1;
        if (r < N_C1) { transpose_item<0, false>(p.in[10], 2048, 256, (bf16_t*)(ws + WS_CW1V), 4, scr, r, lane); continue; } r -= N_C1;
        if (r < N_C2) { transpose_item<0, false>(p.in[8], 256, 64, (bf16_t*)(ws + WS_CW2K), 1, scr, r, lane); continue; } r -= N_C2;
        transpose_item<0, false>(p.in[11], 256, 64, (bf16_t*)(ws + WS_CW2V), 1, scr, r, lane);
    }
    for (int m = gw * 4; m < MTOK; m += NGW * 4) rms_rows_to_bf16<4>(p.in[0] + (size_t)m * DM, DM, p.in[2], (bf16_t*)(ws + WS_H) + (size_t)m * DM, DM, lane);
    for (int i = blk * NTHREADS + tid; i < NEXP * DM; i += G * NTHREADS) { const int e = i >> 10, d = i & 1023; ((float*)(ws + WS_WRT))[i] = p.in[16][d] * p.in[17][d * NEXP + e]; }
    if (blk == G - 1) {
        const int which = tid >> 8, j = tid & 255;
        const float* pos = which ? p.in[9] : p.in[6]; const float* w1 = which ? p.in[10] : p.in[7];
        float s = 0.f;
#pragma unroll 8
        for (int k = 0; k < 2048; ++k) s += pos[k] * w1[(size_t)k * 256 + j];
        ((float*)(ws + WS_CBIAS))[tid] = s;
    }
}

__device__ __forceinline__ void p2a_unit(const Params& p, LAS unsigned char* lds, int unit) {
    const int tid = opaque_tid(), lane = tid & 63, wave = tid >> 6, vec = lane >> 4, li = lane & 15;
    unsigned char* ws = p.ws;
    const bf16_t* PROJ = (const bf16_t*)(ws + WS_PROJ);
    const int b = unit >> 5, blkc = unit & 31, tok0 = unit * 64;
    u32x4 vraw[4];
    { const int tk = tid >> 3, ch = tid & 7;
#pragma unroll
      for (int v = 0; v < 4; ++v) vraw[v] = *(const u32x4*)(PROJ + (size_t)(tok0 + tk) * NPROJ + (v < 2 ? CVS : CVW) + (v & 1) * 64 + 8 * ch); }
    const int col0 = CQ + vec * 64 + 4 * li, col1 = CQ + (4 + vec) * 64 + 4 * li, col2 = (vec < 2 ? CKS + vec * 64 : CKW + (vec - 2) * 64) + 4 * li;
    u32x2 raw[8][3];
#pragma unroll
    for (int ti = 0; ti < 8; ++ti) { const bf16_t* pr = PROJ + (size_t)(tok0 + wave * 8 + ti) * NPROJ;
        raw[ti][0] = *(const u32x2*)(pr + col0); raw[ti][1] = *(const u32x2*)(pr + col1); raw[ti][2] = *(const u32x2*)(pr + col2); }
    const f32x4 gq = *(const f32x4*)(p.in[4] + 4 * li);
    const f32x4 gk = *(const f32x4*)(p.in[5] + (vec < 2 ? 64 : 128) + 4 * li);
    float invf[4];
#pragma unroll
    for (int i = 0; i < 4; ++i) invf[i] = __expf(-13.122363377404328f * (float)(2 * ((4 * li + i) & 7)) * (1.f / 16.f));
    const float sgn = (li < 2) ? -1.f : 1.f;
#pragma unroll
    for (int ti = 0; ti < 8; ++ti) {
        const int t = tok0 + wave * 8 + ti;
        const float pos = (float)((const int*)p.in[1])[t];
        float cs[4], sn[4];
#pragma unroll
        for (int i = 0; i < 4; ++i) { const float ang = pos * invf[i]; cs[i] = __cosf(ang); sn[i] = __sinf(ang); }
#pragma unroll
        for (int vg = 0; vg < 3; ++vg) {
            const u32x2 rw = raw[ti][vg];
            float x[4] = {__uint_as_float(rw.x << 16), __uint_as_float(rw.x & 0xffff0000u), __uint_as_float(rw.y << 16), __uint_as_float(rw.y & 0xffff0000u)};
            const float ss = red16_sum((x[0] * x[0] + x[1] * x[1]) + (x[2] * x[2] + x[3] * x[3]));
            const float rstd = 1.f / sqrtf(ss * (1.f / 64.f) + EPS);
            const f32x4 g = (vg < 2) ? gq : gk;
            float y[4], yr[4];
#pragma unroll
            for (int i = 0; i < 4; ++i) y[i] = x[i] * rstd * g[i];
#pragma unroll
            for (int i = 0; i < 4; ++i) { const float partner = dppf<0x4E>(y[i]); yr[i] = (li < 4) ? (y[i] * cs[i] + sgn * partner * sn[i]) : y[i]; }
            if (vg < 2) {
                const float sc = 0.125f * 1.4426950408889634f;
                u32x2 o; o.x = pk2(y[0] * sc, y[1] * sc); o.y = pk2(y[2] * sc, y[3] * sc);
                *(u32x2*)((bf16_t*)(ws + WS_QN) + (size_t)t * 512 + (4 * vg + vec) * 64 + 4 * li) = o;
                o.x = pk2(yr[0] * sc, yr[1] * sc); o.y = pk2(yr[2] * sc, yr[3] * sc);
                *(u32x2*)((bf16_t*)(ws + WS_QR) + (size_t)t * 512 + (4 * vg + vec) * 64 + 4 * li) = o;
            } else {
                u32x2 o; o.x = pk2(yr[0], yr[1]); o.y = pk2(yr[2], yr[3]);
                bf16_t* dst = (bf16_t*)(ws + (vec < 2 ? WS_KS : WS_KW)) + ((size_t)(b * 2 + (vec & 1)) * SEQ + (t & (SEQ - 1))) * 64 + 4 * li;
                *(u32x2*)dst = o;
            }
        }
    }
    __syncthreads();
    { const int tk = tid >> 3, ch = tid & 7;
#pragma unroll
      for (int v = 0; v < 4; ++v) { LAS bf16_t* T = (LAS bf16_t*)lds + v * (64 * 72);
#pragma unroll
          for (int q = 0; q < 4; ++q) { const unsigned wv = vraw[v][q]; T[(8 * ch + 2 * q) * 72 + tk] = (bf16_t)(wv & 0xffffu); T[(8 * ch + 2 * q + 1) * 72 + tk] = (bf16_t)(wv >> 16); } } }
    __syncthreads();
    { const int d = tid >> 3, ch = tid & 7;
#pragma unroll
      for (int v = 0; v < 4; ++v) { const LAS bf16_t* T = (const LAS bf16_t*)lds + v * (64 * 72);
          const u32x4 o = *(const LAS u32x4*)(T + d * 72 + 8 * ch);
          bf16_t* dst = (bf16_t*)(ws + (v < 2 ? WS_VST : WS_VWT)) + (((size_t)(b * 2 + (v & 1)) * 32 + blkc) * 64 + d) * 64 + 8 * ch;
          *(u32x4*)dst = o; } }
}

__device__ __forceinline__ void p2b_unit(const Params& p, LAS unsigned char* lds, int unit) {
    const int tid = opaque_tid(), lane = tid & 63, w = tid >> 6, fr = lane & 15, fq = lane >> 4;
    unsigned char* ws = p.ws;
    const bf16_t* PROJ = (const bf16_t*)(ws + WS_PROJ);
    const int which = unit >> 6, rt = unit & 63;
    const bf16_t* W1T = (const bf16_t*)(ws + (which ? WS_CW1V : WS_CW1K));
    const bf16_t* W2T = (const bf16_t*)(ws + (which ? WS_CW2V : WS_CW2K));
    const float* cb = (const float*)(ws + WS_CBIAS) + which * 256;
    const int colbase = which ? CVC : CKC;
    LAS bf16_t* Hd = (LAS bf16_t*)lds;
    LAS float* Of = (LAS float*)(lds + 64 * 264 * 2);
    const bf16_t* arow[4];
#pragma unroll
    for (int m = 0; m < 4; ++m) { const int R = rt * 64 + 16 * m + fr; const int bb = R >> 8, kh = (R >> 7) & 1; int n = R & 127; if (n > 126) n = 126;
        arow[m] = PROJ + (size_t)(bb * SEQ + 16 * n) * NPROJ + colbase + kh * 64 + 8 * fq; }
    const bf16_t* brow[2];
#pragma unroll
    for (int nf = 0; nf < 2; ++nf) brow[nf] = W1T + (size_t)(32 * w + 16 * nf + fr) * 2048 + 8 * fq;
    f32x4 acc[4][2];
#pragma unroll
    for (int m = 0; m < 4; ++m)
#pragma unroll
        for (int nf = 0; nf < 2; ++nf) acc[m][nf] = (f32x4){0.f, 0.f, 0.f, 0.f};
#pragma unroll 4
    for (int ks = 0; ks < 64; ++ks) {
        bf16x8 a[4], bb2[2];
        const size_t aoff = (size_t)(ks >> 1) * NPROJ + 32 * (ks & 1);
#pragma unroll
        for (int m = 0; m < 4; ++m) a[m] = *(const bf16x8*)(arow[m] + aoff);
#pragma unroll
        for (int nf = 0; nf < 2; ++nf) bb2[nf] = *(const bf16x8*)(brow[nf] + 32 * ks);
#pragma unroll
        for (int m = 0; m < 4; ++m)
#pragma unroll
            for (int nf = 0; nf < 2; ++nf) acc[m][nf] = __builtin_amdgcn_mfma_f32_16x16x32_bf16(a[m], bb2[nf], acc[m][nf], 0, 0, 0);
    }
#pragma unroll
    for (int nf = 0; nf < 2; ++nf) { const int col = 32 * w + 16 * nf + fr; const float bias = cb[col];
#pragma unroll
        for (int m = 0; m < 4; ++m)
#pragma unroll
            for (int j = 0; j < 4; ++j) { const float hv = acc[m][nf][j] + bias; Hd[(16 * m + 4 * fq + j) * 264 + col] = (bf16_t)f2bf(hv * sigmoidf_(hv)); } }
    __syncthreads();
    {
        const int m2 = w >> 1;
        f32x4 acc2[2] = {(f32x4){0.f, 0.f, 0.f, 0.f}, (f32x4){0.f, 0.f, 0.f, 0.f}};
#pragma unroll
        for (int ks = 0; ks < 8; ++ks) {
            const bf16x8 a = *(const LAS bf16x8*)(Hd + (16 * m2 + fr) * 264 + 32 * ks + 8 * fq);
#pragma unroll
            for (int q = 0; q < 2; ++q) { const int nf2 = 2 * (w & 1) + q; const bf16x8 bv = *(const bf16x8*)(W2T + (size_t)(16 * nf2 + fr) * 256 + 32 * ks + 8 * fq);
                acc2[q] = __builtin_amdgcn_mfma_f32_16x16x32_bf16(a, bv, acc2[q], 0, 0, 0); }
        }
#pragma unroll
        for (int q = 0; q < 2; ++q) { const int nf2 = 2 * (w & 1) + q;
#pragma unroll
            for (int j = 0; j < 4; ++j) Of[(16 * m2 + 4 * fq + j) * 65 + 16 * nf2 + fr] = acc2[q][j]; }
    }
    __syncthreads();
    for (int rr = 0; rr < 8; ++rr) {
        const int r = 8 * w + rr, R = rt * 64 + r, bb = R >> 8, kh = (R >> 7) & 1, n = R & 127;
        float v = Of[r * 65 + lane];
        if (which == 0) {
            const float ss = wave_sum(v * v);
            v = v * (1.f / sqrtf(ss * (1.f / 64.f) + EPS)) * p.in[5][lane];
            if (n == 127) v = 0.f;
            ((bf16_t*)(ws + WS_KC))[((size_t)(bb * 2 + kh) * 128 + n) * 64 + lane] = (bf16_t)f2bf(v);
        } else {
            if (n == 127) v = 0.f;
            ((bf16_t*)(ws + WS_VCT))[((size_t)(bb * 2 + kh) * 64 + lane) * 128 + n] = (bf16_t)f2bf(v);
        }
    }
    __syncthreads();
}

constexpr int NSA_KT0 = 0, NSA_VT0 = 10240, NSA_KT1 = 20480, NSA_VT1 = 30720, NSA_PW = 40960, NSA_IMPW = NSA_PW  ,
              NSA_SELM = NSA_PW + 8 * 5120, NSA_UNI = NSA_SELM + 256, NSA_OUT = NSA_UNI + 256;
static_assert(4 * 64 * 33 * 4 <= 8 * 5120 && NSA_OUT + 256 * 68 * 4 <= LDS_BYTES - 64, "NSA LDS map");
constexpr float NEGBIG = -1e30f;


__device__ __forceinline__ void nsa_qk(const bf16x8 (&aq)[2][2], const LAS bf16_t* KT, f32x4 (&S)[2][4], int fr, int fq) {
#pragma unroll
    for (int nf = 0; nf < 4; ++nf) {
        bf16x8 bk[2];
#pragma unroll
        for (int ks = 0; ks < 2; ++ks) bk[ks] = *(const LAS bf16x8*)(KT + (16 * nf + fr) * 80 + 32 * ks + 8 * fq);
#pragma unroll
        for (int m = 0; m < 2; ++m) { f32x4 s = (f32x4){0.f, 0.f, 0.f, 0.f};
#pragma unroll
            for (int ks = 0; ks < 2; ++ks) s = __builtin_amdgcn_mfma_f32_16x16x32_bf16(aq[m][ks], bk[ks], s, 0, 0, 0);
            S[m][nf] = s; }
    }
}
__device__ __forceinline__ void nsa_pv(const LAS bf16_t* PWw, const LAS bf16_t* VT, f32x4 (&O)[2][4], int fr, int fq) {
    bf16x8 ap[2][2];
#pragma unroll
    for (int m = 0; m < 2; ++m)
#pragma unroll
        for (int ks = 0; ks < 2; ++ks) ap[m][ks] = *(const LAS bf16x8*)(PWw + (16 * m + fr) * 80 + 32 * ks + 8 * fq);
#pragma unroll
    for (int nfd = 0; nfd < 4; ++nfd) {
        bf16x8 bv[2];
#pragma unroll
        for (int ks = 0; ks < 2; ++ks) bv[ks] = *(const LAS bf16x8*)(VT + (16 * nfd + fr) * 80 + 32 * ks + 8 * fq);
#pragma unroll
        for (int m = 0; m < 2; ++m)
#pragma unroll
            for (int ks = 0; ks < 2; ++ks) O[m][nfd] = __builtin_amdgcn_mfma_f32_16x16x32_bf16(ap[m][ks], bv[ks], O[m][nfd], 0, 0, 0);
    }
}
__device__ __forceinline__ void nsa_bounds(int mode, bool rok, int i, int cq, int koff, int& lo, int& hi) {
    hi = (mode == 1) ? i : ((mode == 3) ? (((cq + i - 31) >> 4) - koff) : 63);
    lo = (mode == 2) ? i + 1 : 0;
    hi = rok ? hi : -1;
}
__device__ __forceinline__ void nsa_tile(int MM, const bf16x8 (&aq)[2][2], const LAS bf16_t* KT, const LAS bf16_t* VT, LAS bf16_t* PWw, float (&lsum)[2][4], f32x4 (&O)[2][4],
                                         unsigned rowok, int mode, int ibase, int cq, int koff, int fr_, int fq_) {
    int fr = fr_, fq = fq_;
    asm volatile("" : "+v"(fr), "+v"(fq));
    f32x4 S[2][4];
    nsa_qk(aq, KT, S, fr, fq);
#pragma unroll
    for (int m = 0; m < 2; ++m)
#pragma unroll
        for (int j = 0; j < 4; ++j) {
            float pv[4];
            if (MM == 0) {
#pragma unroll
                for (int nf = 0; nf < 4; ++nf) pv[nf] = __builtin_amdgcn_exp2f(S[m][nf][j]);
            } else if (MM == 1) {
                const bool rok = (rowok >> (m * 4 + j)) & 1u;
#pragma unroll
                for (int nf = 0; nf < 4; ++nf) { const float e = __builtin_amdgcn_exp2f(S[m][nf][j]); pv[nf] = rok ? e : 0.f; }
            } else {
                const int i = ibase + 16 * m + 4 * fq + j;
                int lo, hi; nsa_bounds(mode, (rowok >> (m * 4 + j)) & 1u, i, cq, koff, lo, hi);
#pragma unroll
                for (int nf = 0; nf < 4; ++nf) { const int key = 4 * fr + nf; const bool ok = (key >= lo) & (key <= hi); const float e = __builtin_amdgcn_exp2f(S[m][nf][j]); pv[nf] = ok ? e : 0.f; }
            }
            lsum[m][j] += (pv[0] + pv[1]) + (pv[2] + pv[3]);
            u32x2 pw; pw.x = pg8::cvt_pk_bf16(pv[0], pv[1]); pw.y = pg8::cvt_pk_bf16(pv[2], pv[3]);
            *(LAS u32x2*)(PWw + (16 * m + 4 * fq + j) * 80 + 4 * fr) = pw;
        }
    LDS_WAIT();
    nsa_pv(PWw, VT, O, fr, fq);
}
struct NsaStage { u32x4 k, v; };
__device__ __forceinline__ void nsa_fetch(NsaStage& st, const bf16_t* Ksrc, int kstride, const bf16_t* Vsrc, int vstride, int tid) {
    const int r = tid >> 3, ch = tid & 7;
    st.k = *(const u32x4*)(Ksrc + (size_t)r * kstride + 8 * ch);
    st.v = *(const u32x4*)(Vsrc + (size_t)r * vstride + 8 * ch);
}
__device__ __forceinline__ void nsa_commit(const NsaStage& st, LAS bf16_t* KT, LAS bf16_t* VT, int tid) {
    const int r = tid >> 3, ch = tid & 7;
    *(LAS u32x4*)(KT + (16 * (r & 3) + (r >> 2)) * 80 + 8 * ch) = st.k;
    *(LAS u32x4*)(VT + r * 80 + 8 * ch) = st.v;
}

__device__ __forceinline__ void nsa_unit(const Params& p, LAS unsigned char* lds, int b, int kh, int c) {
    const int tid = opaque_tid(), lane = tid & 63, w = tid >> 6, fr = lane & 15, fq = lane >> 4, g = w >> 1, ih = w & 1;
    unsigned char* ws = p.ws;
    const int hh = kh * 4 + g, tok0 = b * SEQ + 64 * c, ibase = 32 * ih;
    const bf16_t* PROJ = (const bf16_t*)(ws + WS_PROJ);
    LAS bf16_t* PWw = (LAS bf16_t*)(lds + NSA_PW + w * 5120);
    LAS float* IMPW = (LAS float*)(lds + NSA_IMPW);
    LAS unsigned* SELM = (LAS unsigned*)(lds + NSA_SELM); LAS unsigned* UNI = (LAS unsigned*)(lds + NSA_UNI);
    LAS float* OUTw = (LAS float*)(lds + NSA_OUT) + (w * 32) * 68;
    const size_t bk = (size_t)(b * 2 + kh);
#define NSA_KTB(bb) ((LAS bf16_t*)(lds + ((bb) ? NSA_KT1 : NSA_KT0)))
#define NSA_VTB(bb) ((LAS bf16_t*)(lds + ((bb) ? NSA_VT1 : NSA_VT0)))
    bf16x8 aq[2][2];
    NsaStage st;
    if (tid == 0) *UNI = 0u;
    {
#pragma unroll
        for (int m = 0; m < 2; ++m)
#pragma unroll
            for (int ks = 0; ks < 2; ++ks) aq[m][ks] = *(const bf16x8*)((const bf16_t*)(ws + WS_QN) + (size_t)(tok0 + ibase + 16 * m + fr) * 512 + hh * 64 + 32 * ks + 8 * fq);
        const int nh = (4 * c + 2 >= 64) ? 2 : 1;
        const bf16_t* KCb = (const bf16_t*)(ws + WS_KC) + bk * 128 * 64; const bf16_t* VCb = (const bf16_t*)(ws + WS_VCT) + bk * 64 * 128;
        float lrow[2][4]; f32x4 O[2][4];
#pragma unroll
        for (int m = 0; m < 2; ++m) {
#pragma unroll
            for (int j = 0; j < 4; ++j) lrow[m][j] = 0.f;
#pragma unroll
            for (int nfd = 0; nfd < 4; ++nfd) O[m][nfd] = (f32x4){0.f, 0.f, 0.f, 0.f};
        }
        nsa_fetch(st, KCb, 64, VCb, 128, tid);
        BAR_LDS();
        nsa_commit(st, NSA_KTB(0), NSA_VTB(0), tid);
        if (nh == 2) { nsa_fetch(st, KCb + 64 * 64, 64, VCb + 64, 128, tid); nsa_commit(st, NSA_KTB(1), NSA_VTB(1), tid); }
        BAR_LDS();
        for (int half = 0; half < nh; ++half) nsa_tile(2, aq, NSA_KTB(half), NSA_VTB(half), PWw, lrow, O, 0xffu, 3, ibase, 64 * c, 64 * half, fr, fq);
#pragma unroll
        for (int m = 0; m < 2; ++m)
#pragma unroll
            for (int j = 0; j < 4; ++j) { const int t = tok0 + ibase + 16 * m + 4 * fq + j; const float gt = sigmoidf_(bf2f(PROJ[(size_t)t * NPROJ + CGATE + hh * 3 + 0]));
                const float lt = red16_sum(lrow[m][j]);
                const float inv = lt > 0.f ? 1.f / lt : 0.f;
                lrow[m][j] = inv;
#pragma unroll
                for (int nfd = 0; nfd < 4; ++nfd) OUTw[(16 * m + 4 * fq + j) * 68 + 16 * nfd + fr] = gt * inv * O[m][nfd][j]; }
        BAR_LDS();
        float carry[2][4];
#pragma unroll
        for (int m = 0; m < 2; ++m)
#pragma unroll
            for (int j = 0; j < 4; ++j) carry[m][j] = 0.f;
        for (int half = 0; half < nh; ++half) {
            f32x4 S[2][4];
            int fr2 = fr, fq2 = fq;
            asm volatile("" : "+v"(fr2), "+v"(fq2));
            nsa_qk(aq, NSA_KTB(half), S, fr2, fq2);
#pragma unroll
            for (int m = 0; m < 2; ++m)
#pragma unroll
                for (int j = 0; j < 4; ++j) {
                    const int i = ibase + 16 * m + 4 * fq2 + j;
                    const int hi = ((64 * c + i - 31) >> 4) - 64 * half;
                    float pv[4];
#pragma unroll
                    for (int nf = 0; nf < 4; ++nf) pv[nf] = (4 * fr2 + nf <= hi) ? __builtin_amdgcn_exp2f(S[m][nf][j]) * lrow[m][j] : 0.f;
                    const float e1 = dppf<0x121>(pv[3]), e2 = dppf<0x121>(carry[m][j]);
                    const float extra = (fr2 == 0) ? e2 : e1;
                    IMPW[(g * 64 + i) * 33 + 16 * half + fr2] = ((pv[0] + pv[1]) + (pv[2] + pv[3])) + extra;
                    carry[m][j] = pv[3];
                }
        }
    }
    BAR_LDS();
    {
        LAS float* SC = (LAS float*)(lds + NSA_KT0);
#pragma unroll
        for (int q = 0; q < 4; ++q) { const int pr = q * NTHREADS + tid, i = pr >> 5, j = pr & 31;
            float v = NEGBIG;
            if (j <= c) { v = (IMPW[(0 * 64 + i) * 33 + j] + IMPW[(1 * 64 + i) * 33 + j]) + (IMPW[(2 * 64 + i) * 33 + j] + IMPW[(3 * 64 + i) * 33 + j]);
                if (j == 0 || j == c || j == c - 1) v += 1e4f; }
            SC[i * 33 + j] = v; }
        BAR_LDS();
#pragma unroll 1
        for (int q = 0; q < 4; ++q) { const int pr = q * NTHREADS + tid, i = pr >> 5, j = pr & 31;
            const float my = SC[i * 33 + j]; int rank = 0;
#pragma unroll
            for (int k = 0; k < 32; ++k) { const float o = SC[i * 33 + k]; rank += (o > my || (o == my && k < j)) ? 1 : 0; }
            const bool sel = (j <= c) && rank < 8;
            const unsigned long long bal = __ballot(sel);
            const unsigned msk = (lane & 32) ? (unsigned)(bal >> 32) : (unsigned)bal;
            if (j == 0) { SELM[i] = msk; atomicOr((unsigned*)UNI, msk); } }
    }
    BAR_LDS();
    const unsigned uni = *UNI;
#pragma unroll
    for (int m = 0; m < 2; ++m)
#pragma unroll
        for (int ks = 0; ks < 2; ++ks) aq[m][ks] = *(const bf16x8*)((const bf16_t*)(ws + WS_QR) + (size_t)(tok0 + ibase + 16 * m + fr) * 512 + hh * 64 + 32 * ks + 8 * fq);
#pragma unroll 1
    for (int br = 0; br < 2; ++br) {
        float lrow[2][4]; f32x4 O[2][4];
#pragma unroll
        for (int m = 0; m < 2; ++m) {
#pragma unroll
            for (int j = 0; j < 4; ++j) lrow[m][j] = 0.f;
#pragma unroll
            for (int nfd = 0; nfd < 4; ++nfd) O[m][nfd] = (f32x4){0.f, 0.f, 0.f, 0.f};
        }
        const bf16_t* Kb = (const bf16_t*)(ws + (br ? WS_KW : WS_KS)) + bk * SEQ * 64;
        const bf16_t* Vb = (const bf16_t*)(ws + (br ? WS_VWT : WS_VST)) + bk * 32 * 4096;
        unsigned todo = br ? ((c >= 8 ? (0x1ffu << (c - 8)) : ((2u << c) - 1u))) : (uni & ((c == 31) ? 0xffffffffu : ((2u << c) - 1u)));
#define NSA_POP(dst) do { if (todo) { dst = __builtin_ctz(todo); todo &= todo - 1u; } else dst = -1; } while (0)
#define NSA_FETCH(stg, t) nsa_fetch(stg, Kb + (size_t)(t) * 4096, 64, Vb + (size_t)(t) * 4096, 64, tid)
#define NSA_COMPUTE(t, bufi) do { unsigned rowok = 0xffu; int mode = 0, mm = 0; \
            if ((t) == c) { mode = 1; mm = 2; } \
            else if (br == 1) { if ((t) == c - 8) { mode = 2; mm = 2; } } \
            else if ((t) != 0 && (t) != c - 1) { rowok = 0u; mm = 1; \
                _Pragma("unroll") for (int m = 0; m < 2; ++m) _Pragma("unroll") for (int j = 0; j < 4; ++j) rowok |= ((SELM[ibase + 16 * m + 4 * fq + j] >> (t)) & 1u) << (m * 4 + j); } \
            nsa_tile(mm, aq, NSA_KTB(bufi), NSA_VTB(bufi), PWw, lrow, O, rowok, mode, ibase, 0, 0, fr, fq); } while (0)
        NsaStage stY;
        int t0, t1, t2, t3;
        NSA_POP(t0); NSA_POP(t1); NSA_POP(t2);
        NSA_FETCH(st, t0);
        BAR_LDS();
        nsa_commit(st, NSA_KTB(0), NSA_VTB(0), tid);
        if (t1 >= 0) NSA_FETCH(st, t1);
        if (t2 >= 0) NSA_FETCH(stY, t2);
        BAR_LDS();
        for (;;) {
            NSA_COMPUTE(t0, 0);
            if (t1 < 0) break;
            nsa_commit(st, NSA_KTB(1), NSA_VTB(1), tid);
            NSA_POP(t3); if (t3 >= 0) NSA_FETCH(st, t3);
            BAR_LDS();
            t0 = t1; t1 = t2; t2 = t3;
            NSA_COMPUTE(t0, 1);
            if (t1 < 0) break;
            nsa_commit(stY, NSA_KTB(0), NSA_VTB(0), tid);
            NSA_POP(t3); if (t3 >= 0) NSA_FETCH(stY, t3);
            BAR_LDS();
            t0 = t1; t1 = t2; t2 = t3;
        }
#undef NSA_POP
#undef NSA_FETCH
#undef NSA_COMPUTE
#pragma unroll
        for (int m = 0; m < 2; ++m)
#pragma unroll
            for (int j = 0; j < 4; ++j) { const int t = tok0 + ibase + 16 * m + 4 * fq + j; const float gt = sigmoidf_(bf2f(PROJ[(size_t)t * NPROJ + CGATE + hh * 3 + 1 + br]));
                const float lt = red16_sum(lrow[m][j]);
                const float sc = lt > 0.f ? gt / lt : 0.f;
#pragma unroll
                for (int nfd = 0; nfd < 4; ++nfd) OUTw[(16 * m + 4 * fq + j) * 68 + 16 * nfd + fr] += sc * O[m][nfd][j]; }
    }
    LDS_WAIT();
#pragma unroll
    for (int q = 0; q < 4; ++q) {
        const int r = 8 * q + (lane >> 3), ch = lane & 7;
        const LAS f32x4* src = (const LAS f32x4*)(OUTw + r * 68 + 8 * ch);
        const f32x4 a = src[0], bq = src[1];
        u32x4 o; o.x = pk2(a[0], a[1]); o.y = pk2(a[2], a[3]); o.z = pk2(bq[0], bq[1]); o.w = pk2(bq[2], bq[3]);
        *(u32x4*)((bf16_t*)(ws + WS_ATT) + (size_t)(tok0 + ibase + r) * 1024 + hh * 64 + 8 * ch) = o;
    }
#undef NSA_KTB
#undef NSA_VTB
}

constexpr int GLA_QD = 0, GLA_KD = 10240, GLA_KST = 20480, GLA_VT = 30720, GLA_AT = 51200, GLA_ST = 61440, GLA_WG = 81920  , GLA_DEC = 86016  ,
              GLA_OT = 86528  , GLA_END = GLA_OT + 64 * 132 * 4;
static_assert(GLA_END <= LDS_BYTES - 64, "GLA LDS map");
template <int CTRL, int RMASK> __device__ __forceinline__ float dppf_rm(float v) { return __int_as_float(__builtin_amdgcn_update_dpp(0, __float_as_int(v), CTRL, RMASK, 0xf, false)); }
__device__ __forceinline__ float wave_incl_scan(float v) {
    v += __int_as_float(__builtin_amdgcn_update_dpp(0, __float_as_int(v), 0x111, 0xf, 0xf, true));
    v += __int_as_float(__builtin_amdgcn_update_dpp(0, __float_as_int(v), 0x112, 0xf, 0xf, true));
    v += __int_as_float(__builtin_amdgcn_update_dpp(0, __float_as_int(v), 0x114, 0xf, 0xf, true));
    v += __int_as_float(__builtin_amdgcn_update_dpp(0, __float_as_int(v), 0x118, 0xf, 0xf, true));
    v += dppf_rm<0x142, 0xa>(v);
    v += dppf_rm<0x143, 0xc>(v);
    return v;
}
struct GlaStage { u32x4 q, k, g0, g1, v0, v1; };
__device__ __forceinline__ void gla_fetch(GlaStage& st, const bf16_t* PROJ, int tok0, int h, int lane, int w) {
    const bf16_t* row = PROJ + (size_t)(tok0 + lane) * NPROJ;
    st.q = *(const u32x4*)(row + CGQ + h * 64 + 8 * w);
    st.k = *(const u32x4*)(row + CGK + h * 64 + 8 * w);
    st.g0 = *(const u32x4*)(row + CGLR); st.g1 = *(const u32x4*)(row + CGLR + 8);
    st.v0 = *(const u32x4*)(row + CGV + h * 128 + 16 * w); st.v1 = *(const u32x4*)(row + CGV + h * 128 + 16 * w + 8);
}
__device__ __forceinline__ float bflo(unsigned u) { return __uint_as_float(u << 16); }
__device__ __forceinline__ float bfhi(unsigned u) { return __uint_as_float(u & 0xffff0000u); }

__device__ __forceinline__ void gla_unit(const Params& p, LAS unsigned char* lds, int b, int h) {
    const int tid = opaque_tid(), lane = tid & 63, w = tid >> 6, fr = lane & 15, fq = lane >> 4;
    unsigned char* ws = p.ws;
    const bf16_t* PROJ = (const bf16_t*)(ws + WS_PROJ);
    LAS bf16_t* Qd = (LAS bf16_t*)(lds + GLA_QD); LAS bf16_t* Kd = (LAS bf16_t*)(lds + GLA_KD); LAS bf16_t* KsT = (LAS bf16_t*)(lds + GLA_KST);
    LAS bf16_t* VT = (LAS bf16_t*)(lds + GLA_VT); LAS bf16_t* At = (LAS bf16_t*)(lds + GLA_AT); LAS bf16_t* ST = (LAS bf16_t*)(lds + GLA_ST);
    LAS float* WG = (LAS float*)(lds + GLA_WG); LAS float* DEC = (LAS float*)(lds + GLA_DEC); LAS float* OT = (LAS float*)(lds + GLA_OT);
    BAR_LDS();
    for (int i = tid; i < 16 * 64; i += NTHREADS) WG[i] = p.in[12][(i >> 6) * 256 + h * 64 + (i & 63)];
    for (int i = tid; i < 128 * 80 / 2; i += NTHREADS) ((LAS unsigned*)ST)[i] = 0u;
    float bg[8];
#pragma unroll
    for (int q = 0; q < 8; ++q) bg[q] = p.in[13][h * 64 + 8 * w + q];
    const int md = w & 3, nfe0 = 4 * (w >> 2);
    f32x4 Sreg[4];
#pragma unroll
    for (int x = 0; x < 4; ++x) Sreg[x] = (f32x4){0.f, 0.f, 0.f, 0.f};
    GlaStage st;
    gla_fetch(st, PROJ, b * SEQ, h, lane, w);
    BAR_LDS();
#pragma unroll 1
    for (int n = 0; n < 32; ++n) {
        const int tok0 = b * SEQ + n * 64;
        float gl[16];
        { const unsigned gw[8] = {st.g0.x, st.g0.y, st.g0.z, st.g0.w, st.g1.x, st.g1.y, st.g1.z, st.g1.w};
#pragma unroll
          for (int q = 0; q < 8; ++q) { gl[2 * q] = bflo(gw[q]); gl[2 * q + 1] = bfhi(gw[q]); } }
        float bcum[8], blast[8];
#pragma unroll
        for (int q = 0; q < 8; ++q) {
            float x = bg[q];
#pragma unroll
            for (int r = 0; r < 16; ++r) x += gl[r] * WG[r * 64 + 8 * w + q];
            const float la = (fminf(x, 0.f) - __logf(1.f + __expf(-fabsf(x)))) * (1.f / 16.f);
            bcum[q] = wave_incl_scan(la);
            blast[q] = __int_as_float(__builtin_amdgcn_readlane(__float_as_int(bcum[q]), 63));
        }
        {
            const unsigned qw[4] = {st.q.x, st.q.y, st.q.z, st.q.w}, kw[4] = {st.k.x, st.k.y, st.k.z, st.k.w};
            unsigned qo[4], ko[4];
#pragma unroll
            for (int q2 = 0; q2 < 4; ++q2) {
                const float e0 = __expf(bcum[2 * q2]), e1 = __expf(bcum[2 * q2 + 1]);
                const float i0 = __expf(-bcum[2 * q2]), i1 = __expf(-bcum[2 * q2 + 1]);
                const float k0 = bflo(kw[q2]), k1 = bfhi(kw[q2]);
                qo[q2] = pg8::cvt_pk_bf16(bflo(qw[q2]) * 0.125f * e0, bfhi(qw[q2]) * 0.125f * e1);
                ko[q2] = pg8::cvt_pk_bf16(k0 * i0, k1 * i1);
                KsT[(8 * w + 2 * q2) * 80 + lane] = (bf16_t)f2bf(k0 * __expf(blast[2 * q2] - bcum[2 * q2]));
                KsT[(8 * w + 2 * q2 + 1) * 80 + lane] = (bf16_t)f2bf(k1 * __expf(blast[2 * q2 + 1] - bcum[2 * q2 + 1]));
            }
            *(LAS u32x4*)(Qd + lane * 80 + 8 * w) = (u32x4){qo[0], qo[1], qo[2], qo[3]};
            *(LAS u32x4*)(Kd + lane * 80 + 8 * w) = (u32x4){ko[0], ko[1], ko[2], ko[3]};
            if (lane == 63) {
#pragma unroll
                for (int q = 0; q < 8; ++q) DEC[(n & 1) * 64 + 8 * w + q] = __expf(bcum[q]);
            }
            const unsigned vw[8] = {st.v0.x, st.v0.y, st.v0.z, st.v0.w, st.v1.x, st.v1.y, st.v1.z, st.v1.w};
#pragma unroll
            for (int q = 0; q < 8; ++q) { VT[(16 * w + 2 * q) * 80 + lane] = (bf16_t)(vw[q] & 0xffffu); VT[(16 * w + 2 * q + 1) * 80 + lane] = (bf16_t)(vw[q] >> 16); }
        }
        if (n < 31) gla_fetch(st, PROJ, tok0 + 64, h, lane, w);
        const int ec = tid >> 3, eg = tid & 7;
        const u32x4 r0 = *(const u32x4*)(PROJ + (size_t)(tok0 + ec) * NPROJ + CGR + h * 128 + 16 * eg), r1 = *(const u32x4*)(PROJ + (size_t)(tok0 + ec) * NPROJ + CGR + h * 128 + 16 * eg + 8);
        BAR_LDS();
        {
            const int m = w >> 1;
            bf16x8 a[2];
#pragma unroll
            for (int ks = 0; ks < 2; ++ks) a[ks] = *(const LAS bf16x8*)(Qd + (16 * m + fr) * 80 + 32 * ks + 8 * fq);
#pragma unroll
            for (int x = 0; x < 2; ++x) { const int nf = 2 * (w & 1) + x;
                f32x4 s = (f32x4){0.f, 0.f, 0.f, 0.f};
                if (nf <= m) {
#pragma unroll
                    for (int ks = 0; ks < 2; ++ks) { const bf16x8 bk = *(const LAS bf16x8*)(Kd + (16 * nf + fr) * 80 + 32 * ks + 8 * fq); s = __builtin_amdgcn_mfma_f32_16x16x32_bf16(a[ks], bk, s, 0, 0, 0); }
                }
#pragma unroll
                for (int j = 0; j < 4; ++j) { const int cc = 16 * m + 4 * fq + j, ss = 16 * nf + fr; At[cc * 80 + ss] = (bf16_t)f2bf(ss <= cc ? s[j] : 0.f); } }
        }
        f32x4 U[4];
        {
            bf16x8 a[2];
#pragma unroll
            for (int ks = 0; ks < 2; ++ks) a[ks] = *(const LAS bf16x8*)(KsT + (16 * md + fr) * 80 + 32 * ks + 8 * fq);
#pragma unroll
            for (int x = 0; x < 4; ++x) { f32x4 s = (f32x4){0.f, 0.f, 0.f, 0.f};
#pragma unroll
                for (int ks = 0; ks < 2; ++ks) { const bf16x8 bv = *(const LAS bf16x8*)(VT + (16 * (nfe0 + x) + fr) * 80 + 32 * ks + 8 * fq); s = __builtin_amdgcn_mfma_f32_16x16x32_bf16(a[ks], bv, s, 0, 0, 0); }
                U[x] = s; }
        }
        BAR_LDS();
        {
            bf16x8 aa[2], aq2[2];
#pragma unroll
            for (int ks = 0; ks < 2; ++ks) { aa[ks] = *(const LAS bf16x8*)(At + (16 * md + fr) * 80 + 32 * ks + 8 * fq); aq2[ks] = *(const LAS bf16x8*)(Qd + (16 * md + fr) * 80 + 32 * ks + 8 * fq); }
#pragma unroll
            for (int x = 0; x < 4; ++x) { f32x4 s = (f32x4){0.f, 0.f, 0.f, 0.f};
#pragma unroll
                for (int ks = 0; ks < 2; ++ks) { const bf16x8 bv = *(const LAS bf16x8*)(VT + (16 * (nfe0 + x) + fr) * 80 + 32 * ks + 8 * fq); s = __builtin_amdgcn_mfma_f32_16x16x32_bf16(aa[ks], bv, s, 0, 0, 0); }
#pragma unroll
                for (int ks = 0; ks < 2; ++ks) { const bf16x8 bs = *(const LAS bf16x8*)(ST + (16 * (nfe0 + x) + fr) * 80 + 32 * ks + 8 * fq); s = __builtin_amdgcn_mfma_f32_16x16x32_bf16(aq2[ks], bs, s, 0, 0, 0); }
#pragma unroll
                for (int j = 0; j < 4; ++j) OT[(16 * md + 4 * fq + j) * 132 + 16 * (nfe0 + x) + fr] = s[j]; }
        }
        BAR_LDS();
        {
            const LAS f32x4* dp = (const LAS f32x4*)(DEC + (n & 1) * 64 + 16 * md + 4 * fq); const f32x4 dc = dp[0];
#pragma unroll
            for (int x = 0; x < 4; ++x) { Sreg[x] = dc * Sreg[x] + U[x];
                u32x2 o; o.x = pg8::cvt_pk_bf16(Sreg[x][0], Sreg[x][1]); o.y = pg8::cvt_pk_bf16(Sreg[x][2], Sreg[x][3]);
                *(LAS u32x2*)(ST + (16 * (nfe0 + x) + fr) * 80 + 16 * md + 4 * fq) = o; }
        }
        {
            const LAS f32x4* op = (const LAS f32x4*)(OT + ec * 132 + 16 * eg);
            f32x4 o[4]; float ss = 0.f;
#pragma unroll
            for (int q = 0; q < 4; ++q) { o[q] = op[q]; ss += (o[q].x * o[q].x + o[q].y * o[q].y) + (o[q].z * o[q].z + o[q].w * o[q].w); }
            ss += dppf<0xB1>(ss); ss += dppf<0x4E>(ss); ss += dppf<0x141>(ss);
            const float rstd = 1.f / sqrtf(ss * (1.f / 128.f) + EPS);
            const unsigned rw[8] = {r0.x, r0.y, r0.z, r0.w, r1.x, r1.y, r1.z, r1.w};
            const float* gn = p.in[14] + 16 * eg;
            unsigned ow[8];
#pragma unroll
            for (int q = 0; q < 8; ++q) { const float ra = bflo(rw[q]), rb = bfhi(rw[q]);
                const float ya = o[q >> 1][(2 * q) & 3] * rstd * gn[2 * q] * (ra * sigmoidf_(ra)), yb = o[q >> 1][(2 * q + 1) & 3] * rstd * gn[2 * q + 1] * (rb * sigmoidf_(rb));
                ow[q] = pg8::cvt_pk_bf16(ya, yb); }
            u32x4* dst = (u32x4*)((bf16_t*)(ws + WS_ATT) + (size_t)(tok0 + ec) * 1024 + 512 + h * 128 + 16 * eg);
            dst[0] = (u32x4){ow[0], ow[1], ow[2], ow[3]}; dst[1] = (u32x4){ow[4], ow[5], ow[6], ow[7]};
        }
    }
}

__device__ __forceinline__ void p6_chunk(const Params& p, LAS unsigned char* lds, int chunk) {
    const int tid = opaque_tid(), lane = tid & 63, wave = tid >> 6, fr = lane & 15, fq = lane >> 4;
    unsigned char* ws = p.ws;
    LAS int* lcnt = (LAS int*)lds;
    LAS float* LG = (LAS float*)(lds + 256) + wave * (16 * 33 + 16);
    LAS float* RS = LG + 16 * 33;
    if (tid < NEXP) lcnt[tid] = 0;
    __syncthreads();
    const float* WRT = (const float*)(ws + WS_WRT);
    const float* X1 = (const float*)(ws + WS_X1);
    const int t0 = chunk * 128 + wave * 16;
    {
        const float* ap = X1 + (size_t)(t0 + fr) * DM + 4 * fq;
        const float* bp0 = WRT + (size_t)fr * DM + 4 * fq; const float* bp1 = bp0 + 16 * DM;
        f32x4 acc0 = (f32x4){0.f, 0.f, 0.f, 0.f}, acc1 = (f32x4){0.f, 0.f, 0.f, 0.f};
        float ssq = 0.f;
#pragma unroll 4
        for (int ks = 0; ks < 64; ++ks) {
            const f32x4 a4 = *(const f32x4*)(ap + 16 * ks), b0 = *(const f32x4*)(bp0 + 16 * ks), b1 = *(const f32x4*)(bp1 + 16 * ks);
            ssq += (a4.x * a4.x + a4.y * a4.y) + (a4.z * a4.z + a4.w * a4.w);
#pragma unroll
            for (int i = 0; i < 4; ++i) { acc0 = __builtin_amdgcn_mfma_f32_16x16x4f32(a4[i], b0[i], acc0, 0, 0, 0); acc1 = __builtin_amdgcn_mfma_f32_16x16x4f32(a4[i], b1[i], acc1, 0, 0, 0); }
        }
        ssq += __shfl_xor(ssq, 16); ssq += __shfl_xor(ssq, 32);
        const float rstd = 1.f / sqrtf(ssq * (1.f / DM) + EPS);
        if (fq == 0) RS[fr] = rstd;
#pragma unroll
        for (int j = 0; j < 4; ++j) { LG[(4 * fq + j) * 33 + fr] = acc0[j]; LG[(4 * fq + j) * 33 + 16 + fr] = acc1[j]; }
    }
    LDS_WAIT();
    if (lane < 16) {
        const int t = t0 + lane; const float rstd = RS[lane];
        unsigned taken = 0u; float tv[4]; int te[4];
#pragma unroll
        for (int r = 0; r < 4; ++r) { float best = -3e38f; int be = 0;
#pragma unroll 8
            for (int e = 0; e < 32; ++e) { const float v = LG[lane * 33 + e] * rstd + p.in[18][e]; const bool can = !((taken >> e) & 1u); if (can && v > best) { best = v; be = e; } }
            taken |= 1u << be; tv[r] = best; te[r] = be; }
        const float e0 = 1.f, e1 = __expf(tv[1] - tv[0]), e2 = __expf(tv[2] - tv[0]), e3 = __expf(tv[3] - tv[0]);
        const float inv = 1.f / (e0 + e1 + e2 + e3);
        *(int4*)((int*)(ws + WS_TOPI) + (size_t)t * 4) = make_int4(te[0], te[1], te[2], te[3]);
        *(f32x4*)((float*)(ws + WS_TOPG) + (size_t)t * 4) = (f32x4){e0 * inv, e1 * inv, e2 * inv, e3 * inv};
        atomicAdd((int*)&lcnt[te[0]], 1); atomicAdd((int*)&lcnt[te[1]], 1); atomicAdd((int*)&lcnt[te[2]], 1); atomicAdd((int*)&lcnt[te[3]], 1);
    }
    {
        const f32x4* gr = (const f32x4*)p.in[16] + lane;
        f32x4 gg[4];
#pragma unroll
        for (int j = 0; j < 4; ++j) gg[j] = gr[64 * j];
#pragma unroll 1
        for (int ti = 0; ti < 16; ti += 4) {
            f32x4 v[4][4];
#pragma unroll
            for (int r = 0; r < 4; ++r) { const f32x4* xr = (const f32x4*)(X1 + (size_t)(t0 + ti + r) * DM) + lane;
#pragma unroll
                for (int j = 0; j < 4; ++j) v[r][j] = xr[64 * j]; }
#pragma unroll
            for (int r = 0; r < 4; ++r) { const float rstd = RS[ti + r];
                unsigned* o4 = (unsigned*)(ws + WS_H + (size_t)(t0 + ti + r) * DM) + lane;
#pragma unroll
                for (int j = 0; j < 4; ++j) { const f32x4 o = v[r][j] * rstd * gg[j]; o4[64 * j] = pk4_fp8(o.x, o.y, o.z, o.w); } }
        }
    }
    __syncthreads();
    if (tid < NEXP) atomicAdd((int*)(ws + WS_CTL) + CW_CNT + tid, lcnt[tid]);
    __syncthreads();
}

__device__ __forceinline__ int build_tile_table(const Params& p, LAS int* tstart, LAS int* tile_e) {
    const int tid = opaque_tid();
    const int* cnt = (const int*)(p.ws + WS_CTL) + CW_CNT;
    if (tid == 0) { int acc = 0; for (int e = 0; e < NEXP; ++e) { tstart[e] = acc; acc += (__hip_atomic_load(cnt + e, __ATOMIC_RELAXED, __HIP_MEMORY_SCOPE_AGENT) + 255) >> 8; } tstart[NEXP] = acc; }
    __syncthreads();
    const int total = tstart[NEXP];
    for (int i = tid; i < total; i += NTHREADS) { int e = 0;
        for (int q = 1; q < NEXP; ++q) if (tstart[q] <= i) e = q;
        tile_e[i] = e; }
    __syncthreads();
    return total;
}

__device__ __forceinline__ void p7_chunk(const Params& p, LAS unsigned char* lds, int chunk, const LAS int* tstart) {
    const int tid = opaque_tid(), lane = tid & 63, wave = tid >> 6;
    unsigned char* ws = p.ws;
    LAS int* lc = (LAS int*)lds; LAS int* lbase = lc + 32; LAS int* ldst = lbase + 32;
    if (tid < NEXP) lc[tid] = 0;
    __syncthreads();
    const int t = chunk * 128 + (tid >> 2), k = tid & 3;
    const int e = ((const int*)(ws + WS_TOPI))[(size_t)t * 4 + k];
    const int rank = atomicAdd((int*)&lc[e], 1);
    __syncthreads();
    if (tid < NEXP) lbase[tid] = atomicAdd((int*)(ws + WS_CTL) + CW_FILL + tid, lc[tid]);
    __syncthreads();
    const int dest = tstart[e] * 256 + lbase[e] + rank;
    ((int*)(ws + WS_DEST))[(size_t)t * 4 + k] = dest;
    ldst[tid] = dest;
    __syncthreads();
#pragma unroll 1
    for (int ti = 0; ti < 16; ti += 4) {
        u32x4 a[4];
#pragma unroll
        for (int r = 0; r < 4; ++r) a[r] = *((const u32x4*)(ws + WS_H + (size_t)(chunk * 128 + wave * 16 + ti + r) * DM) + lane);
#pragma unroll
        for (int r = 0; r < 4; ++r)
#pragma unroll
            for (int kk = 0; kk < 4; ++kk) *((u32x4*)(ws + WS_XS + (size_t)ldst[(wave * 16 + ti + r) * 4 + kk] * DM) + lane) = a[r];
    }
    __syncthreads();
}

__device__ __forceinline__ void p10_tokens(const Params& p, int t0, int lane) {
    unsigned char* ws = p.ws;
    int4 d4[2]; f32x4 g4[2];
#pragma unroll
    for (int q = 0; q < 2; ++q) { d4[q] = *(const int4*)((const int*)(ws + WS_DEST) + (size_t)(t0 + q) * 4); g4[q] = *(const f32x4*)((const float*)(ws + WS_TOPG) + (size_t)(t0 + q) * 4); }
    f32x4 xa[2][4]; u32x4 yv[2][4][2];
#pragma unroll
    for (int q = 0; q < 2; ++q) {
        const f32x4* xr = (const f32x4*)((const float*)(ws + WS_X1) + (size_t)(t0 + q) * DM);
#pragma unroll
        for (int h2 = 0; h2 < 2; ++h2) { xa[q][2 * h2] = __builtin_nontemporal_load(xr + h2 * 128 + lane * 2); xa[q][2 * h2 + 1] = __builtin_nontemporal_load(xr + h2 * 128 + lane * 2 + 1); }
        const int dd[4] = {d4[q].x, d4[q].y, d4[q].z, d4[q].w};
#pragma unroll
        for (int k = 0; k < 4; ++k)
#pragma unroll
            for (int h2 = 0; h2 < 2; ++h2) yv[q][k][h2] = __builtin_nontemporal_load((const u32x4*)((const bf16_t*)(ws + WS_Y) + (size_t)dd[k] * DM) + h2 * 64 + lane);
    }
#pragma unroll
    for (int q = 0; q < 2; ++q) {
        f32x4* orow = (f32x4*)(p.out + (size_t)(t0 + q) * DM);
#pragma unroll
        for (int h2 = 0; h2 < 2; ++h2) {
            f32x4 a0 = xa[q][2 * h2], a1 = xa[q][2 * h2 + 1];
#pragma unroll
            for (int k = 0; k < 4; ++k) { const u32x4 y = yv[q][k][h2]; const float gk = g4[q][k];
                a0.x += gk * __uint_as_float(y.x << 16); a0.y += gk * __uint_as_float(y.x & 0xffff0000u);
                a0.z += gk * __uint_as_float(y.y << 16); a0.w += gk * __uint_as_float(y.y & 0xffff0000u);
                a1.x += gk * __uint_as_float(y.z << 16); a1.y += gk * __uint_as_float(y.z & 0xffff0000u);
                a1.z += gk * __uint_as_float(y.w << 16); a1.w += gk * __uint_as_float(y.w & 0xffff0000u); }
            orow[h2 * 128 + lane * 2] = a0; orow[h2 * 128 + lane * 2 + 1] = a1;
        }
    }
}

#define XB_TMO      128
#define XB_XCNT(j)  (256  + 64 * (j))
#define XB_XSUB(j)  (1280 + 64 * (j))
#define XB_XGEN(j)  (2304 + 64 * (j))
#define XB_TOP      3328
#define XB_TOPGEN   3392
#define XCD_BAR_WORDS 3456
#define XB_SPIN_CAP (1u << 22)
__device__ __forceinline__ unsigned xb_ld(unsigned* p)              { return __hip_atomic_load(p, __ATOMIC_RELAXED, __HIP_MEMORY_SCOPE_AGENT); }
__device__ __forceinline__ unsigned xb_add(unsigned* p, unsigned v) { return __hip_atomic_fetch_add(p, v, __ATOMIC_RELAXED, __HIP_MEMORY_SCOPE_AGENT); }
__device__ __forceinline__ unsigned xb_xcc_id() { return (unsigned)__builtin_amdgcn_s_getreg((3 << 11) | 20) & 0xFu; }
#define XB_SPIN(cond, bar) do { unsigned _sp = 0; while (cond) { __builtin_amdgcn_s_sleep(1); \
    if ((++_sp & 255u) == 0u) { if (xb_ld(&(bar)[XB_TMO])) break; if (_sp > XB_SPIN_CAP) { atomicAdd(&(bar)[XB_TMO], 1u); break; } } } } while (0)
struct XcdBarrier { unsigned* bar; unsigned x; volatile LAS unsigned* st; };
__device__ __forceinline__ XcdBarrier xcd_barrier_post(unsigned* bar, volatile LAS unsigned* st) {
    XcdBarrier b; b.bar = bar; b.x = xb_xcc_id(); b.st = st;
    if (threadIdx.x == 0) (void)xb_add(&bar[XB_XCNT(b.x)], 1u);
    return b;
}
__device__ __forceinline__ void xcd_barrier_complete(unsigned* bar, unsigned x, unsigned& nloc, unsigned& nx) {
    const unsigned G = gridDim.x * gridDim.y * gridDim.z;
    unsigned sum, cnt, mine, sp = 0u;
    for (;;) {
        sum = 0u; cnt = 0u; mine = 0u;
#pragma unroll
        for (unsigned j = 0; j < 16; ++j) { const unsigned c = xb_ld(&bar[XB_XCNT(j)]); sum += c; cnt += (c > 0u) ? 1u : 0u; mine = (j == x) ? c : mine; }
        if (sum == G) break;
        __builtin_amdgcn_s_sleep(1);
        if ((++sp & 255u) == 0u) { if (xb_ld(&bar[XB_TMO])) break; if (sp > XB_SPIN_CAP) { atomicAdd(&bar[XB_TMO], 1u); break; } }
    }
    nloc = mine > 0u ? mine : 1u; nx = cnt > 0u ? cnt : 1u;
}
__device__ __forceinline__ void xcd_barrier(const XcdBarrier& b) {
    asm volatile("s_waitcnt vmcnt(0)" ::: "memory");
    __syncthreads();
    if (threadIdx.x == 0) {
        unsigned* bar = b.bar;
        __builtin_amdgcn_s_waitcnt(0);
        unsigned nloc = b.st[0], nx = b.st[1];
        if (nloc == 0u) { xcd_barrier_complete(bar, b.x, nloc, nx); b.st[0] = nloc; b.st[1] = nx; }
        const unsigned old = xb_add(&bar[XB_XSUB(b.x)], 1u);
        const unsigned gen = old / nloc;
        if (old + 1u == (gen + 1u) * nloc) {
            __builtin_amdgcn_fence(__ATOMIC_RELEASE, "agent");
            asm volatile("s_waitcnt vmcnt(0)" ::: "memory");
            const unsigned og = xb_add(&bar[XB_TOP], 1u);
            const unsigned tg = og / nx;
            if (og + 1u == (tg + 1u) * nx) xb_add(&bar[XB_TOPGEN], 1u);
            else XB_SPIN(xb_ld(&bar[XB_TOPGEN]) == tg, bar);
            __builtin_amdgcn_fence(__ATOMIC_ACQUIRE, "agent");
            xb_add(&bar[XB_XGEN(b.x)], 1u);
            asm volatile("s_waitcnt vmcnt(0)" ::: "memory");
        } else {
            XB_SPIN(xb_ld(&bar[XB_XGEN(b.x)]) == gen, bar);
            __builtin_amdgcn_fence(__ATOMIC_ACQUIRE, "agent");
            asm volatile("s_waitcnt vmcnt(0)" ::: "memory");
        }
    }
    __syncthreads();
}

template <int ph> __device__ __forceinline__ void mk_phase(const Params& p, LAS unsigned char* lds, int blk, int G) {
    unsigned char* ws = p.ws;
    const int tid = opaque_tid();
    if constexpr (ph == 0) { phase0(p, lds, blk, G); }
    else if constexpr (ph == 1) {
        pg8::Gemm g{ws + WS_H, ws + WS_WIN, 2 * DM};
        pg8::StaticOrder S{MTOK / 256, NPROJ / 256, G, blk};
        pg8::EpiBf16 E{(bf16_t*)(ws + WS_PROJ), NPROJ};
        pg8::gemm_phase<false>(lds, g, S, E);
    }
    else if constexpr (ph == 2) {
        LAS int* qslot = (LAS int*)(lds + LDS_BYTES - 64);
        for (;;) {
            __syncthreads();
            if (tid == 0) *qslot = (int)__hip_atomic_fetch_add((unsigned*)(ws + WS_CTL) + CW_Q2, 1u, __ATOMIC_RELAXED, __HIP_MEMORY_SCOPE_AGENT);
            __syncthreads();
            const int it = *qslot;
            if (it >= 128 + 512) break;
            if (it < 128) p2b_unit(p, lds, it); else p2a_unit(p, lds, it - 128);
        }
    }
    else if constexpr (ph == 3) {
        LAS int* qslot = (LAS int*)(lds + LDS_BYTES - 64);
        for (;;) {
            __syncthreads();
            if (tid == 0) *qslot = (int)__hip_atomic_fetch_add((unsigned*)(ws + WS_CTL) + CW_Q3, 1u, __ATOMIC_RELAXED, __HIP_MEMORY_SCOPE_AGENT);
            __syncthreads();
            const int it = *qslot;
            if (it >= 64 + 1024) break;
            if (it < 64) gla_unit(p, lds, it >> 2, it & 3);
            else { const int u = it - 64, c = 31 - (u >> 5), bkh = u & 31; nsa_unit(p, lds, bkh >> 1, bkh & 1, c); }
        }
    }
    else if constexpr (ph == 4) { }
    else if constexpr (ph == 5) {
        pg8::Gemm g{ws + WS_ATT, ws + WS_WOUT, 2 * DM};
        pg8::StaticOrder S{MTOK / 256, DM / 256, G, blk};
        pg8::EpiResF32 E{p.in[0], (float*)(ws + WS_X1), DM};
        pg8::gemm_phase<false>(lds, g, S, E);
    }
    else if constexpr (ph == 6) { for (int ch = blk; ch < MTOK / 128; ch += G) p6_chunk(p, lds, ch); }
    else if constexpr (ph == 7) {
        LAS int* tstart = (LAS int*)(lds + 8192); LAS int* tile_e = tstart + 64;
        build_tile_table(p, tstart, tile_e);
        for (int ch = blk; ch < MTOK / 128; ch += G) p7_chunk(p, lds, ch, tstart);
    }
    else if constexpr (ph == 8) {
        LAS int* tstart = (LAS int*)(lds + pg8::STAGE_BYTES); LAS int* tile_e = tstart + 64;
        const int total = build_tile_table(p, tstart, tile_e);
        pg8::Gemm g{ws + WS_XS, ws + WS_WGU, DM};
        pg8::MoeOrder S{total, 8, G, blk, tile_e};
        pg8::EpiSwiglu E{ws + WS_ACT, p.in[20], 8};
        pg8::gemm_phase<true>(lds, g, S, E);
    }
    else if constexpr (ph == 9) {
        LAS int* tstart = (LAS int*)(lds + pg8::STAGE_BYTES); LAS int* tile_e = tstart + 64;
        const int total = build_tile_table(p, tstart, tile_e);
        pg8::Gemm g{ws + WS_ACT, ws + WS_WD, DFF};
        pg8::MoeOrder S{total, 4, G, blk, tile_e};
        pg8::EpiDown E{(bf16_t*)(ws + WS_Y), p.in[22], 4};
        pg8::gemm_phase<true>(lds, g, S, E);
    }
    else if constexpr (ph == 10) { for (int t = (blk * 8 + (tid >> 6)) * 2; t < MTOK; t += G * 16) p10_tokens(p, t, tid & 63); }
}

constexpr int NPHASES = 11;

template <int PH> __global__ void __launch_bounds__(NTHREADS, 2) mk_one(Params p) {
    extern __shared__ __attribute__((aligned(16))) unsigned char lds_raw[];
    mk_phase<PH>(p, (LAS unsigned char*)lds_raw, blockIdx.x, gridDim.x);
}
#if MK_ONE_LAUNCH
#define MK_RUN(PH) mk_phase<PH>(p, lds, blk, G)
__global__ void __launch_bounds__(NTHREADS, 2) mk_fwd(Params p) {
    extern __shared__ __attribute__((aligned(16))) unsigned char lds_raw[];
    LAS unsigned char* lds = (LAS unsigned char*)lds_raw;
    const int blk = blockIdx.x, G = gridDim.x;
    volatile LAS unsigned* bst = (volatile LAS unsigned*)(lds + LDS_BYTES - 16);
    if (threadIdx.x < 4) bst[threadIdx.x] = 0u;
    __syncthreads();
    const XcdBarrier gbar = xcd_barrier_post((unsigned*)(p.ws + WS_CTL) + CW_BAR, bst);
#define GSYNC() xcd_barrier(gbar)
#ifndef MK_REP_PHASE
#define MK_REP_PHASE -1
#endif
#ifndef MK_REP_N
#define MK_REP_N 0
#endif
#define MK_STEP(PH) do { MK_RUN(PH); if (MK_REP_PHASE == (PH)) { for (int r_ = 0; r_ < MK_REP_N; ++r_) { GSYNC(); MK_RUN(PH); } } if (MK_REP_PHASE == 100 + (PH)) { for (int r_ = 0; r_ < MK_REP_N; ++r_) GSYNC(); } } while (0)
    MK_STEP(0); GSYNC(); MK_STEP(1); GSYNC(); MK_STEP(2); GSYNC(); MK_STEP(3); GSYNC(); MK_STEP(5); GSYNC();
    MK_STEP(6); GSYNC(); MK_STEP(7); GSYNC(); MK_STEP(8); GSYNC(); MK_STEP(9); GSYNC(); MK_STEP(10);
}
#endif

extern "C" void kernel_launch(void* const* d_in, const int* in_sizes, int n_in, void* d_out, int out_size, void* d_ws, size_t ws_size, hipStream_t stream) {
    static int grid = 0;
    if (grid == 0) {
        int dev = 0, cus = 0, per_cu = 0;
        (void)hipGetDevice(&dev);
        (void)hipDeviceGetAttribute(&cus, hipDeviceAttributeMultiprocessorCount, dev);
#if MK_ONE_LAUNCH
        (void)hipFuncSetAttribute((const void*)mk_fwd, hipFuncAttributeMaxDynamicSharedMemorySize, LDS_BYTES);
        (void)hipOccupancyMaxActiveBlocksPerMultiprocessor(&per_cu, (const void*)mk_fwd, NTHREADS, LDS_BYTES);
#else
#define MK_ATTR(PH) (void)hipFuncSetAttribute((const void*)mk_one<PH>, hipFuncAttributeMaxDynamicSharedMemorySize, LDS_BYTES)
        MK_ATTR(0); MK_ATTR(1); MK_ATTR(2); MK_ATTR(3); MK_ATTR(4); MK_ATTR(5); MK_ATTR(6); MK_ATTR(7); MK_ATTR(8); MK_ATTR(9); MK_ATTR(10);
        per_cu = 1;
#endif
        if (per_cu < 1) { fprintf(stderr, "kernel_launch: occupancy query reports %d blocks/CU\n", per_cu); per_cu = 1; }
        grid = cus;
        if (ws_size < WS_END) { fprintf(stderr, "kernel_launch: workspace too small (%zu < %zu)\n", ws_size, (size_t)WS_END); grid = -1; }
        (void)hipGetLastError();
    }
    if (grid < 0) return;
    (void)hipMemsetAsync((char*)d_ws + WS_CTL, 0, CTL_BYTES, stream);
    Params p{};
    for (int i = 0; i < 23; ++i) p.in[i] = (const float*)d_in[i];
    p.out = (float*)d_out; p.ws = (unsigned char*)d_ws;
#if MK_ONE_LAUNCH
    hipLaunchKernelGGL(mk_fwd, dim3(grid), dim3(NTHREADS), LDS_BYTES, stream, p);
#else
#ifndef MK_DUP_PHASE
#define MK_DUP_PHASE -1
#endif
#define MK_LAUNCH1(PH) do { if ((PH) == 3 || (PH) == 2) (void)hipMemsetAsync((char*)d_ws + WS_CTL + 4 * CW_Q3, 0, 8, stream); if ((PH) == 6) (void)hipMemsetAsync((char*)d_ws + WS_CTL + 4 * CW_CNT, 0, 128, stream); if ((PH) == 7) (void)hipMemsetAsync((char*)d_ws + WS_CTL + 4 * CW_FILL, 0, 128, stream); hipLaunchKernelGGL(mk_one<PH>, dim3(grid), dim3(NTHREADS), LDS_BYTES, stream, p); } while (0)
#define MK_LAUNCH(PH) do { MK_LAUNCH1(PH); if (MK_DUP_PHASE == (PH)) MK_LAUNCH1(PH); } while (0)
    MK_LAUNCH(0); MK_LAUNCH(1); MK_LAUNCH(2); MK_LAUNCH(3); MK_LAUNCH(5); MK_LAUNCH(6); MK_LAUNCH(7); MK_LAUNCH(8); MK_LAUNCH(9); MK_LAUNCH(10);
#endif
}
```

```cpp
#include <hip/hip_runtime.h>
#include <hip/hip_cooperative_groups.h>
#include <cstdint>
#include <cstdio>
namespace cg = cooperative_groups;

#ifndef MK_ONE_LAUNCH
#define MK_ONE_LAUNCH 1
#endif

#define LAS __attribute__((address_space(3)))
typedef unsigned short bf16_t;
typedef short bf16x8 __attribute__((ext_vector_type(8)));
typedef float f32x4 __attribute__((ext_vector_type(4)));
typedef float f32x2 __attribute__((ext_vector_type(2)));
typedef unsigned u32x4 __attribute__((ext_vector_type(4)));
typedef unsigned u32x2 __attribute__((ext_vector_type(2)));
typedef int i32x8 __attribute__((ext_vector_type(8)));
typedef int i32x4 __attribute__((ext_vector_type(4)));

constexpr int NB = 16, SEQ = 2048, DM = 1024, MTOK = NB * SEQ;
constexpr int NPROJ = 3072;
constexpr int CQ = 0, CKC = 512, CVC = 640, CKS = 768, CVS = 896, CKW = 1024, CVW = 1152, CGQ = 1280, CGK = 1536, CGV = 1792, CGR = 2304, CGATE = 2816, CGLR = 2840;
constexpr int NEXP = 32, DFF = 1024;
constexpr int MAXTILES = 544, XROWS = MAXTILES * 256;
constexpr float EPS = 1e-6f;
constexpr int NTHREADS = 512;
constexpr int LDS_BYTES = 160 * 1024;

constexpr size_t MiB = 1u << 20;
constexpr size_t WS_CTL = 0;
constexpr size_t WS_WIN = 2 * MiB;
constexpr size_t WS_WOUT = 8 * MiB;
constexpr size_t WS_CW1K = 10 * MiB, WS_CW1V = 11 * MiB;
constexpr size_t WS_CW2K = 12 * MiB, WS_CW2V = 12 * MiB + 512 * 1024;
constexpr size_t WS_CBIAS = 13 * MiB;
constexpr size_t WS_WRT = 13 * MiB + 512 * 1024;
constexpr size_t WS_WGU = 16 * MiB;
constexpr size_t WS_WD = 144 * MiB;
constexpr size_t WS_H = 208 * MiB;
constexpr size_t WS_PROJ = 272 * MiB;
constexpr size_t WS_QN = 464 * MiB, WS_QR = 496 * MiB;
constexpr size_t WS_KS = 528 * MiB, WS_KW = 536 * MiB;
constexpr size_t WS_VST = 544 * MiB, WS_VWT = 552 * MiB;
constexpr size_t WS_KC = 560 * MiB, WS_VCT = 561 * MiB;
constexpr size_t WS_U = 562 * MiB;
constexpr size_t WS_OI = 626 * MiB;
constexpr size_t WS_QD = 690 * MiB;
constexpr size_t WS_DEC = 722 * MiB;
constexpr size_t WS_SP = 723 * MiB;
constexpr size_t WS_ATT = 787 * MiB;
constexpr size_t WS_TOPI = 851 * MiB, WS_TOPG = 852 * MiB, WS_DEST = 853 * MiB;
constexpr size_t WS_XS = 272 * MiB;
constexpr size_t WS_ACT = 544 * MiB;
constexpr size_t WS_Y = 272 * MiB;
constexpr size_t WS_X1 = 854 * MiB;
constexpr size_t WS_END = 982 * MiB;
constexpr int CW_CNT = 0, CW_FILL = 64, CW_Q3 = 128, CW_Q2 = 129, CW_QC = 130, CW_BAR = 1024;
constexpr int CTL_BYTES = 32768;

struct Params {
    const float* in[23];
    float* out;
    unsigned char* ws;
};

__device__ __forceinline__ float bf2f(bf16_t v) { return __uint_as_float(((unsigned)v) << 16); }
__device__ __forceinline__ unsigned f2bf(float f) { unsigned u = __float_as_uint(f); return (u + 0x7fffu + ((u >> 16) & 1u)) >> 16; }
__device__ __forceinline__ unsigned pk2(float lo, float hi) { return f2bf(lo) | (f2bf(hi) << 16); }
__device__ __forceinline__ unsigned pk4_fp8(float a, float b, float c, float d) { int r = __builtin_amdgcn_cvt_pk_fp8_f32(a, b, 0, false); r = __builtin_amdgcn_cvt_pk_fp8_f32(c, d, r, true); return (unsigned)r; }
__device__ __forceinline__ float wave_sum(float v) {
#pragma unroll
    for (int o = 1; o < 64; o <<= 1) v += __shfl_xor(v, o);
    return v;
}
#define LDS_WAIT() asm volatile("s_waitcnt lgkmcnt(0)" ::: "memory")
#define BAR_LDS() do { asm volatile("s_waitcnt lgkmcnt(0)" ::: "memory"); __builtin_amdgcn_s_barrier(); asm volatile("" ::: "memory"); } while (0)
__device__ __forceinline__ int opaque_tid() { int t = threadIdx.x; asm volatile("" : "+v"(t)); return t; }
__device__ __forceinline__ float sigmoidf_(float x) { return __builtin_amdgcn_rcpf(1.f + __builtin_amdgcn_exp2f(-1.4426950408889634f * x)); }
template <int CTRL> __device__ __forceinline__ float dppf(float v) { return __int_as_float(__builtin_amdgcn_update_dpp(0, __float_as_int(v), CTRL, 0xf, 0xf, true)); }
__device__ __forceinline__ float red16_max(float v) { v = fmaxf(v, dppf<0xB1>(v)); v = fmaxf(v, dppf<0x4E>(v)); v = fmaxf(v, dppf<0x141>(v)); v = fmaxf(v, dppf<0x140>(v)); return v; }
__device__ __forceinline__ float red16_sum(float v) { v += dppf<0xB1>(v); v += dppf<0x4E>(v); v += dppf<0x141>(v); v += dppf<0x140>(v); return v; }


namespace pg8 {
constexpr int BM = 256, BK = 64, HALF = 128, HTB = HALF * BK * 2, STAGE_BYTES = 8 * HTB, NXCD = 8, WGM = 8;
__device__ __forceinline__ int swz(int r) { const int p = (r >> 1) & 7, a = (p >> 2) & 1, b = (p >> 1) & 1, c = p & 1; return ((a ^ b) << 2) | (a << 1) | c; }
template <bool FP8> __device__ __forceinline__ int lds_byte(int r, int c) {
    if (FP8) return r * 128 + ((((c >> 3) ^ swz(r)) & 7) << 4);
    const int st = (r >> 4) * 2 + (c >> 5), rr = r & 15, cc = c & 31, ob = rr * 64 + cc * 2; return st * 1024 + (ob ^ (((ob >> 9) & 1) << 5));
}
template <bool FP8> __device__ __forceinline__ void stage_rc(int b, int& R, int& C) {
    if (FP8) { const int slot = b >> 4; R = slot >> 3; C = (((slot & 7) ^ swz(R)) & 7) * 8; }
    else { const int st = b / 1024, sb = b % 1024, sw = sb ^ (((sb >> 9) & 1) << 5); R = (st >> 1) * 16 + sw / 64; C = (st & 1) * 32 + (sw % 64) / 2; }
}
__device__ __forceinline__ int perm32(int rho) { const int n = rho >> 4, i = rho & 15; return 8 * (i >> 2) + 4 * n + (i & 3); }

struct Unit { int pm, pn, pb; };
struct Gemm { const void* A; const void* Bt; int Kb; };

__device__ __forceinline__ bool order_next(long L, int nM, int nN, int& pm, int& pn) {
    const int nwg = nM * nN; if (L >= nwg) return false;
    int wgid = (int)L; { const int q = nwg / NXCD, r = nwg % NXCD, xcd = wgid % NXCD, off = wgid / NXCD; wgid = (xcd < r ? xcd * (q + 1) : r * (q + 1) + (xcd - r) * q) + off; }
    const int nig = WGM * nN, gid = wgid / nig, fm = gid * WGM, gsz = (nM - fm) < WGM ? (nM - fm) : WGM;
    pm = fm + ((wgid % nig) % gsz); pn = (wgid % nig) / gsz; return true;
}
struct StaticOrder {
    int nM, nN, G, c;
    __device__ __forceinline__ bool next(int i, Unit& u) const { if (!order_next((long)i * G + c, nM, nN, u.pm, u.pn)) return false; u.pb = u.pn; return true; }
};
struct MoeOrder {
    int nM, nN, G, c; const LAS int* tile_e;
    __device__ __forceinline__ bool next(int i, Unit& u) const { if (!order_next((long)i * G + c, nM, nN, u.pm, u.pn)) return false; u.pb = __builtin_amdgcn_readfirstlane(tile_e[u.pm] * nN + u.pn); return true; }
};

__device__ __forceinline__ void mfma8_acc(f32x4& c, const i32x8& a, const i32x8& b, int scl) {
    asm volatile("v_mfma_scale_f32_16x16x128_f8f6f4 %0, %1, %2, %0, %3, %3 op_sel_hi:[0,0,0]" : "+v"(c) : "v"(a), "v"(b), "v"(scl)); }
__device__ __forceinline__ i32x8 cat8(i32x4 a, i32x4 b) { return __builtin_shufflevector(a, b, 0, 1, 2, 3, 4, 5, 6, 7); }
__device__ __forceinline__ i32x8 frag8(bf16x8 lo, bf16x8 hi) { const i32x4 a = __builtin_bit_cast(i32x4, lo), b = __builtin_bit_cast(i32x4, hi); return (i32x8){a.x, a.y, a.z, a.w, b.x, b.y, b.z, b.w}; }
__device__ __forceinline__ unsigned cvt_pk_bf16(float lo, float hi) { unsigned r; asm volatile("v_cvt_pk_bf16_f32 %0, %1, %2" : "=v"(r) : "v"(lo), "v"(hi)); return r; }

struct EpiBf16 {
    static constexpr bool PERM = true;
    struct Pre {}; __device__ __forceinline__ Pre prefetch(const Unit&, int, int, int, int) const { return Pre{}; }
    bf16_t* O; int ldc;
    __device__ __forceinline__ void operator()(const f32x4 (&acc)[2][2][4][2], const Unit& u, const Pre&, int wr, int wc, int fr, int fq) const {
        const int row0 = u.pm * BM + wr * 64 + fr, col0 = u.pn * BM + wc * 32 + 8 * fq;
#pragma unroll
        for (int ai = 0; ai < 2; ++ai)
#pragma unroll
            for (int m = 0; m < 4; ++m) { bf16_t* rowp = O + (size_t)(row0 + ai * HALF + m * 16) * ldc + col0;
#pragma unroll
                for (int bj = 0; bj < 2; ++bj) { const f32x4 v0 = acc[ai][bj][m][0], v1 = acc[ai][bj][m][1];
                    u32x4 w; w.x = cvt_pk_bf16(v0[0], v0[1]); w.y = cvt_pk_bf16(v0[2], v0[3]); w.z = cvt_pk_bf16(v1[0], v1[1]); w.w = cvt_pk_bf16(v1[2], v1[3]);
                    *(u32x4*)(rowp + bj * HALF) = w; } }
    }
};
struct EpiResF32 {
    static constexpr bool PERM = false;
    struct Pre {}; __device__ __forceinline__ Pre prefetch(const Unit&, int, int, int, int) const { return Pre{}; }
    const float* base; float* out; int ldc;
    __device__ __forceinline__ void operator()(const f32x4 (&acc)[2][2][4][2], const Unit& u, const Pre&, int wr, int wc, int fr, int fq) const {
        const int col0 = u.pn * BM + wc * 32 + 4 * fq;
#pragma unroll
        for (int ai = 0; ai < 2; ++ai)
#pragma unroll
            for (int mp = 0; mp < 2; ++mp) {
                f32x4 bs[2][2][2];
#pragma unroll
                for (int mm = 0; mm < 2; ++mm) { const size_t off = (size_t)(u.pm * BM + ai * HALF + wr * 64 + (2 * mp + mm) * 16 + fr) * ldc + col0;
#pragma unroll
                    for (int bj = 0; bj < 2; ++bj)
#pragma unroll
                        for (int n = 0; n < 2; ++n) bs[mm][bj][n] = __builtin_nontemporal_load((const f32x4*)(base + off + bj * HALF + n * 16)); }
                asm volatile("" ::: "memory");
#pragma unroll
                for (int mm = 0; mm < 2; ++mm) { const size_t off = (size_t)(u.pm * BM + ai * HALF + wr * 64 + (2 * mp + mm) * 16 + fr) * ldc + col0;
#pragma unroll
                    for (int bj = 0; bj < 2; ++bj)
#pragma unroll
                        for (int n = 0; n < 2; ++n) *(f32x4*)(out + off + bj * HALF + n * 16) = bs[mm][bj][n] + acc[ai][bj][2 * mp + mm][n]; }
                asm volatile("" ::: "memory");
            }
    }
};
struct EpiSwiglu {
    static constexpr bool PERM = true;
    unsigned char* O; const float* bias; int nN;
    struct Pre { f32x4 bg0, bg1, bl0, bl1; };
    __device__ __forceinline__ Pre prefetch(const Unit& u, int wr, int wc, int fr, int fq) const {
        const int e = u.pb / nN, ch = u.pn * HALF + wc * 32 + 8 * fq;
        const float* bg = bias + (size_t)e * 2048 + ch; const float* bl = bg + 1024;
        return Pre{*(const f32x4*)bg, *(const f32x4*)(bg + 4), *(const f32x4*)bl, *(const f32x4*)(bl + 4)};
    }
    __device__ __forceinline__ void operator()(const f32x4 (&acc)[2][2][4][2], const Unit& u, const Pre& pre, int wr, int wc, int fr, int fq) const {
        const int row0 = u.pm * BM + wr * 64 + fr, ch = u.pn * HALF + wc * 32 + 8 * fq;
        const f32x4 bg0 = pre.bg0, bg1 = pre.bg1, bl0 = pre.bl0, bl1 = pre.bl1;
#pragma unroll
        for (int ai = 0; ai < 2; ++ai)
#pragma unroll
            for (int m = 0; m < 4; ++m) {
                float r[8];
#pragma unroll
                for (int n = 0; n < 2; ++n)
#pragma unroll
                    for (int j = 0; j < 4; ++j) {
                        float gv = acc[ai][0][m][n][j] * (1.f / 32.f) + (n ? bg1[j] : bg0[j]);
                        float lv = acc[ai][1][m][n][j] * (1.f / 32.f) + (n ? bl1[j] : bl0[j]);
                        gv = fminf(gv, 7.0f); lv = fminf(fmaxf(lv, -7.0f), 7.0f);
                        r[n * 4 + j] = gv * __builtin_amdgcn_rcpf(1.f + __builtin_amdgcn_exp2f(-1.702f * 1.4426950408889634f * gv)) * (lv + 1.0f);
                    }
                u32x2 w; w.x = pk4_fp8(r[0], r[1], r[2], r[3]); w.y = pk4_fp8(r[4], r[5], r[6], r[7]);
                *(u32x2*)(O + (size_t)(row0 + ai * HALF + m * 16) * DFF + ch) = w;
            }
    }
};
struct EpiDown {
    static constexpr bool PERM = true;
    bf16_t* O; const float* bias; int nN;
    struct Pre { f32x4 bv[2][2]; };
    __device__ __forceinline__ Pre prefetch(const Unit& u, int wr, int wc, int fr, int fq) const {
        const int e = u.pb / nN, col0 = u.pn * BM + wc * 32 + 8 * fq;
        const float* bp = bias + (size_t)e * 1024 + col0;
        Pre pr;
#pragma unroll
        for (int bj = 0; bj < 2; ++bj)
#pragma unroll
            for (int n = 0; n < 2; ++n) pr.bv[bj][n] = *(const f32x4*)(bp + bj * HALF + 4 * n);
        return pr;
    }
    __device__ __forceinline__ void operator()(const f32x4 (&acc)[2][2][4][2], const Unit& u, const Pre& pre, int wr, int wc, int fr, int fq) const {
        const int row0 = u.pm * BM + wr * 64 + fr, col0 = u.pn * BM + wc * 32 + 8 * fq;
        f32x4 bv[2][2];
#pragma unroll
        for (int bj = 0; bj < 2; ++bj)
#pragma unroll
            for (int n = 0; n < 2; ++n) bv[bj][n] = pre.bv[bj][n];
#pragma unroll
        for (int ai = 0; ai < 2; ++ai)
#pragma unroll
            for (int m = 0; m < 4; ++m) { bf16_t* rowp = O + (size_t)(row0 + ai * HALF + m * 16) * 1024 + col0;
#pragma unroll
                for (int bj = 0; bj < 2; ++bj) { const f32x4 v0 = acc[ai][bj][m][0] * (1.f / 32.f) + bv[bj][0], v1 = acc[ai][bj][m][1] * (1.f / 32.f) + bv[bj][1];
                    u32x4 w; w.x = cvt_pk_bf16(v0[0], v0[1]); w.y = cvt_pk_bf16(v0[2], v0[3]); w.z = cvt_pk_bf16(v1[0], v1[1]); w.w = cvt_pk_bf16(v1[2], v1[3]);
                    *(u32x4*)(rowp + bj * HALF) = w; } }
    }
};

template <bool FP8, class Epi, class Sched>
__device__ __forceinline__ void gemm_phase(LAS unsigned char* lds, const Gemm g, const Sched& S, const Epi& E) {
    const int tid = opaque_tid(), wid = __builtin_amdgcn_readfirstlane(tid >> 6), lane = tid & 63, wr = wid >> 2, wc = wid & 3, fr = lane & 15, fq = lane >> 4;
    const int Kb = g.Kb, nt = Kb / 128;
    unsigned voffA[2], voffB[2];
#pragma unroll
    for (int i = 0; i < 2; ++i) { int R, C; stage_rc<FP8>(tid * 16 + i * 8192, R, C); const int Rb = Epi::PERM ? ((R & ~31) + perm32(R & 31)) : R;
        voffA[i] = (unsigned)(R * Kb + C * 2); voffB[i] = (unsigned)(Rb * Kb + C * 2); }
    const size_t kstep = (size_t)(BK * 2);
    const size_t hstep = (size_t)HALF * Kb;
    const size_t tstep = 2 * hstep;
    const unsigned ldsw = (unsigned)wid * 1024u;
    const int aoff = FP8 ? lds_byte<true>(wr * 64 + fr, fq * 16) : lds_byte<false>(wr * 64 + fr, fq * 8), boff = FP8 ? lds_byte<true>(wc * 32 + fr, fq * 16) : lds_byte<false>(wc * 32 + fr, fq * 8);
    const int aoff1 = FP8 ? (aoff ^ 16) : (aoff + 1024), boff1 = FP8 ? (boff ^ 16) : (boff + 1024);
#define PG8_SA(b, h) (((b) * 2 + (h)) * HTB)
#define PG8_SB(b, h) ((4 + (b) * 2 + (h)) * HTB)
#define PG8_STAGE(bufoff, gbase, voff) do { _Pragma("unroll") for (int _i = 0; _i < 2; ++_i) \
        __builtin_amdgcn_global_load_lds((const unsigned*)((const char*)(gbase) + (voff)[_i]), (LAS unsigned*)(lds + (bufoff) + ldsw + _i * 8192), 16, 0, 0); } while (0)
#define PG8_LDA(dst, b, h) do { if constexpr (FP8) { _Pragma("unroll") for (int m = 0; m < 4; ++m) dst##8[m] = cat8(*(const LAS i32x4*)(lds + PG8_SA(b, h) + aoff + m * 2048), *(const LAS i32x4*)(lds + PG8_SA(b, h) + aoff1 + m * 2048)); } \
        else { _Pragma("unroll") for (int m = 0; m < 4; ++m) { dst[m][0] = *(const LAS bf16x8*)(lds + PG8_SA(b, h) + aoff + m * 2048); dst[m][1] = *(const LAS bf16x8*)(lds + PG8_SA(b, h) + aoff1 + m * 2048); } } } while (0)
#define PG8_LDB(dst, b, h) do { if constexpr (FP8) { _Pragma("unroll") for (int n = 0; n < 2; ++n) dst##8[n] = cat8(*(const LAS i32x4*)(lds + PG8_SB(b, h) + boff + n * 2048), *(const LAS i32x4*)(lds + PG8_SB(b, h) + boff1 + n * 2048)); } \
        else { _Pragma("unroll") for (int n = 0; n < 2; ++n) { dst[n][0] = *(const LAS bf16x8*)(lds + PG8_SB(b, h) + boff + n * 2048); dst[n][1] = *(const LAS bf16x8*)(lds + PG8_SB(b, h) + boff1 + n * 2048); } } } while (0)
#define PG8_MMA(ai, bj, At, Bt) do { __builtin_amdgcn_s_setprio(1); _Pragma("unroll") for (int m = 0; m < 4; ++m) _Pragma("unroll") for (int n = 0; n < 2; ++n) { \
        if constexpr (FP8) mfma8_acc(acc[ai][bj][m][n], Bt##8[n], At##8[m], scl); \
        else { _Pragma("unroll") for (int k = 0; k < 2; ++k) acc[ai][bj][m][n] = __builtin_amdgcn_mfma_f32_16x16x32_bf16(Bt[n][k], At[m][k], acc[ai][bj][m][n], 0, 0, 0); } } \
        __builtin_amdgcn_s_setprio(0); } while (0)
#define PG8_WAIT_V(n) asm volatile("s_waitcnt vmcnt(" #n ")" ::: "memory")
#define PG8_WAIT_L(n) asm volatile("s_waitcnt lgkmcnt(" #n ")" ::: "memory")
#define PG8_BAR __builtin_amdgcn_s_barrier()
#define PG8_SCHED __builtin_amdgcn_sched_barrier(0)
    Unit cur, nxt; int ui = 0;
    if (!S.next(0, cur)) return;
    f32x4 acc[2][2][4][2];
#pragma unroll
    for (int a = 0; a < 2; ++a)
#pragma unroll
        for (int b = 0; b < 2; ++b)
#pragma unroll
            for (int m = 0; m < 4; ++m)
#pragma unroll
                for (int n = 0; n < 2; ++n) acc[a][b][m][n] = (f32x4){0.f, 0.f, 0.f, 0.f};
    bf16x8 At[4][2], B0[2][2], B1[2][2];
    i32x8 At8[4], B08[2], B18[2];
    int scl = 0x7f7f7f7f; asm volatile("" : "+v"(scl));
    const char* cA = (const char*)g.A + (size_t)cur.pm * tstep; const char* cB = (const char*)g.Bt + (size_t)cur.pb * tstep;
    typename Epi::Pre pre = E.prefetch(cur, wr, wc, fr, fq);
    {
        PG8_STAGE(PG8_SB(0, 0), cB, voffB); PG8_STAGE(PG8_SB(0, 1), cB + hstep, voffB); PG8_STAGE(PG8_SA(0, 0), cA, voffA); PG8_STAGE(PG8_SA(0, 1), cA + hstep, voffA);
        if (wr == 1) PG8_BAR;
        PG8_WAIT_V(2); PG8_BAR;
        PG8_STAGE(PG8_SB(1, 0), cB + kstep, voffB); PG8_STAGE(PG8_SA(1, 0), cA + kstep, voffA); PG8_STAGE(PG8_SB(1, 1), cB + hstep + kstep, voffB);
        PG8_WAIT_V(6); PG8_BAR;
    }
    for (;;) {
        const bool has_next = S.next(ui + 1, nxt);
        const char* nA = has_next ? (const char*)g.A + (size_t)nxt.pm * tstep : cA; const char* nB = has_next ? (const char*)g.Bt + (size_t)nxt.pb * tstep : cB;
#pragma unroll 1
        for (int t = 0; t < nt; t += 2) {
            const bool last = (t == nt - 2);
            const char* a1 = cA + (size_t)(t + 1) * kstep;
            const char* a2 = last ? nA : cA + (size_t)(t + 2) * kstep; const char* b2 = last ? nB : cB + (size_t)(t + 2) * kstep;
            const char* a3 = a2 + kstep; const char* b3 = b2 + kstep;
            PG8_LDB(B0, 0, 0); PG8_LDB(B1, 0, 1); PG8_SCHED; PG8_LDA(At, 0, 0); PG8_STAGE(PG8_SA(1, 1), a1 + hstep, voffA);
            PG8_WAIT_V(8); PG8_WAIT_L(0); PG8_BAR; PG8_MMA(0, 0, At, B0); PG8_MMA(0, 1, At, B1); PG8_BAR; PG8_SCHED;
            PG8_LDA(At, 0, 1); PG8_STAGE(PG8_SB(0, 0), b2, voffB); PG8_STAGE(PG8_SB(0, 1), b2 + hstep, voffB); PG8_STAGE(PG8_SA(0, 0), a2, voffA);
            PG8_WAIT_V(8); PG8_WAIT_L(0); PG8_BAR; PG8_MMA(1, 0, At, B0); PG8_MMA(1, 1, At, B1); PG8_BAR; PG8_SCHED;
            PG8_LDB(B0, 1, 0); PG8_LDB(B1, 1, 1); PG8_SCHED; PG8_LDA(At, 1, 0); PG8_STAGE(PG8_SA(0, 1), a2 + hstep, voffA);
            PG8_WAIT_V(8); PG8_WAIT_L(0); PG8_BAR; PG8_MMA(0, 0, At, B0); PG8_MMA(0, 1, At, B1); PG8_BAR; PG8_SCHED;
            PG8_LDA(At, 1, 1); PG8_STAGE(PG8_SB(1, 0), b3, voffB); PG8_STAGE(PG8_SB(1, 1), b3 + hstep, voffB); PG8_STAGE(PG8_SA(1, 0), a3, voffA);
            PG8_WAIT_V(8); PG8_WAIT_L(0); PG8_BAR; PG8_MMA(1, 0, At, B0); PG8_MMA(1, 1, At, B1); PG8_BAR; PG8_SCHED;
        }
        if (wr == 0) PG8_BAR;
        if constexpr (FP8) asm volatile("s_nop 15\n\ts_nop 15" ::: "memory");
        E(acc, cur, pre, wr, wc, fr, fq);
        if (!has_next) break;
#pragma unroll
        for (int a = 0; a < 2; ++a)
#pragma unroll
            for (int b = 0; b < 2; ++b)
#pragma unroll
                for (int m = 0; m < 4; ++m)
#pragma unroll
                    for (int n = 0; n < 2; ++n) acc[a][b][m][n] = (f32x4){0.f, 0.f, 0.f, 0.f};
        cur = nxt; cA = nA; cB = nB; ++ui;
        pre = E.prefetch(cur, wr, wc, fr, fq);
        if (wr == 1) PG8_BAR;
    }
    PG8_WAIT_V(0);
    PG8_BAR;
#undef PG8_SA
#undef PG8_SB
#undef PG8_STAGE
#undef PG8_LDA
#undef PG8_LDB
#undef PG8_MMA
#undef PG8_WAIT_V
#undef PG8_WAIT_L
#undef PG8_BAR
#undef PG8_SCHED
}
}

__device__ __forceinline__ int win_map(int n) {
    if (n < 1280) return n;
    if (n < 2304) return n + 24;
    if (n < 2816) return n + 40;
    if (n < 2840) return n - 1536;
    if (n < 2856) return n - 512;
    return -1;
}
template <int MODE> __device__ __forceinline__ int colmap(int r) {
    if (MODE == 1) return win_map(r);
    if (MODE == 2) return ((r >> 7) & 1) * 1024 + (r >> 8) * 128 + (r & 127);
    return r;
}
template <int MODE, bool OUT8>
__device__ __forceinline__ void transpose_item(const float* W, int K, int Nsrc, void* WTv, int nblk, LAS float* scr, int item, int lane) {
    const int kb = item / nblk, nb = item % nblk, k0 = 64 * kb, n0 = 64 * nb;
    const int nq = 4 * (lane & 15), kq = lane >> 4;
    const int sc = colmap<MODE>(n0 + nq);
    f32x4 v[16];
#pragma unroll
    for (int i = 0; i < 16; ++i) v[i] = sc >= 0 ? __builtin_nontemporal_load((const f32x4*)(W + (size_t)(k0 + 4 * i + kq) * Nsrc + sc)) : (f32x4){0.f, 0.f, 0.f, 0.f};
#pragma unroll
    for (int i = 0; i < 16; ++i) { LAS float* d = scr + (4 * i + kq) * 65 + nq; d[0] = v[i].x; d[1] = v[i].y; d[2] = v[i].z; d[3] = v[i].w; }
    LDS_WAIT();
    const int c = lane & 7;
#pragma unroll
    for (int j = 0; j < 8; ++j) { const int n = (lane >> 3) + 8 * j; const LAS float* s = scr + (8 * c) * 65 + n;
        if (OUT8) {
            u32x2 o; o.x = pk4_fp8(s[0 * 65] * 32.f, s[1 * 65] * 32.f, s[2 * 65] * 32.f, s[3 * 65] * 32.f); o.y = pk4_fp8(s[4 * 65] * 32.f, s[5 * 65] * 32.f, s[6 * 65] * 32.f, s[7 * 65] * 32.f);
            *(u32x2*)((unsigned char*)WTv + (size_t)(n0 + n) * K + k0 + 8 * c) = o;
        } else {
            u32x4 o; o.x = pk2(s[0 * 65], s[1 * 65]); o.y = pk2(s[2 * 65], s[3 * 65]); o.z = pk2(s[4 * 65], s[5 * 65]); o.w = pk2(s[6 * 65], s[7 * 65]);
            *(u32x4*)((bf16_t*)WTv + (size_t)(n0 + n) * K + k0 + 8 * c) = o; } }
    LDS_WAIT();
}
template <int NR>
__device__ __forceinline__ void rms_rows_to_bf16(const float* x0, size_t xstride, const float* g, bf16_t* o0, size_t ostride, int lane) {
    f32x4 v[NR][4];
#pragma unroll
    for (int r = 0; r < NR; ++r) { const f32x4* xr = (const f32x4*)(x0 + r * xstride) + lane;
#pragma unroll
        for (int j = 0; j < 4; ++j) v[r][j] = __builtin_nontemporal_load(xr + 64 * j); }
    const f32x4* gr = (const f32x4*)g + lane;
    f32x4 gg[4];
#pragma unroll
    for (int j = 0; j < 4; ++j) gg[j] = gr[64 * j];
#pragma unroll
    for (int r = 0; r < NR; ++r) {
        float s = 0.f;
#pragma unroll
        for (int j = 0; j < 4; ++j) s += (v[r][j].x * v[r][j].x + v[r][j].y * v[r][j].y) + (v[r][j].z * v[r][j].z + v[r][j].w * v[r][j].w);
        const float rstd = 1.f / sqrtf(wave_sum(s) * (1.f / DM) + EPS);
        unsigned long long* o8 = (unsigned long long*)(o0 + r * ostride) + lane;
#pragma unroll
        for (int j = 0; j < 4; ++j) { const f32x4 o = v[r][j] * rstd * gg[j];
            o8[64 * j] = (unsigned long long)pk2(o.x, o.y) | ((unsigned long long)pk2(o.z, o.w) << 32); }
    }
}
__device__ __forceinline__ void phase0(const Params& p, LAS unsigned char* lds, int blk, int G) {
    const int tid = opaque_tid(), lane = tid & 63, wave = tid >> 6;
    LAS float* scr = (LAS float*)(lds + wave * 16640);
    const int gw = blk * 8 + wave, NGW = G * 8;
    unsigned char* ws = p.ws;
    constexpr int I_GU = 16 * 32, I_DN = 16 * 16;
    constexpr int N_GU = NEXP * I_GU, N_DN = NEXP * I_DN, N_IN = 16 * (NPROJ / 64), N_OUT = 16 * 16, N_C1 = 32 * 4, N_C2 = 4 * 1;
    constexpr int NITEMS = N_IN + N_OUT + 2 * N_C1 + 2 * N_C2;
    (void)N_GU; (void)N_DN;
    for (int it = gw; it < NITEMS; it += NGW) {
        int r = it;
        if (r < N_IN) { transpose_item<1, false>(p.in[3], 1024, 2856, (bf16_t*)(ws + WS_WIN), NPROJ / 64, scr, r, lane); continue; } r -= N_IN;
        if (r < N_OUT) { transpose_item<0, false>(p.in[15], 1024, 1024, (bf16_t*)(ws + WS_WOUT), 16, scr, r, lane); continue; } r -= N_OUT;
        if (r < N_C1) { transpose_item<0, false>(p.in[7], 2048, 256, (bf16_t*)(ws + WS_CW1K), 4, scr, r, lane); continue; } r -= N_C1;
        if (r < N_C1) { transpose_item<0, false>(p.in[10], 2048, 256, (bf16_t*)(ws + WS_CW1V), 4, scr, r, lane); continue; } r -= N_C1;
        if (r < N_C2) { transpose_item<0, false>(p.in[8], 256, 64, (bf16_t*)(ws + WS_CW2K), 1, scr, r, lane); continue; } r -= N_C2;
        transpose_item<0, false>(p.in[11], 256, 64, (bf16_t*)(ws + WS_CW2V), 1, scr, r, lane);
    }
    for (int m = gw * 4; m < MTOK; m += NGW * 4) rms_rows_to_bf16<4>(p.in[0] + (size_t)m * DM, DM, p.in[2], (bf16_t*)(ws + WS_H) + (size_t)m * DM, DM, lane);
    for (int i = blk * NTHREADS + tid; i < NEXP * DM; i += G * NTHREADS) { const int e = i >> 10, d = i & 1023; ((float*)(ws + WS_WRT))[i] = p.in[16][d] * p.in[17][d * NEXP + e]; }
    if (blk == G - 1) {
        const int which = tid >> 8, j = tid & 255;
        const float* pos = which ? p.in[9] : p.in[6]; const float* w1 = which ? p.in[10] : p.in[7];
        float s = 0.f;
#pragma unroll 8
        for (int k = 0; k < 2048; ++k) s += pos[k] * w1[(size_t)k * 256 + j];
        ((float*)(ws + WS_CBIAS))[tid] = s;
    }
}

__device__ __forceinline__ void p2a_unit(const Params& p, LAS unsigned char* lds, int unit) {
    const int tid = opaque_tid(), lane = tid & 63, wave = tid >> 6, vec = lane >> 4, li = lane & 15;
    unsigned char* ws = p.ws;
    const bf16_t* PROJ = (const bf16_t*)(ws + WS_PROJ);
    const int b = unit >> 5, blkc = unit & 31, tok0 = unit * 64;
    u32x4 vraw[4];
    { const int tk = tid >> 3, ch = tid & 7;
#pragma unroll
      for (int v = 0; v < 4; ++v) vraw[v] = *(const u32x4*)(PROJ + (size_t)(tok0 + tk) * NPROJ + (v < 2 ? CVS : CVW) + (v & 1) * 64 + 8 * ch); }
    const int col0 = CQ + vec * 64 + 4 * li, col1 = CQ + (4 + vec) * 64 + 4 * li, col2 = (vec < 2 ? CKS + vec * 64 : CKW + (vec - 2) * 64) + 4 * li;
    u32x2 raw[8][3];
#pragma unroll
    for (int ti = 0; ti < 8; ++ti) { const bf16_t* pr = PROJ + (size_t)(tok0 + wave * 8 + ti) * NPROJ;
        raw[ti][0] = *(const u32x2*)(pr + col0); raw[ti][1] = *(const u32x2*)(pr + col1); raw[ti][2] = *(const u32x2*)(pr + col2); }
    const f32x4 gq = *(const f32x4*)(p.in[4] + 4 * li);
    const f32x4 gk = *(const f32x4*)(p.in[5] + (vec < 2 ? 64 : 128) + 4 * li);
    float invf[4];
#pragma unroll
    for (int i = 0; i < 4; ++i) invf[i] = __expf(-13.122363377404328f * (float)(2 * ((4 * li + i) & 7)) * (1.f / 16.f));
    const float sgn = (li < 2) ? -1.f : 1.f;
#pragma unroll
    for (int ti = 0; ti < 8; ++ti) {
        const int t = tok0 + wave * 8 + ti;
        const float pos = (float)((const int*)p.in[1])[t];
        float cs[4], sn[4];
#pragma unroll
        for (int i = 0; i < 4; ++i) { const float ang = pos * invf[i]; cs[i] = __cosf(ang); sn[i] = __sinf(ang); }
#pragma unroll
        for (int vg = 0; vg < 3; ++vg) {
            const u32x2 rw = raw[ti][vg];
            float x[4] = {__uint_as_float(rw.x << 16), __uint_as_float(rw.x & 0xffff0000u), __uint_as_float(rw.y << 16), __uint_as_float(rw.y & 0xffff0000u)};
            const float ss = red16_sum((x[0] * x[0] + x[1] * x[1]) + (x[2] * x[2] + x[3] * x[3]));
            const float rstd = 1.f / sqrtf(ss * (1.f / 64.f) + EPS);
            const f32x4 g = (vg < 2) ? gq : gk;
            float y[4], yr[4];
#pragma unroll
            for (int i = 0; i < 4; ++i) y[i] = x[i] * rstd * g[i];
#pragma unroll
            for (int i = 0; i < 4; ++i) { const float partner = dppf<0x4E>(y[i]); yr[i] = (li < 4) ? (y[i] * cs[i] + sgn * partner * sn[i]) : y[i]; }
            if (vg < 2) {
                const float sc = 0.125f * 1.4426950408889634f;
                u32x2 o; o.x = pk2(y[0] * sc, y[1] * sc); o.y = pk2(y[2] * sc, y[3] * sc);
                *(u32x2*)((bf16_t*)(ws + WS_QN) + (size_t)t * 512 + (4 * vg + vec) * 64 + 4 * li) = o;
                o.x = pk2(yr[0] * sc, yr[1] * sc); o.y = pk2(yr[2] * sc, yr[3] * sc);
                *(u32x2*)((bf16_t*)(ws + WS_QR) + (size_t)t * 512 + (4 * vg + vec) * 64 + 4 * li) = o;
            } else {
                u32x2 o; o.x = pk2(yr[0], yr[1]); o.y = pk2(yr[2], yr[3]);
                bf16_t* dst = (bf16_t*)(ws + (vec < 2 ? WS_KS : WS_KW)) + ((size_t)(b * 2 + (vec & 1)) * SEQ + (t & (SEQ - 1))) * 64 + 4 * li;
                *(u32x2*)dst = o;
            }
        }
    }
    __syncthreads();
    { const int tk = tid >> 3, ch = tid & 7, tkp = (tk & ~12) | ((tk & 4) << 1) | ((tk & 8) >> 1);
#pragma unroll
      for (int v = 0; v < 4; ++v) { LAS bf16_t* T = (LAS bf16_t*)lds + v * (64 * 72);
#pragma unroll
          for (int q = 0; q < 4; ++q) { const unsigned wv = vraw[v][q]; T[(8 * ch + 2 * q) * 72 + tkp] = (bf16_t)(wv & 0xffffu); T[(8 * ch + 2 * q + 1) * 72 + tkp] = (bf16_t)(wv >> 16); } } }
    __syncthreads();
    { const int d = tid >> 3, ch = tid & 7;
#pragma unroll
      for (int v = 0; v < 4; ++v) { const LAS bf16_t* T = (const LAS bf16_t*)lds + v * (64 * 72);
          const u32x4 o = *(const LAS u32x4*)(T + d * 72 + 8 * ch);
          bf16_t* dst = (bf16_t*)(ws + (v < 2 ? WS_VST : WS_VWT)) + (((size_t)(b * 2 + (v & 1)) * 32 + blkc) * 64 + d) * 64 + 8 * ch;
          *(u32x4*)dst = o; } }
}

__device__ __forceinline__ void p2b_unit(const Params& p, LAS unsigned char* lds, int unit) {
    const int tid = opaque_tid(), lane = tid & 63, w = tid >> 6, fr = lane & 15, fq = lane >> 4;
    unsigned char* ws = p.ws;
    const bf16_t* PROJ = (const bf16_t*)(ws + WS_PROJ);
    const int which = unit >> 6, rt = unit & 63;
    const bf16_t* W1T = (const bf16_t*)(ws + (which ? WS_CW1V : WS_CW1K));
    const bf16_t* W2T = (const bf16_t*)(ws + (which ? WS_CW2V : WS_CW2K));
    const float* cb = (const float*)(ws + WS_CBIAS) + which * 256;
    const int colbase = which ? CVC : CKC;
    LAS bf16_t* Hd = (LAS bf16_t*)lds;
    LAS float* Of = (LAS float*)(lds + 64 * 264 * 2);
    const bf16_t* arow[4];
#pragma unroll
    for (int m = 0; m < 4; ++m) { const int R = rt * 64 + 16 * m + fr; const int bb = R >> 8, kh = (R >> 7) & 1; int n = R & 127; if (n > 126) n = 126;
        arow[m] = PROJ + (size_t)(bb * SEQ + 16 * n) * NPROJ + colbase + kh * 64 + 8 * fq; }
    const bf16_t* brow[2];
#pragma unroll
    for (int nf = 0; nf < 2; ++nf) brow[nf] = W1T + (size_t)(32 * w + 16 * nf + fr) * 2048 + 8 * fq;
    f32x4 acc[4][2];
#pragma unroll
    for (int m = 0; m < 4; ++m)
#pragma unroll
        for (int nf = 0; nf < 2; ++nf) acc[m][nf] = (f32x4){0.f, 0.f, 0.f, 0.f};
#pragma unroll 4
    for (int ks = 0; ks < 64; ++ks) {
        bf16x8 a[4], bb2[2];
        const size_t aoff = (size_t)(ks >> 1) * NPROJ + 32 * (ks & 1);
#pragma unroll
        for (int m = 0; m < 4; ++m) a[m] = *(const bf16x8*)(arow[m] + aoff);
#pragma unroll
        for (int nf = 0; nf < 2; ++nf) bb2[nf] = *(const bf16x8*)(brow[nf] + 32 * ks);
#pragma unroll
        for (int m = 0; m < 4; ++m)
#pragma unroll
            for (int nf = 0; nf < 2; ++nf) acc[m][nf] = __builtin_amdgcn_mfma_f32_16x16x32_bf16(a[m], bb2[nf], acc[m][nf], 0, 0, 0);
    }
#pragma unroll
    for (int nf = 0; nf < 2; ++nf) { const int col = 32 * w + 16 * nf + fr; const float bias = cb[col];
#pragma unroll
        for (int m = 0; m < 4; ++m)
#pragma unroll
            for (int j = 0; j < 4; ++j) { const float hv = acc[m][nf][j] + bias; Hd[(16 * m + 4 * fq + j) * 264 + col] = (bf16_t)f2bf(hv * sigmoidf_(hv)); } }
    __syncthreads();
    {
        const int m2 = w >> 1;
        f32x4 acc2[2] = {(f32x4){0.f, 0.f, 0.f, 0.f}, (f32x4){0.f, 0.f, 0.f, 0.f}};
#pragma unroll
        for (int ks = 0; ks < 8; ++ks) {
            const bf16x8 a = *(const LAS bf16x8*)(Hd + (16 * m2 + fr) * 264 + 32 * ks + 8 * fq);
#pragma unroll
            for (int q = 0; q < 2; ++q) { const int nf2 = 2 * (w & 1) + q; const bf16x8 bv = *(const bf16x8*)(W2T + (size_t)(16 * nf2 + fr) * 256 + 32 * ks + 8 * fq);
                acc2[q] = __builtin_amdgcn_mfma_f32_16x16x32_bf16(a, bv, acc2[q], 0, 0, 0); }
        }
#pragma unroll
        for (int q = 0; q < 2; ++q) { const int nf2 = 2 * (w & 1) + q;
#pragma unroll
            for (int j = 0; j < 4; ++j) Of[(16 * m2 + 4 * fq + j) * 65 + 16 * nf2 + fr] = acc2[q][j]; }
    }
    __syncthreads();
    for (int rr = 0; rr < 8; ++rr) {
        const int r = 8 * w + rr, R = rt * 64 + r, bb = R >> 8, kh = (R >> 7) & 1, n = R & 127;
        float v = Of[r * 65 + lane];
        if (which == 0) {
            const float ss = wave_sum(v * v);
            v = v * (1.f / sqrtf(ss * (1.f / 64.f) + EPS)) * p.in[5][lane];
            if (n == 127) v = 0.f;
            ((bf16_t*)(ws + WS_KC))[((size_t)(bb * 2 + kh) * 128 + n) * 64 + lane] = (bf16_t)f2bf(v);
        } else {
            if (n == 127) v = 0.f;
            ((bf16_t*)(ws + WS_VCT))[((size_t)(bb * 2 + kh) * 64 + lane) * 128 + ((n & ~12) | ((n & 4) << 1) | ((n & 8) >> 1))] = (bf16_t)f2bf(v);
        }
    }
    __syncthreads();
}

typedef float f32x16 __attribute__((ext_vector_type(16)));
constexpr int NSA_KT0 = 0, NSA_VT0 = 9216, NSA_KT1 = 18432, NSA_VT1 = 27648, NSA_IMPW = 36864, NSA_SELM = NSA_IMPW + 4 * 64 * 33 * 4, NSA_UNI = NSA_SELM + 256,
              NSA_OUT = NSA_UNI + 256;
static_assert(NSA_OUT + 256 * 68 * 4 <= LDS_BYTES - 64, "NSA LDS map");
constexpr float NEGBIG = -1e30f;
#define MFMA32(a, b, c) __builtin_amdgcn_mfma_f32_32x32x16_bf16((a), (b), (c), 0, 0, 0)

__device__ __forceinline__ bf16x8 pack_step(const f32x16& x, int s) {
    u32x4 p;
    if (s == 0) asm volatile("v_cvt_pk_bf16_f32 %0, %4, %5\n\tv_cvt_pk_bf16_f32 %1, %6, %7\n\tv_cvt_pk_bf16_f32 %2, %8, %9\n\tv_cvt_pk_bf16_f32 %3, %10, %11\n\ts_nop 1"
                     : "=&v"(p[0]), "=&v"(p[1]), "=&v"(p[2]), "=&v"(p[3]) : "v"(x[0]), "v"(x[1]), "v"(x[2]), "v"(x[3]), "v"(x[4]), "v"(x[5]), "v"(x[6]), "v"(x[7]));
    else asm volatile("v_cvt_pk_bf16_f32 %0, %4, %5\n\tv_cvt_pk_bf16_f32 %1, %6, %7\n\tv_cvt_pk_bf16_f32 %2, %8, %9\n\tv_cvt_pk_bf16_f32 %3, %10, %11\n\ts_nop 1"
                     : "=&v"(p[0]), "=&v"(p[1]), "=&v"(p[2]), "=&v"(p[3]) : "v"(x[8]), "v"(x[9]), "v"(x[10]), "v"(x[11]), "v"(x[12]), "v"(x[13]), "v"(x[14]), "v"(x[15]));
    return __builtin_bit_cast(bf16x8, p);
}
__device__ __forceinline__ void nsa_qk(const bf16x8 (&bq)[4], const LAS bf16_t* KT, f32x16 (&X)[2], int r, int h) {
#pragma unroll
    for (int kt = 0; kt < 2; ++kt) {
        f32x16 x;
#pragma unroll
        for (int i = 0; i < 16; ++i) x[i] = 0.f;
#pragma unroll
        for (int ks = 0; ks < 4; ++ks) { const bf16x8 a = *(const LAS bf16x8*)(KT + (32 * kt + r) * 72 + 16 * ks + 8 * h); x = MFMA32(a, bq[ks], x); }
        X[kt] = x;
    }
}
__device__ __forceinline__ void nsa_bounds(int mode, bool rok, int i, int cq, int koff, int& lo, int& hi) {
    hi = (mode == 1) ? i : ((mode == 3) ? (((cq + i - 31) >> 4) - koff) : 63);
    lo = (mode == 2) ? i + 1 : 0;
    hi = rok ? hi : -1;
}
__device__ __forceinline__ void nsa_tile(int MM, const bf16x8 (&bq)[4], const LAS bf16_t* KT, const LAS bf16_t* VT, float& lsum, f32x16 (&O)[2],
                                         bool rok, int mode, int iq, int cq, int koff, int r_, int h_) {
    int r = r_, h = h_;
    asm volatile("" : "+v"(r), "+v"(h));
    f32x16 X[2];
    nsa_qk(bq, KT, X, r, h);
#pragma unroll
    for (int kt = 0; kt < 2; ++kt)
#pragma unroll
        for (int i = 0; i < 16; ++i) X[kt][i] = __builtin_amdgcn_exp2f(X[kt][i]);
    if (MM == 1) {
#pragma unroll
        for (int kt = 0; kt < 2; ++kt)
#pragma unroll
            for (int i = 0; i < 16; ++i) X[kt][i] = rok ? X[kt][i] : 0.f;
    } else if (MM == 2) {
        int lo, hi; nsa_bounds(mode, rok, iq, cq, koff, lo, hi);
#pragma unroll
        for (int kt = 0; kt < 2; ++kt)
#pragma unroll
            for (int i = 0; i < 16; ++i) { const int key = 32 * kt + (i & 3) + 8 * (i >> 2) + 4 * h; X[kt][i] = ((key >= lo) & (key <= hi)) ? X[kt][i] : 0.f; }
    }
    bf16x8 pf[2][2];
    float ls = 0.f;
#pragma unroll
    for (int kt = 0; kt < 2; ++kt) {
#pragma unroll
        for (int i = 0; i < 16; i += 4) ls += (X[kt][i] + X[kt][i + 1]) + (X[kt][i + 2] + X[kt][i + 3]);
        pf[kt][0] = pack_step(X[kt], 0); pf[kt][1] = pack_step(X[kt], 1);
    }
    lsum += ls;
#pragma unroll
    for (int dt = 0; dt < 2; ++dt)
#pragma unroll
        for (int kt = 0; kt < 2; ++kt)
#pragma unroll
            for (int s = 0; s < 2; ++s) { const bf16x8 a = *(const LAS bf16x8*)(VT + (32 * dt + r) * 72 + 32 * kt + 16 * s + 8 * h); O[dt] = MFMA32(a, pf[kt][s], O[dt]); }
}
struct NsaStage { u32x4 k, v; };
__device__ __forceinline__ void nsa_fetch(NsaStage& st, const bf16_t* Ksrc, int kstride, const bf16_t* Vsrc, int vstride, int tid) {
    const int r = tid >> 3, ch = tid & 7;
    st.k = *(const u32x4*)(Ksrc + (size_t)r * kstride + 8 * ch);
    st.v = *(const u32x4*)(Vsrc + (size_t)r * vstride + 8 * ch);
}
__device__ __forceinline__ void nsa_commit(const NsaStage& st, LAS bf16_t* KT, LAS bf16_t* VT, int tid) {
    const int r = tid >> 3, ch = tid & 7;
    *(LAS u32x4*)(KT + r * 72 + 8 * ch) = st.k;
    *(LAS u32x4*)(VT + r * 72 + 8 * ch) = st.v;
}
template <bool FIRST>
__device__ __forceinline__ void nsa_out_acc(LAS float* OUTw, const f32x16 (&O)[2], float sc, int r, int h) {
#pragma unroll
    for (int dt = 0; dt < 2; ++dt)
#pragma unroll
        for (int gq = 0; gq < 4; ++gq) {
            LAS f32x4* dst = (LAS f32x4*)(OUTw + r * 68 + 32 * dt + 8 * gq + 4 * h);
            f32x4 v = (f32x4){O[dt][4 * gq] * sc, O[dt][4 * gq + 1] * sc, O[dt][4 * gq + 2] * sc, O[dt][4 * gq + 3] * sc};
            if (!FIRST) v += *dst;
            *dst = v;
        }
}

__device__ __forceinline__ void nsa_unit(const Params& p, LAS unsigned char* lds, int b, int kh, int c) {
    const int tid = opaque_tid(), lane = tid & 63, w = tid >> 6, r = lane & 31, h = lane >> 5, g = w >> 1, ih = w & 1;
    unsigned char* ws = p.ws;
    const int hh = kh * 4 + g, tok0 = b * SEQ + 64 * c, ibase = 32 * ih, iq = ibase + r, tq = tok0 + iq;
    const bf16_t* PROJ = (const bf16_t*)(ws + WS_PROJ);
    LAS float* IMPW = (LAS float*)(lds + NSA_IMPW);
    LAS unsigned* SELM = (LAS unsigned*)(lds + NSA_SELM); LAS unsigned* UNI = (LAS unsigned*)(lds + NSA_UNI);
    LAS float* OUTw = (LAS float*)(lds + NSA_OUT) + (w * 32) * 68;
    const size_t bk = (size_t)(b * 2 + kh);
#define NSA_KTB(bb) ((LAS bf16_t*)(lds + ((bb) ? NSA_KT1 : NSA_KT0)))
#define NSA_VTB(bb) ((LAS bf16_t*)(lds + ((bb) ? NSA_VT1 : NSA_VT0)))
    bf16x8 bq[4];
    NsaStage st;
    if (tid == 0) *UNI = 0u;
    const bf16_t* gp = PROJ + (size_t)tq * NPROJ + CGATE + hh * 3;
    const float gate0 = sigmoidf_(bf2f(gp[0])), gate1 = sigmoidf_(bf2f(gp[1])), gate2 = sigmoidf_(bf2f(gp[2]));
    {
#pragma unroll
        for (int ks = 0; ks < 4; ++ks) bq[ks] = *(const bf16x8*)((const bf16_t*)(ws + WS_QN) + (size_t)tq * 512 + hh * 64 + 16 * ks + 8 * h);
        const int nh = (4 * c + 2 >= 64) ? 2 : 1;
        const bf16_t* KCb = (const bf16_t*)(ws + WS_KC) + bk * 128 * 64; const bf16_t* VCb = (const bf16_t*)(ws + WS_VCT) + bk * 64 * 128;
        float lsum = 0.f; f32x16 O[2];
#pragma unroll
        for (int dt = 0; dt < 2; ++dt)
#pragma unroll
            for (int i = 0; i < 16; ++i) O[dt][i] = 0.f;
        nsa_fetch(st, KCb, 64, VCb, 128, tid);
        BAR_LDS();
        nsa_commit(st, NSA_KTB(0), NSA_VTB(0), tid);
        if (nh == 2) { nsa_fetch(st, KCb + 64 * 64, 64, VCb + 64, 128, tid); nsa_commit(st, NSA_KTB(1), NSA_VTB(1), tid); }
        BAR_LDS();
        for (int half = 0; half < nh; ++half) nsa_tile(2, bq, NSA_KTB(half), NSA_VTB(half), lsum, O, true, 3, iq, 64 * c, 64 * half, r, h);
        const float lt = lsum + __shfl_xor(lsum, 32);
        const float inv = lt > 0.f ? 1.f / lt : 0.f;
        nsa_out_acc<true>(OUTw, O, gate0 * inv, r, h);
        float carry = 0.f;
        for (int half = 0; half < nh; ++half) {
            f32x16 X[2];
            int r2 = r, h2 = h;
            asm volatile("" : "+v"(r2), "+v"(h2));
            nsa_qk(bq, NSA_KTB(half), X, r2, h2);
            const int hi = ((64 * c + iq - 31) >> 4) - 64 * half;
#pragma unroll
            for (int kt = 0; kt < 2; ++kt) {
                float pv[16];
#pragma unroll
                for (int i = 0; i < 16; ++i) { const int key = 32 * kt + (i & 3) + 8 * (i >> 2) + 4 * h2; pv[i] = (key <= hi) ? __builtin_amdgcn_exp2f(X[kt][i]) * inv : 0.f; }
#pragma unroll
                for (int gq = 0; gq < 4; ++gq) {
                    const float send = (h2 == 0) ? pv[4 * gq + 3] : (gq > 0 ? pv[4 * gq - 1] : carry);
                    const float extra = __shfl_xor(send, 32);
                    IMPW[(g * 64 + iq) * 33 + 16 * half + 8 * kt + 2 * gq + h2] = ((pv[4 * gq] + pv[4 * gq + 1]) + (pv[4 * gq + 2] + pv[4 * gq + 3])) + extra;
                }
                carry = pv[15];
            }
        }
    }
    BAR_LDS();
    {
        LAS float* SC = (LAS float*)(lds + NSA_KT0);
#pragma unroll
        for (int q = 0; q < 4; ++q) { const int pr = q * NTHREADS + tid, i = pr >> 5, j = pr & 31;
            float v = NEGBIG;
            if (j <= c) { v = (IMPW[(0 * 64 + i) * 33 + j] + IMPW[(1 * 64 + i) * 33 + j]) + (IMPW[(2 * 64 + i) * 33 + j] + IMPW[(3 * 64 + i) * 33 + j]);
                if (j == 0 || j == c || j == c - 1) v += 1e4f; }
            SC[i * 33 + j] = v; }
        BAR_LDS();
#pragma unroll 1
        for (int q = 0; q < 4; ++q) { const int pr = q * NTHREADS + tid, i = pr >> 5, j = pr & 31;
            const float my = SC[i * 33 + j]; int rank = 0;
#pragma unroll
            for (int k = 0; k < 32; ++k) { const float o = SC[i * 33 + k]; rank += (o > my || (o == my && k < j)) ? 1 : 0; }
            const bool sel = (j <= c) && rank < 8;
            const unsigned long long bal = __ballot(sel);
            const unsigned msk = (lane & 32) ? (unsigned)(bal >> 32) : (unsigned)bal;
            if (j == 0) { SELM[i] = msk; atomicOr((unsigned*)UNI, msk); } }
    }
    BAR_LDS();
    const unsigned uni = *UNI;
    const unsigned mysel = SELM[iq];
#pragma unroll
    for (int ks = 0; ks < 4; ++ks) bq[ks] = *(const bf16x8*)((const bf16_t*)(ws + WS_QR) + (size_t)tq * 512 + hh * 64 + 16 * ks + 8 * h);
#pragma unroll 1
    for (int br = 0; br < 2; ++br) {
        float lsum = 0.f; f32x16 O[2];
#pragma unroll
        for (int dt = 0; dt < 2; ++dt)
#pragma unroll
            for (int i = 0; i < 16; ++i) O[dt][i] = 0.f;
        const bf16_t* Kb = (const bf16_t*)(ws + (br ? WS_KW : WS_KS)) + bk * SEQ * 64;
        const bf16_t* Vb = (const bf16_t*)(ws + (br ? WS_VWT : WS_VST)) + bk * 32 * 4096;
        unsigned todo = br ? ((c >= 8 ? (0x1ffu << (c - 8)) : ((2u << c) - 1u))) : (uni & ((c == 31) ? 0xffffffffu : ((2u << c) - 1u)));
#define NSA_POP(dst) do { if (todo) { dst = __builtin_ctz(todo); todo &= todo - 1u; } else dst = -1; } while (0)
#define NSA_FETCH(stg, t) nsa_fetch(stg, Kb + (size_t)(t) * 4096, 64, Vb + (size_t)(t) * 4096, 64, tid)
#define NSA_COMPUTE(t, bufi) do { bool rok = true; int mode = 0, mm = 0; \
            if ((t) == c) { mode = 1; mm = 2; } \
            else if (br == 1) { if ((t) == c - 8) { mode = 2; mm = 2; } } \
            else if ((t) != 0 && (t) != c - 1) { rok = (mysel >> (t)) & 1u; mm = 1; } \
            nsa_tile(mm, bq, NSA_KTB(bufi), NSA_VTB(bufi), lsum, O, rok, mode, iq, 0, 0, r, h); } while (0)
        NsaStage stY;
        int t0, t1, t2, t3;
        NSA_POP(t0); NSA_POP(t1); NSA_POP(t2);
        NSA_FETCH(st, t0);
        BAR_LDS();
        nsa_commit(st, NSA_KTB(0), NSA_VTB(0), tid);
        if (t1 >= 0) NSA_FETCH(st, t1);
        if (t2 >= 0) NSA_FETCH(stY, t2);
        BAR_LDS();
        for (;;) {
            NSA_COMPUTE(t0, 0);
            if (t1 < 0) break;
            nsa_commit(st, NSA_KTB(1), NSA_VTB(1), tid);
            NSA_POP(t3); if (t3 >= 0) NSA_FETCH(st, t3);
            BAR_LDS();
            t0 = t1; t1 = t2; t2 = t3;
            NSA_COMPUTE(t0, 1);
            if (t1 < 0) break;
            nsa_commit(stY, NSA_KTB(0), NSA_VTB(0), tid);
            NSA_POP(t3); if (t3 >= 0) NSA_FETCH(stY, t3);
            BAR_LDS();
            t0 = t1; t1 = t2; t2 = t3;
        }
#undef NSA_POP
#undef NSA_FETCH
#undef NSA_COMPUTE
        const float lt = lsum + __shfl_xor(lsum, 32);
        nsa_out_acc<false>(OUTw, O, lt > 0.f ? (br ? gate2 : gate1) / lt : 0.f, r, h);
    }
    LDS_WAIT();
#pragma unroll
    for (int q = 0; q < 4; ++q) {
        const int rr = 8 * q + (lane >> 3), ch = lane & 7;
        const LAS f32x4* src = (const LAS f32x4*)(OUTw + rr * 68 + 8 * ch);
        const f32x4 a = src[0], bq2 = src[1];
        u32x4 o; o.x = pk2(a[0], a[1]); o.y = pk2(a[2], a[3]); o.z = pk2(bq2[0], bq2[1]); o.w = pk2(bq2[2], bq2[3]);
        *(u32x4*)((bf16_t*)(ws + WS_ATT) + (size_t)(tok0 + ibase + rr) * 1024 + hh * 64 + 8 * ch) = o;
    }
#undef NSA_KTB
#undef NSA_VTB
}

constexpr int GLA_QD = 0, GLA_KD = 10240, GLA_KST = 20480, GLA_VT = 30720, GLA_AT = 51200, GLA_ST = 61440, GLA_WG = 81920  , GLA_DEC = 86016  ,
              GLA_OT = 86528  , GLA_END = GLA_OT + 64 * 132 * 4;
static_assert(GLA_END <= LDS_BYTES - 64, "GLA LDS map");
template <int CTRL, int RMASK> __device__ __forceinline__ float dppf_rm(float v) { return __int_as_float(__builtin_amdgcn_update_dpp(0, __float_as_int(v), CTRL, RMASK, 0xf, false)); }
__device__ __forceinline__ float wave_incl_scan(float v) {
    v += __int_as_float(__builtin_amdgcn_update_dpp(0, __float_as_int(v), 0x111, 0xf, 0xf, true));
    v += __int_as_float(__builtin_amdgcn_update_dpp(0, __float_as_int(v), 0x112, 0xf, 0xf, true));
    v += __int_as_float(__builtin_amdgcn_update_dpp(0, __float_as_int(v), 0x114, 0xf, 0xf, true));
    v += __int_as_float(__builtin_amdgcn_update_dpp(0, __float_as_int(v), 0x118, 0xf, 0xf, true));
    v += dppf_rm<0x142, 0xa>(v);
    v += dppf_rm<0x143, 0xc>(v);
    return v;
}
struct GlaStage { u32x4 q, k, g0, g1, v0, v1; };
__device__ __forceinline__ void gla_fetch(GlaStage& st, const bf16_t* PROJ, int tok0, int h, int lane, int w) {
    const bf16_t* row = PROJ + (size_t)(tok0 + lane) * NPROJ;
    st.q = *(const u32x4*)(row + CGQ + h * 64 + 8 * w);
    st.k = *(const u32x4*)(row + CGK + h * 64 + 8 * w);
    st.g0 = *(const u32x4*)(row + CGLR); st.g1 = *(const u32x4*)(row + CGLR + 8);
    st.v0 = *(const u32x4*)(row + CGV + h * 128 + 16 * w); st.v1 = *(const u32x4*)(row + CGV + h * 128 + 16 * w + 8);
}
__device__ __forceinline__ float bflo(unsigned u) { return __uint_as_float(u << 16); }
__device__ __forceinline__ float bfhi(unsigned u) { return __uint_as_float(u & 0xffff0000u); }

__device__ __forceinline__ void gla_unit(const Params& p, LAS unsigned char* lds, int b, int h) {
    const int tid = opaque_tid(), lane = tid & 63, w = tid >> 6, fr = lane & 15, fq = lane >> 4;
    unsigned char* ws = p.ws;
    const bf16_t* PROJ = (const bf16_t*)(ws + WS_PROJ);
    LAS bf16_t* Qd = (LAS bf16_t*)(lds + GLA_QD); LAS bf16_t* Kd = (LAS bf16_t*)(lds + GLA_KD); LAS bf16_t* KsT = (LAS bf16_t*)(lds + GLA_KST);
    LAS bf16_t* VT = (LAS bf16_t*)(lds + GLA_VT); LAS bf16_t* At = (LAS bf16_t*)(lds + GLA_AT); LAS bf16_t* ST = (LAS bf16_t*)(lds + GLA_ST);
    LAS float* WG = (LAS float*)(lds + GLA_WG); LAS float* DEC = (LAS float*)(lds + GLA_DEC); LAS float* OT = (LAS float*)(lds + GLA_OT);
    BAR_LDS();
    for (int i = tid; i < 16 * 64; i += NTHREADS) WG[i] = p.in[12][(i >> 6) * 256 + h * 64 + (i & 63)];
    for (int i = tid; i < 128 * 80 / 2; i += NTHREADS) ((LAS unsigned*)ST)[i] = 0u;
    float bg[8];
#pragma unroll
    for (int q = 0; q < 8; ++q) bg[q] = p.in[13][h * 64 + 8 * w + q];
    const int md = w & 3, nfe0 = 4 * (w >> 2);
    f32x4 Sreg[4];
#pragma unroll
    for (int x = 0; x < 4; ++x) Sreg[x] = (f32x4){0.f, 0.f, 0.f, 0.f};
    GlaStage st;
    gla_fetch(st, PROJ, b * SEQ, h, lane, w);
    BAR_LDS();
#pragma unroll 1
    for (int n = 0; n < 32; ++n) {
        const int tok0 = b * SEQ + n * 64;
        float gl[16];
        { const unsigned gw[8] = {st.g0.x, st.g0.y, st.g0.z, st.g0.w, st.g1.x, st.g1.y, st.g1.z, st.g1.w};
#pragma unroll
          for (int q = 0; q < 8; ++q) { gl[2 * q] = bflo(gw[q]); gl[2 * q + 1] = bfhi(gw[q]); } }
        float bcum[8], blast[8];
#pragma unroll
        for (int q = 0; q < 8; ++q) {
            float x = bg[q];
#pragma unroll
            for (int r = 0; r < 16; ++r) x += gl[r] * WG[r * 64 + 8 * w + q];
            const float la = (fminf(x, 0.f) - __logf(1.f + __expf(-fabsf(x)))) * (1.f / 16.f);
            bcum[q] = wave_incl_scan(la);
            blast[q] = __int_as_float(__builtin_amdgcn_readlane(__float_as_int(bcum[q]), 63));
        }
        {
            const unsigned qw[4] = {st.q.x, st.q.y, st.q.z, st.q.w}, kw[4] = {st.k.x, st.k.y, st.k.z, st.k.w};
            unsigned qo[4], ko[4];
#pragma unroll
            for (int q2 = 0; q2 < 4; ++q2) {
                const float e0 = __expf(bcum[2 * q2]), e1 = __expf(bcum[2 * q2 + 1]);
                const float i0 = __expf(-bcum[2 * q2]), i1 = __expf(-bcum[2 * q2 + 1]);
                const float k0 = bflo(kw[q2]), k1 = bfhi(kw[q2]);
                qo[q2] = pg8::cvt_pk_bf16(bflo(qw[q2]) * 0.125f * e0, bfhi(qw[q2]) * 0.125f * e1);
                ko[q2] = pg8::cvt_pk_bf16(k0 * i0, k1 * i1);
                KsT[(8 * w + 2 * q2) * 80 + lane] = (bf16_t)f2bf(k0 * __expf(blast[2 * q2] - bcum[2 * q2]));
                KsT[(8 * w + 2 * q2 + 1) * 80 + lane] = (bf16_t)f2bf(k1 * __expf(blast[2 * q2 + 1] - bcum[2 * q2 + 1]));
            }
            *(LAS u32x4*)(Qd + lane * 80 + 8 * w) = (u32x4){qo[0], qo[1], qo[2], qo[3]};
            *(LAS u32x4*)(Kd + lane * 80 + 8 * w) = (u32x4){ko[0], ko[1], ko[2], ko[3]};
            if (lane == 63) {
#pragma unroll
                for (int q = 0; q < 8; ++q) DEC[(n & 1) * 64 + 8 * w + q] = __expf(bcum[q]);
            }
            const unsigned vw[8] = {st.v0.x, st.v0.y, st.v0.z, st.v0.w, st.v1.x, st.v1.y, st.v1.z, st.v1.w};
#pragma unroll
            for (int q = 0; q < 8; ++q) { VT[(16 * w + 2 * q) * 80 + lane] = (bf16_t)(vw[q] & 0xffffu); VT[(16 * w + 2 * q + 1) * 80 + lane] = (bf16_t)(vw[q] >> 16); }
        }
        if (n < 31) gla_fetch(st, PROJ, tok0 + 64, h, lane, w);
        const int ec = tid >> 3, eg = tid & 7;
        const u32x4 r0 = *(const u32x4*)(PROJ + (size_t)(tok0 + ec) * NPROJ + CGR + h * 128 + 16 * eg), r1 = *(const u32x4*)(PROJ + (size_t)(tok0 + ec) * NPROJ + CGR + h * 128 + 16 * eg + 8);
        BAR_LDS();
        {
            const int m = w >> 1;
            bf16x8 a[2];
#pragma unroll
            for (int ks = 0; ks < 2; ++ks) a[ks] = *(const LAS bf16x8*)(Qd + (16 * m + fr) * 80 + 32 * ks + 8 * fq);
#pragma unroll
            for (int x = 0; x < 2; ++x) { const int nf = 2 * (w & 1) + x;
                f32x4 s = (f32x4){0.f, 0.f, 0.f, 0.f};
                if (nf <= m) {
#pragma unroll
                    for (int ks = 0; ks < 2; ++ks) { const bf16x8 bk = *(const LAS bf16x8*)(Kd + (16 * nf + fr) * 80 + 32 * ks + 8 * fq); s = __builtin_amdgcn_mfma_f32_16x16x32_bf16(a[ks], bk, s, 0, 0, 0); }
                }
#pragma unroll
                for (int j = 0; j < 4; ++j) { const int cc = 16 * m + 4 * fq + j, ss = 16 * nf + fr; At[cc * 80 + ss] = (bf16_t)f2bf(ss <= cc ? s[j] : 0.f); } }
        }
        f32x4 U[4];
        {
            bf16x8 a[2];
#pragma unroll
            for (int ks = 0; ks < 2; ++ks) a[ks] = *(const LAS bf16x8*)(KsT + (16 * md + fr) * 80 + 32 * ks + 8 * fq);
#pragma unroll
            for (int x = 0; x < 4; ++x) { f32x4 s = (f32x4){0.f, 0.f, 0.f, 0.f};
#pragma unroll
                for (int ks = 0; ks < 2; ++ks) { const bf16x8 bv = *(const LAS bf16x8*)(VT + (16 * (nfe0 + x) + fr) * 80 + 32 * ks + 8 * fq); s = __builtin_amdgcn_mfma_f32_16x16x32_bf16(a[ks], bv, s, 0, 0, 0); }
                U[x] = s; }
        }
        BAR_LDS();
        {
            bf16x8 aa[2], aq2[2];
#pragma unroll
            for (int ks = 0; ks < 2; ++ks) { aa[ks] = *(const LAS bf16x8*)(At + (16 * md + fr) * 80 + 32 * ks + 8 * fq); aq2[ks] = *(const LAS bf16x8*)(Qd + (16 * md + fr) * 80 + 32 * ks + 8 * fq); }
#pragma unroll
            for (int x = 0; x < 4; ++x) { f32x4 s = (f32x4){0.f, 0.f, 0.f, 0.f};
#pragma unroll
                for (int ks = 0; ks < 2; ++ks) { const bf16x8 bv = *(const LAS bf16x8*)(VT + (16 * (nfe0 + x) + fr) * 80 + 32 * ks + 8 * fq); s = __builtin_amdgcn_mfma_f32_16x16x32_bf16(aa[ks], bv, s, 0, 0, 0); }
#pragma unroll
                for (int ks = 0; ks < 2; ++ks) { const bf16x8 bs = *(const LAS bf16x8*)(ST + (16 * (nfe0 + x) + fr) * 80 + 32 * ks + 8 * fq); s = __builtin_amdgcn_mfma_f32_16x16x32_bf16(aq2[ks], bs, s, 0, 0, 0); }
#pragma unroll
                for (int j = 0; j < 4; ++j) OT[(16 * md + 4 * fq + j) * 132 + 16 * (nfe0 + x) + fr] = s[j]; }
        }
        BAR_LDS();
        {
            const LAS f32x4* dp = (const LAS f32x4*)(DEC + (n & 1) * 64 + 16 * md + 4 * fq); const f32x4 dc = dp[0];
#pragma unroll
            for (int x = 0; x < 4; ++x) { Sreg[x] = dc * Sreg[x] + U[x];
                u32x2 o; o.x = pg8::cvt_pk_bf16(Sreg[x][0], Sreg[x][1]); o.y = pg8::cvt_pk_bf16(Sreg[x][2], Sreg[x][3]);
                *(LAS u32x2*)(ST + (16 * (nfe0 + x) + fr) * 80 + 16 * md + 4 * fq) = o; }
        }
        {
            const LAS f32x4* op = (const LAS f32x4*)(OT + ec * 132 + 16 * eg);
            f32x4 o[4]; float ss = 0.f;
#pragma unroll
            for (int q = 0; q < 4; ++q) { o[q] = op[q]; ss += (o[q].x * o[q].x + o[q].y * o[q].y) + (o[q].z * o[q].z + o[q].w * o[q].w); }
            ss += dppf<0xB1>(ss); ss += dppf<0x4E>(ss); ss += dppf<0x141>(ss);
            const float rstd = 1.f / sqrtf(ss * (1.f / 128.f) + EPS);
            const unsigned rw[8] = {r0.x, r0.y, r0.z, r0.w, r1.x, r1.y, r1.z, r1.w};
            const float* gn = p.in[14] + 16 * eg;
            unsigned ow[8];
#pragma unroll
            for (int q = 0; q < 8; ++q) { const float ra = bflo(rw[q]), rb = bfhi(rw[q]);
                const float ya = o[q >> 1][(2 * q) & 3] * rstd * gn[2 * q] * (ra * sigmoidf_(ra)), yb = o[q >> 1][(2 * q + 1) & 3] * rstd * gn[2 * q + 1] * (rb * sigmoidf_(rb));
                ow[q] = pg8::cvt_pk_bf16(ya, yb); }
            u32x4* dst = (u32x4*)((bf16_t*)(ws + WS_ATT) + (size_t)(tok0 + ec) * 1024 + 512 + h * 128 + 16 * eg);
            dst[0] = (u32x4){ow[0], ow[1], ow[2], ow[3]}; dst[1] = (u32x4){ow[4], ow[5], ow[6], ow[7]};
        }
    }
}

__device__ __forceinline__ void p6_chunk(const Params& p, LAS unsigned char* lds, int chunk) {
    const int tid = opaque_tid(), lane = tid & 63, wave = tid >> 6, fr = lane & 15, fq = lane >> 4;
    unsigned char* ws = p.ws;
    LAS int* lcnt = (LAS int*)lds;
    LAS float* LG = (LAS float*)(lds + 256) + wave * (16 * 33 + 16);
    LAS float* RS = LG + 16 * 33;
    if (tid < NEXP) lcnt[tid] = 0;
    __syncthreads();
    const float* WRT = (const float*)(ws + WS_WRT);
    const float* X1 = (const float*)(ws + WS_X1);
    const int t0 = chunk * 128 + wave * 16;
    {
        const float* ap = X1 + (size_t)(t0 + fr) * DM + 4 * fq;
        const float* bp0 = WRT + (size_t)fr * DM + 4 * fq; const float* bp1 = bp0 + 16 * DM;
        f32x4 acc0 = (f32x4){0.f, 0.f, 0.f, 0.f}, acc1 = (f32x4){0.f, 0.f, 0.f, 0.f};
        float ssq = 0.f;
#pragma unroll 4
        for (int ks = 0; ks < 64; ++ks) {
            const f32x4 a4 = *(const f32x4*)(ap + 16 * ks), b0 = *(const f32x4*)(bp0 + 16 * ks), b1 = *(const f32x4*)(bp1 + 16 * ks);
            ssq += (a4.x * a4.x + a4.y * a4.y) + (a4.z * a4.z + a4.w * a4.w);
#pragma unroll
            for (int i = 0; i < 4; ++i) { acc0 = __builtin_amdgcn_mfma_f32_16x16x4f32(a4[i], b0[i], acc0, 0, 0, 0); acc1 = __builtin_amdgcn_mfma_f32_16x16x4f32(a4[i], b1[i], acc1, 0, 0, 0); }
        }
        ssq += __shfl_xor(ssq, 16); ssq += __shfl_xor(ssq, 32);
        const float rstd = 1.f / sqrtf(ssq * (1.f / DM) + EPS);
        if (fq == 0) RS[fr] = rstd;
#pragma unroll
        for (int j = 0; j < 4; ++j) { LG[(4 * fq + j) * 33 + fr] = acc0[j]; LG[(4 * fq + j) * 33 + 16 + fr] = acc1[j]; }
    }
    LDS_WAIT();
    if (lane < 16) {
        const int t = t0 + lane; const float rstd = RS[lane];
        unsigned taken = 0u; float tv[4]; int te[4];
#pragma unroll
        for (int r = 0; r < 4; ++r) { float best = -3e38f; int be = 0;
#pragma unroll 8
            for (int e = 0; e < 32; ++e) { const float v = LG[lane * 33 + e] * rstd + p.in[18][e]; const bool can = !((taken >> e) & 1u); if (can && v > best) { best = v; be = e; } }
            taken |= 1u << be; tv[r] = best; te[r] = be; }
        const float e0 = 1.f, e1 = __expf(tv[1] - tv[0]), e2 = __expf(tv[2] - tv[0]), e3 = __expf(tv[3] - tv[0]);
        const float inv = 1.f / (e0 + e1 + e2 + e3);
        *(int4*)((int*)(ws + WS_TOPI) + (size_t)t * 4) = make_int4(te[0], te[1], te[2], te[3]);
        *(f32x4*)((float*)(ws + WS_TOPG) + (size_t)t * 4) = (f32x4){e0 * inv, e1 * inv, e2 * inv, e3 * inv};
        atomicAdd((int*)&lcnt[te[0]], 1); atomicAdd((int*)&lcnt[te[1]], 1); atomicAdd((int*)&lcnt[te[2]], 1); atomicAdd((int*)&lcnt[te[3]], 1);
    }
    {
        const f32x4* gr = (const f32x4*)p.in[16] + lane;
        f32x4 gg[4];
#pragma unroll
        for (int j = 0; j < 4; ++j) gg[j] = gr[64 * j];
#pragma unroll 1
        for (int ti = 0; ti < 16; ti += 4) {
            f32x4 v[4][4];
#pragma unroll
            for (int r = 0; r < 4; ++r) { const f32x4* xr = (const f32x4*)(X1 + (size_t)(t0 + ti + r) * DM) + lane;
#pragma unroll
                for (int j = 0; j < 4; ++j) v[r][j] = xr[64 * j]; }
#pragma unroll
            for (int r = 0; r < 4; ++r) { const float rstd = RS[ti + r];
                unsigned* o4 = (unsigned*)(ws + WS_H + (size_t)(t0 + ti + r) * DM) + lane;
#pragma unroll
                for (int j = 0; j < 4; ++j) { const f32x4 o = v[r][j] * rstd * gg[j]; o4[64 * j] = pk4_fp8(o.x, o.y, o.z, o.w); } }
        }
    }
    __syncthreads();
    if (tid < NEXP) atomicAdd((int*)(ws + WS_CTL) + CW_CNT + tid, lcnt[tid]);
    __syncthreads();
}

__device__ __forceinline__ int build_tile_table(const Params& p, LAS int* tstart, LAS int* tile_e) {
    const int tid = opaque_tid();
    const int* cnt = (const int*)(p.ws + WS_CTL) + CW_CNT;
    if (tid == 0) { int acc = 0; for (int e = 0; e < NEXP; ++e) { tstart[e] = acc; acc += (__hip_atomic_load(cnt + e, __ATOMIC_RELAXED, __HIP_MEMORY_SCOPE_AGENT) + 255) >> 8; } tstart[NEXP] = acc; }
    __syncthreads();
    const int total = tstart[NEXP];
    for (int i = tid; i < total; i += NTHREADS) { int e = 0;
        for (int q = 1; q < NEXP; ++q) if (tstart[q] <= i) e = q;
        tile_e[i] = e; }
    __syncthreads();
    return total;
}

__device__ __forceinline__ void p7_chunk(const Params& p, LAS unsigned char* lds, int chunk, const LAS int* tstart) {
    const int tid = opaque_tid(), lane = tid & 63, wave = tid >> 6;
    unsigned char* ws = p.ws;
    LAS int* lc = (LAS int*)lds; LAS int* lbase = lc + 32; LAS int* ldst = lbase + 32;
    if (tid < NEXP) lc[tid] = 0;
    __syncthreads();
    const int t = chunk * 128 + (tid >> 2), k = tid & 3;
    const int e = ((const int*)(ws + WS_TOPI))[(size_t)t * 4 + k];
    const int rank = atomicAdd((int*)&lc[e], 1);
    __syncthreads();
    if (tid < NEXP) lbase[tid] = atomicAdd((int*)(ws + WS_CTL) + CW_FILL + tid, lc[tid]);
    __syncthreads();
    const int dest = tstart[e] * 256 + lbase[e] + rank;
    ((int*)(ws + WS_DEST))[(size_t)t * 4 + k] = dest;
    ldst[tid] = dest;
    __syncthreads();
#pragma unroll 1
    for (int ti = 0; ti < 16; ti += 4) {
        u32x4 a[4];
#pragma unroll
        for (int r = 0; r < 4; ++r) a[r] = *((const u32x4*)(ws + WS_H + (size_t)(chunk * 128 + wave * 16 + ti + r) * DM) + lane);
#pragma unroll
        for (int r = 0; r < 4; ++r)
#pragma unroll
            for (int kk = 0; kk < 4; ++kk) *((u32x4*)(ws + WS_XS + (size_t)ldst[(wave * 16 + ti + r) * 4 + kk] * DM) + lane) = a[r];
    }
    __syncthreads();
}

__device__ __forceinline__ void p10_tokens(const Params& p, int t0, int lane) {
    unsigned char* ws = p.ws;
    int4 d4[2]; f32x4 g4[2];
#pragma unroll
    for (int q = 0; q < 2; ++q) { d4[q] = *(const int4*)((const int*)(ws + WS_DEST) + (size_t)(t0 + q) * 4); g4[q] = *(const f32x4*)((const float*)(ws + WS_TOPG) + (size_t)(t0 + q) * 4); }
    f32x4 xa[2][4]; u32x4 yv[2][4][2];
#pragma unroll
    for (int q = 0; q < 2; ++q) {
        const f32x4* xr = (const f32x4*)((const float*)(ws + WS_X1) + (size_t)(t0 + q) * DM);
#pragma unroll
        for (int h2 = 0; h2 < 2; ++h2) { xa[q][2 * h2] = __builtin_nontemporal_load(xr + h2 * 128 + lane * 2); xa[q][2 * h2 + 1] = __builtin_nontemporal_load(xr + h2 * 128 + lane * 2 + 1); }
        const int dd[4] = {d4[q].x, d4[q].y, d4[q].z, d4[q].w};
#pragma unroll
        for (int k = 0; k < 4; ++k)
#pragma unroll
            for (int h2 = 0; h2 < 2; ++h2) yv[q][k][h2] = __builtin_nontemporal_load((const u32x4*)((const bf16_t*)(ws + WS_Y) + (size_t)dd[k] * DM) + h2 * 64 + lane);
    }
#pragma unroll
    for (int q = 0; q < 2; ++q) {
        f32x4* orow = (f32x4*)(p.out + (size_t)(t0 + q) * DM);
#pragma unroll
        for (int h2 = 0; h2 < 2; ++h2) {
            f32x4 a0 = xa[q][2 * h2], a1 = xa[q][2 * h2 + 1];
#pragma unroll
            for (int k = 0; k < 4; ++k) { const u32x4 y = yv[q][k][h2]; const float gk = g4[q][k];
                a0.x += gk * __uint_as_float(y.x << 16); a0.y += gk * __uint_as_float(y.x & 0xffff0000u);
                a0.z += gk * __uint_as_float(y.y << 16); a0.w += gk * __uint_as_float(y.y & 0xffff0000u);
                a1.x += gk * __uint_as_float(y.z << 16); a1.y += gk * __uint_as_float(y.z & 0xffff0000u);
                a1.z += gk * __uint_as_float(y.w << 16); a1.w += gk * __uint_as_float(y.w & 0xffff0000u); }
            orow[h2 * 128 + lane * 2] = a0; orow[h2 * 128 + lane * 2 + 1] = a1;
        }
    }
}

#define XB_TMO      128
#define XB_XCNT(j)  (256  + 64 * (j))
#define XB_XSUB(j)  (1280 + 64 * (j))
#define XB_XGEN(j)  (2304 + 64 * (j))
#define XB_TOP      3328
#define XB_TOPGEN   3392
#define XCD_BAR_WORDS 3456
#define XB_SPIN_CAP (1u << 22)
__device__ __forceinline__ unsigned xb_ld(unsigned* p)              { return __hip_atomic_load(p, __ATOMIC_RELAXED, __HIP_MEMORY_SCOPE_AGENT); }
__device__ __forceinline__ unsigned xb_add(unsigned* p, unsigned v) { return __hip_atomic_fetch_add(p, v, __ATOMIC_RELAXED, __HIP_MEMORY_SCOPE_AGENT); }
__device__ __forceinline__ unsigned xb_xcc_id() { return (unsigned)__builtin_amdgcn_s_getreg((3 << 11) | 20) & 0xFu; }
#define XB_SPIN(cond, bar) do { unsigned _sp = 0; while (cond) { __builtin_amdgcn_s_sleep(1); \
    if ((++_sp & 255u) == 0u) { if (xb_ld(&(bar)[XB_TMO])) break; if (_sp > XB_SPIN_CAP) { atomicAdd(&(bar)[XB_TMO], 1u); break; } } } } while (0)
struct XcdBarrier { unsigned* bar; unsigned x; volatile LAS unsigned* st; };
__device__ __forceinline__ XcdBarrier xcd_barrier_post(unsigned* bar, volatile LAS unsigned* st) {
    XcdBarrier b; b.bar = bar; b.x = xb_xcc_id(); b.st = st;
    if (threadIdx.x == 0) (void)xb_add(&bar[XB_XCNT(b.x)], 1u);
    return b;
}
__device__ __forceinline__ void xcd_barrier_complete(unsigned* bar, unsigned x, unsigned& nloc, unsigned& nx) {
    const unsigned G = gridDim.x * gridDim.y * gridDim.z;
    unsigned sum, cnt, mine, sp = 0u;
    for (;;) {
        sum = 0u; cnt = 0u; mine = 0u;
#pragma unroll
        for (unsigned j = 0; j < 16; ++j) { const unsigned c = xb_ld(&bar[XB_XCNT(j)]); sum += c; cnt += (c > 0u) ? 1u : 0u; mine = (j == x) ? c : mine; }
        if (sum == G) break;
        __builtin_amdgcn_s_sleep(1);
        if ((++sp & 255u) == 0u) { if (xb_ld(&bar[XB_TMO])) break; if (sp > XB_SPIN_CAP) { atomicAdd(&bar[XB_TMO], 1u); break; } }
    }
    nloc = mine > 0u ? mine : 1u; nx = cnt > 0u ? cnt : 1u;
}
__device__ __forceinline__ void xcd_barrier(const XcdBarrier& b) {
    asm volatile("s_waitcnt vmcnt(0)" ::: "memory");
    __syncthreads();
    if (threadIdx.x == 0) {
        unsigned* bar = b.bar;
        __builtin_amdgcn_s_waitcnt(0);
        unsigned nloc = b.st[0], nx = b.st[1];
        if (nloc == 0u) { xcd_barrier_complete(bar, b.x, nloc, nx); b.st[0] = nloc; b.st[1] = nx; }
        const unsigned old = xb_add(&bar[XB_XSUB(b.x)], 1u);
        const unsigned gen = old / nloc;
        if (old + 1u == (gen + 1u) * nloc) {
            __builtin_amdgcn_fence(__ATOMIC_RELEASE, "agent");
            asm volatile("s_waitcnt vmcnt(0)" ::: "memory");
            const unsigned og = xb_add(&bar[XB_TOP], 1u);
            const unsigned tg = og / nx;
            if (og + 1u == (tg + 1u) * nx) xb_add(&bar[XB_TOPGEN], 1u);
            else XB_SPIN(xb_ld(&bar[XB_TOPGEN]) == tg, bar);
            __builtin_amdgcn_fence(__ATOMIC_ACQUIRE, "agent");
            xb_add(&bar[XB_XGEN(b.x)], 1u);
            asm volatile("s_waitcnt vmcnt(0)" ::: "memory");
        } else {
            XB_SPIN(xb_ld(&bar[XB_XGEN(b.x)]) == gen, bar);
            __builtin_amdgcn_fence(__ATOMIC_ACQUIRE, "agent");
            asm volatile("s_waitcnt vmcnt(0)" ::: "memory");
        }
    }
    __syncthreads();
}

__device__ __forceinline__ void expert_weight_items(const Params& p, LAS unsigned char* lds) {
    const int tid = opaque_tid(), lane = tid & 63, wave = tid >> 6;
    unsigned char* ws = p.ws;
    LAS float* scr = (LAS float*)(lds + wave * 16640);
    LAS int* qslot = (LAS int*)(lds + LDS_BYTES - 64);
    constexpr int I_GU = 16 * 32, I_DN = 16 * 16, N_GU = NEXP * I_GU, N_DN = NEXP * I_DN;
    for (;;) {
        __syncthreads();
        if (tid == 0) *qslot = (int)__hip_atomic_fetch_add((unsigned*)(ws + WS_CTL) + CW_QC, 8u, __ATOMIC_RELAXED, __HIP_MEMORY_SCOPE_AGENT);
        __syncthreads();
        const int base = *qslot;
        if (base >= N_GU + N_DN) break;
        int r = base + wave;
        if (r < N_GU) { const int e = r / I_GU; transpose_item<2, true>(p.in[19] + (size_t)e * 1024 * 2048, 1024, 2048, ws + WS_WGU + (size_t)e * 2048 * 1024, 32, scr, r % I_GU, lane); }
        else { r -= N_GU; const int e = r / I_DN; transpose_item<0, true>(p.in[21] + (size_t)e * 1024 * 1024, 1024, 1024, ws + WS_WD + (size_t)e * 1024 * 1024, 16, scr, r % I_DN, lane); }
    }
}

template <int ph> __device__ __forceinline__ void mk_phase(const Params& p, LAS unsigned char* lds, int blk, int G) {
    unsigned char* ws = p.ws;
    const int tid = opaque_tid();
    if constexpr (ph == 0) { phase0(p, lds, blk, G); }
    else if constexpr (ph == 1) {
        pg8::Gemm g{ws + WS_H, ws + WS_WIN, 2 * DM};
        pg8::StaticOrder S{MTOK / 256, NPROJ / 256, G, blk};
        pg8::EpiBf16 E{(bf16_t*)(ws + WS_PROJ), NPROJ};
        pg8::gemm_phase<false>(lds, g, S, E);
    }
    else if constexpr (ph == 2) {
        LAS int* qslot = (LAS int*)(lds + LDS_BYTES - 64);
        for (;;) {
            __syncthreads();
            if (tid == 0) *qslot = (int)__hip_atomic_fetch_add((unsigned*)(ws + WS_CTL) + CW_Q2, 1u, __ATOMIC_RELAXED, __HIP_MEMORY_SCOPE_AGENT);
            __syncthreads();
            const int it = *qslot;
            if (it >= 128 + 512) break;
            if (it < 128) p2b_unit(p, lds, it); else p2a_unit(p, lds, it - 128);
        }
    }
    else if constexpr (ph == 3) {
        LAS int* qslot = (LAS int*)(lds + LDS_BYTES - 64);
        if ((blk & 7) < 4) expert_weight_items(p, lds);
        for (;;) {
            __syncthreads();
            if (tid == 0) *qslot = (int)__hip_atomic_fetch_add((unsigned*)(ws + WS_CTL) + CW_Q3, 1u, __ATOMIC_RELAXED, __HIP_MEMORY_SCOPE_AGENT);
            __syncthreads();
            const int it = *qslot;
            if (it >= 64 + 1024) break;
            if (it < 64) gla_unit(p, lds, it >> 2, it & 3);
            else { const int u = it - 64, c = 31 - (u >> 5), bkh = u & 31; nsa_unit(p, lds, bkh >> 1, bkh & 1, c); }
        }
    }
    else if constexpr (ph == 4) { }
    else if constexpr (ph == 5) {
        pg8::Gemm g{ws + WS_ATT, ws + WS_WOUT, 2 * DM};
        pg8::StaticOrder S{MTOK / 256, DM / 256, G, blk};
        pg8::EpiResF32 E{p.in[0], (float*)(ws + WS_X1), DM};
        pg8::gemm_phase<false>(lds, g, S, E);
    }
    else if constexpr (ph == 6) { for (int ch = blk; ch < MTOK / 128; ch += G) p6_chunk(p, lds, ch); }
    else if constexpr (ph == 7) {
        LAS int* tstart = (LAS int*)(lds + 8192); LAS int* tile_e = tstart + 64;
        build_tile_table(p, tstart, tile_e);
        for (int ch = blk; ch < MTOK / 128; ch += G) p7_chunk(p, lds, ch, tstart);
    }
    else if constexpr (ph == 8) {
        LAS int* tstart = (LAS int*)(lds + pg8::STAGE_BYTES); LAS int* tile_e = tstart + 64;
        const int total = build_tile_table(p, tstart, tile_e);
        pg8::Gemm g{ws + WS_XS, ws + WS_WGU, DM};
        pg8::MoeOrder S{total, 8, G, blk, tile_e};
        pg8::EpiSwiglu E{ws + WS_ACT, p.in[20], 8};
        pg8::gemm_phase<true>(lds, g, S, E);
    }
    else if constexpr (ph == 9) {
        LAS int* tstart = (LAS int*)(lds + pg8::STAGE_BYTES); LAS int* tile_e = tstart + 64;
        const int total = build_tile_table(p, tstart, tile_e);
        pg8::Gemm g{ws + WS_ACT, ws + WS_WD, DFF};
        pg8::MoeOrder S{total, 4, G, blk, tile_e};
        pg8::EpiDown E{(bf16_t*)(ws + WS_Y), p.in[22], 4};
        pg8::gemm_phase<true>(lds, g, S, E);
    }
    else if constexpr (ph == 10) { for (int t = (blk * 8 + (tid >> 6)) * 2; t < MTOK; t += G * 16) p10_tokens(p, t, tid & 63); }
}

constexpr int NPHASES = 11;

template <int PH> __global__ void __launch_bounds__(NTHREADS, 2) mk_one(Params p) {
    extern __shared__ __attribute__((aligned(16))) unsigned char lds_raw[];
    mk_phase<PH>(p, (LAS unsigned char*)lds_raw, blockIdx.x, gridDim.x);
}
#if MK_ONE_LAUNCH
#define MK_RUN(PH) mk_phase<PH>(p, lds, blk, G)
__global__ void __launch_bounds__(NTHREADS, 2) mk_fwd(Params p) {
    extern __shared__ __attribute__((aligned(16))) unsigned char lds_raw[];
    LAS unsigned char* lds = (LAS unsigned char*)lds_raw;
    const int blk = blockIdx.x, G = gridDim.x;
    volatile LAS unsigned* bst = (volatile LAS unsigned*)(lds + LDS_BYTES - 16);
    if (threadIdx.x < 4) bst[threadIdx.x] = 0u;
    __syncthreads();
    const XcdBarrier gbar = xcd_barrier_post((unsigned*)(p.ws + WS_CTL) + CW_BAR, bst);
#define GSYNC() xcd_barrier(gbar)
#ifndef MK_REP_PHASE
#define MK_REP_PHASE -1
#endif
#ifndef MK_REP_N
#define MK_REP_N 0
#endif
#define MK_STEP(PH) do { MK_RUN(PH); if (MK_REP_PHASE == (PH)) { for (int r_ = 0; r_ < MK_REP_N; ++r_) { GSYNC(); MK_RUN(PH); } } if (MK_REP_PHASE == 100 + (PH)) { for (int r_ = 0; r_ < MK_REP_N; ++r_) GSYNC(); } } while (0)
    MK_STEP(0); GSYNC(); MK_STEP(1); GSYNC(); MK_STEP(2); GSYNC(); MK_STEP(3); GSYNC(); MK_STEP(5); GSYNC();
    MK_STEP(6); GSYNC(); MK_STEP(7); GSYNC(); MK_STEP(8); GSYNC(); MK_STEP(9); GSYNC(); MK_STEP(10);
}
#endif

extern "C" void kernel_launch(void* const* d_in, const int* in_sizes, int n_in, void* d_out, int out_size, void* d_ws, size_t ws_size, hipStream_t stream) {
    static int grid = 0;
    if (grid == 0) {
        int dev = 0, cus = 0, per_cu = 0;
        (void)hipGetDevice(&dev);
        (void)hipDeviceGetAttribute(&cus, hipDeviceAttributeMultiprocessorCount, dev);
#if MK_ONE_LAUNCH
        (void)hipFuncSetAttribute((const void*)mk_fwd, hipFuncAttributeMaxDynamicSharedMemorySize, LDS_BYTES);
        (void)hipOccupancyMaxActiveBlocksPerMultiprocessor(&per_cu, (const void*)mk_fwd, NTHREADS, LDS_BYTES);
#else
#define MK_ATTR(PH) (void)hipFuncSetAttribute((const void*)mk_one<PH>, hipFuncAttributeMaxDynamicSharedMemorySize, LDS_BYTES)
        MK_ATTR(0); MK_ATTR(1); MK_ATTR(2); MK_ATTR(3); MK_ATTR(4); MK_ATTR(5); MK_ATTR(6); MK_ATTR(7); MK_ATTR(8); MK_ATTR(9); MK_ATTR(10);
        per_cu = 1;
#endif
        if (per_cu < 1) { fprintf(stderr, "kernel_launch: occupancy query reports %d blocks/CU\n", per_cu); per_cu = 1; }
        grid = cus;
        if (ws_size < WS_END) { fprintf(stderr, "kernel_launch: workspace too small (%zu < %zu)\n", ws_size, (size_t)WS_END); grid = -1; }
        (void)hipGetLastError();
    }
    if (grid < 0) return;
    (void)hipMemsetAsync((char*)d_ws + WS_CTL, 0, CTL_BYTES, stream);
    Params p{};
    for (int i = 0; i < 23; ++i) p.in[i] = (const float*)d_in[i];
    p.out = (float*)d_out; p.ws = (unsigned char*)d_ws;
#if MK_ONE_LAUNCH
    hipLaunchKernelGGL(mk_fwd, dim3(grid), dim3(NTHREADS), LDS_BYTES, stream, p);
#else
#ifndef MK_DUP_PHASE
#define MK_DUP_PHASE -1
#endif
#define MK_LAUNCH1(PH) do { if ((PH) == 3 || (PH) == 2) (void)hipMemsetAsync((char*)d_ws + WS_CTL + 4 * CW_Q3, 0, 12, stream); if ((PH) == 6) (void)hipMemsetAsync((char*)d_ws + WS_CTL + 4 * CW_CNT, 0, 128, stream); if ((PH) == 7) (void)hipMemsetAsync((char*)d_ws + WS_CTL + 4 * CW_FILL, 0, 128, stream); hipLaunchKernelGGL(mk_one<PH>, dim3(grid), dim3(NTHREADS), LDS_BYTES, stream, p); } while (0)
#define MK_LAUNCH(PH) do { MK_LAUNCH1(PH); if (MK_DUP_PHASE == (PH)) MK_LAUNCH1(PH); } while (0)
    MK_LAUNCH(0); MK_LAUNCH(1); MK_LAUNCH(2); MK_LAUNCH(3); MK_LAUNCH(5); MK_LAUNCH(6); MK_LAUNCH(7); MK_LAUNCH(8); MK_LAUNCH(9); MK_LAUNCH(10);
#endif
}
```

```cpp
#include <hip/hip_runtime.h>
#include <hip/hip_cooperative_groups.h>
#include <cstdint>
#include <cstdio>
namespace cg = cooperative_groups;

#ifndef MK_ONE_LAUNCH
#define MK_ONE_LAUNCH 1
#endif

#ifndef MK_P2_GRABS
#define MK_P2_GRABS 10
#endif
#define LAS __attribute__((address_space(3)))
typedef unsigned short bf16_t;
typedef short bf16x8 __attribute__((ext_vector_type(8)));
typedef float f32x4 __attribute__((ext_vector_type(4)));
typedef float f32x2 __attribute__((ext_vector_type(2)));
typedef unsigned u32x4 __attribute__((ext_vector_type(4)));
typedef unsigned u32x2 __attribute__((ext_vector_type(2)));
typedef int i32x8 __attribute__((ext_vector_type(8)));
typedef int i32x4 __attribute__((ext_vector_type(4)));

constexpr int NB = 16, SEQ = 2048, DM = 1024, MTOK = NB * SEQ;
constexpr int NPROJ = 3072;
constexpr int CQ = 0, CKC = 512, CVC = 640, CKS = 768, CVS = 896, CKW = 1024, CVW = 1152, CGQ = 1280, CGK = 1536, CGV = 1792, CGR = 2304, CGATE = 2816, CGLR = 2840;
constexpr int NEXP = 32, DFF = 1024;
constexpr int MAXTILES = 544, XROWS = MAXTILES * 256;
constexpr float EPS = 1e-6f;
constexpr int NTHREADS = 512;
constexpr int LDS_BYTES = 160 * 1024;

constexpr size_t MiB = 1u << 20;
constexpr size_t WS_CTL = 0;
constexpr size_t WS_WIN = 2 * MiB;
constexpr size_t WS_WOUT = 8 * MiB;
constexpr size_t WS_CW1K = 10 * MiB, WS_CW1V = 11 * MiB;
constexpr size_t WS_CW2K = 12 * MiB, WS_CW2V = 12 * MiB + 512 * 1024;
constexpr size_t WS_CBIAS = 13 * MiB;
constexpr size_t WS_WRT = 13 * MiB + 512 * 1024;
constexpr size_t WS_WGU = 16 * MiB;
constexpr size_t WS_WD = 144 * MiB;
constexpr size_t WS_H = 208 * MiB;
constexpr size_t WS_PROJ = 272 * MiB;
constexpr size_t WS_QN = 464 * MiB, WS_QR = 496 * MiB;
constexpr size_t WS_KS = 528 * MiB, WS_KW = 536 * MiB;
constexpr size_t WS_VST = 544 * MiB, WS_VWT = 552 * MiB;
constexpr size_t WS_KC = 560 * MiB, WS_VCT = 561 * MiB;
constexpr size_t WS_U = 562 * MiB;
constexpr size_t WS_OI = 626 * MiB;
constexpr size_t WS_QD = 690 * MiB;
constexpr size_t WS_DEC = 722 * MiB;
constexpr size_t WS_SP = 723 * MiB;
constexpr size_t WS_ATT = 787 * MiB;
constexpr size_t WS_TOPI = 851 * MiB, WS_TOPG = 852 * MiB, WS_DEST = 853 * MiB;
constexpr size_t WS_RL = 272 * MiB;
constexpr size_t WS_ACT = 544 * MiB;
constexpr size_t WS_Y = 272 * MiB;
constexpr size_t WS_X1 = 854 * MiB;
constexpr size_t WS_END = 982 * MiB;
constexpr int CW_CNT = 0, CW_FILL = 64, CW_Q3 = 128, CW_Q2 = 129, CW_QC = 130, CW_BAR = 1024;
constexpr int CTL_BYTES = 32768;

struct Params {
    const float* in[23];
    float* out;
    unsigned char* ws;
};

__device__ __forceinline__ float bf2f(bf16_t v) { return __uint_as_float(((unsigned)v) << 16); }
__device__ __forceinline__ unsigned f2bf(float f) { unsigned u = __float_as_uint(f); return (u + 0x7fffu + ((u >> 16) & 1u)) >> 16; }
__device__ __forceinline__ unsigned pk2(float lo, float hi) { return f2bf(lo) | (f2bf(hi) << 16); }
__device__ __forceinline__ unsigned pk4_fp8(float a, float b, float c, float d) { int r = __builtin_amdgcn_cvt_pk_fp8_f32(a, b, 0, false); r = __builtin_amdgcn_cvt_pk_fp8_f32(c, d, r, true); return (unsigned)r; }
__device__ __forceinline__ float wave_sum(float v) {
#pragma unroll
    for (int o = 1; o < 64; o <<= 1) v += __shfl_xor(v, o);
    return v;
}
#define LDS_WAIT() asm volatile("s_waitcnt lgkmcnt(0)" ::: "memory")
#define BAR_LDS() do { asm volatile("s_waitcnt lgkmcnt(0)" ::: "memory"); __builtin_amdgcn_s_barrier(); asm volatile("" ::: "memory"); } while (0)
__device__ __forceinline__ int opaque_tid() { int t = threadIdx.x; asm volatile("" : "+v"(t)); return t; }
__device__ __forceinline__ float sigmoidf_(float x) { return __builtin_amdgcn_rcpf(1.f + __builtin_amdgcn_exp2f(-1.4426950408889634f * x)); }
template <int CTRL> __device__ __forceinline__ float dppf(float v) { return __int_as_float(__builtin_amdgcn_update_dpp(0, __float_as_int(v), CTRL, 0xf, 0xf, true)); }
__device__ __forceinline__ float red16_max(float v) { v = fmaxf(v, dppf<0xB1>(v)); v = fmaxf(v, dppf<0x4E>(v)); v = fmaxf(v, dppf<0x141>(v)); v = fmaxf(v, dppf<0x140>(v)); return v; }
__device__ __forceinline__ float red16_sum(float v) { v += dppf<0xB1>(v); v += dppf<0x4E>(v); v += dppf<0x141>(v); v += dppf<0x140>(v); return v; }


namespace pg8 {
constexpr int BM = 256, BK = 64, HALF = 128, HTB = HALF * BK * 2, STAGE_BYTES = 8 * HTB, NXCD = 8, WGM = 8;
__device__ __forceinline__ int swz(int r) { const int p = (r >> 1) & 7, a = (p >> 2) & 1, b = (p >> 1) & 1, c = p & 1; return ((a ^ b) << 2) | (a << 1) | c; }
template <bool FP8> __device__ __forceinline__ int lds_byte(int r, int c) {
    if (FP8) return r * 128 + ((((c >> 3) ^ swz(r)) & 7) << 4);
    const int st = (r >> 4) * 2 + (c >> 5), rr = r & 15, cc = c & 31, ob = rr * 64 + cc * 2; return st * 1024 + (ob ^ (((ob >> 9) & 1) << 5));
}
template <bool FP8> __device__ __forceinline__ void stage_rc(int b, int& R, int& C) {
    if (FP8) { const int slot = b >> 4; R = slot >> 3; C = (((slot & 7) ^ swz(R)) & 7) * 8; }
    else { const int st = b / 1024, sb = b % 1024, sw = sb ^ (((sb >> 9) & 1) << 5); R = (st >> 1) * 16 + sw / 64; C = (st & 1) * 32 + (sw % 64) / 2; }
}
__device__ __forceinline__ int perm32(int rho) { const int n = rho >> 4, i = rho & 15; return 8 * (i >> 2) + 4 * n + (i & 3); }

struct Unit { int pm, pn, pb; };
struct Gemm { const void* A; const void* Bt; int Kb; };

__device__ __forceinline__ bool order_next(long L, int nM, int nN, int& pm, int& pn) {
    const int nwg = nM * nN; if (L >= nwg) return false;
    int wgid = (int)L; { const int q = nwg / NXCD, r = nwg % NXCD, xcd = wgid % NXCD, off = wgid / NXCD; wgid = (xcd < r ? xcd * (q + 1) : r * (q + 1) + (xcd - r) * q) + off; }
    const int nig = WGM * nN, gid = wgid / nig, fm = gid * WGM, gsz = (nM - fm) < WGM ? (nM - fm) : WGM;
    pm = fm + ((wgid % nig) % gsz); pn = (wgid % nig) / gsz; return true;
}
struct StaticOrder {
    static constexpr bool GATHER = false;
    int nM, nN, G, c;
    __device__ __forceinline__ bool next(int i, Unit& u) const { if (!order_next((long)i * G + c, nM, nN, u.pm, u.pn)) return false; u.pb = u.pn; return true; }
    __device__ __forceinline__ void a_offsets(const Unit&, const int (&)[2], const int (&)[2], int, unsigned (&)[2][2]) const {}
};
struct MoeOrder {
    static constexpr bool GATHER = false;
    int nM, nN, G, c; const LAS int* tile_e;
    __device__ __forceinline__ bool next(int i, Unit& u) const { if (!order_next((long)i * G + c, nM, nN, u.pm, u.pn)) return false; u.pb = __builtin_amdgcn_readfirstlane(tile_e[u.pm] * nN + u.pn); return true; }
    __device__ __forceinline__ void a_offsets(const Unit&, const int (&)[2], const int (&)[2], int, unsigned (&)[2][2]) const {}
};
struct MoeGatherOrder {
    static constexpr bool GATHER = true;
    int nM, nN, G, c; const LAS int* tile_e; const LAS int* tstart; const LAS int* tcnt; const int* rowlist;
    __device__ __forceinline__ bool next(int i, Unit& u) const { if (!order_next((long)i * G + c, nM, nN, u.pm, u.pn)) return false; u.pb = __builtin_amdgcn_readfirstlane(tile_e[u.pm] * nN + u.pn); return true; }
    __device__ __forceinline__ void a_offsets(const Unit& u, const int (&R)[2], const int (&Cb)[2], int Kb, unsigned (&off)[2][2]) const {
        const int e = u.pb / nN, lt = u.pm - tstart[e], n = tcnt[e];
#pragma unroll
        for (int h = 0; h < 2; ++h)
#pragma unroll
            for (int i = 0; i < 2; ++i) { const int idx = lt * 256 + h * 128 + R[i]; const int tok = idx < n ? rowlist[(size_t)e * 32768 + idx] : 0; off[h][i] = (unsigned)tok * (unsigned)Kb + (unsigned)Cb[i]; }
    }
};

__device__ __forceinline__ void mfma8_acc(f32x4& c, const i32x8& a, const i32x8& b, int scl) {
    asm volatile("v_mfma_scale_f32_16x16x128_f8f6f4 %0, %1, %2, %0, %3, %3 op_sel_hi:[0,0,0]" : "+v"(c) : "v"(a), "v"(b), "v"(scl)); }
__device__ __forceinline__ i32x8 cat8(i32x4 a, i32x4 b) { return __builtin_shufflevector(a, b, 0, 1, 2, 3, 4, 5, 6, 7); }
__device__ __forceinline__ i32x8 frag8(bf16x8 lo, bf16x8 hi) { const i32x4 a = __builtin_bit_cast(i32x4, lo), b = __builtin_bit_cast(i32x4, hi); return (i32x8){a.x, a.y, a.z, a.w, b.x, b.y, b.z, b.w}; }
__device__ __forceinline__ unsigned cvt_pk_bf16(float lo, float hi) { unsigned r; asm volatile("v_cvt_pk_bf16_f32 %0, %1, %2" : "=v"(r) : "v"(lo), "v"(hi)); return r; }

struct EpiBf16 {
    static constexpr bool PERM = true;
    struct Pre {}; __device__ __forceinline__ Pre prefetch(const Unit&, int, int, int, int) const { return Pre{}; }
    bf16_t* O; int ldc;
    __device__ __forceinline__ void operator()(const f32x4 (&acc)[2][2][4][2], const Unit& u, const Pre&, int wr, int wc, int fr, int fq) const {
        const int row0 = u.pm * BM + wr * 64 + fr, col0 = u.pn * BM + wc * 32 + 8 * fq;
#pragma unroll
        for (int ai = 0; ai < 2; ++ai)
#pragma unroll
            for (int m = 0; m < 4; ++m) { bf16_t* rowp = O + (size_t)(row0 + ai * HALF + m * 16) * ldc + col0;
#pragma unroll
                for (int bj = 0; bj < 2; ++bj) { const f32x4 v0 = acc[ai][bj][m][0], v1 = acc[ai][bj][m][1];
                    u32x4 w; w.x = cvt_pk_bf16(v0[0], v0[1]); w.y = cvt_pk_bf16(v0[2], v0[3]); w.z = cvt_pk_bf16(v1[0], v1[1]); w.w = cvt_pk_bf16(v1[2], v1[3]);
                    *(u32x4*)(rowp + bj * HALF) = w; } }
    }
};
struct EpiResF32 {
    static constexpr bool PERM = false;
    struct Pre {}; __device__ __forceinline__ Pre prefetch(const Unit&, int, int, int, int) const { return Pre{}; }
    const float* base; float* out; int ldc;
    __device__ __forceinline__ void operator()(const f32x4 (&acc)[2][2][4][2], const Unit& u, const Pre&, int wr, int wc, int fr, int fq) const {
        const int col0 = u.pn * BM + wc * 32 + 4 * fq;
#pragma unroll
        for (int ai = 0; ai < 2; ++ai)
#pragma unroll
            for (int mp = 0; mp < 2; ++mp) {
                f32x4 bs[2][2][2];
#pragma unroll
                for (int mm = 0; mm < 2; ++mm) { const size_t off = (size_t)(u.pm * BM + ai * HALF + wr * 64 + (2 * mp + mm) * 16 + fr) * ldc + col0;
#pragma unroll
                    for (int bj = 0; bj < 2; ++bj)
#pragma unroll
                        for (int n = 0; n < 2; ++n) bs[mm][bj][n] = __builtin_nontemporal_load((const f32x4*)(base + off + bj * HALF + n * 16)); }
                asm volatile("" ::: "memory");
#pragma unroll
                for (int mm = 0; mm < 2; ++mm) { const size_t off = (size_t)(u.pm * BM + ai * HALF + wr * 64 + (2 * mp + mm) * 16 + fr) * ldc + col0;
#pragma unroll
                    for (int bj = 0; bj < 2; ++bj)
#pragma unroll
                        for (int n = 0; n < 2; ++n) *(f32x4*)(out + off + bj * HALF + n * 16) = bs[mm][bj][n] + acc[ai][bj][2 * mp + mm][n]; }
                asm volatile("" ::: "memory");
            }
    }
};
struct EpiSwiglu {
    static constexpr bool PERM = true;
    unsigned char* O; const float* bias; int nN;
    struct Pre { f32x4 bg0, bg1, bl0, bl1; };
    __device__ __forceinline__ Pre prefetch(const Unit& u, int wr, int wc, int fr, int fq) const {
        const int e = u.pb / nN, ch = u.pn * HALF + wc * 32 + 8 * fq;
        const float* bg = bias + (size_t)e * 2048 + ch; const float* bl = bg + 1024;
        return Pre{*(const f32x4*)bg, *(const f32x4*)(bg + 4), *(const f32x4*)bl, *(const f32x4*)(bl + 4)};
    }
    __device__ __forceinline__ void operator()(const f32x4 (&acc)[2][2][4][2], const Unit& u, const Pre& pre, int wr, int wc, int fr, int fq) const {
        const int row0 = u.pm * BM + wr * 64 + fr, ch = u.pn * HALF + wc * 32 + 8 * fq;
        const f32x4 bg0 = pre.bg0, bg1 = pre.bg1, bl0 = pre.bl0, bl1 = pre.bl1;
#pragma unroll
        for (int ai = 0; ai < 2; ++ai)
#pragma unroll
            for (int m = 0; m < 4; ++m) {
                float r[8];
#pragma unroll
                for (int n = 0; n < 2; ++n)
#pragma unroll
                    for (int j = 0; j < 4; ++j) {
                        float gv = acc[ai][0][m][n][j] * (1.f / 32.f) + (n ? bg1[j] : bg0[j]);
                        float lv = acc[ai][1][m][n][j] * (1.f / 32.f) + (n ? bl1[j] : bl0[j]);
                        gv = fminf(gv, 7.0f); lv = fminf(fmaxf(lv, -7.0f), 7.0f);
                        r[n * 4 + j] = gv * __builtin_amdgcn_rcpf(1.f + __builtin_amdgcn_exp2f(-1.702f * 1.4426950408889634f * gv)) * (lv + 1.0f);
                    }
                u32x2 w; w.x = pk4_fp8(r[0], r[1], r[2], r[3]); w.y = pk4_fp8(r[4], r[5], r[6], r[7]);
                *(u32x2*)(O + (size_t)(row0 + ai * HALF + m * 16) * DFF + ch) = w;
            }
    }
};
struct EpiDown {
    static constexpr bool PERM = true;
    bf16_t* O; const float* bias; int nN;
    struct Pre { f32x4 bv[2][2]; };
    __device__ __forceinline__ Pre prefetch(const Unit& u, int wr, int wc, int fr, int fq) const {
        const int e = u.pb / nN, col0 = u.pn * BM + wc * 32 + 8 * fq;
        const float* bp = bias + (size_t)e * 1024 + col0;
        Pre pr;
#pragma unroll
        for (int bj = 0; bj < 2; ++bj)
#pragma unroll
            for (int n = 0; n < 2; ++n) pr.bv[bj][n] = *(const f32x4*)(bp + bj * HALF + 4 * n);
        return pr;
    }
    __device__ __forceinline__ void operator()(const f32x4 (&acc)[2][2][4][2], const Unit& u, const Pre& pre, int wr, int wc, int fr, int fq) const {
        const int row0 = u.pm * BM + wr * 64 + fr, col0 = u.pn * BM + wc * 32 + 8 * fq;
        f32x4 bv[2][2];
#pragma unroll
        for (int bj = 0; bj < 2; ++bj)
#pragma unroll
            for (int n = 0; n < 2; ++n) bv[bj][n] = pre.bv[bj][n];
#pragma unroll
        for (int ai = 0; ai < 2; ++ai)
#pragma unroll
            for (int m = 0; m < 4; ++m) { bf16_t* rowp = O + (size_t)(row0 + ai * HALF + m * 16) * 1024 + col0;
#pragma unroll
                for (int bj = 0; bj < 2; ++bj) { const f32x4 v0 = acc[ai][bj][m][0] * (1.f / 32.f) + bv[bj][0], v1 = acc[ai][bj][m][1] * (1.f / 32.f) + bv[bj][1];
                    u32x4 w; w.x = cvt_pk_bf16(v0[0], v0[1]); w.y = cvt_pk_bf16(v0[2], v0[3]); w.z = cvt_pk_bf16(v1[0], v1[1]); w.w = cvt_pk_bf16(v1[2], v1[3]);
                    *(u32x4*)(rowp + bj * HALF) = w; } }
    }
};

template <bool FP8, class Epi, class Sched>
__device__ __forceinline__ void gemm_phase(LAS unsigned char* lds, const Gemm g, const Sched& S, const Epi& E) {
    const int tid = opaque_tid(), wid = __builtin_amdgcn_readfirstlane(tid >> 6), lane = tid & 63, wr = wid >> 2, wc = wid & 3, fr = lane & 15, fq = lane >> 4;
    const int Kb = g.Kb, nt = Kb / 128;
    unsigned voffB[2]; int stR[2], stC[2];
    unsigned offc[2][2], offn[2][2];
#pragma unroll
    for (int i = 0; i < 2; ++i) { int R, C; stage_rc<FP8>(tid * 16 + i * 8192, R, C); const int Rb = Epi::PERM ? ((R & ~31) + perm32(R & 31)) : R;
        stR[i] = R; stC[i] = C * 2; voffB[i] = (unsigned)(Rb * Kb + C * 2);
        offc[0][i] = (unsigned)(R * Kb + C * 2); offc[1][i] = offc[0][i] + (unsigned)(HALF * Kb); offn[0][i] = offc[0][i]; offn[1][i] = offc[1][i]; }
    const size_t kstep = (size_t)(BK * 2);
    const size_t hstep = (size_t)HALF * Kb;
    const size_t tstep = 2 * hstep;
    const unsigned ldsw = (unsigned)wid * 1024u;
    const int aoff = FP8 ? lds_byte<true>(wr * 64 + fr, fq * 16) : lds_byte<false>(wr * 64 + fr, fq * 8), boff = FP8 ? lds_byte<true>(wc * 32 + fr, fq * 16) : lds_byte<false>(wc * 32 + fr, fq * 8);
    const int aoff1 = FP8 ? (aoff ^ 16) : (aoff + 1024), boff1 = FP8 ? (boff ^ 16) : (boff + 1024);
#define PG8_SA(b, h) (((b) * 2 + (h)) * HTB)
#define PG8_SB(b, h) ((4 + (b) * 2 + (h)) * HTB)
#define PG8_STAGE(bufoff, gbase, voff) do { _Pragma("unroll") for (int _i = 0; _i < 2; ++_i) \
        __builtin_amdgcn_global_load_lds((const unsigned*)((const char*)(gbase) + (voff)[_i]), (LAS unsigned*)(lds + (bufoff) + ldsw + _i * 8192), 16, 0, 0); } while (0)
#define PG8_LDA(dst, b, h) do { if constexpr (FP8) { _Pragma("unroll") for (int m = 0; m < 4; ++m) dst##8[m] = cat8(*(const LAS i32x4*)(lds + PG8_SA(b, h) + aoff + m * 2048), *(const LAS i32x4*)(lds + PG8_SA(b, h) + aoff1 + m * 2048)); } \
        else { _Pragma("unroll") for (int m = 0; m < 4; ++m) { dst[m][0] = *(const LAS bf16x8*)(lds + PG8_SA(b, h) + aoff + m * 2048); dst[m][1] = *(const LAS bf16x8*)(lds + PG8_SA(b, h) + aoff1 + m * 2048); } } } while (0)
#define PG8_LDB(dst, b, h) do { if constexpr (FP8) { _Pragma("unroll") for (int n = 0; n < 2; ++n) dst##8[n] = cat8(*(const LAS i32x4*)(lds + PG8_SB(b, h) + boff + n * 2048), *(const LAS i32x4*)(lds + PG8_SB(b, h) + boff1 + n * 2048)); } \
        else { _Pragma("unroll") for (int n = 0; n < 2; ++n) { dst[n][0] = *(const LAS bf16x8*)(lds + PG8_SB(b, h) + boff + n * 2048); dst[n][1] = *(const LAS bf16x8*)(lds + PG8_SB(b, h) + boff1 + n * 2048); } } } while (0)
#define PG8_MMA(ai, bj, At, Bt) do { __builtin_amdgcn_s_setprio(1); _Pragma("unroll") for (int m = 0; m < 4; ++m) _Pragma("unroll") for (int n = 0; n < 2; ++n) { \
        if constexpr (FP8) mfma8_acc(acc[ai][bj][m][n], Bt##8[n], At##8[m], scl); \
        else { _Pragma("unroll") for (int k = 0; k < 2; ++k) acc[ai][bj][m][n] = __builtin_amdgcn_mfma_f32_16x16x32_bf16(Bt[n][k], At[m][k], acc[ai][bj][m][n], 0, 0, 0); } } \
        __builtin_amdgcn_s_setprio(0); } while (0)
#define PG8_WAIT_V(n) asm volatile("s_waitcnt vmcnt(" #n ")" ::: "memory")
#define PG8_WAIT_L(n) asm volatile("s_waitcnt lgkmcnt(" #n ")" ::: "memory")
#define PG8_BAR __builtin_amdgcn_s_barrier()
#define PG8_SCHED __builtin_amdgcn_sched_barrier(0)
    Unit cur, nxt; int ui = 0;
    if (!S.next(0, cur)) return;
    f32x4 acc[2][2][4][2];
#pragma unroll
    for (int a = 0; a < 2; ++a)
#pragma unroll
        for (int b = 0; b < 2; ++b)
#pragma unroll
            for (int m = 0; m < 4; ++m)
#pragma unroll
                for (int n = 0; n < 2; ++n) acc[a][b][m][n] = (f32x4){0.f, 0.f, 0.f, 0.f};
    bf16x8 At[4][2], B0[2][2], B1[2][2];
    i32x8 At8[4], B08[2], B18[2];
    int scl = 0x7f7f7f7f; asm volatile("" : "+v"(scl));
    const char* cA = Sched::GATHER ? (const char*)g.A : (const char*)g.A + (size_t)cur.pm * tstep; const char* cB = (const char*)g.Bt + (size_t)cur.pb * tstep;
    if constexpr (Sched::GATHER) S.a_offsets(cur, stR, stC, Kb, offc);
    typename Epi::Pre pre = E.prefetch(cur, wr, wc, fr, fq);
    {
        PG8_STAGE(PG8_SB(0, 0), cB, voffB); PG8_STAGE(PG8_SB(0, 1), cB + hstep, voffB); PG8_STAGE(PG8_SA(0, 0), cA, offc[0]); PG8_STAGE(PG8_SA(0, 1), cA, offc[1]);
        if (wr == 1) PG8_BAR;
        PG8_WAIT_V(2); PG8_BAR;
        PG8_STAGE(PG8_SB(1, 0), cB + kstep, voffB); PG8_STAGE(PG8_SA(1, 0), cA + kstep, offc[0]); PG8_STAGE(PG8_SB(1, 1), cB + hstep + kstep, voffB);
        PG8_WAIT_V(6); PG8_BAR;
    }
    for (;;) {
        const bool has_next = S.next(ui + 1, nxt);
        const char* nA = Sched::GATHER ? cA : (has_next ? (const char*)g.A + (size_t)nxt.pm * tstep : cA); const char* nB = has_next ? (const char*)g.Bt + (size_t)nxt.pb * tstep : cB;
        if constexpr (Sched::GATHER) {
            if (has_next) S.a_offsets(nxt, stR, stC, Kb, offn);
            else {
#pragma unroll
                for (int h = 0; h < 2; ++h)
#pragma unroll
                    for (int i = 0; i < 2; ++i) offn[h][i] = offc[h][i];
            }
        }
#pragma unroll 1
        for (int t = 0; t < nt; t += 2) {
            const bool last = (t == nt - 2);
            const char* a1 = cA + (size_t)(t + 1) * kstep;
            const char* a2 = last ? nA : cA + (size_t)(t + 2) * kstep; const char* b2 = last ? nB : cB + (size_t)(t + 2) * kstep;
            const char* a3 = a2 + kstep; const char* b3 = b2 + kstep;
            unsigned o20[2], o21[2];
#pragma unroll
            for (int i = 0; i < 2; ++i) { o20[i] = (Sched::GATHER && last) ? offn[0][i] : offc[0][i]; o21[i] = (Sched::GATHER && last) ? offn[1][i] : offc[1][i]; }
            PG8_LDB(B0, 0, 0); PG8_LDB(B1, 0, 1); PG8_SCHED; PG8_LDA(At, 0, 0); PG8_STAGE(PG8_SA(1, 1), a1, offc[1]);
            PG8_WAIT_V(8); PG8_WAIT_L(0); PG8_BAR; PG8_MMA(0, 0, At, B0); PG8_MMA(0, 1, At, B1); PG8_BAR; PG8_SCHED;
            PG8_LDA(At, 0, 1); PG8_STAGE(PG8_SB(0, 0), b2, voffB); PG8_STAGE(PG8_SB(0, 1), b2 + hstep, voffB); PG8_STAGE(PG8_SA(0, 0), a2, o20);
            PG8_WAIT_V(8); PG8_WAIT_L(0); PG8_BAR; PG8_MMA(1, 0, At, B0); PG8_MMA(1, 1, At, B1); PG8_BAR; PG8_SCHED;
            PG8_LDB(B0, 1, 0); PG8_LDB(B1, 1, 1); PG8_SCHED; PG8_LDA(At, 1, 0); PG8_STAGE(PG8_SA(0, 1), a2, o21);
            PG8_WAIT_V(8); PG8_WAIT_L(0); PG8_BAR; PG8_MMA(0, 0, At, B0); PG8_MMA(0, 1, At, B1); PG8_BAR; PG8_SCHED;
            PG8_LDA(At, 1, 1); PG8_STAGE(PG8_SB(1, 0), b3, voffB); PG8_STAGE(PG8_SB(1, 1), b3 + hstep, voffB); PG8_STAGE(PG8_SA(1, 0), a3, o20);
            PG8_WAIT_V(8); PG8_WAIT_L(0); PG8_BAR; PG8_MMA(1, 0, At, B0); PG8_MMA(1, 1, At, B1); PG8_BAR; PG8_SCHED;
        }
        if (wr == 0) PG8_BAR;
        if constexpr (FP8) asm volatile("s_nop 15\n\ts_nop 15" ::: "memory");
        E(acc, cur, pre, wr, wc, fr, fq);
        if (!has_next) break;
#pragma unroll
        for (int a = 0; a < 2; ++a)
#pragma unroll
            for (int b = 0; b < 2; ++b)
#pragma unroll
                for (int m = 0; m < 4; ++m)
#pragma unroll
                    for (int n = 0; n < 2; ++n) acc[a][b][m][n] = (f32x4){0.f, 0.f, 0.f, 0.f};
        cur = nxt; cA = nA; cB = nB; ++ui;
        if constexpr (Sched::GATHER) {
#pragma unroll
            for (int h = 0; h < 2; ++h)
#pragma unroll
                for (int i = 0; i < 2; ++i) offc[h][i] = offn[h][i];
        }
        pre = E.prefetch(cur, wr, wc, fr, fq);
        if (wr == 1) PG8_BAR;
    }
    PG8_WAIT_V(0);
    PG8_BAR;
#undef PG8_SA
#undef PG8_SB
#undef PG8_STAGE
#undef PG8_LDA
#undef PG8_LDB
#undef PG8_MMA
#undef PG8_WAIT_V
#undef PG8_WAIT_L
#undef PG8_BAR
#undef PG8_SCHED
}
}

__device__ __forceinline__ int win_map(int n) {
    if (n < 1280) return n;
    if (n < 2304) return n + 24;
    if (n < 2816) return n + 40;
    if (n < 2840) return n - 1536;
    if (n < 2856) return n - 512;
    return -1;
}
template <int MODE> __device__ __forceinline__ int colmap(int r) {
    if (MODE == 1) return win_map(r);
    if (MODE == 2) return ((r >> 7) & 1) * 1024 + (r >> 8) * 128 + (r & 127);
    return r;
}
template <int MODE, bool OUT8>
__device__ __forceinline__ void transpose_item(const float* W, int K, int Nsrc, void* WTv, int nblk, LAS float* scr, int item, int lane) {
    const int kb = item / nblk, nb = item % nblk, k0 = 64 * kb, n0 = 64 * nb;
    const int nq = 4 * (lane & 15), kq = lane >> 4;
    const int sc = colmap<MODE>(n0 + nq);
    f32x4 v[16];
#pragma unroll
    for (int i = 0; i < 16; ++i) v[i] = sc >= 0 ? __builtin_nontemporal_load((const f32x4*)(W + (size_t)(k0 + 4 * i + kq) * Nsrc + sc)) : (f32x4){0.f, 0.f, 0.f, 0.f};
#pragma unroll
    for (int i = 0; i < 16; ++i) { LAS float* d = scr + (4 * i + kq) * 65 + nq; d[0] = v[i].x; d[1] = v[i].y; d[2] = v[i].z; d[3] = v[i].w; }
    LDS_WAIT();
    const int c = lane & 7;
#pragma unroll
    for (int j = 0; j < 8; ++j) { const int n = (lane >> 3) + 8 * j; const LAS float* s = scr + (8 * c) * 65 + n;
        if (OUT8) {
            u32x2 o; o.x = pk4_fp8(s[0 * 65] * 32.f, s[1 * 65] * 32.f, s[2 * 65] * 32.f, s[3 * 65] * 32.f); o.y = pk4_fp8(s[4 * 65] * 32.f, s[5 * 65] * 32.f, s[6 * 65] * 32.f, s[7 * 65] * 32.f);
            *(u32x2*)((unsigned char*)WTv + (size_t)(n0 + n) * K + k0 + 8 * c) = o;
        } else {
            u32x4 o; o.x = pk2(s[0 * 65], s[1 * 65]); o.y = pk2(s[2 * 65], s[3 * 65]); o.z = pk2(s[4 * 65], s[5 * 65]); o.w = pk2(s[6 * 65], s[7 * 65]);
            *(u32x4*)((bf16_t*)WTv + (size_t)(n0 + n) * K + k0 + 8 * c) = o; } }
    LDS_WAIT();
}
template <int NR>
__device__ __forceinline__ void rms_rows_to_bf16(const float* x0, size_t xstride, const float* g, bf16_t* o0, size_t ostride, int lane) {
    f32x4 v[NR][4];
#pragma unroll
    for (int r = 0; r < NR; ++r) { const f32x4* xr = (const f32x4*)(x0 + r * xstride) + lane;
#pragma unroll
        for (int j = 0; j < 4; ++j) v[r][j] = __builtin_nontemporal_load(xr + 64 * j); }
    const f32x4* gr = (const f32x4*)g + lane;
    f32x4 gg[4];
#pragma unroll
    for (int j = 0; j < 4; ++j) gg[j] = gr[64 * j];
#pragma unroll
    for (int r = 0; r < NR; ++r) {
        float s = 0.f;
#pragma unroll
        for (int j = 0; j < 4; ++j) s += (v[r][j].x * v[r][j].x + v[r][j].y * v[r][j].y) + (v[r][j].z * v[r][j].z + v[r][j].w * v[r][j].w);
        const float rstd = 1.f / sqrtf(wave_sum(s) * (1.f / DM) + EPS);
        unsigned long long* o8 = (unsigned long long*)(o0 + r * ostride) + lane;
#pragma unroll
        for (int j = 0; j < 4; ++j) { const f32x4 o = v[r][j] * rstd * gg[j];
            o8[64 * j] = (unsigned long long)pk2(o.x, o.y) | ((unsigned long long)pk2(o.z, o.w) << 32); }
    }
}
__device__ __forceinline__ void phase0(const Params& p, LAS unsigned char* lds, int blk, int G) {
    const int tid = opaque_tid(), lane = tid & 63, wave = tid >> 6;
    LAS float* scr = (LAS float*)(lds + wave * 16640);
    const int gw = blk * 8 + wave, NGW = G * 8;
    unsigned char* ws = p.ws;
    constexpr int I_GU = 16 * 32, I_DN = 16 * 16;
    constexpr int N_GU = NEXP * I_GU, N_DN = NEXP * I_DN, N_IN = 16 * (NPROJ / 64), N_OUT = 16 * 16, N_C1 = 32 * 4, N_C2 = 4 * 1;
    constexpr int NITEMS = N_IN + N_OUT + 2 * N_C1 + 2 * N_C2;
    (void)N_GU; (void)N_DN;
    for (int it = gw; it < NITEMS; it += NGW) {
        int r = it;
        if (r < N_IN) { transpose_item<1, false>(p.in[3], 1024, 2856, (bf16_t*)(ws + WS_WIN), NPROJ / 64, scr, r, lane); continue; } r -= N_IN;
        if (r < N_OUT) { transpose_item<0, false>(p.in[15], 1024, 1024, (bf16_t*)(ws + WS_WOUT), 16, scr, r, lane); continue; } r -= N_OUT;
        if (r < N_C1) { transpose_item<0, false>(p.in[7], 2048, 256, (bf16_t*)(ws + WS_CW1K), 4, scr, r, lane); continue; } r -= N_C1;
        if (r < N_C1) { transpose_item<0, false>(p.in[10], 2048, 256, (bf16_t*)(ws + WS_CW1V), 4, scr, r, lane); continue; } r -= N_C1;
        if (r < N_C2) { transpose_item<0, false>(p.in[8], 256, 64, (bf16_t*)(ws + WS_CW2K), 1, scr, r, lane); continue; } r -= N_C2;
        transpose_item<0, false>(p.in[11], 256, 64, (bf16_t*)(ws + WS_CW2V), 1, scr, r, lane);
    }
    for (int m = gw * 4; m < MTOK; m += NGW * 4) rms_rows_to_bf16<4>(p.in[0] + (size_t)m * DM, DM, p.in[2], (bf16_t*)(ws + WS_H) + (size_t)m * DM, DM, lane);
    for (int i = blk * NTHREADS + tid; i < NEXP * DM; i += G * NTHREADS) { const int e = i >> 10, d = i & 1023; ((float*)(ws + WS_WRT))[i] = p.in[16][d] * p.in[17][d * NEXP + e]; }
    if (blk == G - 1) {
        const int which = tid >> 8, j = tid & 255;
        const float* pos = which ? p.in[9] : p.in[6]; const float* w1 = which ? p.in[10] : p.in[7];
        float s = 0.f;
#pragma unroll 8
        for (int k = 0; k < 2048; ++k) s += pos[k] * w1[(size_t)k * 256 + j];
        ((float*)(ws + WS_CBIAS))[tid] = s;
    }
}

__device__ __forceinline__ void p2a_unit(const Params& p, LAS unsigned char* lds, int unit) {
    const int tid = opaque_tid(), lane = tid & 63, wave = tid >> 6, vec = lane >> 4, li = lane & 15;
    unsigned char* ws = p.ws;
    const bf16_t* PROJ = (const bf16_t*)(ws + WS_PROJ);
    const int b = unit >> 5, blkc = unit & 31, tok0 = unit * 64;
    u32x4 vraw[4];
    { const int tk = tid >> 3, ch = tid & 7;
#pragma unroll
      for (int v = 0; v < 4; ++v) vraw[v] = *(const u32x4*)(PROJ + (size_t)(tok0 + tk) * NPROJ + (v < 2 ? CVS : CVW) + (v & 1) * 64 + 8 * ch); }
    const int col0 = CQ + vec * 64 + 4 * li, col1 = CQ + (4 + vec) * 64 + 4 * li, col2 = (vec < 2 ? CKS + vec * 64 : CKW + (vec - 2) * 64) + 4 * li;
    u32x2 raw[8][3];
#pragma unroll
    for (int ti = 0; ti < 8; ++ti) { const bf16_t* pr = PROJ + (size_t)(tok0 + wave * 8 + ti) * NPROJ;
        raw[ti][0] = *(const u32x2*)(pr + col0); raw[ti][1] = *(const u32x2*)(pr + col1); raw[ti][2] = *(const u32x2*)(pr + col2); }
    const f32x4 gq = *(const f32x4*)(p.in[4] + 4 * li);
    const f32x4 gk = *(const f32x4*)(p.in[5] + (vec < 2 ? 64 : 128) + 4 * li);
    float invf[4];
#pragma unroll
    for (int i = 0; i < 4; ++i) invf[i] = __expf(-13.122363377404328f * (float)(2 * ((4 * li + i) & 7)) * (1.f / 16.f));
    const float sgn = (li < 2) ? -1.f : 1.f;
#pragma unroll
    for (int ti = 0; ti < 8; ++ti) {
        const int t = tok0 + wave * 8 + ti;
        const float pos = (float)((const int*)p.in[1])[t];
        float cs[4], sn[4];
#pragma unroll
        for (int i = 0; i < 4; ++i) { const float ang = pos * invf[i]; cs[i] = __cosf(ang); sn[i] = __sinf(ang); }
#pragma unroll
        for (int vg = 0; vg < 3; ++vg) {
            const u32x2 rw = raw[ti][vg];
            float x[4] = {__uint_as_float(rw.x << 16), __uint_as_float(rw.x & 0xffff0000u), __uint_as_float(rw.y << 16), __uint_as_float(rw.y & 0xffff0000u)};
            const float ss = red16_sum((x[0] * x[0] + x[1] * x[1]) + (x[2] * x[2] + x[3] * x[3]));
            const float rstd = 1.f / sqrtf(ss * (1.f / 64.f) + EPS);
            const f32x4 g = (vg < 2) ? gq : gk;
            float y[4], yr[4];
#pragma unroll
            for (int i = 0; i < 4; ++i) y[i] = x[i] * rstd * g[i];
#pragma unroll
            for (int i = 0; i < 4; ++i) { const float partner = dppf<0x4E>(y[i]); yr[i] = (li < 4) ? (y[i] * cs[i] + sgn * partner * sn[i]) : y[i]; }
            if (vg < 2) {
                const float sc = 0.125f * 1.4426950408889634f;
                u32x2 o; o.x = pk2(y[0] * sc, y[1] * sc); o.y = pk2(y[2] * sc, y[3] * sc);
                *(u32x2*)((bf16_t*)(ws + WS_QN) + (size_t)t * 512 + (4 * vg + vec) * 64 + 4 * li) = o;
                o.x = pk2(yr[0] * sc, yr[1] * sc); o.y = pk2(yr[2] * sc, yr[3] * sc);
                *(u32x2*)((bf16_t*)(ws + WS_QR) + (size_t)t * 512 + (4 * vg + vec) * 64 + 4 * li) = o;
            } else {
                u32x2 o; o.x = pk2(yr[0], yr[1]); o.y = pk2(yr[2], yr[3]);
                bf16_t* dst = (bf16_t*)(ws + (vec < 2 ? WS_KS : WS_KW)) + ((size_t)(b * 2 + (vec & 1)) * SEQ + (t & (SEQ - 1))) * 64 + 4 * li;
                *(u32x2*)dst = o;
            }
        }
    }
    __syncthreads();
    { const int tk = tid >> 3, ch = tid & 7, tkp = (tk & ~12) | ((tk & 4) << 1) | ((tk & 8) >> 1);
#pragma unroll
      for (int v = 0; v < 4; ++v) { LAS bf16_t* T = (LAS bf16_t*)lds + v * (64 * 72);
#pragma unroll
          for (int q = 0; q < 4; ++q) { const unsigned wv = vraw[v][q]; T[(8 * ch + 2 * q) * 72 + tkp] = (bf16_t)(wv & 0xffffu); T[(8 * ch + 2 * q + 1) * 72 + tkp] = (bf16_t)(wv >> 16); } } }
    __syncthreads();
    { const int d = tid >> 3, ch = tid & 7;
#pragma unroll
      for (int v = 0; v < 4; ++v) { const LAS bf16_t* T = (const LAS bf16_t*)lds + v * (64 * 72);
          const u32x4 o = *(const LAS u32x4*)(T + d * 72 + 8 * ch);
          bf16_t* dst = (bf16_t*)(ws + (v < 2 ? WS_VST : WS_VWT)) + (((size_t)(b * 2 + (v & 1)) * 32 + blkc) * 64 + d) * 64 + 8 * ch;
          *(u32x4*)dst = o; } }
}

__device__ __forceinline__ void p2b_unit(const Params& p, LAS unsigned char* lds, int unit) {
    const int tid = opaque_tid(), lane = tid & 63, w = tid >> 6, fr = lane & 15, fq = lane >> 4;
    unsigned char* ws = p.ws;
    const bf16_t* PROJ = (const bf16_t*)(ws + WS_PROJ);
    const int which = unit >> 6, rt = unit & 63;
    const bf16_t* W1T = (const bf16_t*)(ws + (which ? WS_CW1V : WS_CW1K));
    const bf16_t* W2T = (const bf16_t*)(ws + (which ? WS_CW2V : WS_CW2K));
    const float* cb = (const float*)(ws + WS_CBIAS) + which * 256;
    const int colbase = which ? CVC : CKC;
    LAS bf16_t* Hd = (LAS bf16_t*)lds;
    LAS float* Of = (LAS float*)(lds + 64 * 264 * 2);
    const bf16_t* arow[4];
#pragma unroll
    for (int m = 0; m < 4; ++m) { const int R = rt * 64 + 16 * m + fr; const int bb = R >> 8, kh = (R >> 7) & 1; int n = R & 127; if (n > 126) n = 126;
        arow[m] = PROJ + (size_t)(bb * SEQ + 16 * n) * NPROJ + colbase + kh * 64 + 8 * fq; }
    const bf16_t* brow[2];
#pragma unroll
    for (int nf = 0; nf < 2; ++nf) brow[nf] = W1T + (size_t)(32 * w + 16 * nf + fr) * 2048 + 8 * fq;
    f32x4 acc[4][2];
#pragma unroll
    for (int m = 0; m < 4; ++m)
#pragma unroll
        for (int nf = 0; nf < 2; ++nf) acc[m][nf] = (f32x4){0.f, 0.f, 0.f, 0.f};
#pragma unroll 4
    for (int ks = 0; ks < 64; ++ks) {
        bf16x8 a[4], bb2[2];
        const size_t aoff = (size_t)(ks >> 1) * NPROJ + 32 * (ks & 1);
#pragma unroll
        for (int m = 0; m < 4; ++m) a[m] = *(const bf16x8*)(arow[m] + aoff);
#pragma unroll
        for (int nf = 0; nf < 2; ++nf) bb2[nf] = *(const bf16x8*)(brow[nf] + 32 * ks);
#pragma unroll
        for (int m = 0; m < 4; ++m)
#pragma unroll
            for (int nf = 0; nf < 2; ++nf) acc[m][nf] = __builtin_amdgcn_mfma_f32_16x16x32_bf16(a[m], bb2[nf], acc[m][nf], 0, 0, 0);
    }
#pragma unroll
    for (int nf = 0; nf < 2; ++nf) { const int col = 32 * w + 16 * nf + fr; const float bias = cb[col];
#pragma unroll
        for (int m = 0; m < 4; ++m)
#pragma unroll
            for (int j = 0; j < 4; ++j) { const float hv = acc[m][nf][j] + bias; Hd[(16 * m + 4 * fq + j) * 264 + col] = (bf16_t)f2bf(hv * sigmoidf_(hv)); } }
    __syncthreads();
    {
        const int m2 = w >> 1;
        f32x4 acc2[2] = {(f32x4){0.f, 0.f, 0.f, 0.f}, (f32x4){0.f, 0.f, 0.f, 0.f}};
#pragma unroll
        for (int ks = 0; ks < 8; ++ks) {
            const bf16x8 a = *(const LAS bf16x8*)(Hd + (16 * m2 + fr) * 264 + 32 * ks + 8 * fq);
#pragma unroll
            for (int q = 0; q < 2; ++q) { const int nf2 = 2 * (w & 1) + q; const bf16x8 bv = *(const bf16x8*)(W2T + (size_t)(16 * nf2 + fr) * 256 + 32 * ks + 8 * fq);
                acc2[q] = __builtin_amdgcn_mfma_f32_16x16x32_bf16(a, bv, acc2[q], 0, 0, 0); }
        }
#pragma unroll
        for (int q = 0; q < 2; ++q) { const int nf2 = 2 * (w & 1) + q;
#pragma unroll
            for (int j = 0; j < 4; ++j) Of[(16 * m2 + 4 * fq + j) * 65 + 16 * nf2 + fr] = acc2[q][j]; }
    }
    __syncthreads();
    for (int rr = 0; rr < 8; ++rr) {
        const int r = 8 * w + rr, R = rt * 64 + r, bb = R >> 8, kh = (R >> 7) & 1, n = R & 127;
        float v = Of[r * 65 + lane];
        if (which == 0) {
            const float ss = wave_sum(v * v);
            v = v * (1.f / sqrtf(ss * (1.f / 64.f) + EPS)) * p.in[5][lane];
            if (n == 127) v = 0.f;
            ((bf16_t*)(ws + WS_KC))[((size_t)(bb * 2 + kh) * 128 + n) * 64 + lane] = (bf16_t)f2bf(v);
        } else {
            if (n == 127) v = 0.f;
            ((bf16_t*)(ws + WS_VCT))[((size_t)(bb * 2 + kh) * 64 + lane) * 128 + ((n & ~12) | ((n & 4) << 1) | ((n & 8) >> 1))] = (bf16_t)f2bf(v);
        }
    }
    __syncthreads();
}

typedef float f32x16 __attribute__((ext_vector_type(16)));
constexpr int NSA_KT0 = 0, NSA_VT0 = 9216, NSA_KT1 = 18432, NSA_VT1 = 27648, NSA_IMPW = 36864, NSA_SELM = NSA_IMPW + 4 * 64 * 33 * 4, NSA_UNI = NSA_SELM + 256,
              NSA_OUT = NSA_UNI + 256;
static_assert(NSA_OUT + 256 * 68 * 4 <= LDS_BYTES - 64, "NSA LDS map");
constexpr float NEGBIG = -1e30f;
#define MFMA32(a, b, c) __builtin_amdgcn_mfma_f32_32x32x16_bf16((a), (b), (c), 0, 0, 0)

__device__ __forceinline__ bf16x8 pack_step(const f32x16& x, int s) {
    u32x4 p;
    if (s == 0) asm volatile("v_cvt_pk_bf16_f32 %0, %4, %5\n\tv_cvt_pk_bf16_f32 %1, %6, %7\n\tv_cvt_pk_bf16_f32 %2, %8, %9\n\tv_cvt_pk_bf16_f32 %3, %10, %11\n\ts_nop 1"
                     : "=&v"(p[0]), "=&v"(p[1]), "=&v"(p[2]), "=&v"(p[3]) : "v"(x[0]), "v"(x[1]), "v"(x[2]), "v"(x[3]), "v"(x[4]), "v"(x[5]), "v"(x[6]), "v"(x[7]));
    else asm volatile("v_cvt_pk_bf16_f32 %0, %4, %5\n\tv_cvt_pk_bf16_f32 %1, %6, %7\n\tv_cvt_pk_bf16_f32 %2, %8, %9\n\tv_cvt_pk_bf16_f32 %3, %10, %11\n\ts_nop 1"
                     : "=&v"(p[0]), "=&v"(p[1]), "=&v"(p[2]), "=&v"(p[3]) : "v"(x[8]), "v"(x[9]), "v"(x[10]), "v"(x[11]), "v"(x[12]), "v"(x[13]), "v"(x[14]), "v"(x[15]));
    return __builtin_bit_cast(bf16x8, p);
}
__device__ __forceinline__ void nsa_qk(const bf16x8 (&bq)[4], const LAS bf16_t* KT, f32x16 (&X)[2], int r, int h) {
#pragma unroll
    for (int kt = 0; kt < 2; ++kt) {
        f32x16 x;
#pragma unroll
        for (int i = 0; i < 16; ++i) x[i] = 0.f;
#pragma unroll
        for (int ks = 0; ks < 4; ++ks) { const bf16x8 a = *(const LAS bf16x8*)(KT + (32 * kt + r) * 72 + 16 * ks + 8 * h); x = MFMA32(a, bq[ks], x); }
        X[kt] = x;
    }
}
__device__ __forceinline__ void nsa_bounds(int mode, bool rok, int i, int cq, int koff, int& lo, int& hi) {
    hi = (mode == 1) ? i : ((mode == 3) ? (((cq + i - 31) >> 4) - koff) : 63);
    lo = (mode == 2) ? i + 1 : 0;
    hi = rok ? hi : -1;
}
__device__ __forceinline__ void nsa_tile(int MM, const bf16x8 (&bq)[4], const LAS bf16_t* KT, const LAS bf16_t* VT, float& lsum, f32x16 (&O)[2],
                                         bool rok, int mode, int iq, int cq, int koff, int r_, int h_) {
    int r = r_, h = h_;
    asm volatile("" : "+v"(r), "+v"(h));
    f32x16 X[2];
    nsa_qk(bq, KT, X, r, h);
#pragma unroll
    for (int kt = 0; kt < 2; ++kt)
#pragma unroll
        for (int i = 0; i < 16; ++i) X[kt][i] = __builtin_amdgcn_exp2f(X[kt][i]);
    if (MM == 1) {
#pragma unroll
        for (int kt = 0; kt < 2; ++kt)
#pragma unroll
            for (int i = 0; i < 16; ++i) X[kt][i] = rok ? X[kt][i] : 0.f;
    } else if (MM == 2) {
        int lo, hi; nsa_bounds(mode, rok, iq, cq, koff, lo, hi);
#pragma unroll
        for (int kt = 0; kt < 2; ++kt)
#pragma unroll
            for (int i = 0; i < 16; ++i) { const int key = 32 * kt + (i & 3) + 8 * (i >> 2) + 4 * h; X[kt][i] = ((key >= lo) & (key <= hi)) ? X[kt][i] : 0.f; }
    }
    bf16x8 pf[2][2];
    float ls = 0.f;
#pragma unroll
    for (int kt = 0; kt < 2; ++kt) {
#pragma unroll
        for (int i = 0; i < 16; i += 4) ls += (X[kt][i] + X[kt][i + 1]) + (X[kt][i + 2] + X[kt][i + 3]);
        pf[kt][0] = pack_step(X[kt], 0); pf[kt][1] = pack_step(X[kt], 1);
    }
    lsum += ls;
#pragma unroll
    for (int dt = 0; dt < 2; ++dt)
#pragma unroll
        for (int kt = 0; kt < 2; ++kt)
#pragma unroll
            for (int s = 0; s < 2; ++s) { const bf16x8 a = *(const LAS bf16x8*)(VT + (32 * dt + r) * 72 + 32 * kt + 16 * s + 8 * h); O[dt] = MFMA32(a, pf[kt][s], O[dt]); }
}
struct NsaStage { u32x4 k, v; };
__device__ __forceinline__ void nsa_fetch(NsaStage& st, const bf16_t* Ksrc, int kstride, const bf16_t* Vsrc, int vstride, int tid) {
    const int r = tid >> 3, ch = tid & 7;
    st.k = *(const u32x4*)(Ksrc + (size_t)r * kstride + 8 * ch);
    st.v = *(const u32x4*)(Vsrc + (size_t)r * vstride + 8 * ch);
}
__device__ __forceinline__ void nsa_commit(const NsaStage& st, LAS bf16_t* KT, LAS bf16_t* VT, int tid) {
    const int r = tid >> 3, ch = tid & 7;
    *(LAS u32x4*)(KT + r * 72 + 8 * ch) = st.k;
    *(LAS u32x4*)(VT + r * 72 + 8 * ch) = st.v;
}
template <bool FIRST>
__device__ __forceinline__ void nsa_out_acc(LAS float* OUTw, const f32x16 (&O)[2], float sc, int r, int h) {
#pragma unroll
    for (int dt = 0; dt < 2; ++dt)
#pragma unroll
        for (int gq = 0; gq < 4; ++gq) {
            LAS f32x4* dst = (LAS f32x4*)(OUTw + r * 68 + 32 * dt + 8 * gq + 4 * h);
            f32x4 v = (f32x4){O[dt][4 * gq] * sc, O[dt][4 * gq + 1] * sc, O[dt][4 * gq + 2] * sc, O[dt][4 * gq + 3] * sc};
            if (!FIRST) v += *dst;
            *dst = v;
        }
}

__device__ __forceinline__ void nsa_unit(const Params& p, LAS unsigned char* lds, int b, int kh, int c) {
    const int tid = opaque_tid(), lane = tid & 63, w = tid >> 6, r = lane & 31, h = lane >> 5, g = w >> 1, ih = w & 1;
    unsigned char* ws = p.ws;
    const int hh = kh * 4 + g, tok0 = b * SEQ + 64 * c, ibase = 32 * ih, iq = ibase + r, tq = tok0 + iq;
    const bf16_t* PROJ = (const bf16_t*)(ws + WS_PROJ);
    LAS float* IMPW = (LAS float*)(lds + NSA_IMPW);
    LAS unsigned* SELM = (LAS unsigned*)(lds + NSA_SELM); LAS unsigned* UNI = (LAS unsigned*)(lds + NSA_UNI);
    LAS float* OUTw = (LAS float*)(lds + NSA_OUT) + (w * 32) * 68;
    const size_t bk = (size_t)(b * 2 + kh);
#define NSA_KTB(bb) ((LAS bf16_t*)(lds + ((bb) ? NSA_KT1 : NSA_KT0)))
#define NSA_VTB(bb) ((LAS bf16_t*)(lds + ((bb) ? NSA_VT1 : NSA_VT0)))
    bf16x8 bq[4];
    NsaStage st;
    if (tid == 0) *UNI = 0u;
    const bf16_t* gp = PROJ + (size_t)tq * NPROJ + CGATE + hh * 3;
    const float gate0 = sigmoidf_(bf2f(gp[0])), gate1 = sigmoidf_(bf2f(gp[1])), gate2 = sigmoidf_(bf2f(gp[2]));
    {
#pragma unroll
        for (int ks = 0; ks < 4; ++ks) bq[ks] = *(const bf16x8*)((const bf16_t*)(ws + WS_QN) + (size_t)tq * 512 + hh * 64 + 16 * ks + 8 * h);
        const int nh = (4 * c + 2 >= 64) ? 2 : 1;
        const bf16_t* KCb = (const bf16_t*)(ws + WS_KC) + bk * 128 * 64; const bf16_t* VCb = (const bf16_t*)(ws + WS_VCT) + bk * 64 * 128;
        float lsum = 0.f; f32x16 O[2];
#pragma unroll
        for (int dt = 0; dt < 2; ++dt)
#pragma unroll
            for (int i = 0; i < 16; ++i) O[dt][i] = 0.f;
        nsa_fetch(st, KCb, 64, VCb, 128, tid);
        BAR_LDS();
        nsa_commit(st, NSA_KTB(0), NSA_VTB(0), tid);
        if (nh == 2) { nsa_fetch(st, KCb + 64 * 64, 64, VCb + 64, 128, tid); nsa_commit(st, NSA_KTB(1), NSA_VTB(1), tid); }
        BAR_LDS();
        for (int half = 0; half < nh; ++half) nsa_tile(2, bq, NSA_KTB(half), NSA_VTB(half), lsum, O, true, 3, iq, 64 * c, 64 * half, r, h);
        const float lt = lsum + __shfl_xor(lsum, 32);
        const float inv = lt > 0.f ? 1.f / lt : 0.f;
        nsa_out_acc<true>(OUTw, O, gate0 * inv, r, h);
        float carry = 0.f;
        for (int half = 0; half < nh; ++half) {
            f32x16 X[2];
            int r2 = r, h2 = h;
            asm volatile("" : "+v"(r2), "+v"(h2));
            nsa_qk(bq, NSA_KTB(half), X, r2, h2);
            const int hi = ((64 * c + iq - 31) >> 4) - 64 * half;
#pragma unroll
            for (int kt = 0; kt < 2; ++kt) {
                float pv[16];
#pragma unroll
                for (int i = 0; i < 16; ++i) { const int key = 32 * kt + (i & 3) + 8 * (i >> 2) + 4 * h2; pv[i] = (key <= hi) ? __builtin_amdgcn_exp2f(X[kt][i]) * inv : 0.f; }
#pragma unroll
                for (int gq = 0; gq < 4; ++gq) {
                    const float send = (h2 == 0) ? pv[4 * gq + 3] : (gq > 0 ? pv[4 * gq - 1] : carry);
                    const float extra = __shfl_xor(send, 32);
                    IMPW[(g * 64 + iq) * 33 + 16 * half + 8 * kt + 2 * gq + h2] = ((pv[4 * gq] + pv[4 * gq + 1]) + (pv[4 * gq + 2] + pv[4 * gq + 3])) + extra;
                }
                carry = pv[15];
            }
        }
    }
    BAR_LDS();
    {
        LAS float* SC = (LAS float*)(lds + NSA_KT0);
#pragma unroll
        for (int q = 0; q < 4; ++q) { const int pr = q * NTHREADS + tid, i = pr >> 5, j = pr & 31;
            float v = NEGBIG;
            if (j <= c) { v = (IMPW[(0 * 64 + i) * 33 + j] + IMPW[(1 * 64 + i) * 33 + j]) + (IMPW[(2 * 64 + i) * 33 + j] + IMPW[(3 * 64 + i) * 33 + j]);
                if (j == 0 || j == c || j == c - 1) v += 1e4f; }
            SC[i * 33 + j] = v; }
        BAR_LDS();
#pragma unroll 1
        for (int q = 0; q < 4; ++q) { const int pr = q * NTHREADS + tid, i = pr >> 5, j = pr & 31;
            const float my = SC[i * 33 + j]; int rank = 0;
#pragma unroll
            for (int k = 0; k < 32; ++k) { const float o = SC[i * 33 + k]; rank += (o > my || (o == my && k < j)) ? 1 : 0; }
            const bool sel = (j <= c) && rank < 8;
            const unsigned long long bal = __ballot(sel);
            const unsigned msk = (lane & 32) ? (unsigned)(bal >> 32) : (unsigned)bal;
            if (j == 0) { SELM[i] = msk; atomicOr((unsigned*)UNI, msk); } }
    }
    BAR_LDS();
    const unsigned uni = *UNI;
    const unsigned mysel = SELM[iq];
#pragma unroll
    for (int ks = 0; ks < 4; ++ks) bq[ks] = *(const bf16x8*)((const bf16_t*)(ws + WS_QR) + (size_t)tq * 512 + hh * 64 + 16 * ks + 8 * h);
#pragma unroll 1
    for (int br = 0; br < 2; ++br) {
        float lsum = 0.f; f32x16 O[2];
#pragma unroll
        for (int dt = 0; dt < 2; ++dt)
#pragma unroll
            for (int i = 0; i < 16; ++i) O[dt][i] = 0.f;
        const bf16_t* Kb = (const bf16_t*)(ws + (br ? WS_KW : WS_KS)) + bk * SEQ * 64;
        const bf16_t* Vb = (const bf16_t*)(ws + (br ? WS_VWT : WS_VST)) + bk * 32 * 4096;
        unsigned todo = br ? ((c >= 8 ? (0x1ffu << (c - 8)) : ((2u << c) - 1u))) : (uni & ((c == 31) ? 0xffffffffu : ((2u << c) - 1u)));
#define NSA_POP(dst) do { if (todo) { dst = __builtin_ctz(todo); todo &= todo - 1u; } else dst = -1; } while (0)
#define NSA_FETCH(stg, t) nsa_fetch(stg, Kb + (size_t)(t) * 4096, 64, Vb + (size_t)(t) * 4096, 64, tid)
#define NSA_COMPUTE(t, bufi) do { bool rok = true; int mode = 0, mm = 0; \
            if ((t) == c) { mode = 1; mm = 2; } \
            else if (br == 1) { if ((t) == c - 8) { mode = 2; mm = 2; } } \
            else if ((t) != 0 && (t) != c - 1) { rok = (mysel >> (t)) & 1u; mm = 1; } \
            nsa_tile(mm, bq, NSA_KTB(bufi), NSA_VTB(bufi), lsum, O, rok, mode, iq, 0, 0, r, h); } while (0)
        NsaStage stY;
        int t0, t1, t2, t3;
        NSA_POP(t0); NSA_POP(t1); NSA_POP(t2);
        NSA_FETCH(st, t0);
        BAR_LDS();
        nsa_commit(st, NSA_KTB(0), NSA_VTB(0), tid);
        if (t1 >= 0) NSA_FETCH(st, t1);
        if (t2 >= 0) NSA_FETCH(stY, t2);
        BAR_LDS();
        for (;;) {
            NSA_COMPUTE(t0, 0);
            if (t1 < 0) break;
            nsa_commit(st, NSA_KTB(1), NSA_VTB(1), tid);
            NSA_POP(t3); if (t3 >= 0) NSA_FETCH(st, t3);
            BAR_LDS();
            t0 = t1; t1 = t2; t2 = t3;
            NSA_COMPUTE(t0, 1);
            if (t1 < 0) break;
            nsa_commit(stY, NSA_KTB(0), NSA_VTB(0), tid);
            NSA_POP(t3); if (t3 >= 0) NSA_FETCH(stY, t3);
            BAR_LDS();
            t0 = t1; t1 = t2; t2 = t3;
        }
#undef NSA_POP
#undef NSA_FETCH
#undef NSA_COMPUTE
        const float lt = lsum + __shfl_xor(lsum, 32);
        nsa_out_acc<false>(OUTw, O, lt > 0.f ? (br ? gate2 : gate1) / lt : 0.f, r, h);
    }
    LDS_WAIT();
#pragma unroll
    for (int q = 0; q < 4; ++q) {
        const int rr = 8 * q + (lane >> 3), ch = lane & 7;
        const LAS f32x4* src = (const LAS f32x4*)(OUTw + rr * 68 + 8 * ch);
        const f32x4 a = src[0], bq2 = src[1];
        u32x4 o; o.x = pk2(a[0], a[1]); o.y = pk2(a[2], a[3]); o.z = pk2(bq2[0], bq2[1]); o.w = pk2(bq2[2], bq2[3]);
        *(u32x4*)((bf16_t*)(ws + WS_ATT) + (size_t)(tok0 + ibase + rr) * 1024 + hh * 64 + 8 * ch) = o;
    }
#undef NSA_KTB
#undef NSA_VTB
}

constexpr int GLA_QD = 0, GLA_KD = 10240, GLA_KST = 20480, GLA_VT = 30720, GLA_AT = 51200, GLA_ST = 61440, GLA_WG = 81920  , GLA_DEC = 86016  ,
              GLA_OT = 86528  , GLA_END = GLA_OT + 64 * 132 * 4;
static_assert(GLA_END <= LDS_BYTES - 64, "GLA LDS map");
template <int CTRL, int RMASK> __device__ __forceinline__ float dppf_rm(float v) { return __int_as_float(__builtin_amdgcn_update_dpp(0, __float_as_int(v), CTRL, RMASK, 0xf, false)); }
__device__ __forceinline__ float wave_incl_scan(float v) {
    v += __int_as_float(__builtin_amdgcn_update_dpp(0, __float_as_int(v), 0x111, 0xf, 0xf, true));
    v += __int_as_float(__builtin_amdgcn_update_dpp(0, __float_as_int(v), 0x112, 0xf, 0xf, true));
    v += __int_as_float(__builtin_amdgcn_update_dpp(0, __float_as_int(v), 0x114, 0xf, 0xf, true));
    v += __int_as_float(__builtin_amdgcn_update_dpp(0, __float_as_int(v), 0x118, 0xf, 0xf, true));
    v += dppf_rm<0x142, 0xa>(v);
    v += dppf_rm<0x143, 0xc>(v);
    return v;
}
struct GlaStage { u32x4 q, k, g0, g1, v0, v1; };
__device__ __forceinline__ void gla_fetch(GlaStage& st, const bf16_t* PROJ, int tok0, int h, int lane, int w) {
    const bf16_t* row = PROJ + (size_t)(tok0 + lane) * NPROJ;
    st.q = *(const u32x4*)(row + CGQ + h * 64 + 8 * w);
    st.k = *(const u32x4*)(row + CGK + h * 64 + 8 * w);
    st.g0 = *(const u32x4*)(row + CGLR); st.g1 = *(const u32x4*)(row + CGLR + 8);
    st.v0 = *(const u32x4*)(row + CGV + h * 128 + 16 * w); st.v1 = *(const u32x4*)(row + CGV + h * 128 + 16 * w + 8);
}
__device__ __forceinline__ float bflo(unsigned u) { return __uint_as_float(u << 16); }
__device__ __forceinline__ float bfhi(unsigned u) { return __uint_as_float(u & 0xffff0000u); }

__device__ __forceinline__ void gla_unit(const Params& p, LAS unsigned char* lds, int b, int h) {
    const int tid = opaque_tid(), lane = tid & 63, w = tid >> 6, fr = lane & 15, fq = lane >> 4;
    unsigned char* ws = p.ws;
    const bf16_t* PROJ = (const bf16_t*)(ws + WS_PROJ);
    LAS bf16_t* Qd = (LAS bf16_t*)(lds + GLA_QD); LAS bf16_t* Kd = (LAS bf16_t*)(lds + GLA_KD); LAS bf16_t* KsT = (LAS bf16_t*)(lds + GLA_KST);
    LAS bf16_t* VT = (LAS bf16_t*)(lds + GLA_VT); LAS bf16_t* At = (LAS bf16_t*)(lds + GLA_AT); LAS bf16_t* ST = (LAS bf16_t*)(lds + GLA_ST);
    LAS float* WG = (LAS float*)(lds + GLA_WG); LAS float* DEC = (LAS float*)(lds + GLA_DEC); LAS float* OT = (LAS float*)(lds + GLA_OT);
    BAR_LDS();
    for (int i = tid; i < 16 * 64; i += NTHREADS) WG[i] = p.in[12][(i >> 6) * 256 + h * 64 + (i & 63)];
    for (int i = tid; i < 128 * 80 / 2; i += NTHREADS) ((LAS unsigned*)ST)[i] = 0u;
    float bg[8];
#pragma unroll
    for (int q = 0; q < 8; ++q) bg[q] = p.in[13][h * 64 + 8 * w + q];
    const int md = w & 3, nfe0 = 4 * (w >> 2);
    f32x4 Sreg[4];
#pragma unroll
    for (int x = 0; x < 4; ++x) Sreg[x] = (f32x4){0.f, 0.f, 0.f, 0.f};
    GlaStage st;
    gla_fetch(st, PROJ, b * SEQ, h, lane, w);
    BAR_LDS();
#pragma unroll 1
    for (int n = 0; n < 32; ++n) {
        const int tok0 = b * SEQ + n * 64;
        float gl[16];
        { const unsigned gw[8] = {st.g0.x, st.g0.y, st.g0.z, st.g0.w, st.g1.x, st.g1.y, st.g1.z, st.g1.w};
#pragma unroll
          for (int q = 0; q < 8; ++q) { gl[2 * q] = bflo(gw[q]); gl[2 * q + 1] = bfhi(gw[q]); } }
        float bcum[8], blast[8];
#pragma unroll
        for (int q = 0; q < 8; ++q) {
            float x = bg[q];
#pragma unroll
            for (int r = 0; r < 16; ++r) x += gl[r] * WG[r * 64 + 8 * w + q];
            const float la = (fminf(x, 0.f) - __logf(1.f + __expf(-fabsf(x)))) * (1.f / 16.f);
            bcum[q] = wave_incl_scan(la);
            blast[q] = __int_as_float(__builtin_amdgcn_readlane(__float_as_int(bcum[q]), 63));
        }
        {
            const unsigned qw[4] = {st.q.x, st.q.y, st.q.z, st.q.w}, kw[4] = {st.k.x, st.k.y, st.k.z, st.k.w};
            unsigned qo[4], ko[4];
#pragma unroll
            for (int q2 = 0; q2 < 4; ++q2) {
                const float e0 = __expf(bcum[2 * q2]), e1 = __expf(bcum[2 * q2 + 1]);
                const float i0 = __expf(-bcum[2 * q2]), i1 = __expf(-bcum[2 * q2 + 1]);
                const float k0 = bflo(kw[q2]), k1 = bfhi(kw[q2]);
                qo[q2] = pg8::cvt_pk_bf16(bflo(qw[q2]) * 0.125f * e0, bfhi(qw[q2]) * 0.125f * e1);
                ko[q2] = pg8::cvt_pk_bf16(k0 * i0, k1 * i1);
                KsT[(8 * w + 2 * q2) * 80 + lane] = (bf16_t)f2bf(k0 * __expf(blast[2 * q2] - bcum[2 * q2]));
                KsT[(8 * w + 2 * q2 + 1) * 80 + lane] = (bf16_t)f2bf(k1 * __expf(blast[2 * q2 + 1] - bcum[2 * q2 + 1]));
            }
            *(LAS u32x4*)(Qd + lane * 80 + 8 * w) = (u32x4){qo[0], qo[1], qo[2], qo[3]};
            *(LAS u32x4*)(Kd + lane * 80 + 8 * w) = (u32x4){ko[0], ko[1], ko[2], ko[3]};
            if (lane == 63) {
#pragma unroll
                for (int q = 0; q < 8; ++q) DEC[(n & 1) * 64 + 8 * w + q] = __expf(bcum[q]);
            }
            const unsigned vw[8] = {st.v0.x, st.v0.y, st.v0.z, st.v0.w, st.v1.x, st.v1.y, st.v1.z, st.v1.w};
#pragma unroll
            for (int q = 0; q < 8; ++q) { VT[(16 * w + 2 * q) * 80 + lane] = (bf16_t)(vw[q] & 0xffffu); VT[(16 * w + 2 * q + 1) * 80 + lane] = (bf16_t)(vw[q] >> 16); }
        }
        if (n < 31) gla_fetch(st, PROJ, tok0 + 64, h, lane, w);
        const int ec = tid >> 3, eg = tid & 7;
        const u32x4 r0 = *(const u32x4*)(PROJ + (size_t)(tok0 + ec) * NPROJ + CGR + h * 128 + 16 * eg), r1 = *(const u32x4*)(PROJ + (size_t)(tok0 + ec) * NPROJ + CGR + h * 128 + 16 * eg + 8);
        BAR_LDS();
        {
            const int m = w >> 1;
            bf16x8 a[2];
#pragma unroll
            for (int ks = 0; ks < 2; ++ks) a[ks] = *(const LAS bf16x8*)(Qd + (16 * m + fr) * 80 + 32 * ks + 8 * fq);
#pragma unroll
            for (int x = 0; x < 2; ++x) { const int nf = 2 * (w & 1) + x;
                f32x4 s = (f32x4){0.f, 0.f, 0.f, 0.f};
                if (nf <= m) {
#pragma unroll
                    for (int ks = 0; ks < 2; ++ks) { const bf16x8 bk = *(const LAS bf16x8*)(Kd + (16 * nf + fr) * 80 + 32 * ks + 8 * fq); s = __builtin_amdgcn_mfma_f32_16x16x32_bf16(a[ks], bk, s, 0, 0, 0); }
                }
#pragma unroll
                for (int j = 0; j < 4; ++j) { const int cc = 16 * m + 4 * fq + j, ss = 16 * nf + fr; At[cc * 80 + ss] = (bf16_t)f2bf(ss <= cc ? s[j] : 0.f); } }
        }
        f32x4 U[4];
        {
            bf16x8 a[2];
#pragma unroll
            for (int ks = 0; ks < 2; ++ks) a[ks] = *(const LAS bf16x8*)(KsT + (16 * md + fr) * 80 + 32 * ks + 8 * fq);
#pragma unroll
            for (int x = 0; x < 4; ++x) { f32x4 s = (f32x4){0.f, 0.f, 0.f, 0.f};
#pragma unroll
                for (int ks = 0; ks < 2; ++ks) { const bf16x8 bv = *(const LAS bf16x8*)(VT + (16 * (nfe0 + x) + fr) * 80 + 32 * ks + 8 * fq); s = __builtin_amdgcn_mfma_f32_16x16x32_bf16(a[ks], bv, s, 0, 0, 0); }
                U[x] = s; }
        }
        BAR_LDS();
        {
            bf16x8 aa[2], aq2[2];
#pragma unroll
            for (int ks = 0; ks < 2; ++ks) { aa[ks] = *(const LAS bf16x8*)(At + (16 * md + fr) * 80 + 32 * ks + 8 * fq); aq2[ks] = *(const LAS bf16x8*)(Qd + (16 * md + fr) * 80 + 32 * ks + 8 * fq); }
#pragma unroll
            for (int x = 0; x < 4; ++x) { f32x4 s = (f32x4){0.f, 0.f, 0.f, 0.f};
#pragma unroll
                for (int ks = 0; ks < 2; ++ks) { const bf16x8 bv = *(const LAS bf16x8*)(VT + (16 * (nfe0 + x) + fr) * 80 + 32 * ks + 8 * fq); s = __builtin_amdgcn_mfma_f32_16x16x32_bf16(aa[ks], bv, s, 0, 0, 0); }
#pragma unroll
                for (int ks = 0; ks < 2; ++ks) { const bf16x8 bs = *(const LAS bf16x8*)(ST + (16 * (nfe0 + x) + fr) * 80 + 32 * ks + 8 * fq); s = __builtin_amdgcn_mfma_f32_16x16x32_bf16(aq2[ks], bs, s, 0, 0, 0); }
#pragma unroll
                for (int j = 0; j < 4; ++j) OT[(16 * md + 4 * fq + j) * 132 + 16 * (nfe0 + x) + fr] = s[j]; }
        }
        BAR_LDS();
        {
            const LAS f32x4* dp = (const LAS f32x4*)(DEC + (n & 1) * 64 + 16 * md + 4 * fq); const f32x4 dc = dp[0];
#pragma unroll
            for (int x = 0; x < 4; ++x) { Sreg[x] = dc * Sreg[x] + U[x];
                u32x2 o; o.x = pg8::cvt_pk_bf16(Sreg[x][0], Sreg[x][1]); o.y = pg8::cvt_pk_bf16(Sreg[x][2], Sreg[x][3]);
                *(LAS u32x2*)(ST + (16 * (nfe0 + x) + fr) * 80 + 16 * md + 4 * fq) = o; }
        }
        {
            const LAS f32x4* op = (const LAS f32x4*)(OT + ec * 132 + 16 * eg);
            f32x4 o[4]; float ss = 0.f;
#pragma unroll
            for (int q = 0; q < 4; ++q) { o[q] = op[q]; ss += (o[q].x * o[q].x + o[q].y * o[q].y) + (o[q].z * o[q].z + o[q].w * o[q].w); }
            ss += dppf<0xB1>(ss); ss += dppf<0x4E>(ss); ss += dppf<0x141>(ss);
            const float rstd = 1.f / sqrtf(ss * (1.f / 128.f) + EPS);
            const unsigned rw[8] = {r0.x, r0.y, r0.z, r0.w, r1.x, r1.y, r1.z, r1.w};
            const float* gn = p.in[14] + 16 * eg;
            unsigned ow[8];
#pragma unroll
            for (int q = 0; q < 8; ++q) { const float ra = bflo(rw[q]), rb = bfhi(rw[q]);
                const float ya = o[q >> 1][(2 * q) & 3] * rstd * gn[2 * q] * (ra * sigmoidf_(ra)), yb = o[q >> 1][(2 * q + 1) & 3] * rstd * gn[2 * q + 1] * (rb * sigmoidf_(rb));
                ow[q] = pg8::cvt_pk_bf16(ya, yb); }
            u32x4* dst = (u32x4*)((bf16_t*)(ws + WS_ATT) + (size_t)(tok0 + ec) * 1024 + 512 + h * 128 + 16 * eg);
            dst[0] = (u32x4){ow[0], ow[1], ow[2], ow[3]}; dst[1] = (u32x4){ow[4], ow[5], ow[6], ow[7]};
        }
    }
}

__device__ __forceinline__ void p6_chunk(const Params& p, LAS unsigned char* lds, int chunk) {
    const int tid = opaque_tid(), lane = tid & 63, wave = tid >> 6, fr = lane & 15, fq = lane >> 4;
    unsigned char* ws = p.ws;
    LAS int* lcnt = (LAS int*)lds;
    LAS float* LG = (LAS float*)(lds + 256) + wave * (16 * 33 + 16);
    LAS float* RS = LG + 16 * 33;
    if (tid < NEXP) lcnt[tid] = 0;
    __syncthreads();
    const float* WRT = (const float*)(ws + WS_WRT);
    const float* X1 = (const float*)(ws + WS_X1);
    const int t0 = chunk * 128 + wave * 16;
    {
        const float* ap = X1 + (size_t)(t0 + fr) * DM + 4 * fq;
        const float* bp0 = WRT + (size_t)fr * DM + 4 * fq; const float* bp1 = bp0 + 16 * DM;
        f32x4 acc0 = (f32x4){0.f, 0.f, 0.f, 0.f}, acc1 = (f32x4){0.f, 0.f, 0.f, 0.f};
        float ssq = 0.f;
#pragma unroll 4
        for (int ks = 0; ks < 64; ++ks) {
            const f32x4 a4 = *(const f32x4*)(ap + 16 * ks), b0 = *(const f32x4*)(bp0 + 16 * ks), b1 = *(const f32x4*)(bp1 + 16 * ks);
            ssq += (a4.x * a4.x + a4.y * a4.y) + (a4.z * a4.z + a4.w * a4.w);
#pragma unroll
            for (int i = 0; i < 4; ++i) { acc0 = __builtin_amdgcn_mfma_f32_16x16x4f32(a4[i], b0[i], acc0, 0, 0, 0); acc1 = __builtin_amdgcn_mfma_f32_16x16x4f32(a4[i], b1[i], acc1, 0, 0, 0); }
        }
        ssq += __shfl_xor(ssq, 16); ssq += __shfl_xor(ssq, 32);
        const float rstd = 1.f / sqrtf(ssq * (1.f / DM) + EPS);
        if (fq == 0) RS[fr] = rstd;
#pragma unroll
        for (int j = 0; j < 4; ++j) { LG[(4 * fq + j) * 33 + fr] = acc0[j]; LG[(4 * fq + j) * 33 + 16 + fr] = acc1[j]; }
    }
    LDS_WAIT();
    int myexp[4] = {0, 0, 0, 0}, myrank[4] = {0, 0, 0, 0};
    if (lane < 16) {
        const int t = t0 + lane; const float rstd = RS[lane];
        unsigned taken = 0u; float tv[4]; int te[4];
#pragma unroll
        for (int r = 0; r < 4; ++r) { float best = -3e38f; int be = 0;
#pragma unroll 8
            for (int e = 0; e < 32; ++e) { const float v = LG[lane * 33 + e] * rstd + p.in[18][e]; const bool can = !((taken >> e) & 1u); if (can && v > best) { best = v; be = e; } }
            taken |= 1u << be; tv[r] = best; te[r] = be; }
        const float e0 = 1.f, e1 = __expf(tv[1] - tv[0]), e2 = __expf(tv[2] - tv[0]), e3 = __expf(tv[3] - tv[0]);
        const float inv = 1.f / (e0 + e1 + e2 + e3);
        *(f32x4*)((float*)(ws + WS_TOPG) + (size_t)t * 4) = (f32x4){e0 * inv, e1 * inv, e2 * inv, e3 * inv};
#pragma unroll
        for (int k = 0; k < 4; ++k) { myexp[k] = te[k]; myrank[k] = atomicAdd((int*)&lcnt[te[k]], 1); }
    }
    {
        const f32x4* gr = (const f32x4*)p.in[16] + lane;
        f32x4 gg[4];
#pragma unroll
        for (int j = 0; j < 4; ++j) gg[j] = gr[64 * j];
#pragma unroll 1
        for (int ti = 0; ti < 16; ti += 4) {
            f32x4 v[4][4];
#pragma unroll
            for (int r = 0; r < 4; ++r) { const f32x4* xr = (const f32x4*)(X1 + (size_t)(t0 + ti + r) * DM) + lane;
#pragma unroll
                for (int j = 0; j < 4; ++j) v[r][j] = xr[64 * j]; }
#pragma unroll
            for (int r = 0; r < 4; ++r) { const float rstd = RS[ti + r];
                unsigned* o4 = (unsigned*)(ws + WS_H + (size_t)(t0 + ti + r) * DM) + lane;
#pragma unroll
                for (int j = 0; j < 4; ++j) { const f32x4 o = v[r][j] * rstd * gg[j]; o4[64 * j] = pk4_fp8(o.x, o.y, o.z, o.w); } }
        }
    }
    __syncthreads();
    LAS int* lbase = lcnt + 32;
    if (tid < NEXP) lbase[tid] = atomicAdd((int*)(ws + WS_CTL) + CW_CNT + tid, lcnt[tid]);
    __syncthreads();
    if (lane < 16) {
        const int t = t0 + lane; int d[4];
#pragma unroll
        for (int k = 0; k < 4; ++k) { const int pos = lbase[myexp[k]] + myrank[k]; ((int*)(ws + WS_RL))[(size_t)myexp[k] * 32768 + pos] = t; d[k] = (myexp[k] << 16) | pos; }
        *(int4*)((int*)(ws + WS_DEST) + (size_t)t * 4) = make_int4(d[0], d[1], d[2], d[3]);
    }
    __syncthreads();
}

__device__ __forceinline__ int build_tile_table(const Params& p, LAS int* tstart, LAS int* tile_e) {
    const int tid = opaque_tid();
    const int* cnt = (const int*)(p.ws + WS_CTL) + CW_CNT;
    if (tid == 0) { int acc = 0; for (int e = 0; e < NEXP; ++e) { const int n = __hip_atomic_load(cnt + e, __ATOMIC_RELAXED, __HIP_MEMORY_SCOPE_AGENT); tstart[e] = acc; tstart[NEXP + 1 + e] = n; acc += (n + 255) >> 8; } tstart[NEXP] = acc; }
    __syncthreads();
    const int total = tstart[NEXP];
    for (int i = tid; i < total; i += NTHREADS) { int e = 0;
        for (int q = 1; q < NEXP; ++q) if (tstart[q] <= i) e = q;
        tile_e[i] = e; }
    __syncthreads();
    return total;
}

__device__ __forceinline__ void p10_tokens(const Params& p, int t0, int lane, const LAS int* tstart) {
    unsigned char* ws = p.ws;
    int4 d4[2]; f32x4 g4[2];
#pragma unroll
    for (int q = 0; q < 2; ++q) { d4[q] = *(const int4*)((const int*)(ws + WS_DEST) + (size_t)(t0 + q) * 4); g4[q] = *(const f32x4*)((const float*)(ws + WS_TOPG) + (size_t)(t0 + q) * 4); }
    f32x4 xa[2][4]; u32x4 yv[2][4][2];
#pragma unroll
    for (int q = 0; q < 2; ++q) {
        const f32x4* xr = (const f32x4*)((const float*)(ws + WS_X1) + (size_t)(t0 + q) * DM);
#pragma unroll
        for (int h2 = 0; h2 < 2; ++h2) { xa[q][2 * h2] = __builtin_nontemporal_load(xr + h2 * 128 + lane * 2); xa[q][2 * h2 + 1] = __builtin_nontemporal_load(xr + h2 * 128 + lane * 2 + 1); }
        const int dr[4] = {d4[q].x, d4[q].y, d4[q].z, d4[q].w};
        int dd[4];
#pragma unroll
        for (int k = 0; k < 4; ++k) dd[k] = tstart[dr[k] >> 16] * 256 + (dr[k] & 0xffff);
#pragma unroll
        for (int k = 0; k < 4; ++k)
#pragma unroll
            for (int h2 = 0; h2 < 2; ++h2) yv[q][k][h2] = __builtin_nontemporal_load((const u32x4*)((const bf16_t*)(ws + WS_Y) + (size_t)dd[k] * DM) + h2 * 64 + lane);
    }
#pragma unroll
    for (int q = 0; q < 2; ++q) {
        f32x4* orow = (f32x4*)(p.out + (size_t)(t0 + q) * DM);
#pragma unroll
        for (int h2 = 0; h2 < 2; ++h2) {
            f32x4 a0 = xa[q][2 * h2], a1 = xa[q][2 * h2 + 1];
#pragma unroll
            for (int k = 0; k < 4; ++k) { const u32x4 y = yv[q][k][h2]; const float gk = g4[q][k];
                a0.x += gk * __uint_as_float(y.x << 16); a0.y += gk * __uint_as_float(y.x & 0xffff0000u);
                a0.z += gk * __uint_as_float(y.y << 16); a0.w += gk * __uint_as_float(y.y & 0xffff0000u);
                a1.x += gk * __uint_as_float(y.z << 16); a1.y += gk * __uint_as_float(y.z & 0xffff0000u);
                a1.z += gk * __uint_as_float(y.w << 16); a1.w += gk * __uint_as_float(y.w & 0xffff0000u); }
            orow[h2 * 128 + lane * 2] = a0; orow[h2 * 128 + lane * 2 + 1] = a1;
        }
    }
}

#define XB_TMO      128
#define XB_XCNT(j)  (256  + 64 * (j))
#define XB_XSUB(j)  (1280 + 64 * (j))
#define XB_XGEN(j)  (2304 + 64 * (j))
#define XB_TOP      3328
#define XB_TOPGEN   3392
#define XCD_BAR_WORDS 3456
#define XB_SPIN_CAP (1u << 22)
__device__ __forceinline__ unsigned xb_ld(unsigned* p)              { return __hip_atomic_load(p, __ATOMIC_RELAXED, __HIP_MEMORY_SCOPE_AGENT); }
__device__ __forceinline__ unsigned xb_add(unsigned* p, unsigned v) { return __hip_atomic_fetch_add(p, v, __ATOMIC_RELAXED, __HIP_MEMORY_SCOPE_AGENT); }
__device__ __forceinline__ unsigned xb_xcc_id() { return (unsigned)__builtin_amdgcn_s_getreg((3 << 11) | 20) & 0xFu; }
#define XB_SPIN(cond, bar) do { unsigned _sp = 0; while (cond) { __builtin_amdgcn_s_sleep(1); \
    if ((++_sp & 255u) == 0u) { if (xb_ld(&(bar)[XB_TMO])) break; if (_sp > XB_SPIN_CAP) { atomicAdd(&(bar)[XB_TMO], 1u); break; } } } } while (0)
struct XcdBarrier { unsigned* bar; unsigned x; volatile LAS unsigned* st; };
__device__ __forceinline__ XcdBarrier xcd_barrier_post(unsigned* bar, volatile LAS unsigned* st) {
    XcdBarrier b; b.bar = bar; b.x = xb_xcc_id(); b.st = st;
    if (threadIdx.x == 0) (void)xb_add(&bar[XB_XCNT(b.x)], 1u);
    return b;
}
__device__ __forceinline__ void xcd_barrier_complete(unsigned* bar, unsigned x, unsigned& nloc, unsigned& nx) {
    const unsigned G = gridDim.x * gridDim.y * gridDim.z;
    unsigned sum, cnt, mine, sp = 0u;
    for (;;) {
        sum = 0u; cnt = 0u; mine = 0u;
#pragma unroll
        for (unsigned j = 0; j < 16; ++j) { const unsigned c = xb_ld(&bar[XB_XCNT(j)]); sum += c; cnt += (c > 0u) ? 1u : 0u; mine = (j == x) ? c : mine; }
        if (sum == G) break;
        __builtin_amdgcn_s_sleep(1);
        if ((++sp & 255u) == 0u) { if (xb_ld(&bar[XB_TMO])) break; if (sp > XB_SPIN_CAP) { atomicAdd(&bar[XB_TMO], 1u); break; } }
    }
    nloc = mine > 0u ? mine : 1u; nx = cnt > 0u ? cnt : 1u;
}
__device__ __forceinline__ void xcd_barrier(const XcdBarrier& b) {
    asm volatile("s_waitcnt vmcnt(0)" ::: "memory");
    __syncthreads();
    if (threadIdx.x == 0) {
        unsigned* bar = b.bar;
        __builtin_amdgcn_s_waitcnt(0);
        unsigned nloc = b.st[0], nx = b.st[1];
        if (nloc == 0u) { xcd_barrier_complete(bar, b.x, nloc, nx); b.st[0] = nloc; b.st[1] = nx; }
        const unsigned old = xb_add(&bar[XB_XSUB(b.x)], 1u);
        const unsigned gen = old / nloc;
        if (old + 1u == (gen + 1u) * nloc) {
            __builtin_amdgcn_fence(__ATOMIC_RELEASE, "agent");
            asm volatile("s_waitcnt vmcnt(0)" ::: "memory");
            const unsigned og = xb_add(&bar[XB_TOP], 1u);
            const unsigned tg = og / nx;
            if (og + 1u == (tg + 1u) * nx) xb_add(&bar[XB_TOPGEN], 1u);
            else XB_SPIN(xb_ld(&bar[XB_TOPGEN]) == tg, bar);
            __builtin_amdgcn_fence(__ATOMIC_ACQUIRE, "agent");
            xb_add(&bar[XB_XGEN(b.x)], 1u);
            asm volatile("s_waitcnt vmcnt(0)" ::: "memory");
        } else {
            XB_SPIN(xb_ld(&bar[XB_XGEN(b.x)]) == gen, bar);
            __builtin_amdgcn_fence(__ATOMIC_ACQUIRE, "agent");
            asm volatile("s_waitcnt vmcnt(0)" ::: "memory");
        }
    }
    __syncthreads();
}

__device__ __forceinline__ void expert_weight_items(const Params& p, LAS unsigned char* lds, int max_grabs) {
    const int tid = opaque_tid(), lane = tid & 63, wave = tid >> 6;
    unsigned char* ws = p.ws;
    LAS float* scr = (LAS float*)(lds + wave * 16640);
    LAS int* qslot = (LAS int*)(lds + LDS_BYTES - 64);
    constexpr int I_GU = 16 * 32, I_DN = 16 * 16, N_GU = NEXP * I_GU, N_DN = NEXP * I_DN;
    for (int grab = 0; grab < max_grabs; ++grab) {
        __syncthreads();
        if (tid == 0) *qslot = (int)__hip_atomic_fetch_add((unsigned*)(ws + WS_CTL) + CW_QC, 8u, __ATOMIC_RELAXED, __HIP_MEMORY_SCOPE_AGENT);
        __syncthreads();
        const int base = *qslot;
        if (base >= N_GU + N_DN) break;
        int r = base + wave;
        if (r < N_GU) { const int e = r / I_GU; transpose_item<2, true>(p.in[19] + (size_t)e * 1024 * 2048, 1024, 2048, ws + WS_WGU + (size_t)e * 2048 * 1024, 32, scr, r % I_GU, lane); }
        else { r -= N_GU; const int e = r / I_DN; transpose_item<0, true>(p.in[21] + (size_t)e * 1024 * 1024, 1024, 1024, ws + WS_WD + (size_t)e * 1024 * 1024, 16, scr, r % I_DN, lane); }
    }
}

template <int ph> __device__ __forceinline__ void mk_phase(const Params& p, LAS unsigned char* lds, int blk, int G) {
    unsigned char* ws = p.ws;
    const int tid = opaque_tid();
    if constexpr (ph == 0) { phase0(p, lds, blk, G); }
    else if constexpr (ph == 1) {
        pg8::Gemm g{ws + WS_H, ws + WS_WIN, 2 * DM};
        pg8::StaticOrder S{MTOK / 256, NPROJ / 256, G, blk};
        pg8::EpiBf16 E{(bf16_t*)(ws + WS_PROJ), NPROJ};
        pg8::gemm_phase<false>(lds, g, S, E);
    }
    else if constexpr (ph == 2) {
        LAS int* qslot = (LAS int*)(lds + LDS_BYTES - 64);
        if ((blk & 7) >= 4) expert_weight_items(p, lds, MK_P2_GRABS);
        for (;;) {
            __syncthreads();
            if (tid == 0) *qslot = (int)__hip_atomic_fetch_add((unsigned*)(ws + WS_CTL) + CW_Q2, 1u, __ATOMIC_RELAXED, __HIP_MEMORY_SCOPE_AGENT);
            __syncthreads();
            const int it = *qslot;
            if (it >= 128 + 512) break;
            if (it < 128) p2b_unit(p, lds, it); else p2a_unit(p, lds, it - 128);
        }
    }
    else if constexpr (ph == 3) {
        LAS int* qslot = (LAS int*)(lds + LDS_BYTES - 64);
        if ((blk & 7) < 4) expert_weight_items(p, lds, 1 << 30);
        for (;;) {
            __syncthreads();
            if (tid == 0) *qslot = (int)__hip_atomic_fetch_add((unsigned*)(ws + WS_CTL) + CW_Q3, 1u, __ATOMIC_RELAXED, __HIP_MEMORY_SCOPE_AGENT);
            __syncthreads();
            const int it = *qslot;
            if (it >= 64 + 1024) break;
            if (it < 64) gla_unit(p, lds, it >> 2, it & 3);
            else { const int u = it - 64, c = 31 - (u >> 5), bkh = u & 31; nsa_unit(p, lds, bkh >> 1, bkh & 1, c); }
        }
    }
    else if constexpr (ph == 4) { }
    else if constexpr (ph == 5) {
        pg8::Gemm g{ws + WS_ATT, ws + WS_WOUT, 2 * DM};
        pg8::StaticOrder S{MTOK / 256, DM / 256, G, blk};
        pg8::EpiResF32 E{p.in[0], (float*)(ws + WS_X1), DM};
        pg8::gemm_phase<false>(lds, g, S, E);
    }
    else if constexpr (ph == 6) { for (int ch = blk; ch < MTOK / 128; ch += G) p6_chunk(p, lds, ch); }
    else if constexpr (ph == 7) { }
    else if constexpr (ph == 8) {
        LAS int* tstart = (LAS int*)(lds + pg8::STAGE_BYTES); LAS int* tile_e = tstart + 80;
        const int total = build_tile_table(p, tstart, tile_e);
        pg8::Gemm g{ws + WS_H, ws + WS_WGU, DM};
        pg8::MoeGatherOrder S{total, 8, G, blk, tile_e, tstart, tstart + NEXP + 1, (const int*)(ws + WS_RL)};
        pg8::EpiSwiglu E{ws + WS_ACT, p.in[20], 8};
        pg8::gemm_phase<true>(lds, g, S, E);
    }
    else if constexpr (ph == 9) {
        LAS int* tstart = (LAS int*)(lds + pg8::STAGE_BYTES); LAS int* tile_e = tstart + 80;
        const int total = build_tile_table(p, tstart, tile_e);
        pg8::Gemm g{ws + WS_ACT, ws + WS_WD, DFF};
        pg8::MoeOrder S{total, 4, G, blk, tile_e};
        pg8::EpiDown E{(bf16_t*)(ws + WS_Y), p.in[22], 4};
        pg8::gemm_phase<true>(lds, g, S, E);
    }
    else if constexpr (ph == 10) {
        LAS int* tstart = (LAS int*)(lds + pg8::STAGE_BYTES); LAS int* tile_e = tstart + 80;
        build_tile_table(p, tstart, tile_e);
        for (int t = (blk * 8 + (tid >> 6)) * 2; t < MTOK; t += G * 16) p10_tokens(p, t, tid & 63, tstart);
    }
}

constexpr int NPHASES = 11;

template <int PH> __global__ void __launch_bounds__(NTHREADS, 2) mk_one(Params p) {
    extern __shared__ __attribute__((aligned(16))) unsigned char lds_raw[];
    mk_phase<PH>(p, (LAS unsigned char*)lds_raw, blockIdx.x, gridDim.x);
}
#if MK_ONE_LAUNCH
#define MK_RUN(PH) mk_phase<PH>(p, lds, blk, G)
__global__ void __launch_bounds__(NTHREADS, 2) mk_fwd(Params p) {
    extern __shared__ __attribute__((aligned(16))) unsigned char lds_raw[];
    LAS unsigned char* lds = (LAS unsigned char*)lds_raw;
    const int blk = blockIdx.x, G = gridDim.x;
    volatile LAS unsigned* bst = (volatile LAS unsigned*)(lds + LDS_BYTES - 16);
    if (threadIdx.x < 4) bst[threadIdx.x] = 0u;
    __syncthreads();
    const XcdBarrier gbar = xcd_barrier_post((unsigned*)(p.ws + WS_CTL) + CW_BAR, bst);
#define GSYNC() xcd_barrier(gbar)
#ifndef MK_REP_PHASE
#define MK_REP_PHASE -1
#endif
#ifndef MK_REP_N
#define MK_REP_N 0
#endif
#define MK_STEP(PH) do { MK_RUN(PH); if (MK_REP_PHASE == (PH)) { for (int r_ = 0; r_ < MK_REP_N; ++r_) { GSYNC(); MK_RUN(PH); } } if (MK_REP_PHASE == 100 + (PH)) { for (int r_ = 0; r_ < MK_REP_N; ++r_) GSYNC(); } } while (0)
    MK_STEP(0); GSYNC(); MK_STEP(1); GSYNC(); MK_STEP(2); GSYNC(); MK_STEP(3); GSYNC(); MK_STEP(5); GSYNC();
    MK_STEP(6); GSYNC(); MK_STEP(8); GSYNC(); MK_STEP(9); GSYNC(); MK_STEP(10);
}
#endif

extern "C" void kernel_launch(void* const* d_in, const int* in_sizes, int n_in, void* d_out, int out_size, void* d_ws, size_t ws_size, hipStream_t stream) {
    static int grid = 0;
    if (grid == 0) {
        int dev = 0, cus = 0, per_cu = 0;
        (void)hipGetDevice(&dev);
        (void)hipDeviceGetAttribute(&cus, hipDeviceAttributeMultiprocessorCount, dev);
#if MK_ONE_LAUNCH
        (void)hipFuncSetAttribute((const void*)mk_fwd, hipFuncAttributeMaxDynamicSharedMemorySize, LDS_BYTES);
        (void)hipOccupancyMaxActiveBlocksPerMultiprocessor(&per_cu, (const void*)mk_fwd, NTHREADS, LDS_BYTES);
#else
#define MK_ATTR(PH) (void)hipFuncSetAttribute((const void*)mk_one<PH>, hipFuncAttributeMaxDynamicSharedMemorySize, LDS_BYTES)
        MK_ATTR(0); MK_ATTR(1); MK_ATTR(2); MK_ATTR(3); MK_ATTR(4); MK_ATTR(5); MK_ATTR(6); MK_ATTR(7); MK_ATTR(8); MK_ATTR(9); MK_ATTR(10);
        per_cu = 1;
#endif
        if (per_cu < 1) { fprintf(stderr, "kernel_launch: occupancy query reports %d blocks/CU\n", per_cu); per_cu = 1; }
        grid = cus;
        if (ws_size < WS_END) { fprintf(stderr, "kernel_launch: workspace too small (%zu < %zu)\n", ws_size, (size_t)WS_END); grid = -1; }
        (void)hipGetLastError();
    }
    if (grid < 0) return;
    (void)hipMemsetAsync((char*)d_ws + WS_CTL, 0, CTL_BYTES, stream);
    Params p{};
    for (int i = 0; i < 23; ++i) p.in[i] = (const float*)d_in[i];
    p.out = (float*)d_out; p.ws = (unsigned char*)d_ws;
#if MK_ONE_LAUNCH
    hipLaunchKernelGGL(mk_fwd, dim3(grid), dim3(NTHREADS), LDS_BYTES, stream, p);
#else
#ifndef MK_DUP_PHASE
#define MK_DUP_PHASE -1
#endif
#define MK_LAUNCH1(PH) do { if ((PH) == 3 || (PH) == 2) (void)hipMemsetAsync((char*)d_ws + WS_CTL + 4 * CW_Q3, 0, 12, stream); if ((PH) == 6) (void)hipMemsetAsync((char*)d_ws + WS_CTL + 4 * CW_CNT, 0, 128, stream); if ((PH) == 7) (void)hipMemsetAsync((char*)d_ws + WS_CTL + 4 * CW_FILL, 0, 128, stream); hipLaunchKernelGGL(mk_one<PH>, dim3(grid), dim3(NTHREADS), LDS_BYTES, stream, p); } while (0)
#define MK_LAUNCH(PH) do { MK_LAUNCH1(PH); if (MK_DUP_PHASE == (PH)) MK_LAUNCH1(PH); } while (0)
    MK_LAUNCH(0); MK_LAUNCH(1); MK_LAUNCH(2); MK_LAUNCH(3); MK_LAUNCH(5); MK_LAUNCH(6); MK_LAUNCH(8); MK_LAUNCH(9); MK_LAUNCH(10);
#endif
}
```

```cpp
#include <hip/hip_runtime.h>
#include <hip/hip_cooperative_groups.h>
#include <cstdint>
#include <cstdio>
namespace cg = cooperative_groups;

#ifndef MK_ONE_LAUNCH
#define MK_ONE_LAUNCH 1
#endif

#ifndef MK_P2_GRABS
#define MK_P2_GRABS 10
#endif
#define LAS __attribute__((address_space(3)))
typedef unsigned short bf16_t;
typedef short bf16x8 __attribute__((ext_vector_type(8)));
typedef float f32x4 __attribute__((ext_vector_type(4)));
typedef float f32x2 __attribute__((ext_vector_type(2)));
typedef unsigned u32x4 __attribute__((ext_vector_type(4)));
typedef unsigned u32x2 __attribute__((ext_vector_type(2)));
typedef int i32x8 __attribute__((ext_vector_type(8)));
typedef int i32x4 __attribute__((ext_vector_type(4)));

constexpr int NB = 16, SEQ = 2048, DM = 1024, MTOK = NB * SEQ;
constexpr int NPROJ = 3072;
constexpr int CQ = 0, CKC = 512, CVC = 640, CKS = 768, CVS = 896, CKW = 1024, CVW = 1152, CGQ = 1280, CGK = 1536, CGV = 1792, CGR = 2304, CGATE = 2816, CGLR = 2840;
constexpr int NEXP = 32, DFF = 1024;
constexpr int MAXTILES = 544, XROWS = MAXTILES * 256;
constexpr float EPS = 1e-6f;
constexpr int NTHREADS = 512;
constexpr int LDS_BYTES = 160 * 1024;

constexpr size_t MiB = 1u << 20;
constexpr size_t WS_CTL = 0;
constexpr size_t WS_WIN = 2 * MiB;
constexpr size_t WS_WOUT = 8 * MiB;
constexpr size_t WS_CW1K = 10 * MiB, WS_CW1V = 11 * MiB;
constexpr size_t WS_CW2K = 12 * MiB, WS_CW2V = 12 * MiB + 512 * 1024;
constexpr size_t WS_CBIAS = 13 * MiB;
constexpr size_t WS_WRT = 13 * MiB + 512 * 1024;
constexpr size_t WS_WGU = 16 * MiB;
constexpr size_t WS_WD = 144 * MiB;
constexpr size_t WS_H = 208 * MiB;
constexpr size_t WS_PROJ = 272 * MiB;
constexpr size_t WS_QN = 464 * MiB, WS_QR = 496 * MiB;
constexpr size_t WS_KS = 528 * MiB, WS_KW = 536 * MiB;
constexpr size_t WS_VST = 544 * MiB, WS_VWT = 552 * MiB;
constexpr size_t WS_KC = 560 * MiB, WS_VCT = 561 * MiB;
constexpr size_t WS_U = 562 * MiB;
constexpr size_t WS_OI = 626 * MiB;
constexpr size_t WS_QD = 690 * MiB;
constexpr size_t WS_DEC = 722 * MiB;
constexpr size_t WS_SP = 723 * MiB;
constexpr size_t WS_ATT = 787 * MiB;
constexpr size_t WS_TOPI = 851 * MiB, WS_TOPG = 852 * MiB, WS_DEST = 853 * MiB;
constexpr size_t WS_RL = 272 * MiB;
constexpr size_t WS_ACT = 544 * MiB;
constexpr size_t WS_Y = 272 * MiB;
constexpr size_t WS_X1 = 854 * MiB;
constexpr size_t WS_END = 982 * MiB;
constexpr int CW_CNT = 0, CW_FILL = 64, CW_Q3 = 128, CW_Q2 = 129, CW_QC = 130, CW_BAR = 1024;
constexpr int CTL_BYTES = 32768;

struct Params {
    const float* in[23];
    float* out;
    unsigned char* ws;
};

__device__ __forceinline__ float bf2f(bf16_t v) { return __uint_as_float(((unsigned)v) << 16); }
__device__ __forceinline__ unsigned f2bf(float f) { unsigned u = __float_as_uint(f); return (u + 0x7fffu + ((u >> 16) & 1u)) >> 16; }
__device__ __forceinline__ unsigned pk2(float lo, float hi) { return f2bf(lo) | (f2bf(hi) << 16); }
__device__ __forceinline__ unsigned pk4_fp8(float a, float b, float c, float d) { int r = __builtin_amdgcn_cvt_pk_fp8_f32(a, b, 0, false); r = __builtin_amdgcn_cvt_pk_fp8_f32(c, d, r, true); return (unsigned)r; }
__device__ __forceinline__ float wave_sum(float v) {
#pragma unroll
    for (int o = 1; o < 64; o <<= 1) v += __shfl_xor(v, o);
    return v;
}
#define LDS_WAIT() asm volatile("s_waitcnt lgkmcnt(0)" ::: "memory")
#define BAR_LDS() do { asm volatile("s_waitcnt lgkmcnt(0)" ::: "memory"); __builtin_amdgcn_s_barrier(); asm volatile("" ::: "memory"); } while (0)
__device__ __forceinline__ int opaque_tid() { int t = threadIdx.x; asm volatile("" : "+v"(t)); return t; }
__device__ __forceinline__ float sigmoidf_(float x) { return __builtin_amdgcn_rcpf(1.f + __builtin_amdgcn_exp2f(-1.4426950408889634f * x)); }
template <int CTRL> __device__ __forceinline__ float dppf(float v) { return __int_as_float(__builtin_amdgcn_update_dpp(0, __float_as_int(v), CTRL, 0xf, 0xf, true)); }
__device__ __forceinline__ float red16_max(float v) { v = fmaxf(v, dppf<0xB1>(v)); v = fmaxf(v, dppf<0x4E>(v)); v = fmaxf(v, dppf<0x141>(v)); v = fmaxf(v, dppf<0x140>(v)); return v; }
__device__ __forceinline__ float red16_sum(float v) { v += dppf<0xB1>(v); v += dppf<0x4E>(v); v += dppf<0x141>(v); v += dppf<0x140>(v); return v; }


namespace pg8 {
constexpr int BM = 256, BK = 64, HALF = 128, HTB = HALF * BK * 2, STAGE_BYTES = 8 * HTB, NXCD = 8, WGM = 8;
__device__ __forceinline__ int swz(int r) { const int p = (r >> 1) & 7, a = (p >> 2) & 1, b = (p >> 1) & 1, c = p & 1; return ((a ^ b) << 2) | (a << 1) | c; }
template <bool FP8> __device__ __forceinline__ int lds_byte(int r, int c) {
    if (FP8) return r * 128 + ((((c >> 3) ^ swz(r)) & 7) << 4);
    const int st = (r >> 4) * 2 + (c >> 5), rr = r & 15, cc = c & 31, ob = rr * 64 + cc * 2; return st * 1024 + (ob ^ (((ob >> 9) & 1) << 5));
}
template <bool FP8> __device__ __forceinline__ void stage_rc(int b, int& R, int& C) {
    if (FP8) { const int slot = b >> 4; R = slot >> 3; C = (((slot & 7) ^ swz(R)) & 7) * 8; }
    else { const int st = b / 1024, sb = b % 1024, sw = sb ^ (((sb >> 9) & 1) << 5); R = (st >> 1) * 16 + sw / 64; C = (st & 1) * 32 + (sw % 64) / 2; }
}
__device__ __forceinline__ int perm32(int rho) { const int n = rho >> 4, i = rho & 15; return 8 * (i >> 2) + 4 * n + (i & 3); }

struct Unit { int pm, pn, pb; };
struct Gemm { const void* A; const void* Bt; int Kb; };

__device__ __forceinline__ bool order_next(long L, int nM, int nN, int& pm, int& pn) {
    const int nwg = nM * nN; if (L >= nwg) return false;
    int wgid = (int)L; { const int q = nwg / NXCD, r = nwg % NXCD, xcd = wgid % NXCD, off = wgid / NXCD; wgid = (xcd < r ? xcd * (q + 1) : r * (q + 1) + (xcd - r) * q) + off; }
    const int nig = WGM * nN, gid = wgid / nig, fm = gid * WGM, gsz = (nM - fm) < WGM ? (nM - fm) : WGM;
    pm = fm + ((wgid % nig) % gsz); pn = (wgid % nig) / gsz; return true;
}
struct StaticOrder {
    static constexpr bool GATHER = false;
    int nM, nN, G, c;
    __device__ __forceinline__ bool next(int i, Unit& u) const { if (!order_next((long)i * G + c, nM, nN, u.pm, u.pn)) return false; u.pb = u.pn; return true; }
    __device__ __forceinline__ void a_offsets(const Unit&, const int (&)[2], const int (&)[2], int, unsigned (&)[2][2]) const {}
};
struct MoeOrder {
    static constexpr bool GATHER = false;
    int nM, nN, G, c; const LAS int* tile_e;
    __device__ __forceinline__ bool next(int i, Unit& u) const { if (!order_next((long)i * G + c, nM, nN, u.pm, u.pn)) return false; u.pb = __builtin_amdgcn_readfirstlane(tile_e[u.pm] * nN + u.pn); return true; }
    __device__ __forceinline__ void a_offsets(const Unit&, const int (&)[2], const int (&)[2], int, unsigned (&)[2][2]) const {}
};
struct MoeGatherOrder {
    static constexpr bool GATHER = true;
    int nM, nN, G, c; const LAS int* tile_e; const LAS int* tstart; const LAS int* tcnt; const int* rowlist;
    __device__ __forceinline__ bool next(int i, Unit& u) const { if (!order_next((long)i * G + c, nM, nN, u.pm, u.pn)) return false; u.pb = __builtin_amdgcn_readfirstlane(tile_e[u.pm] * nN + u.pn); return true; }
    __device__ __forceinline__ void a_offsets(const Unit& u, const int (&R)[2], const int (&Cb)[2], int Kb, unsigned (&off)[2][2]) const {
        const int e = u.pb / nN, lt = u.pm - tstart[e], n = tcnt[e];
#pragma unroll
        for (int h = 0; h < 2; ++h)
#pragma unroll
            for (int i = 0; i < 2; ++i) { const int idx = lt * 256 + h * 128 + R[i]; const int tok = idx < n ? rowlist[(size_t)e * 32768 + idx] : 0; off[h][i] = (unsigned)tok * (unsigned)Kb + (unsigned)Cb[i]; }
    }
};

__device__ __forceinline__ void mfma8_acc(f32x4& c, const i32x8& a, const i32x8& b, int scl) {
    asm volatile("v_mfma_scale_f32_16x16x128_f8f6f4 %0, %1, %2, %0, %3, %3 op_sel_hi:[0,0,0]" : "+v"(c) : "v"(a), "v"(b), "v"(scl)); }
__device__ __forceinline__ i32x8 cat8(i32x4 a, i32x4 b) { return __builtin_shufflevector(a, b, 0, 1, 2, 3, 4, 5, 6, 7); }
__device__ __forceinline__ i32x8 frag8(bf16x8 lo, bf16x8 hi) { const i32x4 a = __builtin_bit_cast(i32x4, lo), b = __builtin_bit_cast(i32x4, hi); return (i32x8){a.x, a.y, a.z, a.w, b.x, b.y, b.z, b.w}; }
__device__ __forceinline__ unsigned cvt_pk_bf16(float lo, float hi) { unsigned r; asm volatile("v_cvt_pk_bf16_f32 %0, %1, %2" : "=v"(r) : "v"(lo), "v"(hi)); return r; }

struct EpiBf16 {
    static constexpr bool PERM = true;
    struct Pre {}; __device__ __forceinline__ Pre prefetch(const Unit&, int, int, int, int) const { return Pre{}; }
    bf16_t* O; int ldc;
    __device__ __forceinline__ void operator()(const f32x4 (&acc)[2][2][4][2], const Unit& u, const Pre&, int wr, int wc, int fr, int fq) const {
        const int row0 = u.pm * BM + wr * 64 + fr, col0 = u.pn * BM + wc * 32 + 8 * fq;
#pragma unroll
        for (int ai = 0; ai < 2; ++ai)
#pragma unroll
            for (int m = 0; m < 4; ++m) { bf16_t* rowp = O + (size_t)(row0 + ai * HALF + m * 16) * ldc + col0;
#pragma unroll
                for (int bj = 0; bj < 2; ++bj) { const f32x4 v0 = acc[ai][bj][m][0], v1 = acc[ai][bj][m][1];
                    u32x4 w; w.x = cvt_pk_bf16(v0[0], v0[1]); w.y = cvt_pk_bf16(v0[2], v0[3]); w.z = cvt_pk_bf16(v1[0], v1[1]); w.w = cvt_pk_bf16(v1[2], v1[3]);
                    *(u32x4*)(rowp + bj * HALF) = w; } }
    }
};
struct EpiResF32 {
    static constexpr bool PERM = false;
    struct Pre {}; __device__ __forceinline__ Pre prefetch(const Unit&, int, int, int, int) const { return Pre{}; }
    const float* base; float* out; int ldc;
    __device__ __forceinline__ void operator()(const f32x4 (&acc)[2][2][4][2], const Unit& u, const Pre&, int wr, int wc, int fr, int fq) const {
        const int col0 = u.pn * BM + wc * 32 + 4 * fq;
#pragma unroll
        for (int ai = 0; ai < 2; ++ai) {
            f32x4 bs[4][2][2];
#pragma unroll
            for (int m = 0; m < 4; ++m) { const size_t off = (size_t)(u.pm * BM + ai * HALF + wr * 64 + m * 16 + fr) * ldc + col0;
#pragma unroll
                for (int bj = 0; bj < 2; ++bj)
#pragma unroll
                    for (int n = 0; n < 2; ++n) bs[m][bj][n] = __builtin_nontemporal_load((const f32x4*)(base + off + bj * HALF + n * 16)); }
            asm volatile("" ::: "memory");
#pragma unroll
            for (int m = 0; m < 4; ++m) { const size_t off = (size_t)(u.pm * BM + ai * HALF + wr * 64 + m * 16 + fr) * ldc + col0;
#pragma unroll
                for (int bj = 0; bj < 2; ++bj)
#pragma unroll
                    for (int n = 0; n < 2; ++n) *(f32x4*)(out + off + bj * HALF + n * 16) = bs[m][bj][n] + acc[ai][bj][m][n]; }
            asm volatile("" ::: "memory");
        }
    }
};
struct EpiSwiglu {
    static constexpr bool PERM = true;
    unsigned char* O; const float* bias; int nN;
    struct Pre { f32x4 bg0, bg1, bl0, bl1; };
    __device__ __forceinline__ Pre prefetch(const Unit& u, int wr, int wc, int fr, int fq) const {
        const int e = u.pb / nN, ch = u.pn * HALF + wc * 32 + 8 * fq;
        const float* bg = bias + (size_t)e * 2048 + ch; const float* bl = bg + 1024;
        return Pre{*(const f32x4*)bg, *(const f32x4*)(bg + 4), *(const f32x4*)bl, *(const f32x4*)(bl + 4)};
    }
    __device__ __forceinline__ void operator()(const f32x4 (&acc)[2][2][4][2], const Unit& u, const Pre& pre, int wr, int wc, int fr, int fq) const {
        const int row0 = u.pm * BM + wr * 64 + fr, ch = u.pn * HALF + wc * 32 + 8 * fq;
        const f32x4 bg0 = pre.bg0, bg1 = pre.bg1, bl0 = pre.bl0, bl1 = pre.bl1;
#pragma unroll
        for (int ai = 0; ai < 2; ++ai)
#pragma unroll
            for (int m = 0; m < 4; ++m) {
                float r[8];
#pragma unroll
                for (int n = 0; n < 2; ++n)
#pragma unroll
                    for (int j = 0; j < 4; ++j) {
                        float gv = acc[ai][0][m][n][j] * (1.f / 32.f) + (n ? bg1[j] : bg0[j]);
                        float lv = acc[ai][1][m][n][j] * (1.f / 32.f) + (n ? bl1[j] : bl0[j]);
                        gv = fminf(gv, 7.0f); lv = fminf(fmaxf(lv, -7.0f), 7.0f);
                        r[n * 4 + j] = gv * __builtin_amdgcn_rcpf(1.f + __builtin_amdgcn_exp2f(-1.702f * 1.4426950408889634f * gv)) * (lv + 1.0f);
                    }
                u32x2 w; w.x = pk4_fp8(r[0], r[1], r[2], r[3]); w.y = pk4_fp8(r[4], r[5], r[6], r[7]);
                *(u32x2*)(O + (size_t)(row0 + ai * HALF + m * 16) * DFF + ch) = w;
            }
    }
};
struct EpiDown {
    static constexpr bool PERM = true;
    bf16_t* O; const float* bias; int nN;
    struct Pre { f32x4 bv[2][2]; };
    __device__ __forceinline__ Pre prefetch(const Unit& u, int wr, int wc, int fr, int fq) const {
        const int e = u.pb / nN, col0 = u.pn * BM + wc * 32 + 8 * fq;
        const float* bp = bias + (size_t)e * 1024 + col0;
        Pre pr;
#pragma unroll
        for (int bj = 0; bj < 2; ++bj)
#pragma unroll
            for (int n = 0; n < 2; ++n) pr.bv[bj][n] = *(const f32x4*)(bp + bj * HALF + 4 * n);
        return pr;
    }
    __device__ __forceinline__ void operator()(const f32x4 (&acc)[2][2][4][2], const Unit& u, const Pre& pre, int wr, int wc, int fr, int fq) const {
        const int row0 = u.pm * BM + wr * 64 + fr, col0 = u.pn * BM + wc * 32 + 8 * fq;
        f32x4 bv[2][2];
#pragma unroll
        for (int bj = 0; bj < 2; ++bj)
#pragma unroll
            for (int n = 0; n < 2; ++n) bv[bj][n] = pre.bv[bj][n];
#pragma unroll
        for (int ai = 0; ai < 2; ++ai)
#pragma unroll
            for (int m = 0; m < 4; ++m) { bf16_t* rowp = O + (size_t)(row0 + ai * HALF + m * 16) * 1024 + col0;
#pragma unroll
                for (int bj = 0; bj < 2; ++bj) { const f32x4 v0 = acc[ai][bj][m][0] * (1.f / 32.f) + bv[bj][0], v1 = acc[ai][bj][m][1] * (1.f / 32.f) + bv[bj][1];
                    u32x4 w; w.x = cvt_pk_bf16(v0[0], v0[1]); w.y = cvt_pk_bf16(v0[2], v0[3]); w.z = cvt_pk_bf16(v1[0], v1[1]); w.w = cvt_pk_bf16(v1[2], v1[3]);
                    *(u32x4*)(rowp + bj * HALF) = w; } }
    }
};

template <bool FP8, class Epi, class Sched>
__device__ __forceinline__ void gemm_phase(LAS unsigned char* lds, const Gemm g, const Sched& S, const Epi& E) {
    const int tid = opaque_tid(), wid = __builtin_amdgcn_readfirstlane(tid >> 6), lane = tid & 63, wr = wid >> 2, wc = wid & 3, fr = lane & 15, fq = lane >> 4;
    const int Kb = g.Kb, nt = Kb / 128;
    unsigned voffB[2]; int stR[2], stC[2];
    unsigned offc[2][2], offn[2][2];
#pragma unroll
    for (int i = 0; i < 2; ++i) { int R, C; stage_rc<FP8>(tid * 16 + i * 8192, R, C); const int Rb = Epi::PERM ? ((R & ~31) + perm32(R & 31)) : R;
        stR[i] = R; stC[i] = C * 2; voffB[i] = (unsigned)(Rb * Kb + C * 2);
        offc[0][i] = (unsigned)(R * Kb + C * 2); offc[1][i] = offc[0][i] + (unsigned)(HALF * Kb); offn[0][i] = offc[0][i]; offn[1][i] = offc[1][i]; }
    const size_t kstep = (size_t)(BK * 2);
    const size_t hstep = (size_t)HALF * Kb;
    const size_t tstep = 2 * hstep;
    const unsigned ldsw = (unsigned)wid * 1024u;
    const int aoff = FP8 ? lds_byte<true>(wr * 64 + fr, fq * 16) : lds_byte<false>(wr * 64 + fr, fq * 8), boff = FP8 ? lds_byte<true>(wc * 32 + fr, fq * 16) : lds_byte<false>(wc * 32 + fr, fq * 8);
    const int aoff1 = FP8 ? (aoff ^ 16) : (aoff + 1024), boff1 = FP8 ? (boff ^ 16) : (boff + 1024);
#define PG8_SA(b, h) (((b) * 2 + (h)) * HTB)
#define PG8_SB(b, h) ((4 + (b) * 2 + (h)) * HTB)
#define PG8_STAGE(bufoff, gbase, voff) do { _Pragma("unroll") for (int _i = 0; _i < 2; ++_i) \
        __builtin_amdgcn_global_load_lds((const unsigned*)((const char*)(gbase) + (voff)[_i]), (LAS unsigned*)(lds + (bufoff) + ldsw + _i * 8192), 16, 0, 0); } while (0)
#define PG8_LDA(dst, b, h) do { if constexpr (FP8) { _Pragma("unroll") for (int m = 0; m < 4; ++m) dst##8[m] = cat8(*(const LAS i32x4*)(lds + PG8_SA(b, h) + aoff + m * 2048), *(const LAS i32x4*)(lds + PG8_SA(b, h) + aoff1 + m * 2048)); } \
        else { _Pragma("unroll") for (int m = 0; m < 4; ++m) { dst[m][0] = *(const LAS bf16x8*)(lds + PG8_SA(b, h) + aoff + m * 2048); dst[m][1] = *(const LAS bf16x8*)(lds + PG8_SA(b, h) + aoff1 + m * 2048); } } } while (0)
#define PG8_LDB(dst, b, h) do { if constexpr (FP8) { _Pragma("unroll") for (int n = 0; n < 2; ++n) dst##8[n] = cat8(*(const LAS i32x4*)(lds + PG8_SB(b, h) + boff + n * 2048), *(const LAS i32x4*)(lds + PG8_SB(b, h) + boff1 + n * 2048)); } \
        else { _Pragma("unroll") for (int n = 0; n < 2; ++n) { dst[n][0] = *(const LAS bf16x8*)(lds + PG8_SB(b, h) + boff + n * 2048); dst[n][1] = *(const LAS bf16x8*)(lds + PG8_SB(b, h) + boff1 + n * 2048); } } } while (0)
#define PG8_MMA(ai, bj, At, Bt) do { __builtin_amdgcn_s_setprio(1); _Pragma("unroll") for (int m = 0; m < 4; ++m) _Pragma("unroll") for (int n = 0; n < 2; ++n) { \
        if constexpr (FP8) mfma8_acc(acc[ai][bj][m][n], Bt##8[n], At##8[m], scl); \
        else { _Pragma("unroll") for (int k = 0; k < 2; ++k) acc[ai][bj][m][n] = __builtin_amdgcn_mfma_f32_16x16x32_bf16(Bt[n][k], At[m][k], acc[ai][bj][m][n], 0, 0, 0); } } \
        __builtin_amdgcn_s_setprio(0); } while (0)
#define PG8_WAIT_V(n) asm volatile("s_waitcnt vmcnt(" #n ")" ::: "memory")
#define PG8_WAIT_L(n) asm volatile("s_waitcnt lgkmcnt(" #n ")" ::: "memory")
#define PG8_BAR __builtin_amdgcn_s_barrier()
#define PG8_SCHED __builtin_amdgcn_sched_barrier(0)
    Unit cur, nxt; int ui = 0;
    if (!S.next(0, cur)) return;
    f32x4 acc[2][2][4][2];
#pragma unroll
    for (int a = 0; a < 2; ++a)
#pragma unroll
        for (int b = 0; b < 2; ++b)
#pragma unroll
            for (int m = 0; m < 4; ++m)
#pragma unroll
                for (int n = 0; n < 2; ++n) acc[a][b][m][n] = (f32x4){0.f, 0.f, 0.f, 0.f};
    bf16x8 At[4][2], B0[2][2], B1[2][2];
    i32x8 At8[4], B08[2], B18[2];
    int scl = 0x7f7f7f7f; asm volatile("" : "+v"(scl));
    const char* cA = Sched::GATHER ? (const char*)g.A : (const char*)g.A + (size_t)cur.pm * tstep; const char* cB = (const char*)g.Bt + (size_t)cur.pb * tstep;
    if constexpr (Sched::GATHER) S.a_offsets(cur, stR, stC, Kb, offc);
    typename Epi::Pre pre = E.prefetch(cur, wr, wc, fr, fq);
    {
        PG8_STAGE(PG8_SB(0, 0), cB, voffB); PG8_STAGE(PG8_SB(0, 1), cB + hstep, voffB); PG8_STAGE(PG8_SA(0, 0), cA, offc[0]); PG8_STAGE(PG8_SA(0, 1), cA, offc[1]);
        if (wr == 1) PG8_BAR;
        PG8_WAIT_V(2); PG8_BAR;
        PG8_STAGE(PG8_SB(1, 0), cB + kstep, voffB); PG8_STAGE(PG8_SA(1, 0), cA + kstep, offc[0]); PG8_STAGE(PG8_SB(1, 1), cB + hstep + kstep, voffB);
        PG8_WAIT_V(6); PG8_BAR;
    }
    for (;;) {
        const bool has_next = S.next(ui + 1, nxt);
        const char* nA = Sched::GATHER ? cA : (has_next ? (const char*)g.A + (size_t)nxt.pm * tstep : cA); const char* nB = has_next ? (const char*)g.Bt + (size_t)nxt.pb * tstep : cB;
        if constexpr (Sched::GATHER) {
            if (has_next) S.a_offsets(nxt, stR, stC, Kb, offn);
            else {
#pragma unroll
                for (int h = 0; h < 2; ++h)
#pragma unroll
                    for (int i = 0; i < 2; ++i) offn[h][i] = offc[h][i];
            }
        }
#pragma unroll 1
        for (int t = 0; t < nt; t += 2) {
            const bool last = (t == nt - 2);
            const char* a1 = cA + (size_t)(t + 1) * kstep;
            const char* a2 = last ? nA : cA + (size_t)(t + 2) * kstep; const char* b2 = last ? nB : cB + (size_t)(t + 2) * kstep;
            const char* a3 = a2 + kstep; const char* b3 = b2 + kstep;
            unsigned o20[2], o21[2];
#pragma unroll
            for (int i = 0; i < 2; ++i) { o20[i] = (Sched::GATHER && last) ? offn[0][i] : offc[0][i]; o21[i] = (Sched::GATHER && last) ? offn[1][i] : offc[1][i]; }
            PG8_LDB(B0, 0, 0); PG8_LDB(B1, 0, 1); PG8_SCHED; PG8_LDA(At, 0, 0); PG8_STAGE(PG8_SA(1, 1), a1, offc[1]);
            PG8_WAIT_V(8); PG8_WAIT_L(0); PG8_BAR; PG8_MMA(0, 0, At, B0); PG8_MMA(0, 1, At, B1); PG8_BAR; PG8_SCHED;
            PG8_LDA(At, 0, 1); PG8_STAGE(PG8_SB(0, 0), b2, voffB); PG8_STAGE(PG8_SB(0, 1), b2 + hstep, voffB); PG8_STAGE(PG8_SA(0, 0), a2, o20);
            PG8_WAIT_V(8); PG8_WAIT_L(0); PG8_BAR; PG8_MMA(1, 0, At, B0); PG8_MMA(1, 1, At, B1); PG8_BAR; PG8_SCHED;
            PG8_LDB(B0, 1, 0); PG8_LDB(B1, 1, 1); PG8_SCHED; PG8_LDA(At, 1, 0); PG8_STAGE(PG8_SA(0, 1), a2, o21);
            PG8_WAIT_V(8); PG8_WAIT_L(0); PG8_BAR; PG8_MMA(0, 0, At, B0); PG8_MMA(0, 1, At, B1); PG8_BAR; PG8_SCHED;
            PG8_LDA(At, 1, 1); PG8_STAGE(PG8_SB(1, 0), b3, voffB); PG8_STAGE(PG8_SB(1, 1), b3 + hstep, voffB); PG8_STAGE(PG8_SA(1, 0), a3, o20);
            PG8_WAIT_V(8); PG8_WAIT_L(0); PG8_BAR; PG8_MMA(1, 0, At, B0); PG8_MMA(1, 1, At, B1); PG8_BAR; PG8_SCHED;
        }
        if (wr == 0) PG8_BAR;
        if constexpr (FP8) asm volatile("s_nop 15\n\ts_nop 15" ::: "memory");
        E(acc, cur, pre, wr, wc, fr, fq);
        if (!has_next) break;
#pragma unroll
        for (int a = 0; a < 2; ++a)
#pragma unroll
            for (int b = 0; b < 2; ++b)
#pragma unroll
                for (int m = 0; m < 4; ++m)
#pragma unroll
                    for (int n = 0; n < 2; ++n) acc[a][b][m][n] = (f32x4){0.f, 0.f, 0.f, 0.f};
        cur = nxt; cA = nA; cB = nB; ++ui;
        if constexpr (Sched::GATHER) {
#pragma unroll
            for (int h = 0; h < 2; ++h)
#pragma unroll
                for (int i = 0; i < 2; ++i) offc[h][i] = offn[h][i];
        }
        pre = E.prefetch(cur, wr, wc, fr, fq);
        if (wr == 1) PG8_BAR;
    }
    PG8_WAIT_V(0);
    PG8_BAR;
#undef PG8_SA
#undef PG8_SB
#undef PG8_STAGE
#undef PG8_LDA
#undef PG8_LDB
#undef PG8_MMA
#undef PG8_WAIT_V
#undef PG8_WAIT_L
#undef PG8_BAR
#undef PG8_SCHED
}
}

__device__ __forceinline__ int win_map(int n) {
    if (n < 1280) return n;
    if (n < 2304) return n + 24;
    if (n < 2816) return n + 40;
    if (n < 2840) return n - 1536;
    if (n < 2856) return n - 512;
    return -1;
}
template <int MODE> __device__ __forceinline__ int colmap(int r) {
    if (MODE == 1) return win_map(r);
    if (MODE == 2) return ((r >> 7) & 1) * 1024 + (r >> 8) * 128 + (r & 127);
    return r;
}
template <int MODE, bool OUT8>
__device__ __forceinline__ void transpose_item(const float* W, int K, int Nsrc, void* WTv, int nblk, LAS float* scr, int item, int lane) {
    const int kb = item / nblk, nb = item % nblk, k0 = 64 * kb, n0 = 64 * nb;
    const int nq = 4 * (lane & 15), kq = lane >> 4;
    const int sc = colmap<MODE>(n0 + nq);
    f32x4 v[16];
#pragma unroll
    for (int i = 0; i < 16; ++i) v[i] = sc >= 0 ? __builtin_nontemporal_load((const f32x4*)(W + (size_t)(k0 + 4 * i + kq) * Nsrc + sc)) : (f32x4){0.f, 0.f, 0.f, 0.f};
#pragma unroll
    for (int i = 0; i < 16; ++i) { LAS float* d = scr + (4 * i + kq) * 65 + nq; d[0] = v[i].x; d[1] = v[i].y; d[2] = v[i].z; d[3] = v[i].w; }
    LDS_WAIT();
    const int c = lane & 7;
#pragma unroll
    for (int j = 0; j < 8; ++j) { const int n = (lane >> 3) + 8 * j; const LAS float* s = scr + (8 * c) * 65 + n;
        if (OUT8) {
            u32x2 o; o.x = pk4_fp8(s[0 * 65] * 32.f, s[1 * 65] * 32.f, s[2 * 65] * 32.f, s[3 * 65] * 32.f); o.y = pk4_fp8(s[4 * 65] * 32.f, s[5 * 65] * 32.f, s[6 * 65] * 32.f, s[7 * 65] * 32.f);
            *(u32x2*)((unsigned char*)WTv + (size_t)(n0 + n) * K + k0 + 8 * c) = o;
        } else {
            u32x4 o; o.x = pk2(s[0 * 65], s[1 * 65]); o.y = pk2(s[2 * 65], s[3 * 65]); o.z = pk2(s[4 * 65], s[5 * 65]); o.w = pk2(s[6 * 65], s[7 * 65]);
            *(u32x4*)((bf16_t*)WTv + (size_t)(n0 + n) * K + k0 + 8 * c) = o; } }
    LDS_WAIT();
}
template <int NR>
__device__ __forceinline__ void rms_rows_to_bf16(const float* x0, size_t xstride, const float* g, bf16_t* o0, size_t ostride, int lane) {
    f32x4 v[NR][4];
#pragma unroll
    for (int r = 0; r < NR; ++r) { const f32x4* xr = (const f32x4*)(x0 + r * xstride) + lane;
#pragma unroll
        for (int j = 0; j < 4; ++j) v[r][j] = __builtin_nontemporal_load(xr + 64 * j); }
    const f32x4* gr = (const f32x4*)g + lane;
    f32x4 gg[4];
#pragma unroll
    for (int j = 0; j < 4; ++j) gg[j] = gr[64 * j];
#pragma unroll
    for (int r = 0; r < NR; ++r) {
        float s = 0.f;
#pragma unroll
        for (int j = 0; j < 4; ++j) s += (v[r][j].x * v[r][j].x + v[r][j].y * v[r][j].y) + (v[r][j].z * v[r][j].z + v[r][j].w * v[r][j].w);
        const float rstd = 1.f / sqrtf(wave_sum(s) * (1.f / DM) + EPS);
        unsigned long long* o8 = (unsigned long long*)(o0 + r * ostride) + lane;
#pragma unroll
        for (int j = 0; j < 4; ++j) { const f32x4 o = v[r][j] * rstd * gg[j];
            o8[64 * j] = (unsigned long long)pk2(o.x, o.y) | ((unsigned long long)pk2(o.z, o.w) << 32); }
    }
}
__device__ __forceinline__ void phase0(const Params& p, LAS unsigned char* lds, int blk, int G) {
    const int tid = opaque_tid(), lane = tid & 63, wave = tid >> 6;
    LAS float* scr = (LAS float*)(lds + wave * 16640);
    const int gw = blk * 8 + wave, NGW = G * 8;
    unsigned char* ws = p.ws;
    constexpr int I_GU = 16 * 32, I_DN = 16 * 16;
    constexpr int N_GU = NEXP * I_GU, N_DN = NEXP * I_DN, N_IN = 16 * (NPROJ / 64), N_OUT = 16 * 16, N_C1 = 32 * 4, N_C2 = 4 * 1;
    constexpr int NITEMS = N_IN + N_OUT + 2 * N_C1 + 2 * N_C2;
    (void)N_GU; (void)N_DN;
    for (int it = gw; it < NITEMS; it += NGW) {
        int r = it;
        if (r < N_IN) { transpose_item<1, false>(p.in[3], 1024, 2856, (bf16_t*)(ws + WS_WIN), NPROJ / 64, scr, r, lane); continue; } r -= N_IN;
        if (r < N_OUT) { transpose_item<0, false>(p.in[15], 1024, 1024, (bf16_t*)(ws + WS_WOUT), 16, scr, r, lane); continue; } r -= N_OUT;
        if (r < N_C1) { transpose_item<0, false>(p.in[7], 2048, 256, (bf16_t*)(ws + WS_CW1K), 4, scr, r, lane); continue; } r -= N_C1;
        if (r < N_C1) { transpose_item<0, false>(p.in[10], 2048, 256, (bf16_t*)(ws + WS_CW1V), 4, scr, r, lane); continue; } r -= N_C1;
        if (r < N_C2) { transpose_item<0, false>(p.in[8], 256, 64, (bf16_t*)(ws + WS_CW2K), 1, scr, r, lane); continue; } r -= N_C2;
        transpose_item<0, false>(p.in[11], 256, 64, (bf16_t*)(ws + WS_CW2V), 1, scr, r, lane);
    }
    for (int m = gw * 4; m < MTOK; m += NGW * 4) rms_rows_to_bf16<4>(p.in[0] + (size_t)m * DM, DM, p.in[2], (bf16_t*)(ws + WS_H) + (size_t)m * DM, DM, lane);
    for (int i = blk * NTHREADS + tid; i < NEXP * DM; i += G * NTHREADS) { const int e = i >> 10, d = i & 1023; ((float*)(ws + WS_WRT))[i] = p.in[16][d] * p.in[17][d * NEXP + e]; }
    if (blk == G - 1) {
        const int which = tid >> 8, j = tid & 255;
        const float* pos = which ? p.in[9] : p.in[6]; const float* w1 = which ? p.in[10] : p.in[7];
        float s = 0.f;
#pragma unroll 8
        for (int k = 0; k < 2048; ++k) s += pos[k] * w1[(size_t)k * 256 + j];
        ((float*)(ws + WS_CBIAS))[tid] = s;
    }
}

__device__ __forceinline__ void p2a_unit(const Params& p, LAS unsigned char* lds, int unit) {
    const int tid = opaque_tid(), lane = tid & 63, wave = tid >> 6, vec = lane >> 4, li = lane & 15;
    unsigned char* ws = p.ws;
    const bf16_t* PROJ = (const bf16_t*)(ws + WS_PROJ);
    const int b = unit >> 5, blkc = unit & 31, tok0 = unit * 64;
    u32x4 vraw[4];
    { const int tk = tid >> 3, ch = tid & 7;
#pragma unroll
      for (int v = 0; v < 4; ++v) vraw[v] = *(const u32x4*)(PROJ + (size_t)(tok0 + tk) * NPROJ + (v < 2 ? CVS : CVW) + (v & 1) * 64 + 8 * ch); }
    const int col0 = CQ + vec * 64 + 4 * li, col1 = CQ + (4 + vec) * 64 + 4 * li, col2 = (vec < 2 ? CKS + vec * 64 : CKW + (vec - 2) * 64) + 4 * li;
    u32x2 raw[8][3];
#pragma unroll
    for (int ti = 0; ti < 8; ++ti) { const bf16_t* pr = PROJ + (size_t)(tok0 + wave * 8 + ti) * NPROJ;
        raw[ti][0] = *(const u32x2*)(pr + col0); raw[ti][1] = *(const u32x2*)(pr + col1); raw[ti][2] = *(const u32x2*)(pr + col2); }
    const f32x4 gq = *(const f32x4*)(p.in[4] + 4 * li);
    const f32x4 gk = *(const f32x4*)(p.in[5] + (vec < 2 ? 64 : 128) + 4 * li);
    float invf[4];
#pragma unroll
    for (int i = 0; i < 4; ++i) invf[i] = __expf(-13.122363377404328f * (float)(2 * ((4 * li + i) & 7)) * (1.f / 16.f));
    const float sgn = (li < 2) ? -1.f : 1.f;
#pragma unroll
    for (int ti = 0; ti < 8; ++ti) {
        const int t = tok0 + wave * 8 + ti;
        const float pos = (float)((const int*)p.in[1])[t];
        float cs[4], sn[4];
#pragma unroll
        for (int i = 0; i < 4; ++i) { const float ang = pos * invf[i]; cs[i] = __cosf(ang); sn[i] = __sinf(ang); }
#pragma unroll
        for (int vg = 0; vg < 3; ++vg) {
            const u32x2 rw = raw[ti][vg];
            float x[4] = {__uint_as_float(rw.x << 16), __uint_as_float(rw.x & 0xffff0000u), __uint_as_float(rw.y << 16), __uint_as_float(rw.y & 0xffff0000u)};
            const float ss = red16_sum((x[0] * x[0] + x[1] * x[1]) + (x[2] * x[2] + x[3] * x[3]));
            const float rstd = 1.f / sqrtf(ss * (1.f / 64.f) + EPS);
            const f32x4 g = (vg < 2) ? gq : gk;
            float y[4], yr[4];
#pragma unroll
            for (int i = 0; i < 4; ++i) y[i] = x[i] * rstd * g[i];
#pragma unroll
            for (int i = 0; i < 4; ++i) { const float partner = dppf<0x4E>(y[i]); yr[i] = (li < 4) ? (y[i] * cs[i] + sgn * partner * sn[i]) : y[i]; }
            if (vg < 2) {
                const float sc = 0.125f * 1.4426950408889634f;
                u32x2 o; o.x = pk2(y[0] * sc, y[1] * sc); o.y = pk2(y[2] * sc, y[3] * sc);
                *(u32x2*)((bf16_t*)(ws + WS_QN) + (size_t)t * 512 + (4 * vg + vec) * 64 + 4 * li) = o;
                o.x = pk2(yr[0] * sc, yr[1] * sc); o.y = pk2(yr[2] * sc, yr[3] * sc);
                *(u32x2*)((bf16_t*)(ws + WS_QR) + (size_t)t * 512 + (4 * vg + vec) * 64 + 4 * li) = o;
            } else {
                u32x2 o; o.x = pk2(yr[0], yr[1]); o.y = pk2(yr[2], yr[3]);
                bf16_t* dst = (bf16_t*)(ws + (vec < 2 ? WS_KS : WS_KW)) + ((size_t)(b * 2 + (vec & 1)) * SEQ + (t & (SEQ - 1))) * 64 + 4 * li;
                *(u32x2*)dst = o;
            }
        }
    }
    __syncthreads();
    { const int tk = tid >> 3, ch = tid & 7, tkp = (tk & ~12) | ((tk & 4) << 1) | ((tk & 8) >> 1);
#pragma unroll
      for (int v = 0; v < 4; ++v) { LAS bf16_t* T = (LAS bf16_t*)lds + v * (64 * 72);
#pragma unroll
          for (int q = 0; q < 4; ++q) { const unsigned wv = vraw[v][q]; T[(8 * ch + 2 * q) * 72 + tkp] = (bf16_t)(wv & 0xffffu); T[(8 * ch + 2 * q + 1) * 72 + tkp] = (bf16_t)(wv >> 16); } } }
    __syncthreads();
    { const int d = tid >> 3, ch = tid & 7;
#pragma unroll
      for (int v = 0; v < 4; ++v) { const LAS bf16_t* T = (const LAS bf16_t*)lds + v * (64 * 72);
          const u32x4 o = *(const LAS u32x4*)(T + d * 72 + 8 * ch);
          bf16_t* dst = (bf16_t*)(ws + (v < 2 ? WS_VST : WS_VWT)) + (((size_t)(b * 2 + (v & 1)) * 32 + blkc) * 64 + d) * 64 + 8 * ch;
          *(u32x4*)dst = o; } }
}

__device__ __forceinline__ void p2b_unit(const Params& p, LAS unsigned char* lds, int unit) {
    const int tid = opaque_tid(), lane = tid & 63, w = tid >> 6, fr = lane & 15, fq = lane >> 4;
    unsigned char* ws = p.ws;
    const bf16_t* PROJ = (const bf16_t*)(ws + WS_PROJ);
    const int which = unit >> 6, rt = unit & 63;
    const bf16_t* W1T = (const bf16_t*)(ws + (which ? WS_CW1V : WS_CW1K));
    const bf16_t* W2T = (const bf16_t*)(ws + (which ? WS_CW2V : WS_CW2K));
    const float* cb = (const float*)(ws + WS_CBIAS) + which * 256;
    const int colbase = which ? CVC : CKC;
    LAS bf16_t* Hd = (LAS bf16_t*)lds;
    LAS float* Of = (LAS float*)(lds + 64 * 264 * 2);
    const bf16_t* arow[4];
#pragma unroll
    for (int m = 0; m < 4; ++m) { const int R = rt * 64 + 16 * m + fr; const int bb = R >> 8, kh = (R >> 7) & 1; int n = R & 127; if (n > 126) n = 126;
        arow[m] = PROJ + (size_t)(bb * SEQ + 16 * n) * NPROJ + colbase + kh * 64 + 8 * fq; }
    const bf16_t* brow[2];
#pragma unroll
    for (int nf = 0; nf < 2; ++nf) brow[nf] = W1T + (size_t)(32 * w + 16 * nf + fr) * 2048 + 8 * fq;
    f32x4 acc[4][2];
#pragma unroll
    for (int m = 0; m < 4; ++m)
#pragma unroll
        for (int nf = 0; nf < 2; ++nf) acc[m][nf] = (f32x4){0.f, 0.f, 0.f, 0.f};
#pragma unroll 4
    for (int ks = 0; ks < 64; ++ks) {
        bf16x8 a[4], bb2[2];
        const size_t aoff = (size_t)(ks >> 1) * NPROJ + 32 * (ks & 1);
#pragma unroll
        for (int m = 0; m < 4; ++m) a[m] = *(const bf16x8*)(arow[m] + aoff);
#pragma unroll
        for (int nf = 0; nf < 2; ++nf) bb2[nf] = *(const bf16x8*)(brow[nf] + 32 * ks);
#pragma unroll
        for (int m = 0; m < 4; ++m)
#pragma unroll
            for (int nf = 0; nf < 2; ++nf) acc[m][nf] = __builtin_amdgcn_mfma_f32_16x16x32_bf16(a[m], bb2[nf], acc[m][nf], 0, 0, 0);
    }
#pragma unroll
    for (int nf = 0; nf < 2; ++nf) { const int col = 32 * w + 16 * nf + fr; const float bias = cb[col];
#pragma unroll
        for (int m = 0; m < 4; ++m)
#pragma unroll
            for (int j = 0; j < 4; ++j) { const float hv = acc[m][nf][j] + bias; Hd[(16 * m + 4 * fq + j) * 264 + col] = (bf16_t)f2bf(hv * sigmoidf_(hv)); } }
    __syncthreads();
    {
        const int m2 = w >> 1;
        f32x4 acc2[2] = {(f32x4){0.f, 0.f, 0.f, 0.f}, (f32x4){0.f, 0.f, 0.f, 0.f}};
#pragma unroll
        for (int ks = 0; ks < 8; ++ks) {
            const bf16x8 a = *(const LAS bf16x8*)(Hd + (16 * m2 + fr) * 264 + 32 * ks + 8 * fq);
#pragma unroll
            for (int q = 0; q < 2; ++q) { const int nf2 = 2 * (w & 1) + q; const bf16x8 bv = *(const bf16x8*)(W2T + (size_t)(16 * nf2 + fr) * 256 + 32 * ks + 8 * fq);
                acc2[q] = __builtin_amdgcn_mfma_f32_16x16x32_bf16(a, bv, acc2[q], 0, 0, 0); }
        }
#pragma unroll
        for (int q = 0; q < 2; ++q) { const int nf2 = 2 * (w & 1) + q;
#pragma unroll
            for (int j = 0; j < 4; ++j) Of[(16 * m2 + 4 * fq + j) * 65 + 16 * nf2 + fr] = acc2[q][j]; }
    }
    __syncthreads();
    for (int rr = 0; rr < 8; ++rr) {
        const int r = 8 * w + rr, R = rt * 64 + r, bb = R >> 8, kh = (R >> 7) & 1, n = R & 127;
        float v = Of[r * 65 + lane];
        if (which == 0) {
            const float ss = wave_sum(v * v);
            v = v * (1.f / sqrtf(ss * (1.f / 64.f) + EPS)) * p.in[5][lane];
            if (n == 127) v = 0.f;
            ((bf16_t*)(ws + WS_KC))[((size_t)(bb * 2 + kh) * 128 + n) * 64 + lane] = (bf16_t)f2bf(v);
        } else {
            if (n == 127) v = 0.f;
            ((bf16_t*)(ws + WS_VCT))[((size_t)(bb * 2 + kh) * 64 + lane) * 128 + ((n & ~12) | ((n & 4) << 1) | ((n & 8) >> 1))] = (bf16_t)f2bf(v);
        }
    }
    __syncthreads();
}

typedef float f32x16 __attribute__((ext_vector_type(16)));
constexpr int NSA_KT0 = 0, NSA_VT0 = 9216, NSA_KT1 = 18432, NSA_VT1 = 27648, NSA_IMPW = 36864, NSA_SELM = NSA_IMPW + 4 * 64 * 33 * 4, NSA_UNI = NSA_SELM + 256,
              NSA_OUT = NSA_UNI + 256;
static_assert(NSA_OUT + 256 * 68 * 4 <= LDS_BYTES - 64, "NSA LDS map");
constexpr float NEGBIG = -1e30f;
#define MFMA32(a, b, c) __builtin_amdgcn_mfma_f32_32x32x16_bf16((a), (b), (c), 0, 0, 0)

__device__ __forceinline__ bf16x8 pack_step(const f32x16& x, int s) {
    u32x4 p;
    if (s == 0) asm volatile("v_cvt_pk_bf16_f32 %0, %4, %5\n\tv_cvt_pk_bf16_f32 %1, %6, %7\n\tv_cvt_pk_bf16_f32 %2, %8, %9\n\tv_cvt_pk_bf16_f32 %3, %10, %11\n\ts_nop 1"
                     : "=&v"(p[0]), "=&v"(p[1]), "=&v"(p[2]), "=&v"(p[3]) : "v"(x[0]), "v"(x[1]), "v"(x[2]), "v"(x[3]), "v"(x[4]), "v"(x[5]), "v"(x[6]), "v"(x[7]));
    else asm volatile("v_cvt_pk_bf16_f32 %0, %4, %5\n\tv_cvt_pk_bf16_f32 %1, %6, %7\n\tv_cvt_pk_bf16_f32 %2, %8, %9\n\tv_cvt_pk_bf16_f32 %3, %10, %11\n\ts_nop 1"
                     : "=&v"(p[0]), "=&v"(p[1]), "=&v"(p[2]), "=&v"(p[3]) : "v"(x[8]), "v"(x[9]), "v"(x[10]), "v"(x[11]), "v"(x[12]), "v"(x[13]), "v"(x[14]), "v"(x[15]));
    return __builtin_bit_cast(bf16x8, p);
}
__device__ __forceinline__ void nsa_qk(const bf16x8 (&bq)[4], const LAS bf16_t* KT, f32x16 (&X)[2], int r, int h, float init = 0.f) {
#pragma unroll
    for (int kt = 0; kt < 2; ++kt) {
        f32x16 x;
#pragma unroll
        for (int i = 0; i < 16; ++i) x[i] = init;
#pragma unroll
        for (int ks = 0; ks < 4; ++ks) { const bf16x8 a = *(const LAS bf16x8*)(KT + (32 * kt + r) * 72 + 16 * ks + 8 * h); x = MFMA32(a, bq[ks], x); }
        X[kt] = x;
    }
}
__device__ __forceinline__ void nsa_bounds(int mode, bool rok, int i, int cq, int koff, int& lo, int& hi) {
    hi = (mode == 1) ? i : ((mode == 3) ? (((cq + i - 31) >> 4) - koff) : 63);
    lo = (mode == 2) ? i + 1 : 0;
    hi = rok ? hi : -1;
}
__device__ __forceinline__ void nsa_tile(int MM, const bf16x8 (&bq)[4], const LAS bf16_t* KT, const LAS bf16_t* VT, float& lsum, f32x16 (&O)[2],
                                         bool rok, int mode, int iq, int cq, int koff, int r_, int h_) {
    int r = r_, h = h_;
    asm volatile("" : "+v"(r), "+v"(h));
    f32x16 X[2];
    nsa_qk(bq, KT, X, r, h, (MM == 1 && !rok) ? NEGBIG : 0.f);
#pragma unroll
    for (int kt = 0; kt < 2; ++kt)
#pragma unroll
        for (int i = 0; i < 16; ++i) X[kt][i] = __builtin_amdgcn_exp2f(X[kt][i]);
    if (MM == 2) {
        int lo, hi; nsa_bounds(mode, rok, iq, cq, koff, lo, hi);
#pragma unroll
        for (int kt = 0; kt < 2; ++kt)
#pragma unroll
            for (int i = 0; i < 16; ++i) { const int key = 32 * kt + (i & 3) + 8 * (i >> 2) + 4 * h; X[kt][i] = ((key >= lo) & (key <= hi)) ? X[kt][i] : 0.f; }
    }
    bf16x8 pf[2][2];
    float ls = 0.f;
#pragma unroll
    for (int kt = 0; kt < 2; ++kt) {
#pragma unroll
        for (int i = 0; i < 16; i += 4) ls += (X[kt][i] + X[kt][i + 1]) + (X[kt][i + 2] + X[kt][i + 3]);
        pf[kt][0] = pack_step(X[kt], 0); pf[kt][1] = pack_step(X[kt], 1);
    }
    lsum += ls;
#pragma unroll
    for (int dt = 0; dt < 2; ++dt)
#pragma unroll
        for (int kt = 0; kt < 2; ++kt)
#pragma unroll
            for (int s = 0; s < 2; ++s) { const bf16x8 a = *(const LAS bf16x8*)(VT + (32 * dt + r) * 72 + 32 * kt + 16 * s + 8 * h); O[dt] = MFMA32(a, pf[kt][s], O[dt]); }
}
struct NsaStage { u32x4 k, v; };
__device__ __forceinline__ void nsa_fetch(NsaStage& st, const bf16_t* Ksrc, int kstride, const bf16_t* Vsrc, int vstride, int tid) {
    const int r = tid >> 3, ch = tid & 7;
    st.k = *(const u32x4*)(Ksrc + (size_t)r * kstride + 8 * ch);
    st.v = *(const u32x4*)(Vsrc + (size_t)r * vstride + 8 * ch);
}
__device__ __forceinline__ void nsa_commit(const NsaStage& st, LAS bf16_t* KT, LAS bf16_t* VT, int tid) {
    const int r = tid >> 3, ch = tid & 7;
    *(LAS u32x4*)(KT + r * 72 + 8 * ch) = st.k;
    *(LAS u32x4*)(VT + r * 72 + 8 * ch) = st.v;
}
template <bool FIRST>
__device__ __forceinline__ void nsa_out_acc(LAS float* OUTw, const f32x16 (&O)[2], float sc, int r, int h) {
#pragma unroll
    for (int dt = 0; dt < 2; ++dt)
#pragma unroll
        for (int gq = 0; gq < 4; ++gq) {
            LAS f32x4* dst = (LAS f32x4*)(OUTw + r * 68 + 32 * dt + 8 * gq + 4 * h);
            f32x4 v = (f32x4){O[dt][4 * gq] * sc, O[dt][4 * gq + 1] * sc, O[dt][4 * gq + 2] * sc, O[dt][4 * gq + 3] * sc};
            if (!FIRST) v += *dst;
            *dst = v;
        }
}

__device__ __forceinline__ void nsa_unit(const Params& p, LAS unsigned char* lds, int b, int kh, int c) {
    const int tid = opaque_tid(), lane = tid & 63, w = tid >> 6, r = lane & 31, h = lane >> 5, g = w >> 1, ih = w & 1;
    unsigned char* ws = p.ws;
    const int hh = kh * 4 + g, tok0 = b * SEQ + 64 * c, ibase = 32 * ih, iq = ibase + r, tq = tok0 + iq;
    const bf16_t* PROJ = (const bf16_t*)(ws + WS_PROJ);
    LAS float* IMPW = (LAS float*)(lds + NSA_IMPW);
    LAS unsigned* SELM = (LAS unsigned*)(lds + NSA_SELM); LAS unsigned* UNI = (LAS unsigned*)(lds + NSA_UNI);
    LAS float* OUTw = (LAS float*)(lds + NSA_OUT) + (w * 32) * 68;
    const size_t bk = (size_t)(b * 2 + kh);
#define NSA_KTB(bb) ((LAS bf16_t*)(lds + ((bb) ? NSA_KT1 : NSA_KT0)))
#define NSA_VTB(bb) ((LAS bf16_t*)(lds + ((bb) ? NSA_VT1 : NSA_VT0)))
    bf16x8 bq[4];
    NsaStage st;
    if (tid == 0) *UNI = 0u;
    const bf16_t* gp = PROJ + (size_t)tq * NPROJ + CGATE + hh * 3;
    const float gate0 = sigmoidf_(bf2f(gp[0])), gate1 = sigmoidf_(bf2f(gp[1])), gate2 = sigmoidf_(bf2f(gp[2]));
    {
#pragma unroll
        for (int ks = 0; ks < 4; ++ks) bq[ks] = *(const bf16x8*)((const bf16_t*)(ws + WS_QN) + (size_t)tq * 512 + hh * 64 + 16 * ks + 8 * h);
        const int nh = (4 * c + 2 >= 64) ? 2 : 1;
        const bf16_t* KCb = (const bf16_t*)(ws + WS_KC) + bk * 128 * 64; const bf16_t* VCb = (const bf16_t*)(ws + WS_VCT) + bk * 64 * 128;
        float lsum = 0.f; f32x16 O[2];
#pragma unroll
        for (int dt = 0; dt < 2; ++dt)
#pragma unroll
            for (int i = 0; i < 16; ++i) O[dt][i] = 0.f;
        nsa_fetch(st, KCb, 64, VCb, 128, tid);
        BAR_LDS();
        nsa_commit(st, NSA_KTB(0), NSA_VTB(0), tid);
        if (nh == 2) { nsa_fetch(st, KCb + 64 * 64, 64, VCb + 64, 128, tid); nsa_commit(st, NSA_KTB(1), NSA_VTB(1), tid); }
        BAR_LDS();
        for (int half = 0; half < nh; ++half) nsa_tile(2, bq, NSA_KTB(half), NSA_VTB(half), lsum, O, true, 3, iq, 64 * c, 64 * half, r, h);
        const float lt = lsum + __shfl_xor(lsum, 32);
        const float inv = lt > 0.f ? 1.f / lt : 0.f;
        nsa_out_acc<true>(OUTw, O, gate0 * inv, r, h);
        float carry = 0.f;
        for (int half = 0; half < nh; ++half) {
            f32x16 X[2];
            int r2 = r, h2 = h;
            asm volatile("" : "+v"(r2), "+v"(h2));
            nsa_qk(bq, NSA_KTB(half), X, r2, h2);
            const int hi = ((64 * c + iq - 31) >> 4) - 64 * half;
#pragma unroll
            for (int kt = 0; kt < 2; ++kt) {
                float pv[16];
#pragma unroll
                for (int i = 0; i < 16; ++i) { const int key = 32 * kt + (i & 3) + 8 * (i >> 2) + 4 * h2; pv[i] = (key <= hi) ? __builtin_amdgcn_exp2f(X[kt][i]) * inv : 0.f; }
#pragma unroll
                for (int gq = 0; gq < 4; ++gq) {
                    const float send = (h2 == 0) ? pv[4 * gq + 3] : (gq > 0 ? pv[4 * gq - 1] : carry);
                    const float extra = __shfl_xor(send, 32);
                    IMPW[(g * 64 + iq) * 33 + 16 * half + 8 * kt + 2 * gq + h2] = ((pv[4 * gq] + pv[4 * gq + 1]) + (pv[4 * gq + 2] + pv[4 * gq + 3])) + extra;
                }
                carry = pv[15];
            }
        }
    }
    BAR_LDS();
    {
        LAS float* SC = (LAS float*)(lds + NSA_KT0);
#pragma unroll
        for (int q = 0; q < 4; ++q) { const int pr = q * NTHREADS + tid, i = pr >> 5, j = pr & 31;
            float v = NEGBIG;
            if (j <= c) { v = (IMPW[(0 * 64 + i) * 33 + j] + IMPW[(1 * 64 + i) * 33 + j]) + (IMPW[(2 * 64 + i) * 33 + j] + IMPW[(3 * 64 + i) * 33 + j]);
                if (j == 0 || j == c || j == c - 1) v += 1e4f; }
            SC[i * 33 + j] = v; }
        BAR_LDS();
#pragma unroll 1
        for (int q = 0; q < 4; ++q) { const int pr = q * NTHREADS + tid, i = pr >> 5, j = pr & 31;
            const float my = SC[i * 33 + j]; int rank = 0;
#pragma unroll
            for (int k = 0; k < 32; ++k) { const float o = SC[i * 33 + k]; rank += (o > my || (o == my && k < j)) ? 1 : 0; }
            const bool sel = (j <= c) && rank < 8;
            const unsigned long long bal = __ballot(sel);
            const unsigned msk = (lane & 32) ? (unsigned)(bal >> 32) : (unsigned)bal;
            if (j == 0) { SELM[i] = msk; atomicOr((unsigned*)UNI, msk); } }
    }
    BAR_LDS();
    const unsigned uni = *UNI;
    const unsigned mysel = SELM[iq];
#pragma unroll
    for (int ks = 0; ks < 4; ++ks) bq[ks] = *(const bf16x8*)((const bf16_t*)(ws + WS_QR) + (size_t)tq * 512 + hh * 64 + 16 * ks + 8 * h);
#pragma unroll 1
    for (int br = 0; br < 2; ++br) {
        float lsum = 0.f; f32x16 O[2];
#pragma unroll
        for (int dt = 0; dt < 2; ++dt)
#pragma unroll
            for (int i = 0; i < 16; ++i) O[dt][i] = 0.f;
        const bf16_t* Kb = (const bf16_t*)(ws + (br ? WS_KW : WS_KS)) + bk * SEQ * 64;
        const bf16_t* Vb = (const bf16_t*)(ws + (br ? WS_VWT : WS_VST)) + bk * 32 * 4096;
        unsigned todo = br ? ((c >= 8 ? (0x1ffu << (c - 8)) : ((2u << c) - 1u))) : (uni & ((c == 31) ? 0xffffffffu : ((2u << c) - 1u)));
#define NSA_POP(dst) do { if (todo) { dst = __builtin_ctz(todo); todo &= todo - 1u; } else dst = -1; } while (0)
#define NSA_FETCH(stg, t) nsa_fetch(stg, Kb + (size_t)(t) * 4096, 64, Vb + (size_t)(t) * 4096, 64, tid)
#define NSA_COMPUTE(t, bufi) do { bool rok = true; int mode = 0, mm = 0; \
            if ((t) == c) { mode = 1; mm = 2; } \
            else if (br == 1) { if ((t) == c - 8) { mode = 2; mm = 2; } } \
            else if ((t) != 0 && (t) != c - 1) { rok = (mysel >> (t)) & 1u; mm = 1; } \
            nsa_tile(mm, bq, NSA_KTB(bufi), NSA_VTB(bufi), lsum, O, rok, mode, iq, 0, 0, r, h); } while (0)
        NsaStage stY;
        int t0, t1, t2, t3;
        NSA_POP(t0); NSA_POP(t1); NSA_POP(t2);
        NSA_FETCH(st, t0);
        BAR_LDS();
        nsa_commit(st, NSA_KTB(0), NSA_VTB(0), tid);
        if (t1 >= 0) NSA_FETCH(st, t1);
        if (t2 >= 0) NSA_FETCH(stY, t2);
        BAR_LDS();
        for (;;) {
            NSA_COMPUTE(t0, 0);
            if (t1 < 0) break;
            nsa_commit(st, NSA_KTB(1), NSA_VTB(1), tid);
            NSA_POP(t3); if (t3 >= 0) NSA_FETCH(st, t3);
            BAR_LDS();
            t0 = t1; t1 = t2; t2 = t3;
            NSA_COMPUTE(t0, 1);
            if (t1 < 0) break;
            nsa_commit(stY, NSA_KTB(0), NSA_VTB(0), tid);
            NSA_POP(t3); if (t3 >= 0) NSA_FETCH(stY, t3);
            BAR_LDS();
            t0 = t1; t1 = t2; t2 = t3;
        }
#undef NSA_POP
#undef NSA_FETCH
#undef NSA_COMPUTE
        const float lt = lsum + __shfl_xor(lsum, 32);
        nsa_out_acc<false>(OUTw, O, lt > 0.f ? (br ? gate2 : gate1) / lt : 0.f, r, h);
    }
    LDS_WAIT();
#pragma unroll
    for (int q = 0; q < 4; ++q) {
        const int rr = 8 * q + (lane >> 3), ch = lane & 7;
        const LAS f32x4* src = (const LAS f32x4*)(OUTw + rr * 68 + 8 * ch);
        const f32x4 a = src[0], bq2 = src[1];
        u32x4 o; o.x = pk2(a[0], a[1]); o.y = pk2(a[2], a[3]); o.z = pk2(bq2[0], bq2[1]); o.w = pk2(bq2[2], bq2[3]);
        *(u32x4*)((bf16_t*)(ws + WS_ATT) + (size_t)(tok0 + ibase + rr) * 1024 + hh * 64 + 8 * ch) = o;
    }
#undef NSA_KTB
#undef NSA_VTB
}

constexpr int GLA_QD = 0, GLA_KD = 10240, GLA_KST = 20480, GLA_VT = 30720, GLA_AT = 51200, GLA_ST = 61440, GLA_WG = 81920  , GLA_DEC = 86016  ,
              GLA_OT = 86528  , GLA_END = GLA_OT + 64 * 132 * 4;
static_assert(GLA_END <= LDS_BYTES - 64, "GLA LDS map");
template <int CTRL, int RMASK> __device__ __forceinline__ float dppf_rm(float v) { return __int_as_float(__builtin_amdgcn_update_dpp(0, __float_as_int(v), CTRL, RMASK, 0xf, false)); }
__device__ __forceinline__ float wave_incl_scan(float v) {
    v += __int_as_float(__builtin_amdgcn_update_dpp(0, __float_as_int(v), 0x111, 0xf, 0xf, true));
    v += __int_as_float(__builtin_amdgcn_update_dpp(0, __float_as_int(v), 0x112, 0xf, 0xf, true));
    v += __int_as_float(__builtin_amdgcn_update_dpp(0, __float_as_int(v), 0x114, 0xf, 0xf, true));
    v += __int_as_float(__builtin_amdgcn_update_dpp(0, __float_as_int(v), 0x118, 0xf, 0xf, true));
    v += dppf_rm<0x142, 0xa>(v);
    v += dppf_rm<0x143, 0xc>(v);
    return v;
}
struct GlaStage { u32x4 q, k, g0, g1, v0, v1; };
__device__ __forceinline__ void gla_fetch(GlaStage& st, const bf16_t* PROJ, int tok0, int h, int lane, int w) {
    const bf16_t* row = PROJ + (size_t)(tok0 + lane) * NPROJ;
    st.q = *(const u32x4*)(row + CGQ + h * 64 + 8 * w);
    st.k = *(const u32x4*)(row + CGK + h * 64 + 8 * w);
    st.g0 = *(const u32x4*)(row + CGLR); st.g1 = *(const u32x4*)(row + CGLR + 8);
    st.v0 = *(const u32x4*)(row + CGV + h * 128 + 16 * w); st.v1 = *(const u32x4*)(row + CGV + h * 128 + 16 * w + 8);
}
__device__ __forceinline__ float bflo(unsigned u) { return __uint_as_float(u << 16); }
__device__ __forceinline__ float bfhi(unsigned u) { return __uint_as_float(u & 0xffff0000u); }

__device__ __forceinline__ void gla_unit(const Params& p, LAS unsigned char* lds, int b, int h) {
    const int tid = opaque_tid(), lane = tid & 63, w = tid >> 6, fr = lane & 15, fq = lane >> 4;
    unsigned char* ws = p.ws;
    const bf16_t* PROJ = (const bf16_t*)(ws + WS_PROJ);
    LAS bf16_t* Qd = (LAS bf16_t*)(lds + GLA_QD); LAS bf16_t* Kd = (LAS bf16_t*)(lds + GLA_KD); LAS bf16_t* KsT = (LAS bf16_t*)(lds + GLA_KST);
    LAS bf16_t* VT = (LAS bf16_t*)(lds + GLA_VT); LAS bf16_t* At = (LAS bf16_t*)(lds + GLA_AT); LAS bf16_t* ST = (LAS bf16_t*)(lds + GLA_ST);
    LAS float* WG = (LAS float*)(lds + GLA_WG); LAS float* DEC = (LAS float*)(lds + GLA_DEC); LAS float* OT = (LAS float*)(lds + GLA_OT);
    BAR_LDS();
    for (int i = tid; i < 16 * 64; i += NTHREADS) WG[i] = p.in[12][(i >> 6) * 256 + h * 64 + (i & 63)];
    for (int i = tid; i < 128 * 80 / 2; i += NTHREADS) ((LAS unsigned*)ST)[i] = 0u;
    float bg[8];
#pragma unroll
    for (int q = 0; q < 8; ++q) bg[q] = p.in[13][h * 64 + 8 * w + q];
    const int md = w & 3, nfe0 = 4 * (w >> 2);
    f32x4 Sreg[4];
#pragma unroll
    for (int x = 0; x < 4; ++x) Sreg[x] = (f32x4){0.f, 0.f, 0.f, 0.f};
    GlaStage st;
    gla_fetch(st, PROJ, b * SEQ, h, lane, w);
    BAR_LDS();
#pragma unroll 1
    for (int n = 0; n < 32; ++n) {
        const int tok0 = b * SEQ + n * 64;
        float gl[16];
        { const unsigned gw[8] = {st.g0.x, st.g0.y, st.g0.z, st.g0.w, st.g1.x, st.g1.y, st.g1.z, st.g1.w};
#pragma unroll
          for (int q = 0; q < 8; ++q) { gl[2 * q] = bflo(gw[q]); gl[2 * q + 1] = bfhi(gw[q]); } }
        float bcum[8], blast[8];
#pragma unroll
        for (int q = 0; q < 8; ++q) {
            float x = bg[q];
#pragma unroll
            for (int r = 0; r < 16; ++r) x += gl[r] * WG[r * 64 + 8 * w + q];
            const float la = (fminf(x, 0.f) - __logf(1.f + __expf(-fabsf(x)))) * (1.f / 16.f);
            bcum[q] = wave_incl_scan(la);
            blast[q] = __int_as_float(__builtin_amdgcn_readlane(__float_as_int(bcum[q]), 63));
        }
        {
            const unsigned qw[4] = {st.q.x, st.q.y, st.q.z, st.q.w}, kw[4] = {st.k.x, st.k.y, st.k.z, st.k.w};
            unsigned qo[4], ko[4];
#pragma unroll
            for (int q2 = 0; q2 < 4; ++q2) {
                const float e0 = __expf(bcum[2 * q2]), e1 = __expf(bcum[2 * q2 + 1]);
                const float i0 = __expf(-bcum[2 * q2]), i1 = __expf(-bcum[2 * q2 + 1]);
                const float k0 = bflo(kw[q2]), k1 = bfhi(kw[q2]);
                qo[q2] = pg8::cvt_pk_bf16(bflo(qw[q2]) * 0.125f * e0, bfhi(qw[q2]) * 0.125f * e1);
                ko[q2] = pg8::cvt_pk_bf16(k0 * i0, k1 * i1);
                KsT[(8 * w + 2 * q2) * 80 + lane] = (bf16_t)f2bf(k0 * __expf(blast[2 * q2] - bcum[2 * q2]));
                KsT[(8 * w + 2 * q2 + 1) * 80 + lane] = (bf16_t)f2bf(k1 * __expf(blast[2 * q2 + 1] - bcum[2 * q2 + 1]));
            }
            *(LAS u32x4*)(Qd + lane * 80 + 8 * w) = (u32x4){qo[0], qo[1], qo[2], qo[3]};
            *(LAS u32x4*)(Kd + lane * 80 + 8 * w) = (u32x4){ko[0], ko[1], ko[2], ko[3]};
            if (lane == 63) {
#pragma unroll
                for (int q = 0; q < 8; ++q) DEC[(n & 1) * 64 + 8 * w + q] = __expf(bcum[q]);
            }
            const unsigned vw[8] = {st.v0.x, st.v0.y, st.v0.z, st.v0.w, st.v1.x, st.v1.y, st.v1.z, st.v1.w};
#pragma unroll
            for (int q = 0; q < 8; ++q) { VT[(16 * w + 2 * q) * 80 + lane] = (bf16_t)(vw[q] & 0xffffu); VT[(16 * w + 2 * q + 1) * 80 + lane] = (bf16_t)(vw[q] >> 16); }
        }
        if (n < 31) gla_fetch(st, PROJ, tok0 + 64, h, lane, w);
        const int ec = tid >> 3, eg = tid & 7;
        const u32x4 r0 = *(const u32x4*)(PROJ + (size_t)(tok0 + ec) * NPROJ + CGR + h * 128 + 16 * eg), r1 = *(const u32x4*)(PROJ + (size_t)(tok0 + ec) * NPROJ + CGR + h * 128 + 16 * eg + 8);
        BAR_LDS();
        {
            const int m = w >> 1;
            bf16x8 a[2];
#pragma unroll
            for (int ks = 0; ks < 2; ++ks) a[ks] = *(const LAS bf16x8*)(Qd + (16 * m + fr) * 80 + 32 * ks + 8 * fq);
#pragma unroll
            for (int x = 0; x < 2; ++x) { const int nf = 2 * (w & 1) + x;
                f32x4 s = (f32x4){0.f, 0.f, 0.f, 0.f};
                if (nf <= m) {
#pragma unroll
                    for (int ks = 0; ks < 2; ++ks) { const bf16x8 bk = *(const LAS bf16x8*)(Kd + (16 * nf + fr) * 80 + 32 * ks + 8 * fq); s = __builtin_amdgcn_mfma_f32_16x16x32_bf16(a[ks], bk, s, 0, 0, 0); }
                }
#pragma unroll
                for (int j = 0; j < 4; ++j) { const int cc = 16 * m + 4 * fq + j, ss = 16 * nf + fr; At[cc * 80 + ss] = (bf16_t)f2bf(ss <= cc ? s[j] : 0.f); } }
        }
        f32x4 U[4];
        {
            bf16x8 a[2];
#pragma unroll
            for (int ks = 0; ks < 2; ++ks) a[ks] = *(const LAS bf16x8*)(KsT + (16 * md + fr) * 80 + 32 * ks + 8 * fq);
#pragma unroll
            for (int x = 0; x < 4; ++x) { f32x4 s = (f32x4){0.f, 0.f, 0.f, 0.f};
#pragma unroll
                for (int ks = 0; ks < 2; ++ks) { const bf16x8 bv = *(const LAS bf16x8*)(VT + (16 * (nfe0 + x) + fr) * 80 + 32 * ks + 8 * fq); s = __builtin_amdgcn_mfma_f32_16x16x32_bf16(a[ks], bv, s, 0, 0, 0); }
                U[x] = s; }
        }
        BAR_LDS();
        {
            bf16x8 aa[2], aq2[2];
#pragma unroll
            for (int ks = 0; ks < 2; ++ks) { aa[ks] = *(const LAS bf16x8*)(At + (16 * md + fr) * 80 + 32 * ks + 8 * fq); aq2[ks] = *(const LAS bf16x8*)(Qd + (16 * md + fr) * 80 + 32 * ks + 8 * fq); }
#pragma unroll
            for (int x = 0; x < 4; ++x) { f32x4 s = (f32x4){0.f, 0.f, 0.f, 0.f};
#pragma unroll
                for (int ks = 0; ks < 2; ++ks) { const bf16x8 bv = *(const LAS bf16x8*)(VT + (16 * (nfe0 + x) + fr) * 80 + 32 * ks + 8 * fq); s = __builtin_amdgcn_mfma_f32_16x16x32_bf16(aa[ks], bv, s, 0, 0, 0); }
#pragma unroll
                for (int ks = 0; ks < 2; ++ks) { const bf16x8 bs = *(const LAS bf16x8*)(ST + (16 * (nfe0 + x) + fr) * 80 + 32 * ks + 8 * fq); s = __builtin_amdgcn_mfma_f32_16x16x32_bf16(aq2[ks], bs, s, 0, 0, 0); }
#pragma unroll
                for (int j = 0; j < 4; ++j) OT[(16 * md + 4 * fq + j) * 132 + 16 * (nfe0 + x) + fr] = s[j]; }
        }
        BAR_LDS();
        {
            const LAS f32x4* dp = (const LAS f32x4*)(DEC + (n & 1) * 64 + 16 * md + 4 * fq); const f32x4 dc = dp[0];
#pragma unroll
            for (int x = 0; x < 4; ++x) { Sreg[x] = dc * Sreg[x] + U[x];
                u32x2 o; o.x = pg8::cvt_pk_bf16(Sreg[x][0], Sreg[x][1]); o.y = pg8::cvt_pk_bf16(Sreg[x][2], Sreg[x][3]);
                *(LAS u32x2*)(ST + (16 * (nfe0 + x) + fr) * 80 + 16 * md + 4 * fq) = o; }
        }
        {
            const LAS f32x4* op = (const LAS f32x4*)(OT + ec * 132 + 16 * eg);
            f32x4 o[4]; float ss = 0.f;
#pragma unroll
            for (int q = 0; q < 4; ++q) { o[q] = op[q]; ss += (o[q].x * o[q].x + o[q].y * o[q].y) + (o[q].z * o[q].z + o[q].w * o[q].w); }
            ss += dppf<0xB1>(ss); ss += dppf<0x4E>(ss); ss += dppf<0x141>(ss);
            const float rstd = 1.f / sqrtf(ss * (1.f / 128.f) + EPS);
            const unsigned rw[8] = {r0.x, r0.y, r0.z, r0.w, r1.x, r1.y, r1.z, r1.w};
            const float* gn = p.in[14] + 16 * eg;
            unsigned ow[8];
#pragma unroll
            for (int q = 0; q < 8; ++q) { const float ra = bflo(rw[q]), rb = bfhi(rw[q]);
                const float ya = o[q >> 1][(2 * q) & 3] * rstd * gn[2 * q] * (ra * sigmoidf_(ra)), yb = o[q >> 1][(2 * q + 1) & 3] * rstd * gn[2 * q + 1] * (rb * sigmoidf_(rb));
                ow[q] = pg8::cvt_pk_bf16(ya, yb); }
            u32x4* dst = (u32x4*)((bf16_t*)(ws + WS_ATT) + (size_t)(tok0 + ec) * 1024 + 512 + h * 128 + 16 * eg);
            dst[0] = (u32x4){ow[0], ow[1], ow[2], ow[3]}; dst[1] = (u32x4){ow[4], ow[5], ow[6], ow[7]};
        }
    }
}

__device__ __forceinline__ void p6_chunk(const Params& p, LAS unsigned char* lds, int chunk) {
    const int tid = opaque_tid(), lane = tid & 63, wave = tid >> 6, fr = lane & 15, fq = lane >> 4;
    unsigned char* ws = p.ws;
    LAS int* lcnt = (LAS int*)lds;
    LAS float* LG = (LAS float*)(lds + 256) + wave * (16 * 33 + 16);
    LAS float* RS = LG + 16 * 33;
    if (tid < NEXP) lcnt[tid] = 0;
    __syncthreads();
    const float* WRT = (const float*)(ws + WS_WRT);
    const float* X1 = (const float*)(ws + WS_X1);
    const int t0 = chunk * 128 + wave * 16;
    {
        const float* ap = X1 + (size_t)(t0 + fr) * DM + 4 * fq;
        const float* bp0 = WRT + (size_t)fr * DM + 4 * fq; const float* bp1 = bp0 + 16 * DM;
        f32x4 acc0 = (f32x4){0.f, 0.f, 0.f, 0.f}, acc1 = (f32x4){0.f, 0.f, 0.f, 0.f};
        float ssq = 0.f;
#pragma unroll 4
        for (int ks = 0; ks < 64; ++ks) {
            const f32x4 a4 = *(const f32x4*)(ap + 16 * ks), b0 = *(const f32x4*)(bp0 + 16 * ks), b1 = *(const f32x4*)(bp1 + 16 * ks);
            ssq += (a4.x * a4.x + a4.y * a4.y) + (a4.z * a4.z + a4.w * a4.w);
#pragma unroll
            for (int i = 0; i < 4; ++i) { acc0 = __builtin_amdgcn_mfma_f32_16x16x4f32(a4[i], b0[i], acc0, 0, 0, 0); acc1 = __builtin_amdgcn_mfma_f32_16x16x4f32(a4[i], b1[i], acc1, 0, 0, 0); }
        }
        ssq += __shfl_xor(ssq, 16); ssq += __shfl_xor(ssq, 32);
        const float rstd = 1.f / sqrtf(ssq * (1.f / DM) + EPS);
        if (fq == 0) RS[fr] = rstd;
#pragma unroll
        for (int j = 0; j < 4; ++j) { LG[(4 * fq + j) * 33 + fr] = acc0[j]; LG[(4 * fq + j) * 33 + 16 + fr] = acc1[j]; }
    }
    LDS_WAIT();
    int myexp[4] = {0, 0, 0, 0}, myrank[4] = {0, 0, 0, 0};
    if (lane < 16) {
        const int t = t0 + lane; const float rstd = RS[lane];
        unsigned taken = 0u; float tv[4]; int te[4];
#pragma unroll
        for (int r = 0; r < 4; ++r) { float best = -3e38f; int be = 0;
#pragma unroll 8
            for (int e = 0; e < 32; ++e) { const float v = LG[lane * 33 + e] * rstd + p.in[18][e]; const bool can = !((taken >> e) & 1u); if (can && v > best) { best = v; be = e; } }
            taken |= 1u << be; tv[r] = best; te[r] = be; }
        const float e0 = 1.f, e1 = __expf(tv[1] - tv[0]), e2 = __expf(tv[2] - tv[0]), e3 = __expf(tv[3] - tv[0]);
        const float inv = 1.f / (e0 + e1 + e2 + e3);
        *(f32x4*)((float*)(ws + WS_TOPG) + (size_t)t * 4) = (f32x4){e0 * inv, e1 * inv, e2 * inv, e3 * inv};
#pragma unroll
        for (int k = 0; k < 4; ++k) { myexp[k] = te[k]; myrank[k] = atomicAdd((int*)&lcnt[te[k]], 1); }
    }
    {
        const f32x4* gr = (const f32x4*)p.in[16] + lane;
        f32x4 gg[4];
#pragma unroll
        for (int j = 0; j < 4; ++j) gg[j] = gr[64 * j];
#pragma unroll 1
        for (int ti = 0; ti < 16; ti += 4) {
            f32x4 v[4][4];
#pragma unroll
            for (int r = 0; r < 4; ++r) { const f32x4* xr = (const f32x4*)(X1 + (size_t)(t0 + ti + r) * DM) + lane;
#pragma unroll
                for (int j = 0; j < 4; ++j) v[r][j] = xr[64 * j]; }
#pragma unroll
            for (int r = 0; r < 4; ++r) { const float rstd = RS[ti + r];
                unsigned* o4 = (unsigned*)(ws + WS_H + (size_t)(t0 + ti + r) * DM) + lane;
#pragma unroll
                for (int j = 0; j < 4; ++j) { const f32x4 o = v[r][j] * rstd * gg[j]; o4[64 * j] = pk4_fp8(o.x, o.y, o.z, o.w); } }
        }
    }
    __syncthreads();
    LAS int* lbase = lcnt + 32;
    if (tid < NEXP) lbase[tid] = atomicAdd((int*)(ws + WS_CTL) + CW_CNT + tid, lcnt[tid]);
    __syncthreads();
    if (lane < 16) {
        const int t = t0 + lane; int d[4];
#pragma unroll
        for (int k = 0; k < 4; ++k) { const int pos = lbase[myexp[k]] + myrank[k]; ((int*)(ws + WS_RL))[(size_t)myexp[k] * 32768 + pos] = t; d[k] = (myexp[k] << 16) | pos; }
        *(int4*)((int*)(ws + WS_DEST) + (size_t)t * 4) = make_int4(d[0], d[1], d[2], d[3]);
    }
    __syncthreads();
}

__device__ __forceinline__ int build_tile_table(const Params& p, LAS int* tstart, LAS int* tile_e) {
    const int tid = opaque_tid();
    const int* cnt = (const int*)(p.ws + WS_CTL) + CW_CNT;
    if (tid == 0) { int acc = 0; for (int e = 0; e < NEXP; ++e) { const int n = __hip_atomic_load(cnt + e, __ATOMIC_RELAXED, __HIP_MEMORY_SCOPE_AGENT); tstart[e] = acc; tstart[NEXP + 1 + e] = n; acc += (n + 255) >> 8; } tstart[NEXP] = acc; }
    __syncthreads();
    const int total = tstart[NEXP];
    for (int i = tid; i < total; i += NTHREADS) { int e = 0;
        for (int q = 1; q < NEXP; ++q) if (tstart[q] <= i) e = q;
        tile_e[i] = e; }
    __syncthreads();
    return total;
}

__device__ __forceinline__ void p10_tokens(const Params& p, int t0, int lane, const LAS int* tstart) {
    unsigned char* ws = p.ws;
    int4 d4[2]; f32x4 g4[2];
#pragma unroll
    for (int q = 0; q < 2; ++q) { d4[q] = *(const int4*)((const int*)(ws + WS_DEST) + (size_t)(t0 + q) * 4); g4[q] = *(const f32x4*)((const float*)(ws + WS_TOPG) + (size_t)(t0 + q) * 4); }
    f32x4 xa[2][4]; u32x4 yv[2][4][2];
#pragma unroll
    for (int q = 0; q < 2; ++q) {
        const f32x4* xr = (const f32x4*)((const float*)(ws + WS_X1) + (size_t)(t0 + q) * DM);
#pragma unroll
        for (int h2 = 0; h2 < 2; ++h2) { xa[q][2 * h2] = __builtin_nontemporal_load(xr + h2 * 128 + lane * 2); xa[q][2 * h2 + 1] = __builtin_nontemporal_load(xr + h2 * 128 + lane * 2 + 1); }
        const int dr[4] = {d4[q].x, d4[q].y, d4[q].z, d4[q].w};
        int dd[4];
#pragma unroll
        for (int k = 0; k < 4; ++k) dd[k] = tstart[dr[k] >> 16] * 256 + (dr[k] & 0xffff);
#pragma unroll
        for (int k = 0; k < 4; ++k)
#pragma unroll
            for (int h2 = 0; h2 < 2; ++h2) yv[q][k][h2] = __builtin_nontemporal_load((const u32x4*)((const bf16_t*)(ws + WS_Y) + (size_t)dd[k] * DM) + h2 * 64 + lane);
    }
#pragma unroll
    for (int q = 0; q < 2; ++q) {
        f32x4* orow = (f32x4*)(p.out + (size_t)(t0 + q) * DM);
#pragma unroll
        for (int h2 = 0; h2 < 2; ++h2) {
            f32x4 a0 = xa[q][2 * h2], a1 = xa[q][2 * h2 + 1];
#pragma unroll
            for (int k = 0; k < 4; ++k) { const u32x4 y = yv[q][k][h2]; const float gk = g4[q][k];
                a0.x += gk * __uint_as_float(y.x << 16); a0.y += gk * __uint_as_float(y.x & 0xffff0000u);
                a0.z += gk * __uint_as_float(y.y << 16); a0.w += gk * __uint_as_float(y.y & 0xffff0000u);
                a1.x += gk * __uint_as_float(y.z << 16); a1.y += gk * __uint_as_float(y.z & 0xffff0000u);
                a1.z += gk * __uint_as_float(y.w << 16); a1.w += gk * __uint_as_float(y.w & 0xffff0000u); }
            orow[h2 * 128 + lane * 2] = a0; orow[h2 * 128 + lane * 2 + 1] = a1;
        }
    }
}

#define XB_TMO      128
#define XB_XCNT(j)  (256  + 64 * (j))
#define XB_XSUB(j)  (1280 + 64 * (j))
#define XB_XGEN(j)  (2304 + 64 * (j))
#define XB_TOP      3328
#define XB_TOPGEN   3392
#define XCD_BAR_WORDS 3456
#define XB_SPIN_CAP (1u << 22)
__device__ __forceinline__ unsigned xb_ld(unsigned* p)              { return __hip_atomic_load(p, __ATOMIC_RELAXED, __HIP_MEMORY_SCOPE_AGENT); }
__device__ __forceinline__ unsigned xb_add(unsigned* p, unsigned v) { return __hip_atomic_fetch_add(p, v, __ATOMIC_RELAXED, __HIP_MEMORY_SCOPE_AGENT); }
__device__ __forceinline__ unsigned xb_xcc_id() { return (unsigned)__builtin_amdgcn_s_getreg((3 << 11) | 20) & 0xFu; }
#define XB_SPIN(cond, bar) do { unsigned _sp = 0; while (cond) { __builtin_amdgcn_s_sleep(1); \
    if ((++_sp & 255u) == 0u) { if (xb_ld(&(bar)[XB_TMO])) break; if (_sp > XB_SPIN_CAP) { atomicAdd(&(bar)[XB_TMO], 1u); break; } } } } while (0)
struct XcdBarrier { unsigned* bar; unsigned x; volatile LAS unsigned* st; };
__device__ __forceinline__ XcdBarrier xcd_barrier_post(unsigned* bar, volatile LAS unsigned* st) {
    XcdBarrier b; b.bar = bar; b.x = xb_xcc_id(); b.st = st;
    if (threadIdx.x == 0) (void)xb_add(&bar[XB_XCNT(b.x)], 1u);
    return b;
}
__device__ __forceinline__ void xcd_barrier_complete(unsigned* bar, unsigned x, unsigned& nloc, unsigned& nx) {
    const unsigned G = gridDim.x * gridDim.y * gridDim.z;
    unsigned sum, cnt, mine, sp = 0u;
    for (;;) {
        sum = 0u; cnt = 0u; mine = 0u;
#pragma unroll
        for (unsigned j = 0; j < 16; ++j) { const unsigned c = xb_ld(&bar[XB_XCNT(j)]); sum += c; cnt += (c > 0u) ? 1u : 0u; mine = (j == x) ? c : mine; }
        if (sum == G) break;
        __builtin_amdgcn_s_sleep(1);
        if ((++sp & 255u) == 0u) { if (xb_ld(&bar[XB_TMO])) break; if (sp > XB_SPIN_CAP) { atomicAdd(&bar[XB_TMO], 1u); break; } }
    }
    nloc = mine > 0u ? mine : 1u; nx = cnt > 0u ? cnt : 1u;
}
__device__ __forceinline__ void xcd_barrier(const XcdBarrier& b) {
    asm volatile("s_waitcnt vmcnt(0)" ::: "memory");
    __syncthreads();
    if (threadIdx.x == 0) {
        unsigned* bar = b.bar;
        __builtin_amdgcn_s_waitcnt(0);
        unsigned nloc = b.st[0], nx = b.st[1];
        if (nloc == 0u) { xcd_barrier_complete(bar, b.x, nloc, nx); b.st[0] = nloc; b.st[1] = nx; }
        const unsigned old = xb_add(&bar[XB_XSUB(b.x)], 1u);
        const unsigned gen = old / nloc;
        if (old + 1u == (gen + 1u) * nloc) {
            __builtin_amdgcn_fence(__ATOMIC_RELEASE, "agent");
            asm volatile("s_waitcnt vmcnt(0)" ::: "memory");
            const unsigned og = xb_add(&bar[XB_TOP], 1u);
            const unsigned tg = og / nx;
            if (og + 1u == (tg + 1u) * nx) xb_add(&bar[XB_TOPGEN], 1u);
            else XB_SPIN(xb_ld(&bar[XB_TOPGEN]) == tg, bar);
            __builtin_amdgcn_fence(__ATOMIC_ACQUIRE, "agent");
            xb_add(&bar[XB_XGEN(b.x)], 1u);
            asm volatile("s_waitcnt vmcnt(0)" ::: "memory");
        } else {
            XB_SPIN(xb_ld(&bar[XB_XGEN(b.x)]) == gen, bar);
            __builtin_amdgcn_fence(__ATOMIC_ACQUIRE, "agent");
            asm volatile("s_waitcnt vmcnt(0)" ::: "memory");
        }
    }
    __syncthreads();
}

__device__ __forceinline__ void expert_weight_items(const Params& p, LAS unsigned char* lds, int max_grabs) {
    const int tid = opaque_tid(), lane = tid & 63, wave = tid >> 6;
    unsigned char* ws = p.ws;
    LAS float* scr = (LAS float*)(lds + wave * 16640);
    LAS int* qslot = (LAS int*)(lds + LDS_BYTES - 64);
    constexpr int I_GU = 16 * 32, I_DN = 16 * 16, N_GU = NEXP * I_GU, N_DN = NEXP * I_DN;
    for (int grab = 0; grab < max_grabs; ++grab) {
        __syncthreads();
        if (tid == 0) *qslot = (int)__hip_atomic_fetch_add((unsigned*)(ws + WS_CTL) + CW_QC, 8u, __ATOMIC_RELAXED, __HIP_MEMORY_SCOPE_AGENT);
        __syncthreads();
        const int base = *qslot;
        if (base >= N_GU + N_DN) break;
        int r = base + wave;
        if (r < N_GU) { const int e = r / I_GU; transpose_item<2, true>(p.in[19] + (size_t)e * 1024 * 2048, 1024, 2048, ws + WS_WGU + (size_t)e * 2048 * 1024, 32, scr, r % I_GU, lane); }
        else { r -= N_GU; const int e = r / I_DN; transpose_item<0, true>(p.in[21] + (size_t)e * 1024 * 1024, 1024, 1024, ws + WS_WD + (size_t)e * 1024 * 1024, 16, scr, r % I_DN, lane); }
    }
}

template <int ph> __device__ __forceinline__ void mk_phase(const Params& p, LAS unsigned char* lds, int blk, int G) {
    unsigned char* ws = p.ws;
    const int tid = opaque_tid();
    if constexpr (ph == 0) { phase0(p, lds, blk, G); }
    else if constexpr (ph == 1) {
        pg8::Gemm g{ws + WS_H, ws + WS_WIN, 2 * DM};
        pg8::StaticOrder S{MTOK / 256, NPROJ / 256, G, blk};
        pg8::EpiBf16 E{(bf16_t*)(ws + WS_PROJ), NPROJ};
        pg8::gemm_phase<false>(lds, g, S, E);
    }
    else if constexpr (ph == 2) {
        LAS int* qslot = (LAS int*)(lds + LDS_BYTES - 64);
        if ((blk & 7) >= 4) expert_weight_items(p, lds, MK_P2_GRABS);
        for (;;) {
            __syncthreads();
            if (tid == 0) *qslot = (int)__hip_atomic_fetch_add((unsigned*)(ws + WS_CTL) + CW_Q2, 1u, __ATOMIC_RELAXED, __HIP_MEMORY_SCOPE_AGENT);
            __syncthreads();
            const int it = *qslot;
            if (it >= 128 + 512) break;
            if (it < 128) p2b_unit(p, lds, it); else p2a_unit(p, lds, it - 128);
        }
    }
    else if constexpr (ph == 3) {
        LAS int* qslot = (LAS int*)(lds + LDS_BYTES - 64);
        if ((blk & 7) < 4) expert_weight_items(p, lds, 1 << 30);
        for (;;) {
            __syncthreads();
            if (tid == 0) *qslot = (int)__hip_atomic_fetch_add((unsigned*)(ws + WS_CTL) + CW_Q3, 1u, __ATOMIC_RELAXED, __HIP_MEMORY_SCOPE_AGENT);
            __syncthreads();
            const int it = *qslot;
            if (it >= 64 + 1024) break;
            if (it < 64) gla_unit(p, lds, it >> 2, it & 3);
            else { const int u = it - 64, c = 31 - (u >> 5), bkh = u & 31; nsa_unit(p, lds, bkh >> 1, bkh & 1, c); }
        }
    }
    else if constexpr (ph == 4) { }
    else if constexpr (ph == 5) {
        pg8::Gemm g{ws + WS_ATT, ws + WS_WOUT, 2 * DM};
        pg8::StaticOrder S{MTOK / 256, DM / 256, G, blk};
        pg8::EpiResF32 E{p.in[0], (float*)(ws + WS_X1), DM};
        pg8::gemm_phase<false>(lds, g, S, E);
    }
    else if constexpr (ph == 6) { for (int ch = blk; ch < MTOK / 128; ch += G) p6_chunk(p, lds, ch); }
    else if constexpr (ph == 7) { }
    else if constexpr (ph == 8) {
        LAS int* tstart = (LAS int*)(lds + pg8::STAGE_BYTES); LAS int* tile_e = tstart + 80;
        const int total = build_tile_table(p, tstart, tile_e);
        pg8::Gemm g{ws + WS_H, ws + WS_WGU, DM};
        pg8::MoeGatherOrder S{total, 8, G, blk, tile_e, tstart, tstart + NEXP + 1, (const int*)(ws + WS_RL)};
        pg8::EpiSwiglu E{ws + WS_ACT, p.in[20], 8};
        pg8::gemm_phase<true>(lds, g, S, E);
    }
    else if constexpr (ph == 9) {
        LAS int* tstart = (LAS int*)(lds + pg8::STAGE_BYTES); LAS int* tile_e = tstart + 80;
        const int total = build_tile_table(p, tstart, tile_e);
        pg8::Gemm g{ws + WS_ACT, ws + WS_WD, DFF};
        pg8::MoeOrder S{total, 4, G, blk, tile_e};
        pg8::EpiDown E{(bf16_t*)(ws + WS_Y), p.in[22], 4};
        pg8::gemm_phase<true>(lds, g, S, E);
    }
    else if constexpr (ph == 10) {
        LAS int* tstart = (LAS int*)(lds + pg8::STAGE_BYTES); LAS int* tile_e = tstart + 80;
        build_tile_table(p, tstart, tile_e);
        for (int t = (blk * 8 + (tid >> 6)) * 2; t < MTOK; t += G * 16) p10_tokens(p, t, tid & 63, tstart);
    }
}

constexpr int NPHASES = 11;

template <int PH> __global__ void __launch_bounds__(NTHREADS, 2) mk_one(Params p) {
    extern __shared__ __attribute__((aligned(16))) unsigned char lds_raw[];
    mk_phase<PH>(p, (LAS unsigned char*)lds_raw, blockIdx.x, gridDim.x);
}
#if MK_ONE_LAUNCH
#define MK_RUN(PH) mk_phase<PH>(p, lds, blk, G)
__global__ void __launch_bounds__(NTHREADS, 2) mk_fwd(Params p) {
    extern __shared__ __attribute__((aligned(16))) unsigned char lds_raw[];
    LAS unsigned char* lds = (LAS unsigned char*)lds_raw;
    const int blk = blockIdx.x, G = gridDim.x;
    volatile LAS unsigned* bst = (volatile LAS unsigned*)(lds + LDS_BYTES - 16);
    if (threadIdx.x < 4) bst[threadIdx.x] = 0u;
    __syncthreads();
    const XcdBarrier gbar = xcd_barrier_post((unsigned*)(p.ws + WS_CTL) + CW_BAR, bst);
#define GSYNC() xcd_barrier(gbar)
#ifndef MK_REP_PHASE
#define MK_REP_PHASE -1
#endif
#ifndef MK_REP_N
#define MK_REP_N 0
#endif
#define MK_STEP(PH) do { MK_RUN(PH); if (MK_REP_PHASE == (PH)) { for (int r_ = 0; r_ < MK_REP_N; ++r_) { GSYNC(); MK_RUN(PH); } } if (MK_REP_PHASE == 100 + (PH)) { for (int r_ = 0; r_ < MK_REP_N; ++r_) GSYNC(); } } while (0)
    MK_STEP(0); GSYNC(); MK_STEP(1); GSYNC(); MK_STEP(2); GSYNC(); MK_STEP(3); GSYNC(); MK_STEP(5); GSYNC();
    MK_STEP(6); GSYNC(); MK_STEP(8); GSYNC(); MK_STEP(9); GSYNC(); MK_STEP(10);
}
#endif

extern "C" void kernel_launch(void* const* d_in, const int* in_sizes, int n_in, void* d_out, int out_size, void* d_ws, size_t ws_size, hipStream_t stream) {
    static int grid = 0;
    if (grid == 0) {
        int dev = 0, cus = 0, per_cu = 0;
        (void)hipGetDevice(&dev);
        (void)hipDeviceGetAttribute(&cus, hipDeviceAttributeMultiprocessorCount, dev);
#if MK_ONE_LAUNCH
        (void)hipFuncSetAttribute((const void*)mk_fwd, hipFuncAttributeMaxDynamicSharedMemorySize, LDS_BYTES);
        (void)hipOccupancyMaxActiveBlocksPerMultiprocessor(&per_cu, (const void*)mk_fwd, NTHREADS, LDS_BYTES);
#else
#define MK_ATTR(PH) (void)hipFuncSetAttribute((const void*)mk_one<PH>, hipFuncAttributeMaxDynamicSharedMemorySize, LDS_BYTES)
        MK_ATTR(0); MK_ATTR(1); MK_ATTR(2); MK_ATTR(3); MK_ATTR(4); MK_ATTR(5); MK_ATTR(6); MK_ATTR(7); MK_ATTR(8); MK_ATTR(9); MK_ATTR(10);
        per_cu = 1;
#endif
        if (per_cu < 1) { fprintf(stderr, "kernel_launch: occupancy query reports %d blocks/CU\n", per_cu); per_cu = 1; }
        grid = cus;
        if (ws_size < WS_END) { fprintf(stderr, "kernel_launch: workspace too small (%zu < %zu)\n", ws_size, (size_t)WS_END); grid = -1; }
        (void)hipGetLastError();
    }
    if (grid < 0) return;
    (void)hipMemsetAsync((char*)d_ws + WS_CTL, 0, CTL_BYTES, stream);
    Params p{};
    for (int i = 0; i < 23; ++i) p.in[i] = (const float*)d_in[i];
    p.out = (float*)d_out; p.ws = (unsigned char*)d_ws;
#if MK_ONE_LAUNCH
    hipLaunchKernelGGL(mk_fwd, dim3(grid), dim3(NTHREADS), LDS_BYTES, stream, p);
#else
#ifndef MK_DUP_PHASE
#define MK_DUP_PHASE -1
#endif
#define MK_LAUNCH1(PH) do { if ((PH) == 3 || (PH) == 2) (void)hipMemsetAsync((char*)d_ws + WS_CTL + 4 * CW_Q3, 0, 12, stream); if ((PH) == 6) (void)hipMemsetAsync((char*)d_ws + WS_CTL + 4 * CW_CNT, 0, 128, stream); if ((PH) == 7) (void)hipMemsetAsync((char*)d_ws + WS_CTL + 4 * CW_FILL, 0, 128, stream); hipLaunchKernelGGL(mk_one<PH>, dim3(grid), dim3(NTHREADS), LDS_BYTES, stream, p); } while (0)
#define MK_LAUNCH(PH) do { MK_LAUNCH1(PH); if (MK_DUP_PHASE == (PH)) MK_LAUNCH1(PH); } while (0)
    MK_LAUNCH(0); MK_LAUNCH(1); MK_LAUNCH(2); MK_LAUNCH(3); MK_LAUNCH(5); MK_LAUNCH(6); MK_LAUNCH(8); MK_LAUNCH(9); MK_LAUNCH(10);
#endif
}
```

```cpp
#include <hip/hip_runtime.h>
#include <hip/hip_cooperative_groups.h>
#include <cstdint>
#include <cstdio>
namespace cg = cooperative_groups;

#ifndef MK_ONE_LAUNCH
#define MK_ONE_LAUNCH 1
#endif

#ifndef MK_P2_GRABS
#define MK_P2_GRABS 4
#endif
#ifndef MK_TAIL_GRABS
#define MK_TAIL_GRABS 96
#endif
#ifndef MK_P3_GRABS
#define MK_P3_GRABS 1
#endif
#define LAS __attribute__((address_space(3)))
typedef unsigned short bf16_t;
typedef short bf16x8 __attribute__((ext_vector_type(8)));
typedef float f32x4 __attribute__((ext_vector_type(4)));
typedef float f32x2 __attribute__((ext_vector_type(2)));
typedef unsigned u32x4 __attribute__((ext_vector_type(4)));
typedef unsigned u32x2 __attribute__((ext_vector_type(2)));
typedef int i32x8 __attribute__((ext_vector_type(8)));
typedef int i32x4 __attribute__((ext_vector_type(4)));

constexpr int NB = 16, SEQ = 2048, DM = 1024, MTOK = NB * SEQ;
constexpr int NPROJ = 3072;
constexpr int CQ = 0, CKC = 512, CVC = 640, CKS = 768, CVS = 896, CKW = 1024, CVW = 1152, CGQ = 1280, CGK = 1536, CGV = 1792, CGR = 2304, CGATE = 2816, CGLR = 2840;
constexpr int NEXP = 32, DFF = 1024;
constexpr int MAXTILES = 544, XROWS = MAXTILES * 256;
constexpr float EPS = 1e-6f;
constexpr int NTHREADS = 512;
constexpr int LDS_BYTES = 160 * 1024;

constexpr size_t MiB = 1u << 20;
constexpr size_t WS_CTL = 0;
constexpr size_t WS_WIN = 2 * MiB;
constexpr size_t WS_WOUT = 8 * MiB;
constexpr size_t WS_CW1K = 10 * MiB, WS_CW1V = 11 * MiB;
constexpr size_t WS_CW2K = 12 * MiB, WS_CW2V = 12 * MiB + 512 * 1024;
constexpr size_t WS_CBIAS = 13 * MiB;
constexpr size_t WS_COLS = 13 * MiB + 64 * 1024;
constexpr size_t WS_ROWS = 13 * MiB + 128 * 1024;
constexpr size_t WS_WRT = 13 * MiB + 512 * 1024;
constexpr size_t WS_WGU = 16 * MiB;
constexpr size_t WS_WD = 144 * MiB;
constexpr size_t WS_H = 208 * MiB;
constexpr size_t WS_PROJ = 272 * MiB;
constexpr size_t WS_KS = 528 * MiB, WS_KW = 536 * MiB;
constexpr size_t WS_VST = 544 * MiB, WS_VWT = 552 * MiB;
constexpr size_t WS_KC = 560 * MiB, WS_VCT = 561 * MiB;
constexpr size_t WS_ATT = 787 * MiB;
constexpr size_t WS_TOPG = 852 * MiB, WS_DEST = 853 * MiB;
constexpr size_t WS_RL = 272 * MiB;
constexpr size_t WS_ACT = 544 * MiB;
constexpr size_t WS_Y = 272 * MiB;
constexpr size_t WS_X1 = 854 * MiB;
constexpr size_t WS_END = 982 * MiB;
constexpr int CW_QC8 = 132;
constexpr int CW_CNT = 0, CW_Q3 = 128, CW_Q2 = 129, CW_QC = 130, CW_BAR = 1024;
constexpr int CTL_BYTES = 32768;
constexpr float Y_SCALE = 16.f;
constexpr float ATT_SCALE = 16.f;

struct Params {
    const float* in[23];
    float* out;
    unsigned char* ws;
};

__device__ __forceinline__ float bf2f(bf16_t v) { return __uint_as_float(((unsigned)v) << 16); }
typedef __bf16 hbf16x2 __attribute__((ext_vector_type(2)));
typedef float f32x2_cv __attribute__((ext_vector_type(2)));
__device__ __forceinline__ unsigned pk2(float lo, float hi) { return __builtin_bit_cast(unsigned, __builtin_convertvector((f32x2_cv){lo, hi}, hbf16x2)); }
__device__ __forceinline__ unsigned f2bf(float f) { return pk2(f, 0.f) & 0xffffu; }
__device__ __forceinline__ float bflo(unsigned u) { return __uint_as_float(u << 16); }
__device__ __forceinline__ float bfhi(unsigned u) { return __uint_as_float(u & 0xffff0000u); }
__device__ __forceinline__ unsigned pk4_fp8(float a, float b, float c, float d) { int r = __builtin_amdgcn_cvt_pk_fp8_f32(a, b, 0, false); r = __builtin_amdgcn_cvt_pk_fp8_f32(c, d, r, true); return (unsigned)r; }
__device__ __forceinline__ unsigned pk4_i8(float a, float b, float c, float d) {
    const float M = 12582912.f;
    const unsigned ua = __float_as_uint(a + M), ub = __float_as_uint(b + M), uc = __float_as_uint(c + M), ud = __float_as_uint(d + M);
    return (ua & 0xffu) | ((ub & 0xffu) << 8) | ((uc & 0xffu) << 16) | (ud << 24);
}
__device__ __forceinline__ unsigned pk4_fp8_sat(float a, float b, float c, float d) {
    return pk4_fp8(fminf(fmaxf(a, -448.f), 448.f), fminf(fmaxf(b, -448.f), 448.f), fminf(fmaxf(c, -448.f), 448.f), fminf(fmaxf(d, -448.f), 448.f)); }
__device__ __forceinline__ float wave_max(float v) {
#pragma unroll
    for (int o = 1; o < 64; o <<= 1) v = fmaxf(v, __shfl_xor(v, o));
    return v;
}
__device__ __forceinline__ float wave_sum(float v) {
#pragma unroll
    for (int o = 1; o < 64; o <<= 1) v += __shfl_xor(v, o);
    return v;
}
#define LDS_WAIT() asm volatile("s_waitcnt lgkmcnt(0)" ::: "memory")
#define BAR_LDS() do { asm volatile("s_waitcnt lgkmcnt(0)" ::: "memory"); __builtin_amdgcn_s_barrier(); asm volatile("" ::: "memory"); } while (0)
__device__ __forceinline__ int opaque_tid() { int t = threadIdx.x; asm volatile("" : "+v"(t)); return t; }
__device__ __forceinline__ float sigmoidf_(float x) { return __builtin_amdgcn_rcpf(1.f + __builtin_amdgcn_exp2f(-1.4426950408889634f * x)); }
template <int CTRL> __device__ __forceinline__ float dppf(float v) { return __int_as_float(__builtin_amdgcn_update_dpp(0, __float_as_int(v), CTRL, 0xf, 0xf, true)); }
__device__ __forceinline__ float red16_max(float v) { v = fmaxf(v, dppf<0xB1>(v)); v = fmaxf(v, dppf<0x4E>(v)); v = fmaxf(v, dppf<0x141>(v)); v = fmaxf(v, dppf<0x140>(v)); return v; }
__device__ __forceinline__ float red16_sum(float v) { v += dppf<0xB1>(v); v += dppf<0x4E>(v); v += dppf<0x141>(v); v += dppf<0x140>(v); return v; }


namespace pg8 {
constexpr int BM = 256, BK = 64, HALF = 128, HTB = HALF * BK * 2, STAGE_BYTES = 8 * HTB, NXCD = 8, WGM = 8;
__device__ __forceinline__ int swz(int r) { const int p = (r >> 1) & 7, a = (p >> 2) & 1, b = (p >> 1) & 1, c = p & 1; return ((a ^ b) << 2) | (a << 1) | c; }
template <bool FP8> __device__ __forceinline__ int lds_byte(int r, int c) {
    if (FP8) return r * 128 + ((((c >> 3) ^ swz(r)) & 7) << 4);
    const int st = (r >> 4) * 2 + (c >> 5), rr = r & 15, cc = c & 31, ob = rr * 64 + cc * 2; return st * 1024 + (ob ^ (((ob >> 9) & 1) << 5));
}
template <bool FP8> __device__ __forceinline__ void stage_rc(int b, int& R, int& C) {
    if (FP8) { const int slot = b >> 4; R = slot >> 3; C = (((slot & 7) ^ swz(R)) & 7) * 8; }
    else { const int st = b / 1024, sb = b % 1024, sw = sb ^ (((sb >> 9) & 1) << 5); R = (st >> 1) * 16 + sw / 64; C = (st & 1) * 32 + (sw % 64) / 2; }
}
__device__ __forceinline__ int perm32(int rho) { const int n = rho >> 4, i = rho & 15; return 8 * (i >> 2) + 4 * n + (i & 3); }

struct Unit { int pm, pn, pb; };
struct Gemm { const void* A; const void* Bt; int Kb; };

__device__ __forceinline__ bool order_next(long L, int nM, int nN, int& pm, int& pn) {
    const int nwg = nM * nN; if (L >= nwg) return false;
    int wgid = (int)L; { const int q = nwg / NXCD, r = nwg % NXCD, xcd = wgid % NXCD, off = wgid / NXCD; wgid = (xcd < r ? xcd * (q + 1) : r * (q + 1) + (xcd - r) * q) + off; }
    const int nig = WGM * nN, gid = wgid / nig, fm = gid * WGM, gsz = (nM - fm) < WGM ? (nM - fm) : WGM;
    pm = fm + ((wgid % nig) % gsz); pn = (wgid % nig) / gsz; return true;
}
struct StaticOrder {
    static constexpr bool GATHER = false;
    int nM, nN, G, c;
    __device__ __forceinline__ bool next(int i, Unit& u) const { if (!order_next((long)i * G + c, nM, nN, u.pm, u.pn)) return false; u.pb = u.pn; return true; }
    __device__ __forceinline__ void a_offsets(const Unit&, const int (&)[2], const int (&)[2], int, unsigned (&)[2][2]) const {}
};
struct MoeOrder {
    static constexpr bool GATHER = false;
    int nM, nN, G, c; const LAS int* tile_e;
    __device__ __forceinline__ bool next(int i, Unit& u) const { if (!order_next((long)i * G + c, nM, nN, u.pm, u.pn)) return false; u.pb = __builtin_amdgcn_readfirstlane(tile_e[u.pm] * nN + u.pn); return true; }
    __device__ __forceinline__ void a_offsets(const Unit&, const int (&)[2], const int (&)[2], int, unsigned (&)[2][2]) const {}
};
struct MoeGatherOrder {
    static constexpr bool GATHER = true;
    int nM, nN, G, c; const LAS int* tile_e; const LAS int* tstart; const LAS int* tcnt; const int* rowlist;
    __device__ __forceinline__ bool next(int i, Unit& u) const { if (!order_next((long)i * G + c, nM, nN, u.pm, u.pn)) return false; u.pb = __builtin_amdgcn_readfirstlane(tile_e[u.pm] * nN + u.pn); return true; }
    __device__ __forceinline__ void a_offsets(const Unit& u, const int (&R)[2], const int (&Cb)[2], int Kb, unsigned (&off)[2][2]) const {
        const int e = u.pb / nN, lt = u.pm - tstart[e], n = tcnt[e];
#pragma unroll
        for (int h = 0; h < 2; ++h)
#pragma unroll
            for (int i = 0; i < 2; ++i) { const int idx = lt * 256 + h * 128 + R[i]; const int tok = idx < n ? rowlist[(size_t)e * 32768 + idx] : 0; off[h][i] = (unsigned)tok * (unsigned)Kb + (unsigned)Cb[i]; }
    }
};

__device__ __forceinline__ void mfma8_acc(f32x4& c, const i32x8& a, const i32x8& b, int scl) {
    asm volatile("v_mfma_scale_f32_16x16x128_f8f6f4 %0, %1, %2, %0, %3, %3 op_sel_hi:[0,0,0]" : "+v"(c) : "v"(a), "v"(b), "v"(scl)); }
__device__ __forceinline__ void mfmai8_acc(f32x4& c, const i32x4& a, const i32x4& b) {
    asm volatile("v_mfma_i32_16x16x64_i8 %0, %1, %2, %0" : "+v"(c) : "v"(a), "v"(b)); }
__device__ __forceinline__ i32x4 lo4(const i32x8& v) { return __builtin_shufflevector(v, v, 0, 1, 2, 3); }
__device__ __forceinline__ i32x4 hi4(const i32x8& v) { return __builtin_shufflevector(v, v, 4, 5, 6, 7); }
__device__ __forceinline__ i32x8 cat8(i32x4 a, i32x4 b) { return __builtin_shufflevector(a, b, 0, 1, 2, 3, 4, 5, 6, 7); }
__device__ __forceinline__ unsigned cvt_pk_bf16(float lo, float hi) { return pk2(lo, hi); }

struct EpiBf16 {
    static constexpr bool PERM = true;
    struct Pre {}; __device__ __forceinline__ Pre prefetch(const Unit&, int, int, int, int) const { return Pre{}; }
    bf16_t* O; int ldc;
    __device__ __forceinline__ void operator()(const f32x4 (&acc)[2][2][4][2], const Unit& u, const Pre&, int wr, int wc, int fr, int fq) const {
        const int row0 = u.pm * BM + wr * 64 + fr, col0 = u.pn * BM + wc * 32 + 8 * fq;
#pragma unroll
        for (int ai = 0; ai < 2; ++ai)
#pragma unroll
            for (int m = 0; m < 4; ++m) { bf16_t* rowp = O + (size_t)(row0 + ai * HALF + m * 16) * ldc + col0;
#pragma unroll
                for (int bj = 0; bj < 2; ++bj) { const f32x4 v0 = acc[ai][bj][m][0], v1 = acc[ai][bj][m][1];
                    u32x4 w; w.x = cvt_pk_bf16(v0[0], v0[1]); w.y = cvt_pk_bf16(v0[2], v0[3]); w.z = cvt_pk_bf16(v1[0], v1[1]); w.w = cvt_pk_bf16(v1[2], v1[3]);
                    *(u32x4*)(rowp + bj * HALF) = w; } }
    }
};
struct EpiI8Bf16 {
    static constexpr bool PERM = true;
    bf16_t* O; int ldc; const float* rs; const float* cs;
    struct Pre { unsigned c[2][4]; unsigned r[2][2]; };
    __device__ __forceinline__ Pre prefetch(const Unit& u, int wr, int wc, int fr, int fq) const {
        Pre pr; const float* cp = cs + u.pn * BM + wc * 32 + 8 * fq; const float* rp = rs + u.pm * BM + wr * 64 + fr;
#pragma unroll
        for (int bj = 0; bj < 2; ++bj) { const f32x4 c0 = *(const f32x4*)(cp + bj * HALF), c1 = *(const f32x4*)(cp + bj * HALF + 4);
            pr.c[bj][0] = cvt_pk_bf16(c0[0], c0[1]); pr.c[bj][1] = cvt_pk_bf16(c0[2], c0[3]); pr.c[bj][2] = cvt_pk_bf16(c1[0], c1[1]); pr.c[bj][3] = cvt_pk_bf16(c1[2], c1[3]); }
#pragma unroll
        for (int ai = 0; ai < 2; ++ai) { pr.r[ai][0] = cvt_pk_bf16(rp[ai * HALF], rp[ai * HALF + 16]); pr.r[ai][1] = cvt_pk_bf16(rp[ai * HALF + 32], rp[ai * HALF + 48]); }
        return pr;
    }
    __device__ __forceinline__ void operator()(const f32x4 (&acc)[2][2][4][2], const Unit& u, const Pre& pre, int wr, int wc, int fr, int fq) const {
        const int row0 = u.pm * BM + wr * 64 + fr, col0 = u.pn * BM + wc * 32 + 8 * fq;
#pragma unroll
        for (int ai = 0; ai < 2; ++ai)
#pragma unroll
            for (int m = 0; m < 4; ++m) { bf16_t* rowp = O + (size_t)(row0 + ai * HALF + m * 16) * ldc + col0;
                const unsigned rw = pre.r[ai][m >> 1]; const float rsc = (m & 1) ? __uint_as_float(rw & 0xffff0000u) : __uint_as_float(rw << 16);
#pragma unroll
                for (int bj = 0; bj < 2; ++bj) { f32x4 v0, v1;
#pragma unroll
                    for (int j = 0; j < 4; ++j) { const unsigned c0 = pre.c[bj][j >> 1], c1 = pre.c[bj][2 + (j >> 1)];
                        const float cs0 = (j & 1) ? __uint_as_float(c0 & 0xffff0000u) : __uint_as_float(c0 << 16), cs1 = (j & 1) ? __uint_as_float(c1 & 0xffff0000u) : __uint_as_float(c1 << 16);
                        v0[j] = (float)__float_as_int(acc[ai][bj][m][0][j]) * (rsc * cs0); v1[j] = (float)__float_as_int(acc[ai][bj][m][1][j]) * (rsc * cs1); }
                    u32x4 w; w.x = cvt_pk_bf16(v0[0], v0[1]); w.y = cvt_pk_bf16(v0[2], v0[3]); w.z = cvt_pk_bf16(v1[0], v1[1]); w.w = cvt_pk_bf16(v1[2], v1[3]);
                    *(u32x4*)(rowp + bj * HALF) = w; } }
    }
};
struct EpiResF32 {
    static constexpr bool PERM = false;
    struct Pre {}; __device__ __forceinline__ Pre prefetch(const Unit&, int, int, int, int) const { return Pre{}; }
    const float* base; float* out; int ldc; float scale;
    __device__ __forceinline__ void operator()(const f32x4 (&acc)[2][2][4][2], const Unit& u, const Pre&, int wr, int wc, int fr, int fq) const {
        const int col0 = u.pn * BM + wc * 32 + 4 * fq;
#pragma unroll
        for (int ai = 0; ai < 2; ++ai) {
            f32x4 bs[4][2][2];
#pragma unroll
            for (int m = 0; m < 4; ++m) { const size_t off = (size_t)(u.pm * BM + ai * HALF + wr * 64 + m * 16 + fr) * ldc + col0;
#pragma unroll
                for (int bj = 0; bj < 2; ++bj)
#pragma unroll
                    for (int n = 0; n < 2; ++n) bs[m][bj][n] = __builtin_nontemporal_load((const f32x4*)(base + off + bj * HALF + n * 16)); }
            asm volatile("" ::: "memory");
#pragma unroll
            for (int m = 0; m < 4; ++m) { const size_t off = (size_t)(u.pm * BM + ai * HALF + wr * 64 + m * 16 + fr) * ldc + col0;
#pragma unroll
                for (int bj = 0; bj < 2; ++bj)
#pragma unroll
                    for (int n = 0; n < 2; ++n) *(f32x4*)(out + off + bj * HALF + n * 16) = bs[m][bj][n] + acc[ai][bj][m][n] * scale; }
            asm volatile("" ::: "memory");
        }
    }
};
struct EpiResBf16 {
    static constexpr bool PERM = true;
    struct Pre {}; __device__ __forceinline__ Pre prefetch(const Unit&, int, int, int, int) const { return Pre{}; }
    const float* base; bf16_t* out; int ldc; float scale;
    __device__ __forceinline__ void operator()(const f32x4 (&acc)[2][2][4][2], const Unit& u, const Pre&, int wr, int wc, int fr, int fq) const {
        const int col0 = u.pn * BM + wc * 32 + 8 * fq;
#pragma unroll
        for (int ai = 0; ai < 2; ++ai) {
            f32x4 bs[4][2][2];
#pragma unroll
            for (int m = 0; m < 4; ++m) { const size_t off = (size_t)(u.pm * BM + ai * HALF + wr * 64 + m * 16 + fr) * ldc + col0;
#pragma unroll
                for (int bj = 0; bj < 2; ++bj)
#pragma unroll
                    for (int n = 0; n < 2; ++n) bs[m][bj][n] = *(const f32x4*)(base + off + bj * HALF + n * 4); }
            asm volatile("" ::: "memory");
#pragma unroll
            for (int m = 0; m < 4; ++m) { const size_t off = (size_t)(u.pm * BM + ai * HALF + wr * 64 + m * 16 + fr) * ldc + col0;
#pragma unroll
                for (int bj = 0; bj < 2; ++bj) { const f32x4 v0 = bs[m][bj][0] + acc[ai][bj][m][0] * scale, v1 = bs[m][bj][1] + acc[ai][bj][m][1] * scale;
                    u32x4 w; w.x = cvt_pk_bf16(v0[0], v0[1]); w.y = cvt_pk_bf16(v0[2], v0[3]); w.z = cvt_pk_bf16(v1[0], v1[1]); w.w = cvt_pk_bf16(v1[2], v1[3]);
                    *(u32x4*)(out + off + bj * HALF) = w; } }
            asm volatile("" ::: "memory");
        }
    }
};
struct EpiSwiglu {
    static constexpr bool PERM = true;
    unsigned char* O; const float* bias; int nN;
    struct Pre { unsigned g[4], l[4]; };
    __device__ __forceinline__ Pre prefetch(const Unit& u, int wr, int wc, int fr, int fq) const {
        const int e = u.pb / nN, ch = u.pn * HALF + wc * 32 + 8 * fq;
        const float* bg = bias + (size_t)e * 2048 + ch; const float* bl = bg + 1024;
        const f32x4 g0 = *(const f32x4*)bg, g1 = *(const f32x4*)(bg + 4), l0 = *(const f32x4*)bl, l1 = *(const f32x4*)(bl + 4);
        Pre pr;
        pr.g[0] = cvt_pk_bf16(g0[0], g0[1]); pr.g[1] = cvt_pk_bf16(g0[2], g0[3]); pr.g[2] = cvt_pk_bf16(g1[0], g1[1]); pr.g[3] = cvt_pk_bf16(g1[2], g1[3]);
        pr.l[0] = cvt_pk_bf16(l0[0], l0[1]); pr.l[1] = cvt_pk_bf16(l0[2], l0[3]); pr.l[2] = cvt_pk_bf16(l1[0], l1[1]); pr.l[3] = cvt_pk_bf16(l1[2], l1[3]);
        return pr;
    }
    __device__ __forceinline__ void operator()(const f32x4 (&acc)[2][2][4][2], const Unit& u, const Pre& pre, int wr, int wc, int fr, int fq) const {
        typedef float f32x2 __attribute__((ext_vector_type(2)));
        const int row0 = u.pm * BM + wr * 64 + fr, ch = u.pn * HALF + wc * 32 + 8 * fq;
        f32x2 bg[2][2], bl[2][2];
#pragma unroll
        for (int n = 0; n < 2; ++n)
#pragma unroll
            for (int h = 0; h < 2; ++h) { const unsigned gw = pre.g[2 * n + h], lw = pre.l[2 * n + h];
                bg[n][h] = (f32x2){__uint_as_float(gw << 16), __uint_as_float(gw & 0xffff0000u)}; bl[n][h] = (f32x2){__uint_as_float(lw << 16), __uint_as_float(lw & 0xffff0000u)} + 1.f; }
#pragma unroll
        for (int ai = 0; ai < 2; ++ai)
#pragma unroll
            for (int m = 0; m < 4; ++m) {
                f32x2 r[2][2];
#pragma unroll
                for (int n = 0; n < 2; ++n)
#pragma unroll
                    for (int h = 0; h < 2; ++h) {
                        const f32x2 ag = (f32x2){acc[ai][0][m][n][2 * h], acc[ai][0][m][n][2 * h + 1]}, al = (f32x2){acc[ai][1][m][n][2 * h], acc[ai][1][m][n][2 * h + 1]};
                        f32x2 gv = ag * (1.f / 32.f) + bg[n][h], lv = al * (1.f / 32.f) + bl[n][h];
                        gv.x = fminf(gv.x, 7.0f); gv.y = fminf(gv.y, 7.0f);
                        lv.x = fminf(fmaxf(lv.x, -6.0f), 8.0f); lv.y = fminf(fmaxf(lv.y, -6.0f), 8.0f);
                        const f32x2 ea = gv * (-1.702f * 1.4426950408889634f);
                        f32x2 den; den.x = __builtin_amdgcn_exp2f(ea.x); den.y = __builtin_amdgcn_exp2f(ea.y);
                        den = den + 1.f;
                        f32x2 rc; rc.x = __builtin_amdgcn_rcpf(den.x); rc.y = __builtin_amdgcn_rcpf(den.y);
                        r[n][h] = (gv * rc) * lv;
                    }
                u32x2 w; w.x = pk4_fp8(r[0][0].x, r[0][0].y, r[0][1].x, r[0][1].y); w.y = pk4_fp8(r[1][0].x, r[1][0].y, r[1][1].x, r[1][1].y);
                *(u32x2*)(O + (size_t)(row0 + ai * HALF + m * 16) * DFF + ch) = w;
            }
    }
};
struct EpiDown {
    static constexpr bool PERM = true;
    unsigned char* O; const float* bias; int nN;
    struct Pre { f32x4 bv[2][2]; };
    __device__ __forceinline__ Pre prefetch(const Unit& u, int wr, int wc, int fr, int fq) const {
        const int e = u.pb / nN, col0 = u.pn * BM + wc * 32 + 8 * fq;
        const float* bp = bias + (size_t)e * 1024 + col0;
        Pre pr;
#pragma unroll
        for (int bj = 0; bj < 2; ++bj)
#pragma unroll
            for (int n = 0; n < 2; ++n) pr.bv[bj][n] = *(const f32x4*)(bp + bj * HALF + 4 * n);
        return pr;
    }
    __device__ __forceinline__ void operator()(const f32x4 (&acc)[2][2][4][2], const Unit& u, const Pre& pre, int wr, int wc, int fr, int fq) const {
        const int row0 = u.pm * BM + wr * 64 + fr, col0 = u.pn * BM + wc * 32 + 8 * fq;
        f32x4 bv[2][2];
#pragma unroll
        for (int bj = 0; bj < 2; ++bj)
#pragma unroll
            for (int n = 0; n < 2; ++n) bv[bj][n] = pre.bv[bj][n];
#pragma unroll
        for (int ai = 0; ai < 2; ++ai)
#pragma unroll
            for (int m = 0; m < 4; ++m) { unsigned char* rowp = O + (size_t)(row0 + ai * HALF + m * 16) * 1024 + col0;
#pragma unroll
                for (int bj = 0; bj < 2; ++bj) { const f32x4 v0 = acc[ai][bj][m][0] * (Y_SCALE / 32.f) + bv[bj][0] * Y_SCALE, v1 = acc[ai][bj][m][1] * (Y_SCALE / 32.f) + bv[bj][1] * Y_SCALE;
                    u32x2 w; w.x = pk4_fp8_sat(v0[0], v0[1], v0[2], v0[3]); w.y = pk4_fp8_sat(v1[0], v1[1], v1[2], v1[3]);
                    *(u32x2*)(rowp + bj * HALF) = w; } }
    }
};

template <int MODE, class Epi, class Sched>
__device__ __forceinline__ void gemm_phase(LAS unsigned char* lds, const Gemm g, const Sched& S, const Epi& E) {
    constexpr bool FP8 = MODE >= 1, I8 = MODE == 2;
    const int tid = opaque_tid(), wid = __builtin_amdgcn_readfirstlane(tid >> 6), lane = tid & 63, wr = wid >> 2, wc = wid & 3, fr = lane & 15, fq = lane >> 4;
    const int Kb = g.Kb, nt = Kb / 128;
    unsigned voffB[2]; int stR[2], stC[2];
    unsigned offc[2][2], offn[2][2];
#pragma unroll
    for (int i = 0; i < 2; ++i) { int R, C; stage_rc<FP8>(tid * 16 + i * 8192, R, C); const int Rb = Epi::PERM ? ((R & ~31) + perm32(R & 31)) : R;
        stR[i] = R; stC[i] = C * 2; voffB[i] = (unsigned)(Rb * Kb + C * 2);
        offc[0][i] = (unsigned)(R * Kb + C * 2); offc[1][i] = offc[0][i] + (unsigned)(HALF * Kb); offn[0][i] = offc[0][i]; offn[1][i] = offc[1][i]; }
    const size_t kstep = (size_t)(BK * 2);
    const size_t hstep = (size_t)HALF * Kb;
    const size_t tstep = 2 * hstep;
    const unsigned ldsw = (unsigned)wid * 1024u;
    const int aoff = FP8 ? lds_byte<true>(wr * 64 + fr, fq * 16) : lds_byte<false>(wr * 64 + fr, fq * 8), boff = FP8 ? lds_byte<true>(wc * 32 + fr, fq * 16) : lds_byte<false>(wc * 32 + fr, fq * 8);
    const int aoff1 = FP8 ? (aoff ^ 16) : (aoff + 1024), boff1 = FP8 ? (boff ^ 16) : (boff + 1024);
#define PG8_SA(b, h) (((b) * 2 + (h)) * HTB)
#define PG8_SB(b, h) ((4 + (b) * 2 + (h)) * HTB)
#define PG8_STAGE(bufoff, gbase, voff) do { _Pragma("unroll") for (int _i = 0; _i < 2; ++_i) \
        __builtin_amdgcn_global_load_lds((const unsigned*)((const char*)(gbase) + (voff)[_i]), (LAS unsigned*)(lds + (bufoff) + ldsw + _i * 8192), 16, 0, 0); } while (0)
#define PG8_LDA(dst, b, h) do { if constexpr (FP8) { _Pragma("unroll") for (int m = 0; m < 4; ++m) dst##8[m] = cat8(*(const LAS i32x4*)(lds + PG8_SA(b, h) + aoff + m * 2048), *(const LAS i32x4*)(lds + PG8_SA(b, h) + aoff1 + m * 2048)); } \
        else { _Pragma("unroll") for (int m = 0; m < 4; ++m) { dst[m][0] = *(const LAS bf16x8*)(lds + PG8_SA(b, h) + aoff + m * 2048); dst[m][1] = *(const LAS bf16x8*)(lds + PG8_SA(b, h) + aoff1 + m * 2048); } } } while (0)
#define PG8_LDB(dst, b, h) do { if constexpr (FP8) { _Pragma("unroll") for (int n = 0; n < 2; ++n) dst##8[n] = cat8(*(const LAS i32x4*)(lds + PG8_SB(b, h) + boff + n * 2048), *(const LAS i32x4*)(lds + PG8_SB(b, h) + boff1 + n * 2048)); } \
        else { _Pragma("unroll") for (int n = 0; n < 2; ++n) { dst[n][0] = *(const LAS bf16x8*)(lds + PG8_SB(b, h) + boff + n * 2048); dst[n][1] = *(const LAS bf16x8*)(lds + PG8_SB(b, h) + boff1 + n * 2048); } } } while (0)
#define PG8_MMA(ai, bj, At, Bt) do { __builtin_amdgcn_s_setprio(1); _Pragma("unroll") for (int m = 0; m < 4; ++m) _Pragma("unroll") for (int n = 0; n < 2; ++n) { \
        if constexpr (I8) mfmai8_acc(acc[ai][bj][m][n], lo4(Bt##8[n]), lo4(At##8[m])); \
        else if constexpr (FP8) mfma8_acc(acc[ai][bj][m][n], Bt##8[n], At##8[m], scl); \
        else { _Pragma("unroll") for (int k = 0; k < 2; ++k) acc[ai][bj][m][n] = __builtin_amdgcn_mfma_f32_16x16x32_bf16(Bt[n][k], At[m][k], acc[ai][bj][m][n], 0, 0, 0); } } \
        if constexpr (I8) { _Pragma("unroll") for (int m = 0; m < 4; ++m) _Pragma("unroll") for (int n = 0; n < 2; ++n) mfmai8_acc(acc[ai][bj][m][n], hi4(Bt##8[n]), hi4(At##8[m])); } \
        __builtin_amdgcn_s_setprio(0); } while (0)
#define PG8_WAIT_V(n) asm volatile("s_waitcnt vmcnt(" #n ")" ::: "memory")
#define PG8_WAIT_L(n) asm volatile("s_waitcnt lgkmcnt(" #n ")" ::: "memory")
#define PG8_BAR __builtin_amdgcn_s_barrier()
#define PG8_SCHED __builtin_amdgcn_sched_barrier(0)
    Unit cur, nxt; int ui = 0;
    if (!S.next(0, cur)) return;
    f32x4 acc[2][2][4][2];
#pragma unroll
    for (int a = 0; a < 2; ++a)
#pragma unroll
        for (int b = 0; b < 2; ++b)
#pragma unroll
            for (int m = 0; m < 4; ++m)
#pragma unroll
                for (int n = 0; n < 2; ++n) acc[a][b][m][n] = (f32x4){0.f, 0.f, 0.f, 0.f};
    bf16x8 At[4][2], B0[2][2], B1[2][2];
    i32x8 At8[4], B08[2], B18[2];
    int scl = 0x7f7f7f7f; asm volatile("" : "+v"(scl));
    const char* cA = Sched::GATHER ? (const char*)g.A : (const char*)g.A + (size_t)cur.pm * tstep; const char* cB = (const char*)g.Bt + (size_t)cur.pb * tstep;
    if constexpr (Sched::GATHER) S.a_offsets(cur, stR, stC, Kb, offc);
    typename Epi::Pre pre = E.prefetch(cur, wr, wc, fr, fq);
    {
        PG8_STAGE(PG8_SB(0, 0), cB, voffB); PG8_STAGE(PG8_SB(0, 1), cB + hstep, voffB); PG8_STAGE(PG8_SA(0, 0), cA, offc[0]); PG8_STAGE(PG8_SA(0, 1), cA, offc[1]);
        if (wr == 1) PG8_BAR;
        PG8_WAIT_V(2); PG8_BAR;
        PG8_STAGE(PG8_SB(1, 0), cB + kstep, voffB); PG8_STAGE(PG8_SA(1, 0), cA + kstep, offc[0]); PG8_STAGE(PG8_SB(1, 1), cB + hstep + kstep, voffB);
        PG8_WAIT_V(6); PG8_BAR;
    }
    for (;;) {
        const bool has_next = S.next(ui + 1, nxt);
        const char* nA = Sched::GATHER ? cA : (has_next ? (const char*)g.A + (size_t)nxt.pm * tstep : cA); const char* nB = has_next ? (const char*)g.Bt + (size_t)nxt.pb * tstep : cB;
        if constexpr (Sched::GATHER) {
            if (has_next) S.a_offsets(nxt, stR, stC, Kb, offn);
            else {
#pragma unroll
                for (int h = 0; h < 2; ++h)
#pragma unroll
                    for (int i = 0; i < 2; ++i) offn[h][i] = offc[h][i];
            }
        }
#pragma unroll 1
        for (int t = 0; t < nt; t += 2) {
            const bool last = (t == nt - 2);
            const char* a1 = cA + (size_t)(t + 1) * kstep;
            const char* a2 = last ? nA : cA + (size_t)(t + 2) * kstep; const char* b2 = last ? nB : cB + (size_t)(t + 2) * kstep;
            const char* a3 = a2 + kstep; const char* b3 = b2 + kstep;
            unsigned o20[2], o21[2];
#pragma unroll
            for (int i = 0; i < 2; ++i) { o20[i] = (Sched::GATHER && last) ? offn[0][i] : offc[0][i]; o21[i] = (Sched::GATHER && last) ? offn[1][i] : offc[1][i]; }
            PG8_LDB(B0, 0, 0); PG8_LDB(B1, 0, 1); PG8_SCHED; PG8_LDA(At, 0, 0); PG8_STAGE(PG8_SA(1, 1), a1, offc[1]);
            PG8_WAIT_V(8); PG8_WAIT_L(0); PG8_BAR; PG8_MMA(0, 0, At, B0); PG8_MMA(0, 1, At, B1); PG8_BAR; PG8_SCHED;
            PG8_LDA(At, 0, 1); PG8_STAGE(PG8_SB(0, 0), b2, voffB); PG8_STAGE(PG8_SB(0, 1), b2 + hstep, voffB); PG8_STAGE(PG8_SA(0, 0), a2, o20);
            PG8_WAIT_V(8); PG8_WAIT_L(0); PG8_BAR; PG8_MMA(1, 0, At, B0); PG8_MMA(1, 1, At, B1); PG8_BAR; PG8_SCHED;
            PG8_LDB(B0, 1, 0); PG8_LDB(B1, 1, 1); PG8_SCHED; PG8_LDA(At, 1, 0); PG8_STAGE(PG8_SA(0, 1), a2, o21);
            PG8_WAIT_V(8); PG8_WAIT_L(0); PG8_BAR; PG8_MMA(0, 0, At, B0); PG8_MMA(0, 1, At, B1); PG8_BAR; PG8_SCHED;
            PG8_LDA(At, 1, 1); PG8_STAGE(PG8_SB(1, 0), b3, voffB); PG8_STAGE(PG8_SB(1, 1), b3 + hstep, voffB); PG8_STAGE(PG8_SA(1, 0), a3, o20);
            PG8_WAIT_V(8); PG8_WAIT_L(0); PG8_BAR; PG8_MMA(1, 0, At, B0); PG8_MMA(1, 1, At, B1); PG8_BAR; PG8_SCHED;
        }
        if (wr == 0) PG8_BAR;
        if constexpr (FP8) asm volatile("s_nop 15\n\ts_nop 15" ::: "memory");
        E(acc, cur, pre, wr, wc, fr, fq);
        if (!has_next) break;
#pragma unroll
        for (int a = 0; a < 2; ++a)
#pragma unroll
            for (int b = 0; b < 2; ++b)
#pragma unroll
                for (int m = 0; m < 4; ++m)
#pragma unroll
                    for (int n = 0; n < 2; ++n) acc[a][b][m][n] = (f32x4){0.f, 0.f, 0.f, 0.f};
        cur = nxt; cA = nA; cB = nB; ++ui;
        if constexpr (Sched::GATHER) {
#pragma unroll
            for (int h = 0; h < 2; ++h)
#pragma unroll
                for (int i = 0; i < 2; ++i) offc[h][i] = offn[h][i];
        }
        pre = E.prefetch(cur, wr, wc, fr, fq);
        if (wr == 1) PG8_BAR;
    }
    PG8_WAIT_V(0);
    PG8_BAR;
#undef PG8_SA
#undef PG8_SB
#undef PG8_STAGE
#undef PG8_LDA
#undef PG8_LDB
#undef PG8_MMA
#undef PG8_WAIT_V
#undef PG8_WAIT_L
#undef PG8_BAR
#undef PG8_SCHED
}
}

__device__ __forceinline__ int win_map(int n) {
    if (n < 1280) return n;
    if (n < 2304) return n + 24;
    if (n < 2816) return n + 40;
    if (n < 2840) return n - 1536;
    if (n < 2856) return n - 512;
    return -1;
}
template <int MODE> __device__ __forceinline__ int colmap(int r) {
    if (MODE == 1) return win_map(r);
    if (MODE == 2) return ((r >> 7) & 1) * 1024 + (r >> 8) * 128 + (r & 127);
    return r;
}
template <int MODE>
__device__ __forceinline__ void transpose_load(f32x4 (&v)[16], const float* W, int Nsrc, int nblk, int item, int lane) {
    const int kb = item / nblk, nb = item % nblk, k0 = 64 * kb, n0 = 64 * nb;
    const int nq = 4 * (lane & 15), kq = lane >> 4;
    const int sc = colmap<MODE>(n0 + nq);
#pragma unroll
    for (int i = 0; i < 16; ++i) v[i] = sc >= 0 ? __builtin_nontemporal_load((const f32x4*)(W + (size_t)(k0 + 4 * i + kq) * Nsrc + sc)) : (f32x4){0.f, 0.f, 0.f, 0.f};
}
template <bool OUT8>
__device__ __forceinline__ void transpose_finish(const f32x4 (&v)[16], int K, void* WTv, int nblk, LAS float* scr, int item, int lane) {
    const int kb = item / nblk, nb = item % nblk, k0 = 64 * kb, n0 = 64 * nb;
    const int nq = 4 * (lane & 15), kq = lane >> 4;
#pragma unroll
    for (int i = 0; i < 16; ++i) { LAS float* d = scr + (4 * i + kq) * 65 + nq; d[0] = v[i].x; d[1] = v[i].y; d[2] = v[i].z; d[3] = v[i].w; }
    LDS_WAIT();
    const int c = lane & 7;
#pragma unroll
    for (int j = 0; j < 8; ++j) { const int n = (lane >> 3) + 8 * j; const LAS float* s = scr + (8 * c) * 65 + n;
        if (OUT8) {
            u32x2 o; o.x = pk4_fp8_sat(s[0 * 65] * 32.f, s[1 * 65] * 32.f, s[2 * 65] * 32.f, s[3 * 65] * 32.f); o.y = pk4_fp8_sat(s[4 * 65] * 32.f, s[5 * 65] * 32.f, s[6 * 65] * 32.f, s[7 * 65] * 32.f);
            *(u32x2*)((unsigned char*)WTv + (size_t)(n0 + n) * K + k0 + 8 * c) = o;
        } else {
            u32x4 o; o.x = pk2(s[0 * 65], s[1 * 65]); o.y = pk2(s[2 * 65], s[3 * 65]); o.z = pk2(s[4 * 65], s[5 * 65]); o.w = pk2(s[6 * 65], s[7 * 65]);
            *(u32x4*)((bf16_t*)WTv + (size_t)(n0 + n) * K + k0 + 8 * c) = o; } }
    LDS_WAIT();
}
template <int MODE, bool OUT8>
__device__ __forceinline__ void transpose_item(const float* W, int K, int Nsrc, void* WTv, int nblk, LAS float* scr, int item, int lane) {
    f32x4 v[16];
    transpose_load<MODE>(v, W, Nsrc, nblk, item, lane);
    transpose_finish<OUT8>(v, K, WTv, nblk, scr, item, lane);
}
template <int NR>
__device__ __forceinline__ void rms_rows_to_bf16(const float* x0, size_t xstride, const float* g, bf16_t* o0, size_t ostride, int lane) {
    f32x4 v[NR][4];
#pragma unroll
    for (int r = 0; r < NR; ++r) { const f32x4* xr = (const f32x4*)(x0 + r * xstride) + lane;
#pragma unroll
        for (int j = 0; j < 4; ++j) v[r][j] = __builtin_nontemporal_load(xr + 64 * j); }
    const f32x4* gr = (const f32x4*)g + lane;
    f32x4 gg[4];
#pragma unroll
    for (int j = 0; j < 4; ++j) gg[j] = gr[64 * j];
#pragma unroll
    for (int r = 0; r < NR; ++r) {
        float s = 0.f;
#pragma unroll
        for (int j = 0; j < 4; ++j) s += (v[r][j].x * v[r][j].x + v[r][j].y * v[r][j].y) + (v[r][j].z * v[r][j].z + v[r][j].w * v[r][j].w);
        const float rstd = 1.f / sqrtf(wave_sum(s) * (1.f / DM) + EPS);
        unsigned long long* o8 = (unsigned long long*)(o0 + r * ostride) + lane;
#pragma unroll
        for (int j = 0; j < 4; ++j) { const f32x4 o = v[r][j] * rstd * gg[j];
            o8[64 * j] = (unsigned long long)pk2(o.x, o.y) | ((unsigned long long)pk2(o.z, o.w) << 32); }
    }
}
template <int NR>
__device__ __forceinline__ void rms_rows_to_i8(const float* x0, size_t xstride, const float* g, unsigned char* o0, size_t ostride, float* rowscale, int lane) {
    f32x4 v[NR][4];
#pragma unroll
    for (int r = 0; r < NR; ++r) { const f32x4* xr = (const f32x4*)(x0 + r * xstride) + lane;
#pragma unroll
        for (int j = 0; j < 4; ++j) v[r][j] = __builtin_nontemporal_load(xr + 64 * j); }
    const f32x4* gr = (const f32x4*)g + lane;
    f32x4 gg[4];
#pragma unroll
    for (int j = 0; j < 4; ++j) gg[j] = gr[64 * j];
#pragma unroll
    for (int r = 0; r < NR; ++r) {
        float s = 0.f;
#pragma unroll
        for (int j = 0; j < 4; ++j) s += (v[r][j].x * v[r][j].x + v[r][j].y * v[r][j].y) + (v[r][j].z * v[r][j].z + v[r][j].w * v[r][j].w);
        const float rstd = 1.f / sqrtf(wave_sum(s) * (1.f / DM) + EPS);
        f32x4 o[4]; float am = 0.f;
#pragma unroll
        for (int j = 0; j < 4; ++j) { o[j] = v[r][j] * rstd * gg[j]; am = fmaxf(fmaxf(am, fmaxf(fabsf(o[j].x), fabsf(o[j].y))), fmaxf(fabsf(o[j].z), fabsf(o[j].w))); }
        am = wave_max(am);
        const float inv = am > 0.f ? 127.f / am : 0.f;
        unsigned* o4 = (unsigned*)(o0 + r * ostride) + lane;
#pragma unroll
        for (int j = 0; j < 4; ++j) o4[64 * j] = pk4_i8(o[j].x * inv, o[j].y * inv, o[j].z * inv, o[j].w * inv);
        if (lane == 0) rowscale[r] = am * (1.f / 127.f);
    }
}
__device__ __forceinline__ void win_quant_item(const Params& p, LAS unsigned char* lds, int cb) {
    const int tid = opaque_tid(), lane = tid & 63, wave = tid >> 6;
    unsigned char* ws = p.ws;
    LAS float* scr = (LAS float*)(lds + wave * 16640);
    LAS float* cmax = (LAS float*)(lds + 8 * 16640);
    const float* W = p.in[3];
    const int n0 = 64 * cb, nq = 4 * (lane & 15), kq = lane >> 4;
    const int sc = win_map(n0 + nq);
    f32x4 v[2][16];
#pragma unroll
    for (int t = 0; t < 2; ++t)
#pragma unroll
        for (int i = 0; i < 16; ++i) v[t][i] = sc >= 0 ? __builtin_nontemporal_load((const f32x4*)(W + (size_t)(64 * (2 * wave + t) + 4 * i + kq) * 2856 + sc)) : (f32x4){0.f, 0.f, 0.f, 0.f};
    f32x4 mx = (f32x4){0.f, 0.f, 0.f, 0.f};
#pragma unroll
    for (int t = 0; t < 2; ++t)
#pragma unroll
        for (int i = 0; i < 16; ++i) { mx.x = fmaxf(mx.x, fabsf(v[t][i].x)); mx.y = fmaxf(mx.y, fabsf(v[t][i].y)); mx.z = fmaxf(mx.z, fabsf(v[t][i].z)); mx.w = fmaxf(mx.w, fabsf(v[t][i].w)); }
#pragma unroll
    for (int o = 16; o < 64; o <<= 1) { mx.x = fmaxf(mx.x, __shfl_xor(mx.x, o)); mx.y = fmaxf(mx.y, __shfl_xor(mx.y, o)); mx.z = fmaxf(mx.z, __shfl_xor(mx.z, o)); mx.w = fmaxf(mx.w, __shfl_xor(mx.w, o)); }
    __syncthreads();
    if (kq == 0) *(LAS f32x4*)(cmax + wave * 64 + nq) = mx;
    __syncthreads();
    f32x4 m4 = *(const LAS f32x4*)(cmax + nq);
#pragma unroll
    for (int w2 = 1; w2 < 8; ++w2) { const f32x4 o = *(const LAS f32x4*)(cmax + w2 * 64 + nq); m4.x = fmaxf(m4.x, o.x); m4.y = fmaxf(m4.y, o.y); m4.z = fmaxf(m4.z, o.z); m4.w = fmaxf(m4.w, o.w); }
    f32x4 inv;
#pragma unroll
    for (int j = 0; j < 4; ++j) inv[j] = m4[j] > 0.f ? 127.f / m4[j] : 0.f;
    if (wave == 0 && kq == 0) *(f32x4*)((float*)(ws + WS_COLS) + n0 + nq) = m4 * (1.f / 127.f);
#pragma unroll
    for (int t = 0; t < 2; ++t) {
        const int k0 = 64 * (2 * wave + t);
#pragma unroll
        for (int i = 0; i < 16; ++i) { LAS float* d = scr + (4 * i + kq) * 65 + nq; d[0] = v[t][i].x * inv.x; d[1] = v[t][i].y * inv.y; d[2] = v[t][i].z * inv.z; d[3] = v[t][i].w * inv.w; }
        LDS_WAIT();
        const int c = lane & 7;
#pragma unroll
        for (int j = 0; j < 8; ++j) { const int n = (lane >> 3) + 8 * j; const LAS float* sp = scr + (8 * c) * 65 + n;
            u32x2 o; o.x = pk4_i8(sp[0 * 65], sp[1 * 65], sp[2 * 65], sp[3 * 65]); o.y = pk4_i8(sp[4 * 65], sp[5 * 65], sp[6 * 65], sp[7 * 65]);
            *(u32x2*)(ws + WS_WIN + (size_t)(n0 + n) * 1024 + k0 + 8 * c) = o; }
        LDS_WAIT();
    }
    __syncthreads();
}
__device__ __forceinline__ void phase0(const Params& p, LAS unsigned char* lds, int blk, int G) {
    const int tid = opaque_tid(), lane = tid & 63, wave = tid >> 6;
    LAS float* scr = (LAS float*)(lds + wave * 16640);
    const int gw = blk * 8 + wave, NGW = G * 8;
    unsigned char* ws = p.ws;
    constexpr int I_GU = 16 * 32, I_DN = 16 * 16;
    constexpr int N_GU = NEXP * I_GU, N_DN = NEXP * I_DN, N_IN = 16 * (NPROJ / 64), N_OUT = 16 * 16, N_C1 = 32 * 4, N_C2 = 4 * 1;
    constexpr int NITEMS = N_OUT + 2 * N_C1 + 2 * N_C2;
    (void)N_GU; (void)N_DN; (void)N_IN;
    for (int cb = blk >= 65 ? blk - 65 : blk + G - 65; cb < NPROJ / 64; cb += G) win_quant_item(p, lds, cb);
    for (int it = gw; it < NITEMS; it += NGW) {
        int r = it;
        if (r < N_OUT) { transpose_item<0, true>(p.in[15], 1024, 1024, ws + WS_WOUT, 16, scr, r, lane); continue; } r -= N_OUT;
        if (r < N_C1) { transpose_item<0, false>(p.in[7], 2048, 256, (bf16_t*)(ws + WS_CW1K), 4, scr, r, lane); continue; } r -= N_C1;
        if (r < N_C1) { transpose_item<0, false>(p.in[10], 2048, 256, (bf16_t*)(ws + WS_CW1V), 4, scr, r, lane); continue; } r -= N_C1;
        if (r < N_C2) { transpose_item<0, false>(p.in[8], 256, 64, (bf16_t*)(ws + WS_CW2K), 1, scr, r, lane); continue; } r -= N_C2;
        transpose_item<0, false>(p.in[11], 256, 64, (bf16_t*)(ws + WS_CW2V), 1, scr, r, lane);
    }
    {
        constexpr int NG = MTOK / 4, WQ0 = 65, WQN = NPROJ / 64;
        auto rows = [&](int g) { const int m = g * 4; rms_rows_to_i8<4>(p.in[0] + (size_t)m * DM, DM, p.in[2], ws + WS_H + (size_t)m * DM, DM, (float*)(ws + WS_ROWS) + m, lane); };
        if (G != 256) { for (int g = gw; g < NG; g += NGW) rows(g); }
        else {
            constexpr int CI = 28, CW = 20, CP = 38;
            const int cnt = blk < WQ0 ? CI : (blk < WQ0 + WQN ? CW : CP);
            const int start = blk < WQ0 ? CI * blk : (blk < WQ0 + WQN ? WQ0 * CI + (blk - WQ0) * CW : WQ0 * CI + WQN * CW + (blk - WQ0 - WQN) * CP);
            static_assert(WQ0 * CI + WQN * CW + (256 - WQ0 - WQN) * CP >= NG, "row groups covered");
            for (int g = start + wave; g < start + cnt && g < NG; g += 8) rows(g);
        }
    }
    for (int i = blk * NTHREADS + tid; i < NEXP * DM; i += G * NTHREADS) { const int e = i >> 10, d = i & 1023; ((float*)(ws + WS_WRT))[i] = p.in[16][d] * p.in[17][d * NEXP + e]; }
    for (int o = gw; o < 128; o += NGW) {
        const int which = o >> 6, j0 = (o & 63) * 4;
        const float* pos = which ? p.in[9] : p.in[6]; const float* w1 = which ? p.in[10] : p.in[7];
        f32x4 acc = (f32x4){0.f, 0.f, 0.f, 0.f};
#pragma unroll 8
        for (int i = 0; i < 32; ++i) { const int k = lane + 64 * i; acc += pos[k] * *(const f32x4*)(w1 + (size_t)k * 256 + j0); }
        acc.x = wave_sum(acc.x); acc.y = wave_sum(acc.y); acc.z = wave_sum(acc.z); acc.w = wave_sum(acc.w);
        if (lane == 0) *(f32x4*)((float*)(ws + WS_CBIAS) + which * 256 + j0) = acc;
    }
}

__device__ __forceinline__ void p2a_unit(const Params& p, LAS unsigned char* lds, int unit) {
    const int tid = opaque_tid(), lane = tid & 63, wave = tid >> 6, vec = lane >> 4, li = lane & 15;
    unsigned char* ws = p.ws;
    const bf16_t* PROJ = (const bf16_t*)(ws + WS_PROJ);
    const int b = unit >> 5, blkc = unit & 31, tok0 = unit * 64;
    u32x4 vraw[4];
    { const int tk = tid >> 3, ch = tid & 7;
#pragma unroll
      for (int v = 0; v < 4; ++v) vraw[v] = *(const u32x4*)(PROJ + (size_t)(tok0 + tk) * NPROJ + (v < 2 ? CVS : CVW) + (v & 1) * 64 + 8 * ch); }
    const int col2 = (vec < 2 ? CKS + vec * 64 : CKW + (vec - 2) * 64) + 4 * li;
    u32x2 raw[8][3];
#pragma unroll
    for (int ti = 0; ti < 8; ++ti) { const bf16_t* pr = PROJ + (size_t)(tok0 + wave * 8 + ti) * NPROJ;
        raw[ti][2] = *(const u32x2*)(pr + col2); }
    const f32x4 gq = *(const f32x4*)(p.in[4] + 4 * li);
    const f32x4 gk = *(const f32x4*)(p.in[5] + (vec < 2 ? 64 : 128) + 4 * li);
    float invf[4];
#pragma unroll
    for (int i = 0; i < 4; ++i) invf[i] = __expf(-13.122363377404328f * (float)(2 * ((4 * li + i) & 7)) * (1.f / 16.f));
    const float sgn = (li < 2) ? -1.f : 1.f;
#pragma unroll
    for (int ti = 0; ti < 8; ++ti) {
        const int t = tok0 + wave * 8 + ti;
        const float pos = (float)((const int*)p.in[1])[t];
        float cs[4], sn[4];
#pragma unroll
        for (int i = 0; i < 4; ++i) { const float ang = pos * invf[i]; cs[i] = __cosf(ang); sn[i] = __sinf(ang); }
#pragma unroll
        for (int vg = 2; vg < 3; ++vg) {
            const u32x2 rw = raw[ti][vg];
            float x[4] = {__uint_as_float(rw.x << 16), __uint_as_float(rw.x & 0xffff0000u), __uint_as_float(rw.y << 16), __uint_as_float(rw.y & 0xffff0000u)};
            const float ss = red16_sum((x[0] * x[0] + x[1] * x[1]) + (x[2] * x[2] + x[3] * x[3]));
            const float rstd = 1.f / sqrtf(ss * (1.f / 64.f) + EPS);
            const f32x4 g = (vg < 2) ? gq : gk;
            float y[4], yr[4];
#pragma unroll
            for (int i = 0; i < 4; ++i) y[i] = x[i] * rstd * g[i];
#pragma unroll
            for (int i = 0; i < 4; ++i) { const float partner = dppf<0x4E>(y[i]); yr[i] = (li < 4) ? (y[i] * cs[i] + sgn * partner * sn[i]) : y[i]; }
            {
                u32x2 o; o.x = pk2(yr[0], yr[1]); o.y = pk2(yr[2], yr[3]);
                bf16_t* dst = (bf16_t*)(ws + (vec < 2 ? WS_KS : WS_KW)) + ((size_t)(b * 2 + (vec & 1)) * SEQ + (t & (SEQ - 1))) * 64 + 4 * li;
                *(u32x2*)dst = o;
            }
        }
    }
    __syncthreads();
    { const int tk = tid >> 3, ch = tid & 7, tkp = (tk & ~12) | ((tk & 4) << 1) | ((tk & 8) >> 1);
#pragma unroll
      for (int v = 0; v < 4; ++v) { LAS bf16_t* T = (LAS bf16_t*)lds + v * (64 * 72);
#pragma unroll
          for (int q = 0; q < 4; ++q) { const unsigned wv = vraw[v][q]; T[(8 * ch + 2 * q) * 72 + tkp] = (bf16_t)(wv & 0xffffu); T[(8 * ch + 2 * q + 1) * 72 + tkp] = (bf16_t)(wv >> 16); } } }
    __syncthreads();
    { const int d = tid >> 3, ch = tid & 7;
#pragma unroll
      for (int v = 0; v < 4; ++v) { const LAS bf16_t* T = (const LAS bf16_t*)lds + v * (64 * 72);
          const u32x4 o = *(const LAS u32x4*)(T + d * 72 + 8 * ch);
          bf16_t* dst = (bf16_t*)(ws + (v < 2 ? WS_VST : WS_VWT)) + (((size_t)(b * 2 + (v & 1)) * 32 + blkc) * 64 + d) * 64 + 8 * ch;
          *(u32x4*)dst = o; } }
}

__device__ __forceinline__ void p2b_unit(const Params& p, LAS unsigned char* lds, int unit) {
    const int tid = opaque_tid(), lane = tid & 63, w = tid >> 6, fr = lane & 15, fq = lane >> 4;
    unsigned char* ws = p.ws;
    const bf16_t* PROJ = (const bf16_t*)(ws + WS_PROJ);
    const int which = unit >> 6, rt = unit & 63;
    const bf16_t* W1T = (const bf16_t*)(ws + (which ? WS_CW1V : WS_CW1K));
    const bf16_t* W2T = (const bf16_t*)(ws + (which ? WS_CW2V : WS_CW2K));
    const float* cb = (const float*)(ws + WS_CBIAS) + which * 256;
    const int colbase = which ? CVC : CKC;
    LAS bf16_t* Hd = (LAS bf16_t*)lds;
    LAS float* Of = (LAS float*)(lds + 64 * 264 * 2);
    LAS bf16_t* AT = (LAS bf16_t*)(lds + 65536);
    const bf16_t* asrc;
    { const int ar = tid >> 3, R = rt * 64 + ar; const int bb = R >> 8, kh = (R >> 7) & 1; int n = R & 127; if (n > 126) n = 126;
      asrc = PROJ + (size_t)(bb * SEQ + 16 * n) * NPROJ + colbase + kh * 64 + 8 * (tid & 7); }
    const bf16_t* brow[2];
#pragma unroll
    for (int nf = 0; nf < 2; ++nf) brow[nf] = W1T + (size_t)(32 * w + 16 * nf + fr) * 2048 + 8 * fq;
    f32x4 acc[4][2];
#pragma unroll
    for (int m = 0; m < 4; ++m)
#pragma unroll
        for (int nf = 0; nf < 2; ++nf) acc[m][nf] = (f32x4){0.f, 0.f, 0.f, 0.f};
    bf16x8 bring[8][2][2];
    u32x4 astage[2];
#define P2B_BLOAD(slot, kt) do { _Pragma("unroll") for (int nf = 0; nf < 2; ++nf) _Pragma("unroll") for (int k2 = 0; k2 < 2; ++k2) bring[slot][nf][k2] = *(const bf16x8*)(brow[nf] + 64 * (kt) + 32 * k2); } while (0)
#pragma unroll
    for (int q = 0; q < 8; ++q) P2B_BLOAD(q, q);
    astage[0] = *(const u32x4*)asrc; astage[1] = *(const u32x4*)(asrc + NPROJ);
    __syncthreads();
    *(LAS u32x4*)(AT + (tid >> 3) * 72 + 8 * (tid & 7)) = astage[0];
    astage[0] = *(const u32x4*)(asrc + 2 * (size_t)NPROJ);
    BAR_LDS();
#pragma unroll 1
    for (int kt0 = 0; kt0 < 32; kt0 += 8) {
#pragma unroll
        for (int q = 0; q < 8; ++q) {
            const int kt = kt0 + q;
            const LAS bf16_t* At = AT + (kt & 1) * (64 * 72);
#pragma unroll
            for (int k2 = 0; k2 < 2; ++k2) {
                bf16x8 a[4];
#pragma unroll
                for (int m = 0; m < 4; ++m) a[m] = *(const LAS bf16x8*)(At + (16 * m + fr) * 72 + 32 * k2 + 8 * fq);
#pragma unroll
                for (int m = 0; m < 4; ++m)
#pragma unroll
                    for (int nf = 0; nf < 2; ++nf) acc[m][nf] = __builtin_amdgcn_mfma_f32_16x16x32_bf16(a[m], bring[q][nf][k2], acc[m][nf], 0, 0, 0);
            }
            if (kt + 8 < 32) P2B_BLOAD(q, kt + 8);
            if (kt + 1 < 32) {
                *(LAS u32x4*)(AT + ((kt + 1) & 1) * (64 * 72) + (tid >> 3) * 72 + 8 * (tid & 7)) = astage[(q + 1) & 1];
                if (kt + 3 < 32) astage[(q + 1) & 1] = *(const u32x4*)(asrc + (size_t)(kt + 3) * NPROJ);
                BAR_LDS();
            }
        }
    }
#undef P2B_BLOAD
#pragma unroll
    for (int nf = 0; nf < 2; ++nf) { const int col = 32 * w + 16 * nf + fr; const float bias = cb[col];
#pragma unroll
        for (int m = 0; m < 4; ++m)
#pragma unroll
            for (int j = 0; j < 4; ++j) { const float hv = acc[m][nf][j] + bias; Hd[(16 * m + 4 * fq + j) * 264 + col] = (bf16_t)f2bf(hv * sigmoidf_(hv)); } }
    __syncthreads();
    {
        const int m2 = w >> 1;
        f32x4 acc2[2] = {(f32x4){0.f, 0.f, 0.f, 0.f}, (f32x4){0.f, 0.f, 0.f, 0.f}};
#pragma unroll
        for (int ks = 0; ks < 8; ++ks) {
            const bf16x8 a = *(const LAS bf16x8*)(Hd + (16 * m2 + fr) * 264 + 32 * ks + 8 * fq);
#pragma unroll
            for (int q = 0; q < 2; ++q) { const int nf2 = 2 * (w & 1) + q; const bf16x8 bv = *(const bf16x8*)(W2T + (size_t)(16 * nf2 + fr) * 256 + 32 * ks + 8 * fq);
                acc2[q] = __builtin_amdgcn_mfma_f32_16x16x32_bf16(a, bv, acc2[q], 0, 0, 0); }
        }
#pragma unroll
        for (int q = 0; q < 2; ++q) { const int nf2 = 2 * (w & 1) + q;
#pragma unroll
            for (int j = 0; j < 4; ++j) Of[(16 * m2 + 4 * fq + j) * 65 + 16 * nf2 + fr] = acc2[q][j]; }
    }
    __syncthreads();
    for (int rr = 0; rr < 8; ++rr) {
        const int r = 8 * w + rr, R = rt * 64 + r, bb = R >> 8, kh = (R >> 7) & 1, n = R & 127;
        float v = Of[r * 65 + lane];
        if (which == 0) {
            const float ss = wave_sum(v * v);
            v = v * (1.f / sqrtf(ss * (1.f / 64.f) + EPS)) * p.in[5][lane];
            if (n == 127) v = 0.f;
            ((bf16_t*)(ws + WS_KC))[((size_t)(bb * 2 + kh) * 128 + n) * 64 + lane] = (bf16_t)f2bf(v);
        } else {
            if (n == 127) v = 0.f;
            ((bf16_t*)(ws + WS_VCT))[((size_t)(bb * 2 + kh) * 64 + lane) * 128 + ((n & ~12) | ((n & 4) << 1) | ((n & 8) >> 1))] = (bf16_t)f2bf(v);
        }
    }
    __syncthreads();
}

typedef float f32x16 __attribute__((ext_vector_type(16)));
constexpr int NSA_KT0 = 0, NSA_VT0 = 9216, NSA_KT1 = 18432, NSA_VT1 = 27648, NSA_IMPW = 36864, NSA_SELM = NSA_IMPW + 4 * 64 * 33 * 4, NSA_UNI = NSA_SELM + 256,
              NSA_OUT = NSA_UNI + 256;
static_assert(NSA_OUT + 256 * 68 * 4 <= LDS_BYTES - 64, "NSA LDS map");
constexpr float NEGBIG = -1e30f;
#define MFMA32(a, b, c) __builtin_amdgcn_mfma_f32_32x32x16_bf16((a), (b), (c), 0, 0, 0)

__device__ __forceinline__ bf16x8 pack_step(const f32x16& x, int s) {
    u32x4 p;
#pragma unroll
    for (int q = 0; q < 4; ++q) p[q] = pk2(x[8 * s + 2 * q], x[8 * s + 2 * q + 1]);
    return __builtin_bit_cast(bf16x8, p);
}
template <bool ZERO = false>
__device__ __forceinline__ void nsa_qk(const bf16x8 (&bq)[4], const LAS bf16_t* KT, f32x16 (&X)[2], int r, int h, float init = 0.f) {
    bf16x8 a[2][4];
#pragma unroll
    for (int kt = 0; kt < 2; ++kt)
#pragma unroll
        for (int ks = 0; ks < 4; ++ks) a[kt][ks] = *(const LAS bf16x8*)(KT + (32 * kt + r) * 72 + 16 * ks + 8 * h);
    __builtin_amdgcn_sched_barrier(0);
    f32x16 x0, x1;
#pragma unroll
    for (int i = 0; i < 16; ++i) { x0[i] = ZERO ? 0.f : init; x1[i] = ZERO ? 0.f : init; }
#pragma unroll
    for (int ks = 0; ks < 4; ++ks) { x0 = MFMA32(a[0][ks], bq[ks], x0); x1 = MFMA32(a[1][ks], bq[ks], x1); }
    X[0] = x0; X[1] = x1;
}
__device__ __forceinline__ void nsa_bounds(int mode, bool rok, int i, int cq, int koff, int& lo, int& hi) {
    hi = (mode == 1) ? i : ((mode == 3) ? (((cq + i - 31) >> 4) - koff) : 63);
    lo = (mode == 2) ? i + 1 : 0;
    hi = rok ? hi : -1;
}
__device__ __forceinline__ void nsa_tile(int MM, const bf16x8 (&bq)[4], const LAS bf16_t* KT, const LAS bf16_t* VT, float& lsum, f32x16 (&O)[2],
                                         bool rok, int mode, int iq, int cq, int koff, int r_, int h_) {
    int r = r_, h = h_;
    asm volatile("" : "+v"(r), "+v"(h));
    f32x16 X[2];
    bf16x8 vf[2][2][2];
#pragma unroll
    for (int dt = 0; dt < 2; ++dt)
#pragma unroll
        for (int kt = 0; kt < 2; ++kt)
#pragma unroll
            for (int s = 0; s < 2; ++s) vf[dt][kt][s] = *(const LAS bf16x8*)(VT + (32 * dt + r) * 72 + 32 * kt + 16 * s + 8 * h);
    if (MM == 1) nsa_qk<false>(bq, KT, X, r, h, rok ? 0.f : NEGBIG);
    else nsa_qk<true>(bq, KT, X, r, h);
#pragma unroll
    for (int kt = 0; kt < 2; ++kt)
#pragma unroll
        for (int i = 0; i < 16; ++i) X[kt][i] = __builtin_amdgcn_exp2f(X[kt][i]);
    if (MM == 2) {
        int lo, hi; nsa_bounds(mode, rok, iq, cq, koff, lo, hi);
#pragma unroll
        for (int kt = 0; kt < 2; ++kt)
#pragma unroll
            for (int i = 0; i < 16; ++i) { const int key = 32 * kt + (i & 3) + 8 * (i >> 2) + 4 * h; X[kt][i] = ((key >= lo) & (key <= hi)) ? X[kt][i] : 0.f; }
    }
    bf16x8 pf[2][2];
    float ls = 0.f;
#pragma unroll
    for (int kt = 0; kt < 2; ++kt) {
#pragma unroll
        for (int i = 0; i < 16; i += 4) ls += (X[kt][i] + X[kt][i + 1]) + (X[kt][i + 2] + X[kt][i + 3]);
        pf[kt][0] = pack_step(X[kt], 0); pf[kt][1] = pack_step(X[kt], 1);
    }
    lsum += ls;
#pragma unroll
    for (int kt = 0; kt < 2; ++kt)
#pragma unroll
        for (int s = 0; s < 2; ++s)
#pragma unroll
            for (int dt = 0; dt < 2; ++dt) O[dt] = MFMA32(vf[dt][kt][s], pf[kt][s], O[dt]);
}
__device__ __forceinline__ void nsa_tile_half(int kt, const bf16x8 (&bq)[4], const LAS bf16_t* KT, const LAS bf16_t* VT, float& lsum, f32x16 (&O)[2], int mode, int iq, int r_, int h_) {
    int r = r_, h = h_;
    asm volatile("" : "+v"(r), "+v"(h));
    bf16x8 a[4], vf[2][2];
#pragma unroll
    for (int ks = 0; ks < 4; ++ks) a[ks] = *(const LAS bf16x8*)(KT + (32 * kt + r) * 72 + 16 * ks + 8 * h);
#pragma unroll
    for (int dt = 0; dt < 2; ++dt)
#pragma unroll
        for (int s2 = 0; s2 < 2; ++s2) vf[dt][s2] = *(const LAS bf16x8*)(VT + (32 * dt + r) * 72 + 32 * kt + 16 * s2 + 8 * h);
    f32x16 x;
#pragma unroll
    for (int i = 0; i < 16; ++i) x[i] = 0.f;
#pragma unroll
    for (int ks = 0; ks < 4; ++ks) x = MFMA32(a[ks], bq[ks], x);
#pragma unroll
    for (int i = 0; i < 16; ++i) x[i] = __builtin_amdgcn_exp2f(x[i]);
    int lo, hi; nsa_bounds(mode, true, iq, 0, 0, lo, hi);
#pragma unroll
    for (int i = 0; i < 16; ++i) { const int key = 32 * kt + (i & 3) + 8 * (i >> 2) + 4 * h; x[i] = ((key >= lo) & (key <= hi)) ? x[i] : 0.f; }
    float ls = 0.f;
#pragma unroll
    for (int i = 0; i < 16; i += 4) ls += (x[i] + x[i + 1]) + (x[i + 2] + x[i + 3]);
    lsum += ls;
    const bf16x8 p0 = pack_step(x, 0), p1 = pack_step(x, 1);
#pragma unroll
    for (int dt = 0; dt < 2; ++dt) { O[dt] = MFMA32(vf[dt][0], p0, O[dt]); O[dt] = MFMA32(vf[dt][1], p1, O[dt]); }
}
__device__ __forceinline__ void nsa_tile_cmp(const bf16x8 (&bq)[4], const LAS bf16_t* KT, const LAS bf16_t* VT, float& lsum, f32x16 (&O)[2], float& carry, LAS float* impw_row,
                                             int half, int iq, int cq, int r_, int h_) {
    int r = r_, h = h_;
    asm volatile("" : "+v"(r), "+v"(h));
    f32x16 X[2];
    bf16x8 vf[2][2][2];
#pragma unroll
    for (int dt = 0; dt < 2; ++dt)
#pragma unroll
        for (int kt = 0; kt < 2; ++kt)
#pragma unroll
            for (int s = 0; s < 2; ++s) vf[dt][kt][s] = *(const LAS bf16x8*)(VT + (32 * dt + r) * 72 + 32 * kt + 16 * s + 8 * h);
    nsa_qk<true>(bq, KT, X, r, h);
#pragma unroll
    for (int kt = 0; kt < 2; ++kt)
#pragma unroll
        for (int i = 0; i < 16; ++i) X[kt][i] = __builtin_amdgcn_exp2f(X[kt][i]);
    const int hi = ((cq + iq - 31) >> 4) - 64 * half;
#pragma unroll
    for (int kt = 0; kt < 2; ++kt)
#pragma unroll
        for (int i = 0; i < 16; ++i) { const int key = 32 * kt + (i & 3) + 8 * (i >> 2) + 4 * h; X[kt][i] = (key <= hi) ? X[kt][i] : 0.f; }
    bf16x8 pf[2][2];
    float ls = 0.f;
#pragma unroll
    for (int kt = 0; kt < 2; ++kt) {
#pragma unroll
        for (int gq = 0; gq < 4; ++gq) {
            const float gsum = (X[kt][4 * gq] + X[kt][4 * gq + 1]) + (X[kt][4 * gq + 2] + X[kt][4 * gq + 3]);
            const float send = (h == 0) ? X[kt][4 * gq + 3] : (gq > 0 ? X[kt][4 * gq - 1] : carry);
            const float extra = __shfl_xor(send, 32);
            impw_row[16 * half + 8 * kt + 2 * gq + h] = gsum + extra;
            ls += gsum;
        }
        carry = X[kt][15];
        pf[kt][0] = pack_step(X[kt], 0); pf[kt][1] = pack_step(X[kt], 1);
    }
    lsum += ls;
#pragma unroll
    for (int kt = 0; kt < 2; ++kt)
#pragma unroll
        for (int s = 0; s < 2; ++s)
#pragma unroll
            for (int dt = 0; dt < 2; ++dt) O[dt] = MFMA32(vf[dt][kt][s], pf[kt][s], O[dt]);
}
struct NsaStage { u32x4 k, v; };
__device__ __forceinline__ void nsa_fetch(NsaStage& st, const bf16_t* Ksrc, int kstride, const bf16_t* Vsrc, int vstride, int tid) {
    const int r = tid >> 3, ch = tid & 7;
    st.k = *(const u32x4*)(Ksrc + (size_t)r * kstride + 8 * ch);
    st.v = *(const u32x4*)(Vsrc + (size_t)r * vstride + 8 * ch);
}
__device__ __forceinline__ void nsa_commit(const NsaStage& st, LAS bf16_t* KT, LAS bf16_t* VT, int tid) {
    const int r = tid >> 3, ch = tid & 7;
    *(LAS u32x4*)(KT + r * 72 + 8 * ch) = st.k;
    *(LAS u32x4*)(VT + r * 72 + 8 * ch) = st.v;
}
template <bool FIRST>
__device__ __forceinline__ void nsa_out_acc(LAS float* OUTw, const f32x16 (&O)[2], float sc, int r, int h) {
#pragma unroll
    for (int dt = 0; dt < 2; ++dt)
#pragma unroll
        for (int gq = 0; gq < 4; ++gq) {
            LAS f32x4* dst = (LAS f32x4*)(OUTw + r * 68 + 32 * dt + 8 * gq + 4 * h);
            f32x4 v = (f32x4){O[dt][4 * gq] * sc, O[dt][4 * gq + 1] * sc, O[dt][4 * gq + 2] * sc, O[dt][4 * gq + 3] * sc};
            if (!FIRST) v += *dst;
            *dst = v;
        }
}

__device__ __forceinline__ void nsa_unit(const Params& p, LAS unsigned char* lds, int b, int kh, int c) {
    const int tid = opaque_tid(), lane = tid & 63, w = tid >> 6, r = lane & 31, h = lane >> 5, g = w & 3, ih = w >> 2;
    unsigned char* ws = p.ws;
    const int hh = kh * 4 + g, tok0 = b * SEQ + 64 * c, ibase = 32 * ih, iq = ibase + r, tq = tok0 + iq;
    const bf16_t* PROJ = (const bf16_t*)(ws + WS_PROJ);
    LAS float* IMPW = (LAS float*)(lds + NSA_IMPW);
    LAS unsigned* SELM = (LAS unsigned*)(lds + NSA_SELM); LAS unsigned* UNI = (LAS unsigned*)(lds + NSA_UNI);
    LAS float* OUTw = (LAS float*)(lds + NSA_OUT) + (w * 32) * 68;
    const size_t bk = (size_t)(b * 2 + kh);
#define NSA_KTB(bb) ((LAS bf16_t*)(lds + ((bb) ? NSA_KT1 : NSA_KT0)))
#define NSA_VTB(bb) ((LAS bf16_t*)(lds + ((bb) ? NSA_VT1 : NSA_VT0)))
    bf16x8 bq[4], bq0r;
    NsaStage st;
    if (tid == 0) *UNI = 0u;
    const bf16_t* gp = PROJ + (size_t)tq * NPROJ + CGATE + hh * 3;
    const float gate0 = sigmoidf_(bf2f(gp[0])), gate1 = sigmoidf_(bf2f(gp[1])), gate2 = sigmoidf_(bf2f(gp[2]));
    {
        {
            u32x4 qraw[4];
#pragma unroll
            for (int ks = 0; ks < 4; ++ks) qraw[ks] = *(const u32x4*)(PROJ + (size_t)tq * NPROJ + CQ + hh * 64 + 16 * ks + 8 * h);
            const float pos = (float)((const int*)p.in[1])[tq];
            float ss = 0.f;
#pragma unroll
            for (int ks = 0; ks < 4; ++ks)
#pragma unroll
                for (int q2 = 0; q2 < 4; ++q2) { const float a = bflo(qraw[ks][q2]), b2 = bfhi(qraw[ks][q2]); ss += a * a + b2 * b2; }
            ss += __shfl_xor(ss, 32);
            const float rs = (1.f / sqrtf(ss * (1.f / 64.f) + EPS)) * (0.125f * 1.4426950408889634f);
            float y0[8];
#pragma unroll
            for (int ks = 0; ks < 4; ++ks) {
                const f32x4 g0 = *(const f32x4*)(p.in[4] + 16 * ks + 8 * h), g1 = *(const f32x4*)(p.in[4] + 16 * ks + 8 * h + 4);
                float y[8];
#pragma unroll
                for (int q2 = 0; q2 < 4; ++q2) { y[2 * q2] = bflo(qraw[ks][q2]) * rs * (q2 < 2 ? g0[2 * q2] : g1[2 * q2 - 4]); y[2 * q2 + 1] = bfhi(qraw[ks][q2]) * rs * (q2 < 2 ? g0[2 * q2 + 1] : g1[2 * q2 - 3]); }
                u32x4 o; o.x = pk2(y[0], y[1]); o.y = pk2(y[2], y[3]); o.z = pk2(y[4], y[5]); o.w = pk2(y[6], y[7]);
                bq[ks] = __builtin_bit_cast(bf16x8, o);
                if (ks == 0) {
#pragma unroll
                    for (int j = 0; j < 8; ++j) y0[j] = y[j]; }
            }
            float yr[8];
#pragma unroll
            for (int j = 0; j < 8; ++j) {
                const float ang = pos * __expf(-13.122363377404328f * (float)(2 * j) * (1.f / 16.f));
                const float partner = __shfl_xor(y0[j], 32);
                yr[j] = y0[j] * __cosf(ang) + (h ? partner : -partner) * __sinf(ang);
            }
            u32x4 o; o.x = pk2(yr[0], yr[1]); o.y = pk2(yr[2], yr[3]); o.z = pk2(yr[4], yr[5]); o.w = pk2(yr[6], yr[7]);
            bq0r = __builtin_bit_cast(bf16x8, o);
        }
        const int nh = (4 * c + 2 >= 64) ? 2 : 1;
        const bf16_t* KCb = (const bf16_t*)(ws + WS_KC) + bk * 128 * 64; const bf16_t* VCb = (const bf16_t*)(ws + WS_VCT) + bk * 64 * 128;
        float lsum = 0.f; f32x16 O[2];
#pragma unroll
        for (int dt = 0; dt < 2; ++dt)
#pragma unroll
            for (int i = 0; i < 16; ++i) O[dt][i] = 0.f;
        nsa_fetch(st, KCb, 64, VCb, 128, tid);
        BAR_LDS();
        nsa_commit(st, NSA_KTB(0), NSA_VTB(0), tid);
        if (nh == 2) { nsa_fetch(st, KCb + 64 * 64, 64, VCb + 64, 128, tid); nsa_commit(st, NSA_KTB(1), NSA_VTB(1), tid); }
        BAR_LDS();
        float carry = 0.f;
        for (int half = 0; half < nh; ++half) nsa_tile_cmp(bq, NSA_KTB(half), NSA_VTB(half), lsum, O, carry, IMPW + (g * 64 + iq) * 33, half, iq, 64 * c, r, h);
        const float lt = lsum + __shfl_xor(lsum, 32);
        const float inv = lt > 0.f ? 1.f / lt : 0.f;
        nsa_out_acc<true>(OUTw, O, gate0 * inv, r, h);
        if (h == 0) IMPW[(g * 64 + iq) * 33 + 32] = inv;
    }
    BAR_LDS();
    {
        LAS float* SC = (LAS float*)(lds + NSA_KT0);
#pragma unroll
        for (int q = 0; q < 4; ++q) { const int pr = q * NTHREADS + tid, i = pr >> 5, j = pr & 31;
            float v = NEGBIG;
            if (j <= c) { v = (IMPW[(0 * 64 + i) * 33 + j] * IMPW[(0 * 64 + i) * 33 + 32] + IMPW[(1 * 64 + i) * 33 + j] * IMPW[(1 * 64 + i) * 33 + 32]) + (IMPW[(2 * 64 + i) * 33 + j] * IMPW[(2 * 64 + i) * 33 + 32] + IMPW[(3 * 64 + i) * 33 + j] * IMPW[(3 * 64 + i) * 33 + 32]);
                if (j == 0 || j == c || j == c - 1) v += 1e4f; }
            SC[i * 33 + j] = v; }
        BAR_LDS();
        const int kmax = (c + 8) & ~7;
#pragma unroll 1
        for (int q = 0; q < 4; ++q) { const int pr = q * NTHREADS + tid, i = pr >> 5, j = pr & 31;
            const float my = SC[i * 33 + j]; int rank = 0;
#pragma unroll 1
            for (int k0 = 0; k0 < kmax; k0 += 8) {
#pragma unroll
                for (int kk = 0; kk < 8; ++kk) { const int k = k0 + kk; const float o = SC[i * 33 + k]; rank += (o > my || (o == my && k < j)) ? 1 : 0; } }
            const bool sel = (j <= c) && rank < 8;
            const unsigned long long bal = __ballot(sel);
            const unsigned msk = (lane & 32) ? (unsigned)(bal >> 32) : (unsigned)bal;
            if (j == 0) { SELM[i] = msk; atomicOr((unsigned*)UNI, msk); } }
    }
    BAR_LDS();
    const unsigned uni = *UNI;
    const unsigned mysel = SELM[iq];
    bq[0] = bq0r;
#pragma unroll 1
    for (int br = 0; br < 2; ++br) {
        float lsum = 0.f; f32x16 O[2];
#pragma unroll
        for (int dt = 0; dt < 2; ++dt)
#pragma unroll
            for (int i = 0; i < 16; ++i) O[dt][i] = 0.f;
        const bf16_t* Kb = (const bf16_t*)(ws + (br ? WS_KW : WS_KS)) + bk * SEQ * 64;
        const bf16_t* Vb = (const bf16_t*)(ws + (br ? WS_VWT : WS_VST)) + bk * 32 * 4096;
        unsigned todo = br ? ((c >= 8 ? (0x1ffu << (c - 8)) : ((2u << c) - 1u))) : (uni & ((c == 31) ? 0xffffffffu : ((2u << c) - 1u)));
#define NSA_POP(dst) do { if (todo) { dst = __builtin_ctz(todo); todo &= todo - 1u; } else dst = -1; } while (0)
#define NSA_FETCH(stg, t) nsa_fetch(stg, Kb + (size_t)(t) * 4096, 64, Vb + (size_t)(t) * 4096, 64, tid)
#define NSA_COMPUTE(t, bufi) do { bool rok = true; int mode = 0, mm = 0; \
            if ((t) == c) { mode = 1; mm = 2; } \
            else if (br == 1) { if ((t) == c - 8) { mode = 2; mm = 2; } } \
            else if ((t) != 0 && (t) != c - 1) { rok = (mysel >> (t)) & 1u; mm = 1; } \
            if (mode == 1 && ih == 0) nsa_tile_half(0, bq, NSA_KTB(bufi), NSA_VTB(bufi), lsum, O, 1, iq, r, h);              \
            else if (mode == 2 && ih == 1) nsa_tile_half(1, bq, NSA_KTB(bufi), NSA_VTB(bufi), lsum, O, 2, iq, r, h);         \
            else nsa_tile(mm, bq, NSA_KTB(bufi), NSA_VTB(bufi), lsum, O, rok, mode, iq, 0, 0, r, h); } while (0)
        NsaStage stY;
        int t0, t1, t2, t3;
        NSA_POP(t0); NSA_POP(t1); NSA_POP(t2);
        NSA_FETCH(st, t0);
        BAR_LDS();
        nsa_commit(st, NSA_KTB(0), NSA_VTB(0), tid);
        if (t1 >= 0) NSA_FETCH(st, t1);
        if (t2 >= 0) NSA_FETCH(stY, t2);
        BAR_LDS();
        for (;;) {
            NSA_COMPUTE(t0, 0);
            if (t1 < 0) break;
            nsa_commit(st, NSA_KTB(1), NSA_VTB(1), tid);
            NSA_POP(t3); if (t3 >= 0) NSA_FETCH(st, t3);
            BAR_LDS();
            t0 = t1; t1 = t2; t2 = t3;
            NSA_COMPUTE(t0, 1);
            if (t1 < 0) break;
            nsa_commit(stY, NSA_KTB(0), NSA_VTB(0), tid);
            NSA_POP(t3); if (t3 >= 0) NSA_FETCH(stY, t3);
            BAR_LDS();
            t0 = t1; t1 = t2; t2 = t3;
        }
#undef NSA_POP
#undef NSA_FETCH
#undef NSA_COMPUTE
        const float lt = lsum + __shfl_xor(lsum, 32);
        nsa_out_acc<false>(OUTw, O, lt > 0.f ? (br ? gate2 : gate1) / lt : 0.f, r, h);
    }
    LDS_WAIT();
#pragma unroll
    for (int q = 0; q < 4; ++q) {
        const int rr = 8 * q + (lane >> 3), ch = lane & 7;
        const LAS f32x4* src = (const LAS f32x4*)(OUTw + rr * 68 + 8 * ch);
        const f32x4 a = src[0], bq2 = src[1];
        u32x2 o; o.x = pk4_fp8_sat(a[0] * ATT_SCALE, a[1] * ATT_SCALE, a[2] * ATT_SCALE, a[3] * ATT_SCALE); o.y = pk4_fp8_sat(bq2[0] * ATT_SCALE, bq2[1] * ATT_SCALE, bq2[2] * ATT_SCALE, bq2[3] * ATT_SCALE);
        *(u32x2*)(ws + WS_ATT + (size_t)(tok0 + ibase + rr) * 1024 + hh * 64 + 8 * ch) = o;
    }
#undef NSA_KTB
#undef NSA_VTB
}

constexpr int GLA_QD = 0, GLA_KD = 10240, GLA_KST = 20480, GLA_VT = 30720, GLA_AT = 51200, GLA_ST = 61440, GLA_WG = 81920  , GLA_DEC = 86016  ,
              GLA_OT = 86528  , GLA_END = GLA_OT + 64 * 132 * 4;
static_assert(GLA_END <= LDS_BYTES - 64, "GLA LDS map");
template <int CTRL, int RMASK> __device__ __forceinline__ float dppf_rm(float v) { return __int_as_float(__builtin_amdgcn_update_dpp(0, __float_as_int(v), CTRL, RMASK, 0xf, false)); }
__device__ __forceinline__ float wave_incl_scan(float v) {
    v += __int_as_float(__builtin_amdgcn_update_dpp(0, __float_as_int(v), 0x111, 0xf, 0xf, true));
    v += __int_as_float(__builtin_amdgcn_update_dpp(0, __float_as_int(v), 0x112, 0xf, 0xf, true));
    v += __int_as_float(__builtin_amdgcn_update_dpp(0, __float_as_int(v), 0x114, 0xf, 0xf, true));
    v += __int_as_float(__builtin_amdgcn_update_dpp(0, __float_as_int(v), 0x118, 0xf, 0xf, true));
    v += dppf_rm<0x142, 0xa>(v);
    v += dppf_rm<0x143, 0xc>(v);
    return v;
}
struct GlaStage { u32x4 q, k, g0, g1, v0, v1; };
__device__ __forceinline__ void gla_fetch(GlaStage& st, const bf16_t* PROJ, int tok0, int h, int lane, int w) {
    const bf16_t* row = PROJ + (size_t)(tok0 + lane) * NPROJ;
    st.q = *(const u32x4*)(row + CGQ + h * 64 + 8 * w);
    st.k = *(const u32x4*)(row + CGK + h * 64 + 8 * w);
    st.g0 = *(const u32x4*)(row + CGLR); st.g1 = *(const u32x4*)(row + CGLR + 8);
    st.v0 = *(const u32x4*)(row + CGV + h * 128 + 16 * w); st.v1 = *(const u32x4*)(row + CGV + h * 128 + 16 * w + 8);
}

__device__ __forceinline__ void gla_unit(const Params& p, LAS unsigned char* lds, int b, int h) {
    const int tid = opaque_tid(), lane = tid & 63, w = tid >> 6, fr = lane & 15, fq = lane >> 4;
    unsigned char* ws = p.ws;
    const bf16_t* PROJ = (const bf16_t*)(ws + WS_PROJ);
    LAS bf16_t* Qd = (LAS bf16_t*)(lds + GLA_QD); LAS bf16_t* Kd = (LAS bf16_t*)(lds + GLA_KD); LAS bf16_t* KsT = (LAS bf16_t*)(lds + GLA_KST);
    LAS bf16_t* VT = (LAS bf16_t*)(lds + GLA_VT); LAS bf16_t* At = (LAS bf16_t*)(lds + GLA_AT); LAS bf16_t* ST = (LAS bf16_t*)(lds + GLA_ST);
    LAS float* WG = (LAS float*)(lds + GLA_WG); LAS float* DEC = (LAS float*)(lds + GLA_DEC); LAS float* OT = (LAS float*)(lds + GLA_OT);
    BAR_LDS();
    for (int i = tid; i < 16 * 64; i += NTHREADS) WG[i] = p.in[12][(i >> 6) * 256 + h * 64 + (i & 63)];
    for (int i = tid; i < 128 * 80 / 2; i += NTHREADS) ((LAS unsigned*)ST)[i] = 0u;
    float bg[8];
#pragma unroll
    for (int q = 0; q < 8; ++q) bg[q] = p.in[13][h * 64 + 8 * w + q];
    const int md = w & 3, nfe0 = 4 * (w >> 2);
    f32x4 Sreg[4];
#pragma unroll
    for (int x = 0; x < 4; ++x) Sreg[x] = (f32x4){0.f, 0.f, 0.f, 0.f};
    GlaStage st;
    gla_fetch(st, PROJ, b * SEQ, h, lane, w);
    BAR_LDS();
#pragma unroll 1
    for (int n = 0; n < 32; ++n) {
        const int tok0 = b * SEQ + n * 64;
        float gl[16];
        { const unsigned gw[8] = {st.g0.x, st.g0.y, st.g0.z, st.g0.w, st.g1.x, st.g1.y, st.g1.z, st.g1.w};
#pragma unroll
          for (int q = 0; q < 8; ++q) { gl[2 * q] = bflo(gw[q]); gl[2 * q + 1] = bfhi(gw[q]); } }
        float bcum[8], blast[8];
#pragma unroll
        for (int q = 0; q < 8; ++q) {
            float x = bg[q];
#pragma unroll
            for (int r = 0; r < 16; ++r) x += gl[r] * WG[r * 64 + 8 * w + q];
            const float la = (fminf(x, 0.f) - __logf(1.f + __expf(-fabsf(x)))) * (1.f / 16.f);
            bcum[q] = wave_incl_scan(la);
            blast[q] = __int_as_float(__builtin_amdgcn_readlane(__float_as_int(bcum[q]), 63));
        }
        {
            const unsigned qw[4] = {st.q.x, st.q.y, st.q.z, st.q.w}, kw[4] = {st.k.x, st.k.y, st.k.z, st.k.w};
            unsigned qo[4], ko[4];
#pragma unroll
            for (int q2 = 0; q2 < 4; ++q2) {
                const float e0 = __expf(bcum[2 * q2]), e1 = __expf(bcum[2 * q2 + 1]);
                const float i0 = __expf(-bcum[2 * q2]), i1 = __expf(-bcum[2 * q2 + 1]);
                const float k0 = bflo(kw[q2]), k1 = bfhi(kw[q2]);
                qo[q2] = pg8::cvt_pk_bf16(bflo(qw[q2]) * 0.125f * e0, bfhi(qw[q2]) * 0.125f * e1);
                ko[q2] = pg8::cvt_pk_bf16(k0 * i0, k1 * i1);
                const float el0 = __int_as_float(__builtin_amdgcn_readlane(__float_as_int(e0), 63)), el1 = __int_as_float(__builtin_amdgcn_readlane(__float_as_int(e1), 63));
                KsT[(8 * w + 2 * q2) * 80 + lane] = (bf16_t)f2bf(k0 * (el0 * i0));
                KsT[(8 * w + 2 * q2 + 1) * 80 + lane] = (bf16_t)f2bf(k1 * (el1 * i1));
            }
            *(LAS u32x4*)(Qd + lane * 80 + 8 * w) = (u32x4){qo[0], qo[1], qo[2], qo[3]};
            *(LAS u32x4*)(Kd + lane * 80 + 8 * w) = (u32x4){ko[0], ko[1], ko[2], ko[3]};
            if (lane == 63) {
#pragma unroll
                for (int q = 0; q < 8; ++q) DEC[(n & 1) * 64 + 8 * w + q] = __expf(bcum[q]);
            }
            const unsigned vw[8] = {st.v0.x, st.v0.y, st.v0.z, st.v0.w, st.v1.x, st.v1.y, st.v1.z, st.v1.w};
#pragma unroll
            for (int q = 0; q < 8; ++q) { VT[(16 * w + 2 * q) * 80 + lane] = (bf16_t)(vw[q] & 0xffffu); VT[(16 * w + 2 * q + 1) * 80 + lane] = (bf16_t)(vw[q] >> 16); }
        }
        if (n < 31) gla_fetch(st, PROJ, tok0 + 64, h, lane, w);
        const int ec = tid >> 3, eg = tid & 7;
        const u32x4 r0 = *(const u32x4*)(PROJ + (size_t)(tok0 + ec) * NPROJ + CGR + h * 128 + 16 * eg), r1 = *(const u32x4*)(PROJ + (size_t)(tok0 + ec) * NPROJ + CGR + h * 128 + 16 * eg + 8);
        BAR_LDS();
        {
            const int m = w >> 1;
            bf16x8 a[2];
#pragma unroll
            for (int ks = 0; ks < 2; ++ks) a[ks] = *(const LAS bf16x8*)(Qd + (16 * m + fr) * 80 + 32 * ks + 8 * fq);
            bf16x8 bk[2][2];
#pragma unroll
            for (int x = 0; x < 2; ++x)
#pragma unroll
                for (int ks = 0; ks < 2; ++ks) bk[x][ks] = *(const LAS bf16x8*)(Kd + (16 * (2 * (w & 1) + x) + fr) * 80 + 32 * ks + 8 * fq);
#pragma unroll
            for (int x = 0; x < 2; ++x) { const int nf = 2 * (w & 1) + x;
                f32x4 s = (f32x4){0.f, 0.f, 0.f, 0.f};
                if (nf <= m) {
#pragma unroll
                    for (int ks = 0; ks < 2; ++ks) s = __builtin_amdgcn_mfma_f32_16x16x32_bf16(a[ks], bk[x][ks], s, 0, 0, 0);
                }
#pragma unroll
                for (int j = 0; j < 4; ++j) { const int cc = 16 * m + 4 * fq + j, ss = 16 * nf + fr; At[cc * 80 + ss] = (bf16_t)f2bf(ss <= cc ? s[j] : 0.f); } }
        }
        f32x4 U[4];
        {
            bf16x8 a[2];
#pragma unroll
            for (int ks = 0; ks < 2; ++ks) a[ks] = *(const LAS bf16x8*)(KsT + (16 * md + fr) * 80 + 32 * ks + 8 * fq);
            bf16x8 bv[4][2];
#pragma unroll
            for (int x = 0; x < 4; ++x)
#pragma unroll
                for (int ks = 0; ks < 2; ++ks) bv[x][ks] = *(const LAS bf16x8*)(VT + (16 * (nfe0 + x) + fr) * 80 + 32 * ks + 8 * fq);
#pragma unroll
            for (int x = 0; x < 4; ++x) { f32x4 s = (f32x4){0.f, 0.f, 0.f, 0.f};
#pragma unroll
                for (int ks = 0; ks < 2; ++ks) s = __builtin_amdgcn_mfma_f32_16x16x32_bf16(a[ks], bv[x][ks], s, 0, 0, 0);
                U[x] = s; }
        }
        BAR_LDS();
        {
            bf16x8 aa[2], aq2[2];
#pragma unroll
            for (int ks = 0; ks < 2; ++ks) { aa[ks] = *(const LAS bf16x8*)(At + (16 * md + fr) * 80 + 32 * ks + 8 * fq); aq2[ks] = *(const LAS bf16x8*)(Qd + (16 * md + fr) * 80 + 32 * ks + 8 * fq); }
            bf16x8 bv[4][2], bs[4][2];
#pragma unroll
            for (int x = 0; x < 4; ++x)
#pragma unroll
                for (int ks = 0; ks < 2; ++ks) { bv[x][ks] = *(const LAS bf16x8*)(VT + (16 * (nfe0 + x) + fr) * 80 + 32 * ks + 8 * fq); bs[x][ks] = *(const LAS bf16x8*)(ST + (16 * (nfe0 + x) + fr) * 80 + 32 * ks + 8 * fq); }
#pragma unroll
            for (int x = 0; x < 4; ++x) { f32x4 s = (f32x4){0.f, 0.f, 0.f, 0.f};
#pragma unroll
                for (int ks = 0; ks < 2; ++ks) s = __builtin_amdgcn_mfma_f32_16x16x32_bf16(aa[ks], bv[x][ks], s, 0, 0, 0);
#pragma unroll
                for (int ks = 0; ks < 2; ++ks) s = __builtin_amdgcn_mfma_f32_16x16x32_bf16(aq2[ks], bs[x][ks], s, 0, 0, 0);
#pragma unroll
                for (int j = 0; j < 4; ++j) OT[(16 * md + 4 * fq + j) * 132 + 16 * (nfe0 + x) + fr] = s[j]; }
        }
        BAR_LDS();
        {
            const LAS f32x4* dp = (const LAS f32x4*)(DEC + (n & 1) * 64 + 16 * md + 4 * fq); const f32x4 dc = dp[0];
#pragma unroll
            for (int x = 0; x < 4; ++x) { Sreg[x] = dc * Sreg[x] + U[x];
                u32x2 o; o.x = pg8::cvt_pk_bf16(Sreg[x][0], Sreg[x][1]); o.y = pg8::cvt_pk_bf16(Sreg[x][2], Sreg[x][3]);
                *(LAS u32x2*)(ST + (16 * (nfe0 + x) + fr) * 80 + 16 * md + 4 * fq) = o; }
        }
        {
            const LAS f32x4* op = (const LAS f32x4*)(OT + ec * 132 + 16 * eg);
            f32x4 o[4]; float ss = 0.f;
#pragma unroll
            for (int q = 0; q < 4; ++q) { o[q] = op[q]; ss += (o[q].x * o[q].x + o[q].y * o[q].y) + (o[q].z * o[q].z + o[q].w * o[q].w); }
            ss += dppf<0xB1>(ss); ss += dppf<0x4E>(ss); ss += dppf<0x141>(ss);
            const float rstd = 1.f / sqrtf(ss * (1.f / 128.f) + EPS);
            const unsigned rw[8] = {r0.x, r0.y, r0.z, r0.w, r1.x, r1.y, r1.z, r1.w};
            const float* gn = p.in[14] + 16 * eg;
            float yv[16];
            const float rs16 = rstd * ATT_SCALE;
#pragma unroll
            for (int q = 0; q < 8; ++q) { const float ra = bflo(rw[q]), rb = bfhi(rw[q]);
                yv[2 * q] = o[q >> 1][(2 * q) & 3] * rs16 * gn[2 * q] * (ra * sigmoidf_(ra)); yv[2 * q + 1] = o[q >> 1][(2 * q + 1) & 3] * rs16 * gn[2 * q + 1] * (rb * sigmoidf_(rb)); }
            u32x4 ow;
            ow.x = pk4_fp8_sat(yv[0], yv[1], yv[2], yv[3]); ow.y = pk4_fp8_sat(yv[4], yv[5], yv[6], yv[7]); ow.z = pk4_fp8_sat(yv[8], yv[9], yv[10], yv[11]); ow.w = pk4_fp8_sat(yv[12], yv[13], yv[14], yv[15]);
            *(u32x4*)(ws + WS_ATT + (size_t)(tok0 + ec) * 1024 + 512 + h * 128 + 16 * eg) = ow;
        }
    }
}

__device__ __forceinline__ void p6_chunk(const Params& p, LAS unsigned char* lds, int chunk) {
    int tid = opaque_tid(), lane = tid & 63, wave = tid >> 6, fr = lane & 15, fq = lane >> 4;
    unsigned char* ws = p.ws;
    LAS int* lcnt = (LAS int*)lds;
    LAS float* LG = (LAS float*)(lds + 256) + wave * (16 * 33 + 16);
    LAS float* RS = LG + 16 * 33;
    if (tid < NEXP) lcnt[tid] = 0;
    __syncthreads();
    const float* WRT = (const float*)(ws + WS_WRT);
    const bf16_t* X1 = (const bf16_t*)(ws + WS_X1);
    int t0 = chunk * 128 + wave * 16;
    {
        LAS bf16_t* WH = (LAS bf16_t*)(lds + 20480); LAS bf16_t* WLo = WH + 32 * 1032;
#pragma unroll 4
        for (int i = tid; i < NEXP * (DM / 4); i += NTHREADS) { const int e = i >> 8, c4 = i & 255; const f32x4 w = *(const f32x4*)(WRT + (size_t)e * DM + 4 * c4);
            u32x2 hi, lo; hi.x = pg8::cvt_pk_bf16(w.x, w.y); hi.y = pg8::cvt_pk_bf16(w.z, w.w);
            lo.x = pg8::cvt_pk_bf16(w.x - __uint_as_float(hi.x << 16), w.y - __uint_as_float(hi.x & 0xffff0000u)); lo.y = pg8::cvt_pk_bf16(w.z - __uint_as_float(hi.y << 16), w.w - __uint_as_float(hi.y & 0xffff0000u));
            *(LAS u32x2*)(WH + e * 1032 + 4 * c4) = hi; *(LAS u32x2*)(WLo + e * 1032 + 4 * c4) = lo; }
        const bf16_t* ap = X1 + (size_t)(t0 + fr) * DM + 8 * fq;
        u32x4 A[32];
#pragma unroll
        for (int q = 0; q < 32; ++q) A[q] = *(const u32x4*)(ap + 32 * q);
        __syncthreads();
        const LAS bf16_t* bh = WH + fr * 1032 + 8 * fq; const LAS bf16_t* bl = WLo + fr * 1032 + 8 * fq;
        f32x4 acc0 = (f32x4){0.f, 0.f, 0.f, 0.f}, acc1 = (f32x4){0.f, 0.f, 0.f, 0.f};
        float ssq = 0.f;
#pragma unroll
        for (int q = 0; q < 32; ++q) { const u32x4 a4 = A[q];
#pragma unroll
            for (int i = 0; i < 4; ++i) { const float lo = __uint_as_float(a4[i] << 16), hi = __uint_as_float(a4[i] & 0xffff0000u); ssq += lo * lo + hi * hi; }
            const bf16x8 ah = __builtin_bit_cast(bf16x8, a4);
            const bf16x8 bh0 = *(const LAS bf16x8*)(bh + 32 * q), bh1 = *(const LAS bf16x8*)(bh + 16 * 1032 + 32 * q), bl0 = *(const LAS bf16x8*)(bl + 32 * q), bl1 = *(const LAS bf16x8*)(bl + 16 * 1032 + 32 * q);
            acc0 = __builtin_amdgcn_mfma_f32_16x16x32_bf16(ah, bl0, acc0, 0, 0, 0); acc1 = __builtin_amdgcn_mfma_f32_16x16x32_bf16(ah, bl1, acc1, 0, 0, 0);
            acc0 = __builtin_amdgcn_mfma_f32_16x16x32_bf16(ah, bh0, acc0, 0, 0, 0); acc1 = __builtin_amdgcn_mfma_f32_16x16x32_bf16(ah, bh1, acc1, 0, 0, 0);
            __builtin_amdgcn_sched_barrier(0); }
        tid = opaque_tid(); lane = tid & 63; wave = tid >> 6; fr = lane & 15; fq = lane >> 4;
        LG = (LAS float*)(lds + 256) + wave * (16 * 33 + 16); RS = LG + 16 * 33; t0 = chunk * 128 + wave * 16;
        ssq += __shfl_xor(ssq, 16); ssq += __shfl_xor(ssq, 32);
        const float rstd = 1.f / sqrtf(ssq * (1.f / DM) + EPS);
        if (fq == 0) RS[fr] = rstd;
#pragma unroll
        for (int j = 0; j < 4; ++j) { LG[(4 * fq + j) * 33 + fr] = acc0[j]; LG[(4 * fq + j) * 33 + 16 + fr] = acc1[j]; }
    }
    LDS_WAIT();
    int myexp[4] = {0, 0, 0, 0}, myrank[4] = {0, 0, 0, 0};
    if (lane < 16) {
        const int t = t0 + lane; const float rstd = RS[lane];
        unsigned taken = 0u; float tv[4]; int te[4];
#pragma unroll
        for (int r = 0; r < 4; ++r) { float best = -3e38f; int be = 0;
#pragma unroll 8
            for (int e = 0; e < 32; ++e) { const float v = LG[lane * 33 + e] * rstd + p.in[18][e]; const bool can = !((taken >> e) & 1u); if (can && v > best) { best = v; be = e; } }
            taken |= 1u << be; tv[r] = best; te[r] = be; }
        const float e0 = 1.f, e1 = __expf(tv[1] - tv[0]), e2 = __expf(tv[2] - tv[0]), e3 = __expf(tv[3] - tv[0]);
        const float inv = 1.f / (e0 + e1 + e2 + e3);
        *(f32x4*)((float*)(ws + WS_TOPG) + (size_t)t * 4) = (f32x4){e0 * inv, e1 * inv, e2 * inv, e3 * inv};
#pragma unroll
        for (int k = 0; k < 4; ++k) { myexp[k] = te[k]; myrank[k] = atomicAdd((int*)&lcnt[te[k]], 1); }
    }
    {
        f32x4 gg[2][2];
#pragma unroll
        for (int j = 0; j < 2; ++j) { const f32x4* gr = (const f32x4*)(p.in[16] + 8 * (lane + 64 * j)); gg[j][0] = gr[0]; gg[j][1] = gr[1]; }
#pragma unroll 1
        for (int ti = 0; ti < 16; ti += 4) {
            u32x4 v[4][2];
#pragma unroll
            for (int r = 0; r < 4; ++r) { const u32x4* xr = (const u32x4*)(X1 + (size_t)(t0 + ti + r) * DM) + lane;
#pragma unroll
                for (int j = 0; j < 2; ++j) v[r][j] = xr[64 * j]; }
#pragma unroll
            for (int r = 0; r < 4; ++r) { const float rstd = RS[ti + r];
                u32x2* o8 = (u32x2*)(ws + WS_H + (size_t)(t0 + ti + r) * DM) + lane;
#pragma unroll
                for (int j = 0; j < 2; ++j) { const u32x4 w = v[r][j];
                    u32x2 o;
                    o.x = pk4_fp8(__uint_as_float(w.x << 16) * rstd * gg[j][0].x, __uint_as_float(w.x & 0xffff0000u) * rstd * gg[j][0].y, __uint_as_float(w.y << 16) * rstd * gg[j][0].z, __uint_as_float(w.y & 0xffff0000u) * rstd * gg[j][0].w);
                    o.y = pk4_fp8(__uint_as_float(w.z << 16) * rstd * gg[j][1].x, __uint_as_float(w.z & 0xffff0000u) * rstd * gg[j][1].y, __uint_as_float(w.w << 16) * rstd * gg[j][1].z, __uint_as_float(w.w & 0xffff0000u) * rstd * gg[j][1].w);
                    o8[64 * j] = o; } }
        }
    }
    __syncthreads();
    LAS int* lbase = lcnt + 32;
    if (tid < NEXP) lbase[tid] = atomicAdd((int*)(ws + WS_CTL) + CW_CNT + tid, lcnt[tid]);
    __syncthreads();
    if (lane < 16) {
        const int t = t0 + lane; int d[4];
#pragma unroll
        for (int k = 0; k < 4; ++k) { const int pos = lbase[myexp[k]] + myrank[k]; ((int*)(ws + WS_RL))[(size_t)myexp[k] * 32768 + pos] = t; d[k] = (myexp[k] << 16) | pos; }
        *(int4*)((int*)(ws + WS_DEST) + (size_t)t * 4) = make_int4(d[0], d[1], d[2], d[3]);
    }
    __syncthreads();
}

__device__ __forceinline__ int build_tile_table(const Params& p, LAS int* tstart, LAS int* tile_e) {
    const int tid = opaque_tid();
    const int* cnt = (const int*)(p.ws + WS_CTL) + CW_CNT;
    if (tid < 64) {
        const int c = tid < NEXP ? __hip_atomic_load(cnt + tid, __ATOMIC_RELAXED, __HIP_MEMORY_SCOPE_AGENT) : 0;
        const int t = (c + 255) >> 8;
        int inc = t;
#pragma unroll
        for (int o = 1; o < 32; o <<= 1) { const int up = __shfl_up(inc, o); if ((tid & 63) >= o) inc += up; }
        if (tid < NEXP) { tstart[tid] = inc - t; tstart[NEXP + 1 + tid] = c; }
        if (tid == NEXP - 1) tstart[NEXP] = inc;
    }
    __syncthreads();
    const int total = tstart[NEXP];
    for (int i = tid; i < total; i += NTHREADS) { int e = 0;
        for (int q = 1; q < NEXP; ++q) if (tstart[q] <= i) e = q;
        tile_e[i] = e; }
    __syncthreads();
    return total;
}

__device__ __forceinline__ void p10_tokens(const Params& p, int t0, int lane, const LAS int* tstart) {
    unsigned char* ws = p.ws;
    int4 d4[2]; f32x4 g4[2];
#pragma unroll
    for (int q = 0; q < 2; ++q) { d4[q] = *(const int4*)((const int*)(ws + WS_DEST) + (size_t)(t0 + q) * 4); g4[q] = *(const f32x4*)((const float*)(ws + WS_TOPG) + (size_t)(t0 + q) * 4); }
    f32x4 xa[2][4]; unsigned yv[2][4][4];
#pragma unroll
    for (int q = 0; q < 2; ++q) {
        const u32x2* xr = (const u32x2*)((const bf16_t*)(ws + WS_X1) + (size_t)(t0 + q) * DM) + lane;
#pragma unroll
        for (int i = 0; i < 4; ++i) { const u32x2 w = __builtin_nontemporal_load(xr + 64 * i); xa[q][i] = (f32x4){__uint_as_float(w.x << 16), __uint_as_float(w.x & 0xffff0000u), __uint_as_float(w.y << 16), __uint_as_float(w.y & 0xffff0000u)}; }
        const int dr[4] = {d4[q].x, d4[q].y, d4[q].z, d4[q].w};
        int dd[4];
#pragma unroll
        for (int k = 0; k < 4; ++k) dd[k] = tstart[dr[k] >> 16] * 256 + (dr[k] & 0xffff);
#pragma unroll
        for (int k = 0; k < 4; ++k)
#pragma unroll
            for (int i = 0; i < 4; ++i) yv[q][k][i] = __builtin_nontemporal_load((const unsigned*)(ws + WS_Y + (size_t)dd[k] * DM) + 64 * i + lane);
    }
#pragma unroll
    for (int q = 0; q < 2; ++q) {
        f32x4* orow = (f32x4*)(p.out + (size_t)(t0 + q) * DM) + lane;
        f32x4 a[4] = {xa[q][0], xa[q][1], xa[q][2], xa[q][3]};
#pragma unroll
        for (int k = 0; k < 4; ++k) { const float gk = g4[q][k] * (1.f / Y_SCALE);
#pragma unroll
            for (int i = 0; i < 4; ++i) { const auto lo = __builtin_amdgcn_cvt_pk_f32_fp8((int)yv[q][k][i], false), hi = __builtin_amdgcn_cvt_pk_f32_fp8((int)yv[q][k][i], true);
                a[i].x += gk * lo[0]; a[i].y += gk * lo[1]; a[i].z += gk * hi[0]; a[i].w += gk * hi[1]; } }
#pragma unroll
        for (int i = 0; i < 4; ++i) orow[64 * i] = a[i];
    }
}

#define XB_TMO      128
#define XB_XCNT(j)  (256  + 64 * (j))
#define XB_XSUB(j)  (1280 + 64 * (j))
#define XB_XGEN(j)  (2304 + 64 * (j))
#define XB_TOP      3328
#define XB_TOPGEN   3392
#define XCD_BAR_WORDS 3456
#define XB_SPIN_CAP (1u << 22)
__device__ __forceinline__ unsigned xb_ld(unsigned* p)              { return __hip_atomic_load(p, __ATOMIC_RELAXED, __HIP_MEMORY_SCOPE_AGENT); }
__device__ __forceinline__ unsigned xb_add(unsigned* p, unsigned v) { return __hip_atomic_fetch_add(p, v, __ATOMIC_RELAXED, __HIP_MEMORY_SCOPE_AGENT); }
__device__ __forceinline__ unsigned xb_xcc_id() { return (unsigned)__builtin_amdgcn_s_getreg((3 << 11) | 20) & 0xFu; }
#define XB_SPIN(cond, bar) do { unsigned _sp = 0; while (cond) { __builtin_amdgcn_s_sleep(1); \
    if ((++_sp & 255u) == 0u) { if (xb_ld(&(bar)[XB_TMO])) break; if (_sp > XB_SPIN_CAP) { atomicAdd(&(bar)[XB_TMO], 1u); break; } } } } while (0)
struct XcdBarrier { unsigned* bar; unsigned x; volatile LAS unsigned* st; };
__device__ __forceinline__ XcdBarrier xcd_barrier_post(unsigned* bar, volatile LAS unsigned* st) {
    XcdBarrier b; b.bar = bar; b.x = xb_xcc_id(); b.st = st;
    if (threadIdx.x == 0) (void)xb_add(&bar[XB_XCNT(b.x)], 1u);
    return b;
}
__device__ __forceinline__ void xcd_barrier_complete(unsigned* bar, unsigned x, unsigned& nloc, unsigned& nx) {
    const unsigned G = gridDim.x * gridDim.y * gridDim.z;
    unsigned sum, cnt, mine, sp = 0u;
    for (;;) {
        sum = 0u; cnt = 0u; mine = 0u;
#pragma unroll
        for (unsigned j = 0; j < 16; ++j) { const unsigned c = xb_ld(&bar[XB_XCNT(j)]); sum += c; cnt += (c > 0u) ? 1u : 0u; mine = (j == x) ? c : mine; }
        if (sum == G) break;
        __builtin_amdgcn_s_sleep(1);
        if ((++sp & 255u) == 0u) { if (xb_ld(&bar[XB_TMO])) break; if (sp > XB_SPIN_CAP) { atomicAdd(&bar[XB_TMO], 1u); break; } }
    }
    nloc = mine > 0u ? mine : 1u; nx = cnt > 0u ? cnt : 1u;
}
__device__ __forceinline__ void xcd_barrier(const XcdBarrier& b) {
    asm volatile("s_waitcnt vmcnt(0)" ::: "memory");
    __syncthreads();
    if (threadIdx.x == 0) {
        unsigned* bar = b.bar;
        __builtin_amdgcn_s_waitcnt(0);
        unsigned nloc = b.st[0], nx = b.st[1];
        if (nloc == 0u) { xcd_barrier_complete(bar, b.x, nloc, nx); b.st[0] = nloc; b.st[1] = nx; }
        const unsigned old = xb_add(&bar[XB_XSUB(b.x)], 1u);
        const unsigned gen = old / nloc;
        if (old + 1u == (gen + 1u) * nloc) {
            __builtin_amdgcn_fence(__ATOMIC_RELEASE, "agent");
            asm volatile("s_waitcnt vmcnt(0)" ::: "memory");
            const unsigned og = xb_add(&bar[XB_TOP], 1u);
            const unsigned tg = og / nx;
            if (og + 1u == (tg + 1u) * nx) xb_add(&bar[XB_TOPGEN], 1u);
            else XB_SPIN(xb_ld(&bar[XB_TOPGEN]) == tg, bar);
            __builtin_amdgcn_fence(__ATOMIC_ACQUIRE, "agent");
            xb_add(&bar[XB_XGEN(b.x)], 1u);
            asm volatile("s_waitcnt vmcnt(0)" ::: "memory");
        } else {
            XB_SPIN(xb_ld(&bar[XB_XGEN(b.x)]) == gen, bar);
            __builtin_amdgcn_fence(__ATOMIC_ACQUIRE, "agent");
            asm volatile("s_waitcnt vmcnt(0)" ::: "memory");
        }
    }
    __syncthreads();
}

template <int MODE>
__device__ __forceinline__ void wtile_load(f32x4 (&v)[16], const float* W, int Nsrc, int nblk, int item, int lane) {
    const int kb = item / nblk, nb = item % nblk, k0 = 64 * kb, n0 = 64 * nb;
    const int nq = 4 * (lane & 15), kg = lane >> 4;
    const int sc = colmap<MODE>(n0 + nq);
#pragma unroll
    for (int i = 0; i < 16; ++i) v[i] = __builtin_nontemporal_load((const f32x4*)(W + (size_t)(k0 + 16 * kg + i) * Nsrc + sc));
}
__device__ __forceinline__ void wtile_store_fp8(const f32x4 (&v)[16], int K, unsigned char* WT, int nblk, int item, int lane) {
    const int kb = item / nblk, nb = item % nblk, k0 = 64 * kb, n0 = 64 * nb;
    const int nq = 4 * (lane & 15), kg = lane >> 4;
#pragma unroll
    for (int j = 0; j < 4; ++j) {
        u32x4 o;
        o.x = pk4_fp8_sat(v[0][j] * 32.f, v[1][j] * 32.f, v[2][j] * 32.f, v[3][j] * 32.f);
        o.y = pk4_fp8_sat(v[4][j] * 32.f, v[5][j] * 32.f, v[6][j] * 32.f, v[7][j] * 32.f);
        o.z = pk4_fp8_sat(v[8][j] * 32.f, v[9][j] * 32.f, v[10][j] * 32.f, v[11][j] * 32.f);
        o.w = pk4_fp8_sat(v[12][j] * 32.f, v[13][j] * 32.f, v[14][j] * 32.f, v[15][j] * 32.f);
        *(u32x4*)(WT + (size_t)(n0 + nq + j) * K + k0 + 16 * kg) = o;
    }
}
__device__ __forceinline__ bool expert_weight_items(const Params& p, LAS unsigned char* lds, int max_grabs) {
    const int tid = opaque_tid(), lane = tid & 63, wave = tid >> 6;
    unsigned char* ws = p.ws;
    LAS float* scr = (LAS float*)(lds + wave * 16640);
    LAS int* qslot = (LAS int*)(lds + LDS_BYTES - 64);
    constexpr int I_GU = 8 * 32, I_DN = 8 * 16, N_GU = NEXP * I_GU, N_DN = NEXP * I_DN;
    for (int grab = 0; grab < max_grabs; ++grab) {
        __syncthreads();
        if (tid == 0) *qslot = (int)__hip_atomic_fetch_add((unsigned*)(ws + WS_CTL) + CW_QC, 8u, __ATOMIC_RELAXED, __HIP_MEMORY_SCOPE_AGENT);
        __syncthreads();
        const int base = *qslot;
        if (base >= N_GU + N_DN - 8 * MK_TAIL_GRABS) return true;
        f32x4 va[16], vb[16];
        int r = base + wave;
        if (r < N_GU) { const int e = r / I_GU, it = r % I_GU, ia = (2 * (it >> 5)) * 32 + (it & 31), ib = ia + 32;
            const float* W = p.in[19] + (size_t)e * 1024 * 2048; unsigned char* WT = ws + WS_WGU + (size_t)e * 2048 * 1024;
            transpose_load<2>(va, W, 2048, 32, ia, lane); transpose_load<2>(vb, W, 2048, 32, ib, lane);
            transpose_finish<true>(va, 1024, WT, 32, scr, ia, lane); transpose_finish<true>(vb, 1024, WT, 32, scr, ib, lane); }
        else { r -= N_GU; const int e = r / I_DN, it = r % I_DN, ia = (2 * (it >> 4)) * 16 + (it & 15), ib = ia + 16;
            const float* W = p.in[21] + (size_t)e * 1024 * 1024; unsigned char* WT = ws + WS_WD + (size_t)e * 1024 * 1024;
            transpose_load<0>(va, W, 1024, 16, ia, lane); transpose_load<0>(vb, W, 1024, 16, ib, lane);
            transpose_finish<true>(va, 1024, WT, 16, scr, ia, lane); transpose_finish<true>(vb, 1024, WT, 16, scr, ib, lane); }
    }
    return false;
}
__device__ __forceinline__ void expert_weight_tail(const Params& p, LAS unsigned char* lds) {
    const int tid = opaque_tid(), lane = tid & 63, wave = tid >> 6;
    unsigned char* ws = p.ws;
    LAS int* qslot = (LAS int*)(lds + LDS_BYTES - 64);
    constexpr int I_GU = 8 * 32, I_DN = 8 * 16, N_GU = NEXP * I_GU, N_DN = NEXP * I_DN;
    for (;;) {
        __syncthreads();
        if (tid == 0) *qslot = (int)__hip_atomic_fetch_add((unsigned*)(ws + WS_CTL) + CW_QC8, 8u, __ATOMIC_RELAXED, __HIP_MEMORY_SCOPE_AGENT);
        __syncthreads();
        const int base = *qslot;
        if (base >= 8 * MK_TAIL_GRABS) return;
        f32x4 va[16], vb[16];
        const int r = N_DN - 8 * MK_TAIL_GRABS + base + wave;
        const int e = r / I_DN, it = r % I_DN, ia = (2 * (it >> 4)) * 16 + (it & 15), ib = ia + 16;
        const float* W = p.in[21] + (size_t)e * 1024 * 1024; unsigned char* WT = ws + WS_WD + (size_t)e * 1024 * 1024;
        wtile_load<0>(va, W, 1024, 16, ia, lane); wtile_load<0>(vb, W, 1024, 16, ib, lane);
        wtile_store_fp8(va, 1024, WT, 16, ia, lane); wtile_store_fp8(vb, 1024, WT, 16, ib, lane);
    }
}

template <int ph> __device__ __forceinline__ void mk_phase(const Params& p, LAS unsigned char* lds, int blk, int G) {
    unsigned char* ws = p.ws;
    const int tid = opaque_tid();
    if constexpr (ph == 0) { phase0(p, lds, blk, G); }
    else if constexpr (ph == 1) {
        pg8::Gemm g{ws + WS_H, ws + WS_WIN, DM};
        pg8::StaticOrder S{MTOK / 256, NPROJ / 256, G, blk};
        pg8::EpiI8Bf16 E{(bf16_t*)(ws + WS_PROJ), NPROJ, (const float*)(ws + WS_ROWS), (const float*)(ws + WS_COLS)};
        pg8::gemm_phase<2>(lds, g, S, E);
    }
    else if constexpr (ph == 2) {
        LAS int* qslot = (LAS int*)(lds + LDS_BYTES - 64);
        if ((blk & 7) >= 4) expert_weight_items(p, lds, MK_P2_GRABS);
        for (;;) {
            __syncthreads();
            if (tid == 0) *qslot = (int)__hip_atomic_fetch_add((unsigned*)(ws + WS_CTL) + CW_Q2, 1u, __ATOMIC_RELAXED, __HIP_MEMORY_SCOPE_AGENT);
            __syncthreads();
            const int it = *qslot;
            if (it >= 128 + 512) break;
            if (it < 128) p2b_unit(p, lds, it); else p2a_unit(p, lds, it - 128);
        }
    }
    else if constexpr (ph == 3) {
        LAS int* qslot = (LAS int*)(lds + LDS_BYTES - 64);
        bool conv_done = false;
        for (;;) {
            if (!conv_done) conv_done = expert_weight_items(p, lds, MK_P3_GRABS);
            __syncthreads();
            if (tid == 0) *qslot = (int)__hip_atomic_fetch_add((unsigned*)(ws + WS_CTL) + CW_Q3, 1u, __ATOMIC_RELAXED, __HIP_MEMORY_SCOPE_AGENT);
            __syncthreads();
            const int it = *qslot;
            if (it >= 64 + 1024) break;
            if (it < 64) gla_unit(p, lds, it >> 2, it & 3);
            else { const int u = it - 64, c = 31 - (u >> 5), bkh = u & 31; nsa_unit(p, lds, bkh >> 1, bkh & 1, c); }
        }
        if (!conv_done) expert_weight_items(p, lds, 1 << 30);
    }
    else if constexpr (ph == 4) { }
    else if constexpr (ph == 5) {
        pg8::Gemm g{ws + WS_ATT, ws + WS_WOUT, DM};
        pg8::StaticOrder S{MTOK / 256, DM / 256, G, blk};
        pg8::EpiResBf16 E{p.in[0], (bf16_t*)(ws + WS_X1), DM, 1.f / (32.f * ATT_SCALE)};
        pg8::gemm_phase<1>(lds, g, S, E);
    }
    else if constexpr (ph == 6) { for (int ch = blk; ch < MTOK / 128; ch += G) p6_chunk(p, lds, ch); }
    else if constexpr (ph == 7) { }
    else if constexpr (ph == 8) {
        LAS int* tstart = (LAS int*)(lds + pg8::STAGE_BYTES); LAS int* tile_e = tstart + 80;
        const int total = build_tile_table(p, tstart, tile_e);
        pg8::Gemm g{ws + WS_H, ws + WS_WGU, DM};
        pg8::MoeGatherOrder S{total, 8, G, blk, tile_e, tstart, tstart + NEXP + 1, (const int*)(ws + WS_RL)};
        pg8::EpiSwiglu E{ws + WS_ACT, p.in[20], 8};
        pg8::gemm_phase<1>(lds, g, S, E);
        expert_weight_tail(p, lds);
    }
    else if constexpr (ph == 9) {
        LAS int* tstart = (LAS int*)(lds + pg8::STAGE_BYTES); LAS int* tile_e = tstart + 80;
#if MK_ONE_LAUNCH
        const int total = tstart[NEXP];
#else
        const int total = build_tile_table(p, tstart, tile_e);
#endif
        pg8::Gemm g{ws + WS_ACT, ws + WS_WD, DFF};
        pg8::MoeOrder S{total, 4, G, blk, tile_e};
        pg8::EpiDown E{ws + WS_Y, p.in[22], 4};
        pg8::gemm_phase<1>(lds, g, S, E);
    }
    else if constexpr (ph == 10) {
        LAS int* tstart = (LAS int*)(lds + pg8::STAGE_BYTES); LAS int* tile_e = tstart + 80;
#if !MK_ONE_LAUNCH
        build_tile_table(p, tstart, tile_e);
#else
        (void)tile_e;
#endif
        for (int t = (blk * 8 + (tid >> 6)) * 2; t < MTOK; t += G * 16) p10_tokens(p, t, tid & 63, tstart);
    }
}

constexpr int NPHASES = 11;

template <int PH> __global__ void __launch_bounds__(NTHREADS, 2) mk_one(Params p) {
    extern __shared__ __attribute__((aligned(16))) unsigned char lds_raw[];
    mk_phase<PH>(p, (LAS unsigned char*)lds_raw, blockIdx.x, gridDim.x);
}
#if MK_ONE_LAUNCH
#define MK_RUN(PH) mk_phase<PH>(p, lds, blk, G)
__global__ void __launch_bounds__(NTHREADS, 2) mk_fwd(Params p) {
    extern __shared__ __attribute__((aligned(16))) unsigned char lds_raw[];
    LAS unsigned char* lds = (LAS unsigned char*)lds_raw;
    const int blk = blockIdx.x, G = gridDim.x;
    volatile LAS unsigned* bst = (volatile LAS unsigned*)(lds + LDS_BYTES - 16);
    if (threadIdx.x < 4) bst[threadIdx.x] = 0u;
    __syncthreads();
    const XcdBarrier gbar = xcd_barrier_post((unsigned*)(p.ws + WS_CTL) + CW_BAR, bst);
#define GSYNC() xcd_barrier(gbar)
#ifndef MK_REP_PHASE
#define MK_REP_PHASE -1
#endif
#ifndef MK_REP_N
#define MK_REP_N 0
#endif
#define MK_STEP(PH) do { MK_RUN(PH); if (MK_REP_PHASE == (PH)) { for (int r_ = 0; r_ < MK_REP_N; ++r_) { GSYNC(); MK_RUN(PH); } } if (MK_REP_PHASE == 100 + (PH)) { for (int r_ = 0; r_ < MK_REP_N; ++r_) GSYNC(); } } while (0)
    MK_STEP(0); GSYNC(); MK_STEP(1); GSYNC(); MK_STEP(2); GSYNC(); MK_STEP(3); GSYNC(); MK_STEP(5); GSYNC();
    MK_STEP(6); GSYNC(); MK_STEP(8); GSYNC(); MK_STEP(9); GSYNC(); MK_STEP(10);
}
#endif

extern "C" void kernel_launch(void* const* d_in, const int* in_sizes, int n_in, void* d_out, int out_size, void* d_ws, size_t ws_size, hipStream_t stream) {
    static int grid = 0;
    if (grid == 0) {
        int dev = 0, cus = 0, per_cu = 0;
        (void)hipGetDevice(&dev);
        (void)hipDeviceGetAttribute(&cus, hipDeviceAttributeMultiprocessorCount, dev);
#if MK_ONE_LAUNCH
        (void)hipFuncSetAttribute((const void*)mk_fwd, hipFuncAttributeMaxDynamicSharedMemorySize, LDS_BYTES);
        (void)hipOccupancyMaxActiveBlocksPerMultiprocessor(&per_cu, (const void*)mk_fwd, NTHREADS, LDS_BYTES);
#else
#define MK_ATTR(PH) (void)hipFuncSetAttribute((const void*)mk_one<PH>, hipFuncAttributeMaxDynamicSharedMemorySize, LDS_BYTES)
        MK_ATTR(0); MK_ATTR(1); MK_ATTR(2); MK_ATTR(3); MK_ATTR(4); MK_ATTR(5); MK_ATTR(6); MK_ATTR(7); MK_ATTR(8); MK_ATTR(9); MK_ATTR(10);
        per_cu = 1;
#endif
        if (per_cu < 1) { fprintf(stderr, "kernel_launch: occupancy query reports %d blocks/CU\n", per_cu); per_cu = 1; }
        grid = cus;
        if (ws_size < WS_END) { fprintf(stderr, "kernel_launch: workspace too small (%zu < %zu)\n", ws_size, (size_t)WS_END); grid = -1; }
        (void)hipGetLastError();
    }
    if (grid < 0) return;
    (void)hipMemsetAsync((char*)d_ws + WS_CTL, 0, CTL_BYTES, stream);
    Params p{};
    for (int i = 0; i < 23; ++i) p.in[i] = (const float*)d_in[i];
    p.out = (float*)d_out; p.ws = (unsigned char*)d_ws;
#if MK_ONE_LAUNCH
    hipLaunchKernelGGL(mk_fwd, dim3(grid), dim3(NTHREADS), LDS_BYTES, stream, p);
#else
#ifndef MK_DUP_PHASE
#define MK_DUP_PHASE -1
#endif
#define MK_LAUNCH1(PH) do { if ((PH) == 3 || (PH) == 2) (void)hipMemsetAsync((char*)d_ws + WS_CTL + 4 * CW_Q3, 0, 12, stream); if ((PH) == 6) (void)hipMemsetAsync((char*)d_ws + WS_CTL + 4 * CW_CNT, 0, 128, stream); hipLaunchKernelGGL(mk_one<PH>, dim3(grid), dim3(NTHREADS), LDS_BYTES, stream, p); } while (0)
#define MK_LAUNCH(PH) do { MK_LAUNCH1(PH); if (MK_DUP_PHASE == (PH)) MK_LAUNCH1(PH); } while (0)
    MK_LAUNCH(0); MK_LAUNCH(1); MK_LAUNCH(2); MK_LAUNCH(3); MK_LAUNCH(5); MK_LAUNCH(6); MK_LAUNCH(8); MK_LAUNCH(9); MK_LAUNCH(10);
#endif
}
```
